# Optimizing an MI355X kernel written in HIP

```python
import math
import jax, jax.numpy as jnp
from jax import lax
import numpy as np

D_MODEL = 1024
BATCH = 8
SEQ = 2048
DEPTH = 1
DEC_BATCH = 16
DEC_SEQ = 32
PAST_LEN = 2048

CHUNK = 64
SSM_WIDTH = D_MODEL // 2
SSM_P = 16
SSM_G = SSM_WIDTH // SSM_P
SSM_N = 64
HEAD_DIM = 64
N_Q_HEADS = (D_MODEL - SSM_WIDTH) // HEAD_DIM
N_KV_HEADS = 2
KV_REP = N_Q_HEADS // N_KV_HEADS
ATTN_WIDTH = N_Q_HEADS * HEAD_DIM
KV_WIDTH = N_KV_HEADS * HEAD_DIM
WINDOW = 128
WIN_CHUNKS = WINDOW // CHUNK
MIX_WIDTH = SSM_WIDTH + ATTN_WIDTH
IN_WIDTH = SSM_WIDTH + ATTN_WIDTH + 2 * KV_WIDTH
D_FF = 2816
CONV_W = 3
RMS_EPS = 1e-6
ATTN_SCALE = HEAD_DIM ** -0.5

kernel_name = "hymba_s5_swa_sink_convffn_stream_step"


def _rmsnorm(x, g):
    xf = x.astype(jnp.float32)
    xf = xf * lax.rsqrt(jnp.mean(xf * xf, axis=-1, keepdims=True) + RMS_EPS)
    return (xf * g.astype(jnp.float32)).astype(x.dtype)


def _ssm_combine(e1, e2):
    ar1, ai1, br1, bi1 = e1
    ar2, ai2, br2, bi2 = e2
    ar = ar2 * ar1 - ai2 * ai1
    ai = ar2 * ai1 + ai2 * ar1
    br = ar2 * br1 - ai2 * bi1 + br2
    bi = ar2 * bi1 + ai2 * br1 + bi2
    return (ar, ai, br, bi)


def _s5(u, h0_re, h0_im, a_re, a_im, log_dt, b_re, b_im, c_re, c_im, d):
    f32 = jnp.float32
    bsz, L, _ = u.shape
    ug = u.astype(f32).reshape(bsz, L, SSM_G, SSM_P)
    a_re, a_im = a_re.astype(f32), a_im.astype(f32)
    dt = jnp.exp(log_dt.astype(f32))[:, None]
    mag = jnp.exp(a_re * dt)
    abar_re, abar_im = mag * jnp.cos(a_im * dt), mag * jnp.sin(a_im * dt)
    nr, ni = abar_re - 1.0, abar_im
    den = a_re * a_re + a_im * a_im
    coef_re = (nr * a_re + ni * a_im) / den
    coef_im = (ni * a_re - nr * a_im) / den
    bu_re = jnp.einsum('blgp,gnp->blgn', ug, b_re.astype(f32))
    bu_im = jnp.einsum('blgp,gnp->blgn', ug, b_im.astype(f32))
    x_re = coef_re * bu_re - coef_im * bu_im
    x_im = coef_re * bu_im + coef_im * bu_re
    h0_re, h0_im = h0_re.astype(f32), h0_im.astype(f32)
    x_re = x_re.at[:, 0].add(abar_re * h0_re - abar_im * h0_im)
    x_im = x_im.at[:, 0].add(abar_re * h0_im + abar_im * h0_re)
    ar = jnp.broadcast_to(abar_re[None, None], (1, L, SSM_G, SSM_N))
    ai = jnp.broadcast_to(abar_im[None, None], (1, L, SSM_G, SSM_N))
    _, _, h_re, h_im = lax.associative_scan(_ssm_combine, (ar, ai, x_re, x_im), axis=1)
    y = (jnp.einsum('blgn,gpn->blgp', h_re, c_re.astype(f32))
         - jnp.einsum('blgn,gpn->blgp', h_im, c_im.astype(f32))
         + d.astype(f32) * ug)
    return y.reshape(bsz, L, SSM_WIDTH), h_re[:, -1], h_im[:, -1]


def _attend(qb, kb, vb, key_valid, sinks):
    s = jnp.einsum('bnqgrd,bnkgd->bngrqk', qb, kb).astype(jnp.float32) * ATTN_SCALE
    s = jnp.where(key_valid[None, :, None, None, None, :], s, -jnp.inf)
    sink = sinks.astype(jnp.float32).reshape(N_KV_HEADS, KV_REP)[None, None, :, :, None, None]
    m = jnp.maximum(jnp.max(s, axis=-1, keepdims=True), sink)
    p = jnp.exp(s - m)
    p = p / (jnp.sum(p, axis=-1, keepdims=True) + jnp.exp(sink - m))
    return jnp.einsum('bngrqk,bnkgd->bnqgrd', p.astype(vb.dtype), vb)


def _band(t, n_chunks):
    bsz = t.shape[0]
    tp = jnp.pad(t, ((0, 0), (WINDOW, 0), (0, 0), (0, 0)))
    tb = tp.reshape(bsz, n_chunks + WIN_CHUNKS, CHUNK, N_KV_HEADS, HEAD_DIM)
    return jnp.concatenate([tb[:, j:j + n_chunks] for j in range(WIN_CHUNKS + 1)], axis=2)


def _swa_prompt(q, k, v, sinks):
    bsz, L = q.shape[:2]
    n_chunks = L // CHUNK
    qb = q.reshape(bsz, n_chunks, CHUNK, N_KV_HEADS, KV_REP, HEAD_DIM)
    kb, vb = _band(k, n_chunks), _band(v, n_chunks)
    key_chunk = (jnp.arange(n_chunks)[:, None] - WIN_CHUNKS
                 + (jnp.arange((WIN_CHUNKS + 1) * CHUNK) // CHUNK)[None, :])
    o = _attend(qb, kb, vb, key_chunk >= 0, sinks)
    return o.reshape(bsz, L, ATTN_WIDTH)


def _swa_sample(q, k, v, cache_k, cache_v, sinks):
    bsz, L = q.shape[:2]
    kk = jnp.concatenate([cache_k.astype(k.dtype), k], axis=1)[:, None]
    vv = jnp.concatenate([cache_v.astype(v.dtype), v], axis=1)[:, None]
    qb = q[:, None]
    o = _attend(qb, kk, vv, jnp.ones((1, kk.shape[2]), bool), sinks)
    return o.reshape(bsz, L, ATTN_WIDTH)


def _conv_ffn(xn, conv_prev, w_act, w_up, conv_w, conv_b, w_down):
    L = xn.shape[1]
    a = xn @ w_act
    ap = jnp.concatenate([conv_prev.astype(a.dtype), a], axis=1)
    c = conv_b
    for j in range(CONV_W):
        c = c + conv_w[j] * ap[:, j:j + L]
    h = jax.nn.silu(c) * (xn @ w_up)
    return h @ w_down, ap[:, -(CONV_W - 1):]


def _layer(x, h0_re, h0_im, conv_prev, kv_cache, p):
    bsz, L, _ = x.shape
    xn = _rmsnorm(x, p['g_norm1'])
    z = xn @ p['w_in']
    u, q, k, v = jnp.split(z, [SSM_WIDTH, SSM_WIDTH + ATTN_WIDTH,
                               SSM_WIDTH + ATTN_WIDTH + KV_WIDTH], axis=-1)
    y_ssm, h_re, h_im = _s5(u, h0_re, h0_im, p['ssm_a_re'], p['ssm_a_im'], p['ssm_log_dt'],
                            p['ssm_b_re'], p['ssm_b_im'], p['ssm_c_re'], p['ssm_c_im'], p['ssm_d'])
    y_ssm = jax.nn.gelu(y_ssm.astype(x.dtype))
    y_ssm = y_ssm * jax.nn.sigmoid(y_ssm @ p['w_glu'] + p['b_glu'])
    q = q.reshape(bsz, L, N_KV_HEADS, KV_REP, HEAD_DIM)
    k = k.reshape(bsz, L, N_KV_HEADS, HEAD_DIM)
    v = v.reshape(bsz, L, N_KV_HEADS, HEAD_DIM)
    if kv_cache is None:
        y_attn = _swa_prompt(q, k, v, p['attn_sinks'])
        k_rows, v_rows = k[:, -WINDOW:], v[:, -WINDOW:]
    else:
        y_attn = _swa_sample(q, k, v, kv_cache[0], kv_cache[1], p['attn_sinks'])
        k_rows, v_rows = k, v
    mix = jnp.concatenate([_rmsnorm(y_ssm, p['g_ssm_out']),
                           _rmsnorm(y_attn, p['g_attn_out'])], axis=-1) @ p['w_o']
    x = x + mix
    f, conv_state = _conv_ffn(_rmsnorm(x, p['g_norm2']), conv_prev, p['w_ffn_act'], p['w_ffn_up'],
                              p['ffn_conv_w'], p['ffn_conv_b'], p['w_ffn_down'])
    x = x + f
    return x, (h_re, h_im, k_rows, v_rows, conv_state)


def setup_inputs(seed: int = 0) -> dict:
    key = jax.random.key(seed)
    ks = iter(jax.random.split(key, 40))
    f32 = jnp.float32

    def nrm(shape, scale):
        return scale * jax.random.normal(next(ks), shape, f32)

    w_cache = min(WINDOW, PAST_LEN)
    n_idx = jnp.arange(SSM_N, dtype=f32)
    return {
        'x_prompt': nrm((BATCH, SEQ, D_MODEL), 1.0),
        'x_sample': nrm((DEC_BATCH, DEC_SEQ, D_MODEL), 1.0),
        'state_ssm_re': nrm((DEPTH, DEC_BATCH, SSM_G, SSM_N), 0.5),
        'state_ssm_im': nrm((DEPTH, DEC_BATCH, SSM_G, SSM_N), 0.5),
        'cache_attn_k': nrm((DEPTH, DEC_BATCH, w_cache, N_KV_HEADS, HEAD_DIM), 1.0),
        'cache_attn_v': nrm((DEPTH, DEC_BATCH, w_cache, N_KV_HEADS, HEAD_DIM), 1.0),
        'state_ffn_conv': nrm((DEPTH, DEC_BATCH, CONV_W - 1, D_FF), 1.0),
        'g_norm1': 1.0 + nrm((DEPTH, D_MODEL), 0.01),
        'w_in': nrm((DEPTH, D_MODEL, IN_WIDTH), D_MODEL ** -0.5),
        'ssm_a_re': -0.5 + nrm((DEPTH, SSM_G, SSM_N), 0.01),
        'ssm_a_im': math.pi * n_idx + nrm((DEPTH, SSM_G, SSM_N), 0.01),
        'ssm_log_dt': jax.random.uniform(next(ks), (DEPTH, SSM_G), f32,
                                         math.log(1e-3), math.log(1e-1)),
        'ssm_b_re': nrm((DEPTH, SSM_G, SSM_N, SSM_P), (2 * SSM_P) ** -0.5),
        'ssm_b_im': nrm((DEPTH, SSM_G, SSM_N, SSM_P), (2 * SSM_P) ** -0.5),
        'ssm_c_re': nrm((DEPTH, SSM_G, SSM_P, SSM_N), (2 * SSM_N) ** -0.5),
        'ssm_c_im': nrm((DEPTH, SSM_G, SSM_P, SSM_N), (2 * SSM_N) ** -0.5),
        'ssm_d': nrm((DEPTH, SSM_G, SSM_P), 1.0),
        'w_glu': nrm((DEPTH, SSM_WIDTH, SSM_WIDTH), SSM_WIDTH ** -0.5),
        'b_glu': nrm((DEPTH, SSM_WIDTH), 0.01),
        'attn_sinks': nrm((DEPTH, N_Q_HEADS), 0.5),
        'g_ssm_out': 1.0 + nrm((DEPTH, SSM_WIDTH), 0.01),
        'g_attn_out': 1.0 + nrm((DEPTH, ATTN_WIDTH), 0.01),
        'w_o': nrm((DEPTH, MIX_WIDTH, D_MODEL), MIX_WIDTH ** -0.5),
        'g_norm2': 1.0 + nrm((DEPTH, D_MODEL), 0.01),
        'w_ffn_act': nrm((DEPTH, D_MODEL, D_FF), D_MODEL ** -0.5),
        'w_ffn_up': nrm((DEPTH, D_MODEL, D_FF), D_MODEL ** -0.5),
        'ffn_conv_w': nrm((DEPTH, CONV_W, D_FF), CONV_W ** -0.5),
        'ffn_conv_b': nrm((DEPTH, D_FF), 0.01),
        'w_ffn_down': nrm((DEPTH, D_FF, D_MODEL), D_FF ** -0.5),
        'g_final': 1.0 + nrm((D_MODEL,), 0.01),
    }


def reference(x_prompt, x_sample, state_ssm_re, state_ssm_im, cache_attn_k, cache_attn_v,
              state_ffn_conv, g_norm1, w_in, ssm_a_re, ssm_a_im, ssm_log_dt, ssm_b_re, ssm_b_im,
              ssm_c_re, ssm_c_im, ssm_d, w_glu, b_glu, attn_sinks, g_ssm_out, g_attn_out, w_o,
              g_norm2, w_ffn_act, w_ffn_up, ffn_conv_w, ffn_conv_b, w_ffn_down, g_final):
    bp = x_prompt.shape[0]
    h_zero = jnp.zeros((bp, SSM_G, SSM_N), jnp.float32)
    conv_zero = jnp.zeros((bp, CONV_W - 1, D_FF), x_prompt.dtype)
    yp, ys = x_prompt, x_sample
    p_states, s_states = [], []
    for l in range(DEPTH):
        lp = {
            'g_norm1': g_norm1[l], 'w_in': w_in[l], 'ssm_a_re': ssm_a_re[l], 'ssm_a_im': ssm_a_im[l],
            'ssm_log_dt': ssm_log_dt[l], 'ssm_b_re': ssm_b_re[l], 'ssm_b_im': ssm_b_im[l],
            'ssm_c_re': ssm_c_re[l], 'ssm_c_im': ssm_c_im[l], 'ssm_d': ssm_d[l],
            'w_glu': w_glu[l], 'b_glu': b_glu[l], 'attn_sinks': attn_sinks[l],
            'g_ssm_out': g_ssm_out[l], 'g_attn_out': g_attn_out[l], 'w_o': w_o[l],
            'g_norm2': g_norm2[l], 'w_ffn_act': w_ffn_act[l], 'w_ffn_up': w_ffn_up[l],
            'ffn_conv_w': ffn_conv_w[l], 'ffn_conv_b': ffn_conv_b[l], 'w_ffn_down': w_ffn_down[l],
        }
        yp, sp = _layer(yp, h_zero, h_zero, conv_zero, None, lp)
        ys, ss = _layer(ys, state_ssm_re[l], state_ssm_im[l], state_ffn_conv[l],
                        (cache_attn_k[l], cache_attn_v[l]), lp)
        p_states.append(sp)
        s_states.append(ss)
    y_prompt = _rmsnorm(yp, g_final)
    y_sample = _rmsnorm(ys, g_final)
    p_re = jnp.stack([s[0] for s in p_states])
    p_im = jnp.stack([s[1] for s in p_states])
    p_k = jnp.stack([s[2] for s in p_states])
    p_v = jnp.stack([s[3] for s in p_states])
    p_conv = jnp.stack([s[4] for s in p_states])
    s_re = jnp.stack([s[0] for s in s_states])
    s_im = jnp.stack([s[1] for s in s_states])
    s_k = jnp.stack([s[2] for s in s_states])
    s_v = jnp.stack([s[3] for s in s_states])
    s_conv = jnp.stack([s[4] for s in s_states])
    return (y_prompt, y_sample, p_re, p_im, p_k, p_v, p_conv, s_re, s_im, s_k, s_v, s_conv)
```

```cpp
#include <hip/hip_runtime.h>
#include <hip/hip_cooperative_groups.h>
#include <cstdio>
#include <cstdint>
namespace cg = cooperative_groups;

namespace pg8 {
#define PG8_LAS __attribute__((address_space(3)))
typedef unsigned short bf16_t;
typedef short bf16x8 __attribute__((ext_vector_type(8)));
typedef float f32x4 __attribute__((ext_vector_type(4)));
typedef unsigned u32x4 __attribute__((ext_vector_type(4)));
constexpr int BM = 256, BK = 64, HALF = 128, HTB = HALF * BK * 2  , STAGE_BYTES = 8 * HTB, NXCD = 8, WGM = 8;

__host__ __device__ __forceinline__ int lds_byte(int r, int c) { const int st = (r >> 4) * 2 + (c >> 5), rr = r & 15, cc = c & 31, ob = rr * 64 + cc * 2; return st * 1024 + (ob ^ (((ob >> 9) & 1) << 5)); }
__host__ __device__ __forceinline__ void stage_rc(int b, int& R, int& C) { const int st = b / 1024, sb = b % 1024, swz = sb ^ (((sb >> 9) & 1) << 5); R = (st >> 1) * 16 + swz / 64; C = (st & 1) * 32 + (swz % 64) / 2; }
__host__ __device__ __forceinline__ int perm32(int rho) { const int n = rho >> 4, i = rho & 15; return 8 * (i >> 2) + 4 * n + (i & 3); }

struct Unit { int pm, pn; };
struct Gemm { const bf16_t* A; const bf16_t* Bt; int M, N, K; };

struct StaticOrder {
    int nM, nN, nwg, G, c;
    __host__ __device__ void init(int M, int N, int G_, int c_) { nM = M / BM; nN = N / BM; nwg = nM * nN; G = G_; c = c_; }
    __host__ __device__ bool next(int i, Unit& u) const {
        const long L = (long)i * G + c; if (L >= nwg) return false;
        int wgid = (int)L; { const int q = nwg / NXCD, r = nwg % NXCD, xcd = wgid % NXCD, off = wgid / NXCD; wgid = (xcd < r ? xcd * (q + 1) : r * (q + 1) + (xcd - r) * q) + off; }
        const int nig = WGM * nN, gid = wgid / nig, fm = gid * WGM, gsz = (nM - fm) < WGM ? (nM - fm) : WGM;
        u.pm = fm + ((wgid % nig) % gsz); u.pn = (wgid % nig) / gsz; return true;
    }
    __device__ __forceinline__ void a_ready(const Unit&) const {}
    __device__ __forceinline__ void done(const Unit&) const {}
};

__device__ __forceinline__ unsigned cvt_pk_bf16(float lo, float hi) { unsigned r; asm volatile("v_cvt_pk_bf16_f32 %0, %1, %2" : "=v"(r) : "v"(lo), "v"(hi)); return r; }
template <class Epi, class Sched, bool ALIGN_EPI = false, bool SP2 = false>
__device__ __forceinline__ void gemm_phase(PG8_LAS unsigned char* lds, const Gemm g, const Sched& S, const Epi& E) {
    const int tid = threadIdx.x, wid = __builtin_amdgcn_readfirstlane(tid >> 6), lane = tid & 63, wr = wid >> 2, wc = wid & 3, fr = lane & 15, fq = lane >> 4;
    const int K = g.K, nt = K / BK;
    unsigned voffA[2], voffB[2];
#pragma unroll
    for (int i = 0; i < 2; ++i) { int R, C; stage_rc(tid * 16 + i * 8192, R, C); const int Rb = Epi::PERM ? ((R & ~31) + perm32(R & 31)) : R;
        voffA[i] = (unsigned)(R * K + C) * 2u; voffB[i] = (unsigned)(Rb * K + C) * 2u; }
    const size_t kstep = (size_t)(BK * 2);
    const size_t hstep = (size_t)HALF * K * 2;
    const size_t tstep = 2 * hstep;
    const unsigned ldsw = (unsigned)wid * 1024u;
    const int aoff = lds_byte(wr * 64 + fr, fq * 8), boff = lds_byte(wc * 32 + fr, fq * 8);
#define PG8_SA(b, h) (((b) * 2 + (h)) * HTB)
#define PG8_SB(b, h) ((4 + (b) * 2 + (h)) * HTB)
#define PG8_STAGE(bufoff, gbase, voff) do { _Pragma("unroll") for (int _i = 0; _i < 2; ++_i) \
        __builtin_amdgcn_global_load_lds((const unsigned*)((const char*)(gbase) + (voff)[_i]), (PG8_LAS unsigned*)(lds + (bufoff) + ldsw + _i * 8192), 16, 0, 0); } while (0)
#define PG8_LDA(dst, b, h) do { _Pragma("unroll") for (int m = 0; m < 4; ++m) _Pragma("unroll") for (int k = 0; k < 2; ++k) dst[m][k] = *(const PG8_LAS bf16x8*)(lds + PG8_SA(b, h) + aoff + m * 2048 + k * 1024); } while (0)
#define PG8_LDB(dst, b, h) do { _Pragma("unroll") for (int n = 0; n < 2; ++n) _Pragma("unroll") for (int k = 0; k < 2; ++k) dst[n][k] = *(const PG8_LAS bf16x8*)(lds + PG8_SB(b, h) + boff + n * 2048 + k * 1024); } while (0)
#define PG8_MMA(ai, bj, At, Bt) do { __builtin_amdgcn_s_setprio(1); _Pragma("unroll") for (int m = 0; m < 4; ++m) _Pragma("unroll") for (int n = 0; n < 2; ++n) _Pragma("unroll") for (int k = 0; k < 2; ++k) \
        acc[ai][bj][m][n] = __builtin_amdgcn_mfma_f32_16x16x32_bf16(Bt[n][k], At[m][k], acc[ai][bj][m][n], 0, 0, 0); __builtin_amdgcn_s_setprio(0); } while (0)
#define PG8_WAIT_V(n) asm volatile("s_waitcnt vmcnt(" #n ")" ::: "memory")
#define PG8_WAIT_L(n) asm volatile("s_waitcnt lgkmcnt(" #n ")" ::: "memory")
#define PG8_BAR __builtin_amdgcn_s_barrier()
#define PG8_SCHED __builtin_amdgcn_sched_barrier(0)
    Unit cur, nxt; int ui = 0;
    if (!S.next(0, cur)) return;
    f32x4 acc[2][2][4][2];
#pragma unroll
    for (int a = 0; a < 2; ++a)
#pragma unroll
        for (int b = 0; b < 2; ++b)
#pragma unroll
            for (int m = 0; m < 4; ++m)
#pragma unroll
                for (int n = 0; n < 2; ++n) acc[a][b][m][n] = (f32x4){0.f, 0.f, 0.f, 0.f};
    bf16x8 At[4][2], B0[2][2], B1[2][2];
    const char* cA = (const char*)g.A + (size_t)cur.pm * tstep; const char* cB = (const char*)g.Bt + (size_t)cur.pn * tstep;
    S.a_ready(cur);
    if constexpr (SP2) {
        PG8_STAGE(PG8_SB(0, 0), cB, voffB); PG8_STAGE(PG8_SB(0, 1), cB + hstep, voffB); PG8_STAGE(PG8_SA(0, 0), cA, voffA); PG8_STAGE(PG8_SA(0, 1), cA + hstep, voffA);
        if (wr == 1) PG8_BAR;
        PG8_WAIT_V(2); PG8_BAR;
        PG8_STAGE(PG8_SB(1, 0), cB + kstep, voffB); PG8_STAGE(PG8_SA(1, 0), cA + kstep, voffA); PG8_STAGE(PG8_SB(1, 1), cB + hstep + kstep, voffB);
        PG8_WAIT_V(6); PG8_BAR;
    } else {
        PG8_STAGE(PG8_SB(0, 0), cB, voffB); PG8_STAGE(PG8_SA(0, 0), cA, voffA); PG8_STAGE(PG8_SB(0, 1), cB + hstep, voffB); PG8_STAGE(PG8_SA(0, 1), cA + hstep, voffA);
        if (wr == 1) PG8_BAR;
        PG8_WAIT_V(4); PG8_BAR;
        PG8_STAGE(PG8_SB(1, 0), cB + kstep, voffB); PG8_STAGE(PG8_SA(1, 0), cA + kstep, voffA); PG8_STAGE(PG8_SB(1, 1), cB + hstep + kstep, voffB);
        PG8_WAIT_V(6); PG8_BAR;
    }
    for (;;) {
        const bool has_next = S.next(ui + 1, nxt);
        const char* nA = has_next ? (const char*)g.A + (size_t)nxt.pm * tstep : cA; const char* nB = has_next ? (const char*)g.Bt + (size_t)nxt.pn * tstep : cB;
        for (int t = 0; t < nt; t += 2) {
            const bool last = (t == nt - 2);
            const char* a1 = cA + (size_t)(t + 1) * kstep;
            const char* a2 = last ? nA : cA + (size_t)(t + 2) * kstep; const char* b2 = last ? nB : cB + (size_t)(t + 2) * kstep;
            const char* a3 = a2 + kstep; const char* b3 = b2 + kstep;
            if (last && has_next) S.a_ready(nxt);
            if constexpr (SP2) {
            PG8_LDB(B0, 0, 0); PG8_LDB(B1, 0, 1); PG8_SCHED; PG8_LDA(At, 0, 0); PG8_STAGE(PG8_SA(1, 1), a1 + hstep, voffA);
            PG8_WAIT_V(8); PG8_WAIT_L(0); PG8_BAR; PG8_MMA(0, 0, At, B0); PG8_MMA(0, 1, At, B1); PG8_BAR; PG8_SCHED;
            PG8_LDA(At, 0, 1); PG8_STAGE(PG8_SB(0, 0), b2, voffB); PG8_STAGE(PG8_SB(0, 1), b2 + hstep, voffB); PG8_STAGE(PG8_SA(0, 0), a2, voffA);
            PG8_WAIT_V(8); PG8_WAIT_L(0); PG8_BAR; PG8_MMA(1, 0, At, B0); PG8_MMA(1, 1, At, B1); PG8_BAR; PG8_SCHED;
            PG8_LDB(B0, 1, 0); PG8_LDB(B1, 1, 1); PG8_SCHED; PG8_LDA(At, 1, 0); PG8_STAGE(PG8_SA(0, 1), a2 + hstep, voffA);
            PG8_WAIT_V(8); PG8_WAIT_L(0); PG8_BAR; PG8_MMA(0, 0, At, B0); PG8_MMA(0, 1, At, B1); PG8_BAR; PG8_SCHED;
            PG8_LDA(At, 1, 1); PG8_STAGE(PG8_SB(1, 0), b3, voffB); PG8_STAGE(PG8_SB(1, 1), b3 + hstep, voffB); PG8_STAGE(PG8_SA(1, 0), a3, voffA);
            PG8_WAIT_V(8); PG8_WAIT_L(0); PG8_BAR; PG8_MMA(1, 0, At, B0); PG8_MMA(1, 1, At, B1); PG8_BAR; PG8_SCHED;
            } else {
            PG8_LDB(B0, 0, 0); PG8_SCHED; PG8_LDA(At, 0, 0); PG8_STAGE(PG8_SA(1, 1), a1 + hstep, voffA);
            PG8_WAIT_L(8); PG8_BAR; PG8_WAIT_L(0); PG8_MMA(0, 0, At, B0); PG8_BAR; PG8_SCHED;
            PG8_LDB(B1, 0, 1); PG8_STAGE(PG8_SB(0, 0), b2, voffB);
            PG8_BAR; PG8_WAIT_L(0); PG8_MMA(0, 1, At, B1); PG8_BAR;
            PG8_LDA(At, 0, 1); PG8_STAGE(PG8_SA(0, 0), a2, voffA);
            PG8_BAR; PG8_WAIT_L(0); PG8_MMA(1, 0, At, B0); PG8_BAR; PG8_SCHED;
            PG8_STAGE(PG8_SB(0, 1), b2 + hstep, voffB);
            PG8_WAIT_V(6); PG8_BAR; PG8_MMA(1, 1, At, B1); PG8_BAR;
            PG8_LDB(B0, 1, 0); PG8_SCHED; PG8_LDA(At, 1, 0); PG8_STAGE(PG8_SA(0, 1), a2 + hstep, voffA);
            PG8_WAIT_L(8); PG8_BAR; PG8_WAIT_L(0); PG8_MMA(0, 0, At, B0); PG8_BAR; PG8_SCHED;
            PG8_LDB(B1, 1, 1); PG8_STAGE(PG8_SB(1, 0), b3, voffB);
            PG8_BAR; PG8_WAIT_L(0); PG8_MMA(0, 1, At, B1); PG8_BAR;
            PG8_LDA(At, 1, 1); PG8_STAGE(PG8_SA(1, 0), a3, voffA);
            PG8_BAR; PG8_WAIT_L(0); PG8_MMA(1, 0, At, B0); PG8_BAR; PG8_SCHED;
            PG8_STAGE(PG8_SB(1, 1), b3 + hstep, voffB);
            PG8_WAIT_V(6); PG8_BAR; PG8_MMA(1, 1, At, B1); PG8_BAR;
            }
        }
        if constexpr (ALIGN_EPI) { if (wr == 0) PG8_BAR; }
        if constexpr (!Epi::AFTER_DRAIN) { E(acc, cur, wr, wc, fr, fq); S.done(cur); }
        if (!has_next) break;
#pragma unroll
        for (int a = 0; a < 2; ++a)
#pragma unroll
            for (int b = 0; b < 2; ++b)
#pragma unroll
                for (int m = 0; m < 4; ++m)
#pragma unroll
                    for (int n = 0; n < 2; ++n) acc[a][b][m][n] = (f32x4){0.f, 0.f, 0.f, 0.f};
        cur = nxt; cA = nA; cB = nB; ++ui;
        if constexpr (ALIGN_EPI) { if (wr == 1) PG8_BAR; }
    }
    PG8_WAIT_V(0);
    if constexpr (!ALIGN_EPI) { if (wr == 0) PG8_BAR; }
    PG8_BAR;
    if constexpr (Epi::AFTER_DRAIN) { E.fused(acc, cur, wr, wc, fr, fq, lds, wid, lane); S.done(cur); }
#undef PG8_SA
#undef PG8_SB
#undef PG8_STAGE
#undef PG8_LDA
#undef PG8_LDB
#undef PG8_MMA
#undef PG8_WAIT_V
#undef PG8_WAIT_L
#undef PG8_BAR
#undef PG8_SCHED
}
}

#ifndef HOST_REP
#define HOST_REP 0
#endif
#ifndef N_LAUNCHES
#define N_LAUNCHES 1
#endif
#define DI __device__ __forceinline__
#define LAS __attribute__((address_space(3)))
using pg8::bf16_t; using pg8::bf16x8; using pg8::f32x4; using pg8::u32x4;
typedef unsigned u32x2 __attribute__((ext_vector_type(2)));
typedef short s16x4 __attribute__((ext_vector_type(4)));
#define MFMA16(a, b, c) __builtin_amdgcn_mfma_f32_16x16x32_bf16((a), (b), (c), 0, 0, 0)

constexpr int D = 1024, MP = 16384, MS = 512, M = MP + MS, SEQ = 2048, INW = 1280, FF = 2816, NG = 32;
constexpr float EPS = 1e-6f;
constexpr size_t O_PRE = 17301504, O_PIM = 17317888, O_PK = 17334272, O_PV = 17465344, O_PCONV = 17596416,
                 O_SRE = 17641472, O_SIM = 17674240, O_SK = 17707008, O_SV = 17772544, O_SCONV = 17838080;
constexpr size_t WS_WIN = 0, WS_WGLU = WS_WIN + (size_t)INW * D * 2, WS_WO = WS_WGLU + 512 * 512 * 2, WS_W1 = WS_WO + (size_t)D * D * 2,
                 WS_W2 = WS_W1 + (size_t)2 * FF * D * 2, WS_KT = WS_W2 + (size_t)D * FF * 2, WS_WT = WS_KT + (size_t)NG * 32 * 256 * 2,
                 WS_PRE = WS_WT + (size_t)NG * 128 * 512 * 2, WS_PIM = WS_PRE + (size_t)NG * 4096 * 4, WS_A32 = WS_PIM + (size_t)NG * 32 * 64 * 4,
                 WS_CT = WS_A32 + (size_t)NG * 64 * 2 * 4, WS_SSQ = WS_CT + (size_t)NG * 16 * 128 * 2, WS_MIX = WS_SSQ + (size_t)M * 16 * 4,
                 WS_X1B = WS_MIX + (size_t)M * D * 2, WS_H = WS_X1B + (size_t)M * D * 2, WS_X1F = WS_H + (size_t)M * FF * 2, WS_PART = WS_X1F + (size_t)M * D * 4, WS_PARTS = WS_PART + (size_t)64 * 4 * 256 * 4, WS_CTL = WS_PARTS + (size_t)256 * 32 * 4, WS_END = WS_CTL + 16384;
constexpr size_t WS_XN = WS_H, WS_U = WS_XN + (size_t)M * D * 2, WS_Q = WS_U + (size_t)M * 512 * 2, WS_KB = WS_Q + (size_t)M * 512 * 2,
                 WS_VT = WS_KB + (size_t)M * 128 * 2, WS_KS = WS_VT + (size_t)MP * 128 * 2, WS_VTS = WS_KS + (size_t)16 * 160 * 128 * 2,
                 WS_HIN = WS_VTS + (size_t)16 * 160 * 128 * 2, WS_UF = WS_HIN + (size_t)512 * NG * 128 * 4, WS_ALIAS_END = WS_UF + (size_t)M * 512 * 2;
static_assert(WS_ALIAS_END <= WS_END && WS_END <= 268435456, "d_ws map");
constexpr int LDS_BYTES = 163840, LDS_X = 131072;

DI unsigned f2bf(float f) { unsigned u = __builtin_bit_cast(unsigned, f); return (u + 0x7fffu + ((u >> 16) & 1u)) >> 16; }
typedef float f32x2_t __attribute__((ext_vector_type(2)));
typedef __bf16 bf16x2_t __attribute__((ext_vector_type(2)));
DI unsigned pk2(float lo, float hi) { f32x2_t v = {lo, hi}; bf16x2_t b = __builtin_convertvector(v, bf16x2_t); return __builtin_bit_cast(unsigned, b); }
DI float bflo(unsigned w) { return __builtin_bit_cast(float, w << 16); }
DI float bfhi(unsigned w) { return __builtin_bit_cast(float, w & 0xffff0000u); }
DI u32x4 pack8(const f32x4& a, const f32x4& b) { u32x4 w; w.x = pk2(a[0], a[1]); w.y = pk2(a[2], a[3]); w.z = pk2(b[0], b[1]); w.w = pk2(b[2], b[3]); return w; }
DI float dot2bf(unsigned a, unsigned b, float c) { return __builtin_amdgcn_fdot2_f32_bf16(__builtin_bit_cast(bf16x2_t, a), __builtin_bit_cast(bf16x2_t, b), c, false); }
DI float sigm(float x) { return __builtin_amdgcn_rcpf(1.0f + __expf(-x)); }
DI float gelu_tanh(float x) { const float z = 0.7978845608f * (x + 0.044715f * x * x * x); return x * sigm(2.0f * z); }
template <int CTRL> DI float dpp_shr(float v) { return __builtin_bit_cast(float, __builtin_amdgcn_update_dpp(0, __builtin_bit_cast(int, v), CTRL, 0xF, 0xF, false)); }
#define GAS __attribute__((address_space(1)))
DI void st_agent(float* p, float v) { __hip_atomic_store((GAS unsigned*)p, __builtin_bit_cast(unsigned, v), __ATOMIC_RELAXED, __HIP_MEMORY_SCOPE_AGENT); }
DI float ld_agent(const float* p) { return __builtin_bit_cast(float, __hip_atomic_load((GAS unsigned*)p, __ATOMIC_RELAXED, __HIP_MEMORY_SCOPE_AGENT)); }
DI void arrive_and_wait(unsigned* cnt, unsigned target) {
    (void)__hip_atomic_fetch_add((GAS unsigned*)cnt, 1u, __ATOMIC_RELAXED, __HIP_MEMORY_SCOPE_AGENT);
    while (__hip_atomic_load((GAS unsigned*)cnt, __ATOMIC_RELAXED, __HIP_MEMORY_SCOPE_AGENT) < target) __builtin_amdgcn_s_sleep(1);
}
DI float xsum4(float v) { v += __shfl_xor(v, 16); v += __shfl_xor(v, 32); return v; }

struct Args { const float* in[30]; float* out; unsigned char* ws; int ph_lo, ph_hi; };

struct Frame {
    LAS unsigned char* lds; int tid, lane, wave, G, bid;
    const float* const* in; float* out; unsigned char* ws;
};
#define WSP(T, off) ((T*)(F.ws + (off)))

DI void p0_transpose(const float* __restrict__ W, int N, const float* __restrict__ gk, bf16_t* __restrict__ WT, int ldt, int k0, int n0, int dst0, LAS float* scr, int tid) {
    const int c = tid & 63, r0 = tid >> 6;
#pragma unroll
    for (int i = 0; i < 8; ++i) { const int r = r0 + 8 * i; float v = W[(size_t)(k0 + r) * N + n0 + c]; if (gk) v *= gk[k0 + r]; scr[r * 65 + c] = v; }
    __syncthreads();
#pragma unroll
    for (int i = 0; i < 8; ++i) { const int n = r0 + 8 * i; WT[(size_t)(dst0 + n) * ldt + k0 + c] = (bf16_t)f2bf(scr[c * 65 + n]); }
    __syncthreads();
}

DI void p0_ssm_tables(const Frame& F, int task) {
    const int tid = F.tid, g = task >> 2, part = task & 3;
    LAS float* pwr = (LAS float*)F.lds; LAS float* pwi = pwr + 33 * 64; LAS float* bbr = pwi + 33 * 64; LAS float* bbi = bbr + 1024;
    const float* a_re = F.in[9] + g * 64; const float* a_im = F.in[10] + g * 64;
    const float dt = expf(F.in[11][g]);
    for (int i = tid; i < 33 * 64; i += 512) {
        const int d = i >> 6, n = i & 63; const float fd = (float)d;
        const float mag = expf(a_re[n] * dt * fd), ang = a_im[n] * dt * fd;
        pwr[i] = mag * cosf(ang); pwi[i] = mag * sinf(ang);
    }
    __syncthreads();
    for (int i = tid; i < 1024; i += 512) {
        const int n = i >> 4;
        const float are = a_re[n], aim = a_im[n], nr = pwr[64 + n] - 1.0f, ni = pwi[64 + n], den = are * are + aim * aim;
        const float cr = (nr * are + ni * aim) / den, ci = (ni * are - nr * aim) / den;
        const float br = F.in[12][(size_t)g * 1024 + i], bi = F.in[13][(size_t)g * 1024 + i];
        bbr[i] = cr * br - ci * bi; bbi[i] = cr * bi + ci * br;
    }
    __syncthreads();
    if (part == 0) {
        const int d = tid >> 4, p = tid & 15;
        float acc[16];
#pragma unroll
        for (int q = 0; q < 16; ++q) acc[q] = 0.f;
        const float* cre = F.in[14] + (size_t)(g * 16 + p) * 64; const float* cim = F.in[15] + (size_t)(g * 16 + p) * 64;
        for (int n = 0; n < 64; ++n) {
            const float cr = cre[n], ci = cim[n], pr = pwr[d * 64 + n], pi = pwi[d * 64 + n];
            const float xr = cr * pr - ci * pi, xi = cr * pi + ci * pr;
#pragma unroll
            for (int q = 0; q < 16; ++q) acc[q] += xr * bbr[n * 16 + q] - xi * bbi[n * 16 + q];
        }
        const float dv = (d == 0) ? F.in[16][g * 16 + p] : 0.f;
        u32x4 w0, w1;
#pragma unroll
        for (int q = 0; q < 16; ++q) acc[q] += (q == p) ? dv : 0.f;
        w0.x = pk2(acc[0], acc[1]); w0.y = pk2(acc[2], acc[3]); w0.z = pk2(acc[4], acc[5]); w0.w = pk2(acc[6], acc[7]);
        w1.x = pk2(acc[8], acc[9]); w1.y = pk2(acc[10], acc[11]); w1.z = pk2(acc[12], acc[13]); w1.w = pk2(acc[14], acc[15]);
        bf16_t* dst = WSP(bf16_t, WS_KT) + ((size_t)(g * 16 + (d >> 1)) * 64 + (d & 1) * 32 + p) * 8;
        *(u32x4*)dst = w0; *(u32x4*)(dst + 128) = w1;
    }
    if (part == 1 || part == 2) {
        bf16_t* wt = WSP(bf16_t, WS_WT) + (size_t)g * 65536;
        for (int idx = (part - 1) * 32768 + tid; idx < part * 32768; idx += 512) {
            const int j = idx & 7, lane = (idx >> 3) & 63, kk = (idx >> 9) & 15, nb = idx >> 13;
            const int n2 = nb * 16 + (lane & 15), n = n2 & 63, sidx = 2 * kk + (lane >> 5), pp = ((lane >> 4) & 1) * 8 + j;
            const float pr = pwr[(31 - sidx) * 64 + n], pi = pwi[(31 - sidx) * 64 + n], br = bbr[n * 16 + pp], bi = bbi[n * 16 + pp];
            wt[idx] = (bf16_t)f2bf(n2 < 64 ? pr * br - pi * bi : pr * bi + pi * br);
        }
    }
    if (part == 3) {
    for (int i = tid; i < 4096; i += 512) {
        const int e = i & 3, lane = (i >> 2) & 63, half = (i >> 8) & 1, reim = (i >> 9) & 1, nh = (i >> 10) & 1, mt = i >> 11;
        const int t = mt * 16 + (lane & 15), n = nh * 32 + (lane >> 4) * 8 + half * 4 + e;
        WSP(float, WS_PRE)[(size_t)g * 4096 + i] = reim ? pwi[(t + 1) * 64 + n] : pwr[(t + 1) * 64 + n];
    }
    if (tid < 64) { WSP(float, WS_A32)[(g * 64 + tid) * 2] = pwr[32 * 64 + tid]; WSP(float, WS_A32)[(g * 64 + tid) * 2 + 1] = pwi[32 * 64 + tid]; }
    for (int i = tid; i < 2048; i += 512) {
        const int j = i & 7, lane = (i >> 3) & 63, kk2 = i >> 9, p = lane & 15, n2 = kk2 * 32 + (lane >> 4) * 8 + j;
        const float v = n2 < 64 ? F.in[14][(size_t)(g * 16 + p) * 64 + n2] : -F.in[15][(size_t)(g * 16 + p) * 64 + n2 - 64];
        WSP(bf16_t, WS_CT)[(size_t)g * 2048 + i] = (bf16_t)f2bf(v);
    }
    }
    __syncthreads();
}

DI void p0_prologue(const Frame& F) {
    constexpr int T_SSM = 128, T_WIN = 16 * 20, T_WGLU = 64, T_WO = 256, T_WA = 16 * 44, T_WD = 44 * 16, T_XN = M / 8, T_CK = 64, T_CV = 64;
    LAS float* scr = (LAS float*)F.lds;
    const int G = F.G;
    int r = F.bid;
#define P0_LOOP(COUNT) for (int i = r; i < (COUNT); i += G)
#define P0_NEXT(COUNT) r = (r + G - (COUNT) % G) % G
    P0_LOOP(T_XN) {
        const int row = i * 8 + F.wave;
        const float* xr = row < MP ? F.in[0] + (size_t)row * D : F.in[1] + (size_t)(row - MP) * D;
        f32x4 v[4]; float q = 0.f;
#pragma unroll
        for (int k = 0; k < 4; ++k) { v[k] = *(const f32x4*)(xr + k * 256 + F.lane * 4); q += v[k][0] * v[k][0] + v[k][1] * v[k][1] + v[k][2] * v[k][2] + v[k][3] * v[k][3]; }
#pragma unroll
        for (int o = 1; o < 64; o <<= 1) q += __shfl_xor(q, o);
        const float rr = rsqrtf(q * (1.0f / D) + EPS);
        bf16_t* dst = WSP(bf16_t, WS_XN) + (size_t)row * D;
#pragma unroll
        for (int k = 0; k < 4; ++k) { const f32x4 g = *(const f32x4*)(F.in[7] + k * 256 + F.lane * 4);
            u32x2 w; w.x = pk2(v[k][0] * rr * g[0], v[k][1] * rr * g[1]); w.y = pk2(v[k][2] * rr * g[2], v[k][3] * rr * g[3]); *(u32x2*)(dst + k * 256 + F.lane * 4) = w; }
    }
    P0_NEXT(T_XN);
    P0_LOOP(T_WIN) p0_transpose(F.in[8], INW, nullptr, WSP(bf16_t, WS_WIN), D, (i % 16) * 64, (i / 16) * 64, (i / 16) * 64, scr, F.tid);
    P0_NEXT(T_WIN);
#undef P0_LOOP
#undef P0_NEXT
}

DI void p1_tail(const Frame& F) {
    constexpr int T_SSM = 128, T_WGLU = 64, T_CK = 64, T_CV = 64;
    const int nbusy = (M / 256) * (INW / 256) - F.G;
    if (nbusy < 0 || nbusy >= F.G || F.bid < nbusy) return;
    const int G = F.G - nbusy;
    int r = F.bid - nbusy;
#define P0_LOOP(COUNT) for (int i = r; i < (COUNT); i += G)
#define P0_NEXT(COUNT) r = (r + G - (COUNT) % G) % G
    P0_LOOP(T_SSM) p0_ssm_tables(F, i);
    P0_NEXT(T_SSM);
    P0_LOOP(T_WGLU) {
        const int ch = i * 512 + F.tid, lane = ch & 63, kk = (ch >> 6) & 15, ntg = ch >> 10;
        const float* src = F.in[17] + (size_t)(kk * 32 + (lane >> 4) * 8) * 512 + ntg * 16 + (lane & 15);
        f32x4 a, b;
#pragma unroll
        for (int j = 0; j < 4; ++j) { a[j] = src[(size_t)j * 512]; b[j] = src[(size_t)(j + 4) * 512]; }
        *(u32x4*)(WSP(bf16_t, WS_WGLU) + (size_t)ch * 8) = pack8(a, b);
    }
    P0_NEXT(T_WGLU);
    P0_LOOP(T_CK) {
        const int ch = i * 512 + F.tid, lane = ch & 63, kk = (ch >> 6) & 1, kb = (ch >> 7) & 7, kvh = (ch >> 10) & 1, sb = ch >> 11;
        const float* src = F.in[4] + (((size_t)sb * 128 + kb * 16 + (lane & 15)) * 2 + kvh) * 64 + kk * 32 + (lane >> 4) * 8;
        *(u32x4*)(WSP(bf16_t, WS_KS) + (((size_t)(sb * 2 + kvh) * 10 + kb) * 2 + kk) * 512 + lane * 8) = pack8(*(const f32x4*)src, *(const f32x4*)(src + 4));
    }
    P0_NEXT(T_CK);
    P0_LOOP(T_CV) {
        const int ch = i * 512 + F.tid, lane = ch & 63, db = (ch >> 6) & 3, kb = (ch >> 8) & 3, kvh = (ch >> 10) & 1, sb = ch >> 11;
        const float* src = F.in[5] + (((size_t)sb * 128 + kb * 32 + (lane >> 4) * 4) * 2 + kvh) * 64 + db * 16 + (lane & 15);
        f32x4 a, b;
#pragma unroll
        for (int j = 0; j < 4; ++j) { a[j] = src[(size_t)j * 128]; b[j] = src[(size_t)(16 + j) * 128]; }
        *(u32x4*)(WSP(bf16_t, WS_VTS) + (((size_t)(sb * 2 + kvh) * 5 + kb) * 4 + db) * 512 + lane * 8) = pack8(a, b);
    }
#undef P0_LOOP
#undef P0_NEXT
}

struct EpiIn {
    static constexpr bool PERM = true, AFTER_DRAIN = false;
    unsigned char* ws; float* out;
    DI void operator()(const f32x4 (&acc)[2][2][4][2], const pg8::Unit& u, int wr, int wc, int fr, int fq) const {
        bf16_t* const U = (bf16_t*)(ws + WS_U); bf16_t* const Q = (bf16_t*)(ws + WS_Q); bf16_t* const KB = (bf16_t*)(ws + WS_KB); bf16_t* const VT = (bf16_t*)(ws + WS_VT);
        bf16_t* const KS = (bf16_t*)(ws + WS_KS); bf16_t* const VTS = (bf16_t*)(ws + WS_VTS); bf16_t* const UF = (bf16_t*)(ws + WS_UF);
        const int row0 = u.pm * 256 + wr * 64 + fr;
        if (u.pn < 2) {
            const int colt = u.pn * 256 + wc * 32 + 8 * fq;
#pragma unroll
            for (int ai = 0; ai < 2; ++ai)
#pragma unroll
                for (int m = 0; m < 4; ++m) { const int row = row0 + ai * 128 + m * 16; bf16_t* rp = U + (size_t)row * 512 + colt;
                    const int tq = row < MP ? (row & 2047) : ((row - MP) & 31), sq = tq & 31, chunk = row < MP ? (tq >> 5) : ((row - MP) >> 5);
#pragma unroll
                    for (int bj = 0; bj < 2; ++bj) { const u32x4 w = pack8(acc[ai][bj][m][0], acc[ai][bj][m][1]); *(u32x4*)(rp + bj * 128) = w;
                        const int c0 = colt + bj * 128, g = c0 >> 4, lf = (((sq & 1) * 2 + ((c0 >> 3) & 1)) * 16 + (chunk & 15)) * 8;
                        bf16_t* uf = row < MP ? UF + ((((size_t)((row >> 11) * 32 + g) * 16 + (sq >> 1)) * 4 + (chunk >> 4)) * 64) * 8 + lf
                                              : UF + (size_t)MP * 512 + ((size_t)(g * 16 + (sq >> 1)) * 64) * 8 + lf;
                        *(u32x4*)uf = w; } }
        } else if (u.pn < 4) {
#pragma unroll
            for (int ai = 0; ai < 2; ++ai)
#pragma unroll
                for (int m = 0; m < 4; ++m) { const int rb = (u.pm * 256 + wr * 64 + ai * 128 + m * 16) >> 4;
#pragma unroll
                    for (int bj = 0; bj < 2; ++bj) { const int c0 = (u.pn - 2) * 256 + bj * 128 + wc * 32, h = c0 >> 6, kk = (c0 >> 5) & 1;
                        *(u32x4*)(Q + (((size_t)h * (M / 16) + rb) * 2 + kk) * 512 + (fq * 16 + fr) * 8) = pack8(acc[ai][bj][m][0] * 0.125f, acc[ai][bj][m][1] * 0.125f); } }
        } else {
            const int c = wc * 32 + 8 * fq, kvh = wc >> 1, kk = wc & 1, db = (c >> 4) & 3, fr0 = c & 15;
#pragma unroll
            for (int ai = 0; ai < 2; ++ai)
#pragma unroll
                for (int m = 0; m < 4; ++m) {
                    const int row = row0 + ai * 128 + m * 16;
                    const f32x4 k0 = acc[ai][0][m][0], k1 = acc[ai][0][m][1], v0 = acc[ai][1][m][0], v1 = acc[ai][1][m][1];
                    if (row < MP) {
                        const int b = row >> 11, t = row & 2047;
                        *(u32x4*)(KB + (((size_t)kvh * (M / 16) + (row >> 4)) * 2 + kk) * 512 + (fq * 16 + fr) * 8) = pack8(k0, k1);
                        const int w = t & 31; bf16_t* vt = VT + ((((size_t)(b * 2 + kvh) * 64 + (t >> 5)) * 4 + db) * 64 + ((w & 15) >> 2) * 16 + fr0) * 8 + (w & 3) + 4 * (w >> 4);
#pragma unroll
                        for (int j = 0; j < 4; ++j) { vt[j * 8] = (bf16_t)f2bf(v0[j]); vt[(j + 4) * 8] = (bf16_t)f2bf(v1[j]); }
                        if (t >= 1920) { float* pk = out + O_PK + ((size_t)b * 128 + (t - 1920)) * 128 + c; *(f32x4*)pk = k0; *(f32x4*)(pk + 4) = k1;
                                         float* pv = out + O_PV + ((size_t)b * 128 + (t - 1920)) * 128 + c; *(f32x4*)pv = v0; *(f32x4*)(pv + 4) = v1; }
                    } else {
                        const int sb = (row - MP) >> 5, st = (row - MP) & 31, key = 128 + st;
                        *(u32x4*)(KS + ((((size_t)(sb * 2 + kvh) * 10 + (key >> 4)) * 2 + kk) * 64 + fq * 16 + (key & 15)) * 8) = pack8(k0, k1);
                        const int w = key & 31; bf16_t* vt = VTS + ((((size_t)(sb * 2 + kvh) * 5 + (key >> 5)) * 4 + db) * 64 + ((w & 15) >> 2) * 16 + fr0) * 8 + (w & 3) + 4 * (w >> 4);
#pragma unroll
                        for (int j = 0; j < 4; ++j) { vt[j * 8] = (bf16_t)f2bf(v0[j]); vt[(j + 4) * 8] = (bf16_t)f2bf(v1[j]); }
                        float* pk = out + O_SK + ((size_t)sb * 32 + st) * 128 + c; *(f32x4*)pk = k0; *(f32x4*)(pk + 4) = k1;
                        float* pv = out + O_SV + ((size_t)sb * 32 + st) * 128 + c; *(f32x4*)pv = v0; *(f32x4*)(pv + 4) = v1;
                    }
                }
        }
    }
};

constexpr int LDO = 520;
DI void attn_task(const bf16_t* __restrict__ Qp, int nqb, const bf16_t* __restrict__ Kp, int nkb, const bf16_t* __restrict__ Vtp, int vstride,
                  float sink, const float* __restrict__ gat, bf16_t* __restrict__ outp, LAS float* ob, int h, int wave, int lane) {
    const int fr = lane & 15, fq = lane >> 4;
#pragma unroll 1
    for (int qb = 0; qb < nqb; ++qb) {
        const bf16_t* qrow = Qp + (size_t)qb * 1024 + lane * 8;
        const bf16x8 q0 = *(const bf16x8*)qrow, q1 = *(const bf16x8*)(qrow + 512);
        f32x4 s[12];
#pragma unroll
        for (int kb = 0; kb < 12; ++kb) {
            s[kb] = (f32x4){-INFINITY, -INFINITY, -INFINITY, -INFINITY};
            if (kb < nkb) {
                const bf16_t* krow = Kp + (size_t)kb * 1024 + lane * 8;
                const bf16x8 k0 = *(const bf16x8*)krow, k1 = *(const bf16x8*)(krow + 512);
                f32x4 z = (f32x4){0.f, 0.f, 0.f, 0.f};
                z = MFMA16(k0, q0, z); z = MFMA16(k1, q1, z); s[kb] = z;
            }
        }
        float m = sink;
#pragma unroll
        for (int kb = 0; kb < 12; ++kb) m = fmaxf(fmaxf(m, fmaxf(s[kb][0], s[kb][1])), fmaxf(s[kb][2], s[kb][3]));
        m = fmaxf(m, __shfl_xor(m, 16)); m = fmaxf(m, __shfl_xor(m, 32));
        float sum = 0.f;
#pragma unroll
        for (int kb = 0; kb < 12; ++kb)
#pragma unroll
            for (int e = 0; e < 4; ++e) { const float p = __expf(s[kb][e] - m); s[kb][e] = p; sum += p; }
        sum = xsum4(sum);
        const float inv = 1.0f / (sum + __expf(sink - m));
        f32x4 o[4];
#pragma unroll
        for (int db = 0; db < 4; ++db) o[db] = (f32x4){0.f, 0.f, 0.f, 0.f};
#pragma unroll
        for (int ks = 0; ks < 6; ++ks) {
            if (2 * ks < nkb) {
                const bf16x8 pb = __builtin_bit_cast(bf16x8, pack8(s[2 * ks], s[2 * ks + 1]));
#pragma unroll
                for (int db = 0; db < 4; ++db) {
                    const bf16x8 vf = *(const bf16x8*)(Vtp + (size_t)(ks * 4 + db) * 512 + lane * 8);
                    o[db] = MFMA16(vf, pb, o[db]);
                }
                if (ks & 1) __builtin_amdgcn_sched_barrier(0);
            }
        }
#pragma unroll
        for (int db = 0; db < 4; ++db) *(LAS f32x4*)(ob + (qb * 16 + fr) * LDO + h * 64 + db * 16 + fq * 4) = o[db] * inv;
    }
    __syncthreads();
    const int rpw = nqb * 2;
    const f32x4 g0 = *(const f32x4*)(gat + lane * 8), g1 = *(const f32x4*)(gat + lane * 8 + 4);
#pragma unroll 1
    for (int i = 0; i < rpw; ++i) {
        const int r = wave * rpw + i;
        f32x4 v0 = *(const LAS f32x4*)(ob + r * LDO + lane * 8), v1 = *(const LAS f32x4*)(ob + r * LDO + lane * 8 + 4);
        float q = v0[0] * v0[0] + v0[1] * v0[1] + v0[2] * v0[2] + v0[3] * v0[3] + v1[0] * v1[0] + v1[1] * v1[1] + v1[2] * v1[2] + v1[3] * v1[3];
#pragma unroll
        for (int o2 = 1; o2 < 64; o2 <<= 1) q += __shfl_xor(q, o2);
        const float rs = rsqrtf(q * (1.0f / 512.0f) + EPS);
        *(u32x4*)(outp + (size_t)r * D + lane * 8) = pack8(v0 * rs * g0, v1 * rs * g1);
    }
    __syncthreads();
}

template <int MT, bool SAMPLE>
DI void ssm_state(const Frame& F, int b, int g) {
    const int lane = F.lane, fr = lane & 15, fq = lane >> 4;
    const bf16_t* Ub = WSP(bf16_t, WS_UF) + (SAMPLE ? (size_t)MP * 512 + (size_t)g * 16 * 512 : (size_t)(b * 32 + g) * 16 * 2048) + lane * 8;
    const bf16_t* Wg = WSP(bf16_t, WS_WT) + (size_t)g * 65536 + lane * 8;
    const float* A32 = WSP(float, WS_A32) + g * 128;
    float* HIN = WSP(float, WS_HIN);
#pragma unroll 1
    for (int h2 = 0; h2 < 2; ++h2) {
        f32x4 acc[MT][4];
#pragma unroll
        for (int mt = 0; mt < MT; ++mt)
#pragma unroll
            for (int j = 0; j < 4; ++j) acc[mt][j] = (f32x4){0.f, 0.f, 0.f, 0.f};
#pragma unroll 2
        for (int kk = 0; kk < 16; ++kk) {
            bf16x8 a[MT], w[4];
#pragma unroll
            for (int mt = 0; mt < MT; ++mt) a[mt] = *(const bf16x8*)(Ub + (size_t)kk * (SAMPLE ? 512 : 2048) + mt * 512);
#pragma unroll
            for (int j = 0; j < 4; ++j) { const int nb = (j < 2) ? 2 * h2 + j : 4 + 2 * h2 + (j - 2); w[j] = *(const bf16x8*)(Wg + (size_t)(nb * 16 + kk) * 512); }
#pragma unroll
            for (int mt = 0; mt < MT; ++mt)
#pragma unroll
                for (int j = 0; j < 4; ++j) acc[mt][j] = MFMA16(a[mt], w[j], acc[mt][j]);
        }
#pragma unroll
        for (int i = 0; i < 2; ++i) {
            const int n = (2 * h2 + i) * 16 + fr;
            const float ar = A32[n * 2], ai = A32[n * 2 + 1];
            if constexpr (SAMPLE) {
#pragma unroll
                for (int e = 0; e < 4; ++e) {
                    const int sb = fq * 4 + e; const size_t idx = ((size_t)sb * 32 + g) * 64 + n;
                    const float hr = F.in[2][idx], hi = F.in[3][idx];
                    F.out[O_SRE + idx] = ar * hr - ai * hi + acc[0][i][e]; F.out[O_SIM + idx] = ar * hi + ai * hr + acc[0][2 + i][e];
                }
            } else {
            const float a2r = ar * ar - ai * ai, a2i = 2.f * ar * ai, a3r = a2r * ar - a2i * ai, a3i = a2r * ai + a2i * ar, a4r = a2r * a2r - a2i * a2i, a4i = 2.f * a2r * a2i;
            float h1r[MT], h1i[MT], h2r[MT], h2i[MT], h3r[MT], h3i[MT], er[MT], ei[MT], cr[MT], ci[MT];
#pragma unroll
            for (int mt = 0; mt < MT; ++mt) {
                const f32x4 sr = acc[mt][i], si = acc[mt][2 + i];
                h1r[mt] = sr[0]; h1i[mt] = si[0];
                h2r[mt] = ar * h1r[mt] - ai * h1i[mt] + sr[1]; h2i[mt] = ar * h1i[mt] + ai * h1r[mt] + si[1];
                h3r[mt] = ar * h2r[mt] - ai * h2i[mt] + sr[2]; h3i[mt] = ar * h2i[mt] + ai * h2r[mt] + si[2];
                er[mt] = ar * h3r[mt] - ai * h3i[mt] + sr[3]; ei[mt] = ar * h3i[mt] + ai * h3r[mt] + si[3];
                cr[mt] = 0.f; ci[mt] = 0.f;
            }
            float kr = 0.f, ki = 0.f;
#pragma unroll
            for (int gi = 0; gi < 4 * MT; ++gi) {
                const int mt = gi >> 2, src = (gi & 3) * 16 + fr;
                const float xr = __shfl(er[mt], src), xi = __shfl(ei[mt], src);
                if ((gi & 3) == fq) { cr[mt] = kr; ci[mt] = ki; }
                const float nr = a4r * kr - a4i * ki + xr, ni = a4r * ki + a4i * kr + xi; kr = nr; ki = ni;
            }
            if (fq == 0) { F.out[O_PRE + ((size_t)b * 32 + g) * 64 + n] = kr; F.out[O_PIM + ((size_t)b * 32 + g) * 64 + n] = ki; }
#pragma unroll
            for (int mt = 0; mt < MT; ++mt) {
                const int c0 = mt * 16 + fq * 4;
                float* hp = HIN + (((size_t)b * 64 + c0) * 32 + g) * 128 + n;
                const float kr0 = cr[mt], ki0 = ci[mt];
                hp[0] = kr0; hp[64] = ki0;
                hp[4096] = ar * kr0 - ai * ki0 + h1r[mt]; hp[4096 + 64] = ar * ki0 + ai * kr0 + h1i[mt];
                hp[8192] = a2r * kr0 - a2i * ki0 + h2r[mt]; hp[8192 + 64] = a2r * ki0 + a2i * kr0 + h2i[mt];
                hp[12288] = a3r * kr0 - a3i * ki0 + h3r[mt]; hp[12288 + 64] = a3r * ki0 + a3i * kr0 + h3i[mt];
            }
            }
        }
    }
}

DI void p23_phase(const Frame& F) {
    constexpr int T_SSM = 36, T_ATT = 272, T_P3 = 528;
    unsigned* hc = WSP(unsigned, WS_CTL) + 3584 + 224;
    LAS float* ob = (LAS float*)F.lds;
    for (int t = F.bid; t < T_SSM; t += F.G) {
        const int wt = t * 8 + F.wave;
        if (wt < 256) ssm_state<4, false>(F, wt >> 5, wt & 31); else ssm_state<1, true>(F, 0, wt - 256);
        asm volatile("s_waitcnt vmcnt(0)" ::: "memory");
        __syncthreads();
        if (F.tid == 0 && t < 32) {
            __builtin_amdgcn_fence(__ATOMIC_RELEASE, "agent");
            asm volatile("s_waitcnt vmcnt(0)" ::: "memory");
            (void)__hip_atomic_fetch_add((GAS unsigned*)(hc + (t >> 2)), 1u, __ATOMIC_RELAXED, __HIP_MEMORY_SCOPE_AGENT);
        }
    }
    const int t0 = (F.bid >= T_SSM % F.G) ? F.bid - T_SSM % F.G : F.bid + F.G - T_SSM % F.G;
    for (int a = t0; a < T_ATT; a += F.G) {
        const int h = F.wave, kvh = h >> 2;
        const float sink = F.in[19][h]; const float* gat = F.in[21];
        if (a < 256) {
            const int b = a >> 5, c = a & 31, c0 = c < 2 ? 0 : c - 2, row0 = b * SEQ + c * 64;
            attn_task(WSP(bf16_t, WS_Q) + ((size_t)h * (M / 16) + (row0 >> 4)) * 1024, 4, WSP(bf16_t, WS_KB) + ((size_t)kvh * (M / 16) + ((b * SEQ + c0 * 64) >> 4)) * 1024, (c - c0 + 1) * 4,
                      WSP(bf16_t, WS_VT) + ((size_t)(b * 2 + kvh) * 64 + c0 * 2) * 2048, 0, sink, gat, WSP(bf16_t, WS_MIX) + (size_t)row0 * D + 512, ob, h, F.wave, F.lane);
        } else {
            const int sb = a - 256, row0 = MP + sb * 32;
            attn_task(WSP(bf16_t, WS_Q) + ((size_t)h * (M / 16) + (row0 >> 4)) * 1024, 2, WSP(bf16_t, WS_KS) + (size_t)(sb * 2 + kvh) * 10 * 1024, 10,
                      WSP(bf16_t, WS_VTS) + (size_t)(sb * 2 + kvh) * 5 * 2048, 0, sink, gat, WSP(bf16_t, WS_MIX) + (size_t)row0 * D + 512, ob, h, F.wave, F.lane);
        }
    }
}
constexpr int P3_LDY = 520, P3_LDU = 72, P3_UST = 36864;
DI void p3_zero(const Frame& F) {
    LAS u32x4* z = (LAS u32x4*)(F.lds + P3_UST + F.wave * (64 * P3_LDU * 2));
    for (int i = F.lane; i < 32 * P3_LDU * 2 / 16; i += 64) z[i] = (u32x4){0u, 0u, 0u, 0u};
}
DI void p3_task(const Frame& F, int ci) {
    const int lane = F.lane, fr = lane & 15, fq = lane >> 4, wave = F.wave;
    const int row0 = ci < 512 ? (ci >> 6) * SEQ + (ci & 63) * 32 : MP + (ci - 512) * 32;
    constexpr int LDY = P3_LDY, LDU = P3_LDU;
    LAS bf16_t* y1 = (LAS bf16_t*)F.lds; LAS float* ssq = (LAS float*)(F.lds + 32 * LDY * 2);
    LAS bf16_t* ust = (LAS bf16_t*)(F.lds + P3_UST) + wave * (64 * LDU);
    {
        const bf16_t* up = WSP(bf16_t, WS_U) + (size_t)(row0 + (lane >> 3)) * 512 + wave * 64 + (lane & 7) * 8;
#pragma unroll
        for (int i = 0; i < 4; ++i) *(LAS u32x4*)(ust + (32 + (lane >> 3) + 8 * i) * LDU + (lane & 7) * 8) = *(const u32x4*)(up + (size_t)i * 8 * 512);
    }
#pragma unroll 1
    for (int gi = 0; gi < 4; ++gi) {
        const int g = wave * 4 + gi;
        f32x4 acc0 = (f32x4){0.f, 0.f, 0.f, 0.f}, acc1 = acc0;
        const bf16_t* Kg = WSP(bf16_t, WS_KT) + (size_t)g * 8192 + lane * 8;
        const LAS bf16_t* ub = ust + (32 + fr - (fq >> 1)) * LDU + gi * 16 + (fq & 1) * 8;
#pragma unroll
        for (int kk = 0; kk < 16; ++kk) {
            const bf16x8 kf = *(const bf16x8*)(Kg + kk * 512);
            acc1 = MFMA16(kf, *(const LAS bf16x8*)(ub + (16 - 2 * kk) * LDU), acc1);
            if (kk < 8) acc0 = MFMA16(kf, *(const LAS bf16x8*)(ub - 2 * kk * LDU), acc0);
        }
        const float* hre; const float* him;
        if (ci < 512) { hre = WSP(float, WS_HIN) + ((size_t)ci * 32 + g) * 128; him = hre + 64; }
        else { hre = F.in[2] + ((size_t)(ci - 512) * 32 + g) * 64; him = F.in[3] + ((size_t)(ci - 512) * 32 + g) * 64; }
#pragma unroll
        for (int nh = 0; nh < 2; ++nh) {
            const int n0 = nh * 32 + fq * 8;
            const f32x4 hr0 = *(const f32x4*)(hre + n0), hr1 = *(const f32x4*)(hre + n0 + 4), hi0 = *(const f32x4*)(him + n0), hi1 = *(const f32x4*)(him + n0 + 4);
            const bf16_t* cp = WSP(bf16_t, WS_CT) + (size_t)g * 2048 + lane * 8;
            const bf16x8 cref = *(const bf16x8*)(cp + nh * 512), cimf = *(const bf16x8*)(cp + (2 + nh) * 512);
#pragma unroll
            for (int mt = 0; mt < 2; ++mt) {
                const float* pp = WSP(float, WS_PRE) + (size_t)g * 4096 + (mt * 2 + nh) * 1024 + lane * 4;
                const f32x4 pr0 = *(const f32x4*)pp, pr1 = *(const f32x4*)(pp + 256), pi0 = *(const f32x4*)(pp + 512), pi1 = *(const f32x4*)(pp + 768);
                const f32x4 gr0 = pr0 * hr0 - pi0 * hi0, gr1 = pr1 * hr1 - pi1 * hi1, gi0 = pr0 * hi0 + pi0 * hr0, gi1 = pr1 * hi1 + pi1 * hr1;
                const bf16x8 gre = __builtin_bit_cast(bf16x8, pack8(gr0, gr1)), gim = __builtin_bit_cast(bf16x8, pack8(gi0, gi1));
                if (mt == 0) { acc0 = MFMA16(cref, gre, acc0); acc0 = MFMA16(cimf, gim, acc0); }
                else         { acc1 = MFMA16(cref, gre, acc1); acc1 = MFMA16(cimf, gim, acc1); }
            }
        }
        {   u32x2 w; w.x = pk2(gelu_tanh(acc0[0]), gelu_tanh(acc0[1])); w.y = pk2(gelu_tanh(acc0[2]), gelu_tanh(acc0[3]));
            *(LAS u32x2*)(y1 + fr * LDY + g * 16 + fq * 4) = w;
            w.x = pk2(gelu_tanh(acc1[0]), gelu_tanh(acc1[1])); w.y = pk2(gelu_tanh(acc1[2]), gelu_tanh(acc1[3]));
            *(LAS u32x2*)(y1 + (16 + fr) * LDY + g * 16 + fq * 4) = w; }
    }
    __syncthreads();
    f32x4 a2[2][4];
#pragma unroll
    for (int mt = 0; mt < 2; ++mt)
#pragma unroll
        for (int nt = 0; nt < 4; ++nt) a2[mt][nt] = (f32x4){0.f, 0.f, 0.f, 0.f};
    const bf16_t* Wg = WSP(bf16_t, WS_WGLU) + (size_t)(wave * 4) * 8192 + lane * 8;
#pragma unroll 4
    for (int kk = 0; kk < 16; ++kk) {
        bf16x8 yf[2], wf[4];
#pragma unroll
        for (int mt = 0; mt < 2; ++mt) yf[mt] = *(const LAS bf16x8*)(y1 + (mt * 16 + fr) * LDY + kk * 32 + fq * 8);
#pragma unroll
        for (int nt = 0; nt < 4; ++nt) wf[nt] = *(const bf16x8*)(Wg + (size_t)nt * 8192 + kk * 512);
#pragma unroll
        for (int mt = 0; mt < 2; ++mt)
#pragma unroll
            for (int nt = 0; nt < 4; ++nt) a2[mt][nt] = MFMA16(wf[nt], yf[mt], a2[mt][nt]);
    }
    float q2[2] = {0.f, 0.f};
#pragma unroll
    for (int mt = 0; mt < 2; ++mt)
#pragma unroll
        for (int nt = 0; nt < 4; ++nt) {
            const int n = wave * 64 + nt * 16 + fq * 4;
            const f32x4 bias = *(const f32x4*)(F.in[18] + n);
            const u32x2 yw = *(const LAS u32x2*)(y1 + (mt * 16 + fr) * LDY + n);
            const float y0 = bflo(yw.x), y1v = bfhi(yw.x), y2v = bflo(yw.y), y3 = bfhi(yw.y);
            f32x4 r; r[0] = y0 * sigm(a2[mt][nt][0] + bias[0]); r[1] = y1v * sigm(a2[mt][nt][1] + bias[1]); r[2] = y2v * sigm(a2[mt][nt][2] + bias[2]); r[3] = y3 * sigm(a2[mt][nt][3] + bias[3]);
            a2[mt][nt] = r; q2[mt] += r[0] * r[0] + r[1] * r[1] + r[2] * r[2] + r[3] * r[3];
        }
    q2[0] = xsum4(q2[0]); q2[1] = xsum4(q2[1]);
    if (fq == 0) { ssq[wave * 32 + fr] = q2[0]; ssq[wave * 32 + 16 + fr] = q2[1]; }
    __syncthreads();
#pragma unroll
    for (int mt = 0; mt < 2; ++mt) {
        float tot = 0.f;
#pragma unroll
        for (int w = 0; w < 8; ++w) tot += ssq[w * 32 + mt * 16 + fr];
        const float rs = rsqrtf(tot * (1.0f / 512.0f) + EPS);
#pragma unroll
        for (int nt = 0; nt < 4; ++nt) {
            const int n = wave * 64 + nt * 16 + fq * 4;
            const f32x4 g = *(const f32x4*)(F.in[20] + n);
            u32x2 w; w.x = pk2(a2[mt][nt][0] * rs * g[0], a2[mt][nt][1] * rs * g[1]); w.y = pk2(a2[mt][nt][2] * rs * g[2], a2[mt][nt][3] * rs * g[3]);
            *(u32x2*)(WSP(bf16_t, WS_MIX) + (size_t)(row0 + mt * 16 + fr) * D + n) = w;
        }
    }
    __syncthreads();
}

DI void late_weights(const Frame& F) {
    constexpr int T_WO = 256, T_WA = 16 * 44, T_WD = 44 * 16;
    LAS float* scr = (LAS float*)F.lds;
    const int nskip = ((36 + 272 + 528) % F.G), G = F.G - nskip;
    if (F.bid < nskip || G <= 0) return;
    int r = F.bid - nskip;
#define P0_LOOP(COUNT) for (int i = r; i < (COUNT); i += G)
#define P0_NEXT(COUNT) r = (r + G - (COUNT) % G) % G
    P0_LOOP(T_WO) p0_transpose(F.in[22], D, nullptr, WSP(bf16_t, WS_WO), D, (i % 16) * 64, (i / 16) * 64, (i / 16) * 64, scr, F.tid);
    P0_NEXT(T_WO);
    P0_LOOP(T_WA) { const int n0 = (i / 16) * 64; p0_transpose(F.in[24], FF, F.in[23], WSP(bf16_t, WS_W1), D, (i % 16) * 64, n0, (n0 >> 7) * 256 + (n0 & 127), scr, F.tid); }
    P0_NEXT(T_WA);
    P0_LOOP(T_WA) { const int n0 = (i / 16) * 64; p0_transpose(F.in[25], FF, F.in[23], WSP(bf16_t, WS_W1), D, (i % 16) * 64, n0, (n0 >> 7) * 256 + 128 + (n0 & 127), scr, F.tid); }
    P0_NEXT(T_WA);
    P0_LOOP(T_WD) p0_transpose(F.in[28], D, nullptr, WSP(bf16_t, WS_W2), FF, (i % 44) * 64, (i / 44) * 64, (i / 44) * 64, scr, F.tid);
    P0_NEXT(T_WD);
#undef P0_LOOP
#undef P0_NEXT
}

DI void p3_loop(const Frame& F) {
    constexpr int T_PRE = 36 + 272, T_P3 = 528;
    unsigned* hc = WSP(unsigned, WS_CTL) + 3584 + 224;
    p3_zero(F);
    const int r0 = T_PRE % F.G, c0 = (F.bid >= r0) ? F.bid - r0 : F.bid + F.G - r0;
    for (int ci = c0; ci < T_P3; ci += F.G) {
        if (ci < 512) {
            if (F.tid == 0) {
                while (__hip_atomic_load((GAS unsigned*)(hc + (ci >> 6)), __ATOMIC_RELAXED, __HIP_MEMORY_SCOPE_AGENT) < 4u) __builtin_amdgcn_s_sleep(1);
                __builtin_amdgcn_fence(__ATOMIC_ACQUIRE, "agent");
                asm volatile("s_waitcnt vmcnt(0)" ::: "memory");
            }
            __syncthreads();
        }
        p3_task(F, ci);
    }
}

DI void panel_rs(float* part, unsigned* cnt, LAS float* lx, int pm, int pn, float* rs_out = nullptr) {
    const int tid = threadIdx.x;
    __syncthreads();
    if (tid < 256) st_agent(part + (size_t)(pm * 4 + pn) * 256 + tid, lx[tid] + lx[256 + tid] + lx[512 + tid] + lx[768 + tid]);
    asm volatile("s_waitcnt vmcnt(0)" ::: "memory");
    __syncthreads();
    if (tid == 0) arrive_and_wait(cnt + pm, 4u);
    __syncthreads();
    if (tid < 256) { const float* pp = part + (size_t)pm * 1024 + tid; const float r = rsqrtf((ld_agent(pp) + ld_agent(pp + 256) + ld_agent(pp + 512) + ld_agent(pp + 768)) * (1.0f / D) + EPS); lx[1024 + tid] = r;
        if (rs_out && pn == 0) rs_out[pm * 256 + tid] = r; }
    __syncthreads();
}
struct EpiOut {
    static constexpr bool PERM = true, AFTER_DRAIN = false;
    const float* xp; float* RS; bf16_t* X1B; float* part; unsigned* cnt; LAS float* lx;
    DI void operator()(const f32x4 (&acc_)[2][2][4][2], const pg8::Unit& u, int wr, int wc, int fr, int fq) const {
        f32x4 (&acc)[2][2][4][2] = const_cast<f32x4 (&)[2][2][4][2]>(acc_);
        const int row0 = u.pm * 256 + wr * 64 + fr, col0 = u.pn * 256 + wc * 32 + 8 * fq;
#pragma unroll
        for (int ai = 0; ai < 2; ++ai)
#pragma unroll
            for (int m = 0; m < 4; ++m) {
                const size_t ro = (size_t)(row0 + ai * 128 + m * 16) * D + col0;
                float q = 0.f;
#pragma unroll
                for (int bj = 0; bj < 2; ++bj) {
                    const f32x4 v0 = acc[ai][bj][m][0] + *(const f32x4*)(xp + ro + bj * 128), v1 = acc[ai][bj][m][1] + *(const f32x4*)(xp + ro + bj * 128 + 4);
                    acc[ai][bj][m][0] = v0; acc[ai][bj][m][1] = v1;
                    q += v0[0] * v0[0] + v0[1] * v0[1] + v0[2] * v0[2] + v0[3] * v0[3] + v1[0] * v1[0] + v1[1] * v1[1] + v1[2] * v1[2] + v1[3] * v1[3];
                }
                q = xsum4(q);
                if (fq == 0) lx[wc * 256 + ai * 128 + wr * 64 + m * 16 + fr] = q;
            }
        panel_rs(part, cnt, lx, u.pm, u.pn, RS);
#pragma unroll
        for (int ai = 0; ai < 2; ++ai)
#pragma unroll
            for (int m = 0; m < 4; ++m) {
                const float rs = lx[1024 + ai * 128 + wr * 64 + m * 16 + fr];
                const size_t ro = (size_t)(row0 + ai * 128 + m * 16) * D + col0;
#pragma unroll
                for (int bj = 0; bj < 2; ++bj) *(u32x4*)(X1B + ro + bj * 128) = pack8(acc[ai][bj][m][0] * rs, acc[ai][bj][m][1] * rs);
            }
    }
};

struct EpiFfn {
    static constexpr bool PERM = true, AFTER_DRAIN = false;
    unsigned char* ws; const float* const* in; float* out; LAS float* bnd;
    DI void operator()(const f32x4 (&acc)[2][2][4][2], const pg8::Unit& u, int wr, int wc, int fr, int fq) const {
        const bf16_t* const X1B = (const bf16_t*)(ws + WS_X1B); const bf16_t* const W1T = (const bf16_t*)(ws + WS_W1);
        bf16_t* const H = (bf16_t*)(ws + WS_H); const float* const cstate = in[6];
        const int pm = u.pm, pn = u.pn, rowt = pm * 256, wave = wr * 4 + wc, tid = threadIdx.x;
        const bool sample = pm >= 64;
        const int cl = wc * 32 + 8 * fq, ff = pn * 128 + cl;
        LAS float* cwl = bnd + 17 * 2 * 128;
        if (tid < 128) { const float* cw = in[26] + pn * 128 + tid; cwl[tid] = cw[0]; cwl[128 + tid] = cw[FF]; cwl[256 + tid] = cw[2 * FF]; cwl[384 + tid] = in[27][pn * 128 + tid]; }
#pragma unroll
        for (int ai = 0; ai < 2; ++ai)
#pragma unroll
            for (int m = 0; m < 4; ++m) {
                const int blk = 8 * ai + 4 * wr + m;
                if (fr >= 14) {
                    const f32x4 a0 = acc[ai][0][m][0], a1 = acc[ai][0][m][1];
                    if (!sample || (blk & 1) == 0) { LAS float* bp = bnd + ((blk + 1) * 2 + (fr - 14)) * 128 + cl; *(LAS f32x4*)bp = a0; *(LAS f32x4*)(bp + 4) = a1; }
                    if (sample && (blk & 1)) { float* sp = out + O_SCONV + ((size_t)((pm - 64) * 8 + (blk >> 1)) * 2 + (fr - 14)) * FF + ff; *(f32x4*)sp = a0; *(f32x4*)(sp + 4) = a1; }
                    if (!sample && (pm & 7) == 7 && blk == 15) { float* sp = out + O_PCONV + ((size_t)(pm >> 3) * 2 + (fr - 14)) * FF + ff; *(f32x4*)sp = a0; *(f32x4*)(sp + 4) = a1; }
                    if (sample && (blk & 1) == 0) {
                        const float* sp = cstate + ((size_t)((pm - 64) * 8 + (blk >> 1)) * 2 + (fr - 14)) * FF + ff;
                        LAS float* bp = bnd + (blk * 2 + (fr - 14)) * 128 + cl; *(LAS f32x4*)bp = *(const f32x4*)sp; *(LAS f32x4*)(bp + 4) = *(const f32x4*)(sp + 4);
                    }
                    if (!sample && (pm & 7) == 0 && blk == 0) { LAS float* bp = bnd + (fr - 14) * 128 + cl; *(LAS f32x4*)bp = (f32x4){0.f, 0.f, 0.f, 0.f}; *(LAS f32x4*)(bp + 4) = (f32x4){0.f, 0.f, 0.f, 0.f}; }
                }
            }
        if (!sample && (pm & 7) != 0) {
            const int lane = fq * 16 + fr;
            const bf16_t* xp = X1B + (size_t)(rowt - 2) * D + lane * 8;
            const u32x4 xa0 = *(const u32x4*)xp, xa1 = *(const u32x4*)(xp + 512), xb0 = *(const u32x4*)(xp + D), xb1 = *(const u32x4*)(xp + D + 512);
#pragma unroll 1
            for (int ps = 0; ps < 4; ++ps) {
                float p0[4], p1[4];
                const bf16_t* wp = W1T + (size_t)(pn * 256 + wave * 16 + ps * 4) * D + lane * 8;
#pragma unroll
                for (int c = 0; c < 4; ++c) {
                    const u32x4 a = *(const u32x4*)(wp + (size_t)c * D), b = *(const u32x4*)(wp + (size_t)c * D + 512);
                    float s0 = 0.f, s1 = 0.f;
#pragma unroll
                    for (int j = 0; j < 4; ++j) {
                        s0 = dot2bf(a[j], xa0[j], s0); s0 = dot2bf(b[j], xa1[j], s0);
                        s1 = dot2bf(a[j], xb0[j], s1); s1 = dot2bf(b[j], xb1[j], s1);
                    }
                    p0[c] = s0; p1[c] = s1;
                }
#define HALO_STEP(N, BIT) _Pragma("unroll") for (int c = 0; c < N; ++c) { const bool hi_ = (lane & BIT) != 0; \
                    const float s0_ = hi_ ? p0[c] : p0[c + N], s1_ = hi_ ? p1[c] : p1[c + N]; \
                    const float r0_ = __shfl_xor(s0_, BIT), r1_ = __shfl_xor(s1_, BIT); \
                    p0[c] = (hi_ ? p0[c + N] : p0[c]) + r0_; p1[c] = (hi_ ? p1[c + N] : p1[c]) + r1_; }
                HALO_STEP(2, 32) HALO_STEP(1, 16)
#undef HALO_STEP
                float t0 = p0[0], t1 = p1[0];
                t0 += __shfl_xor(t0, 8); t1 += __shfl_xor(t1, 8); t0 += __shfl_xor(t0, 4); t1 += __shfl_xor(t1, 4); t0 += __shfl_xor(t0, 2); t1 += __shfl_xor(t1, 2); t0 += __shfl_xor(t0, 1); t1 += __shfl_xor(t1, 1);
                if ((lane & 15) == 0) { const int col = wave * 16 + ps * 4 + ((lane >> 5) & 1) * 2 + ((lane >> 4) & 1);
                    bnd[col] = t0; bnd[128 + col] = t1; }
            }
        }
        __syncthreads();
#pragma unroll
        for (int ai = 0; ai < 2; ++ai)
#pragma unroll
            for (int m = 0; m < 4; ++m) {
                const int blk = 8 * ai + 4 * wr + m, row = rowt + ai * 128 + wr * 64 + m * 16 + fr;
                f32x4 hv[2];
#pragma unroll
                for (int n = 0; n < 2; ++n) {
                    const f32x4 cur = acc[ai][0][m][n], upv = acc[ai][1][m][n];
                    f32x4 p1, p2;
#pragma unroll
                    for (int e = 0; e < 4; ++e) { p1[e] = dpp_shr<0x111>(cur[e]); p2[e] = dpp_shr<0x112>(cur[e]); }
                    const f32x4 b0 = *(const LAS f32x4*)(bnd + (blk * 2 + 0) * 128 + cl + 4 * n), b1 = *(const LAS f32x4*)(bnd + (blk * 2 + 1) * 128 + cl + 4 * n);
                    if (fr == 0) { p1 = b1; p2 = b0; } else if (fr == 1) { p2 = b1; }
                    const LAS float* wl = cwl + cl + 4 * n;
                    const f32x4 c = *(const LAS f32x4*)(wl + 384) + *(const LAS f32x4*)wl * p2 + *(const LAS f32x4*)(wl + 128) * p1 + *(const LAS f32x4*)(wl + 256) * cur;
#pragma unroll
                    for (int e = 0; e < 4; ++e) hv[n][e] = c[e] * sigm(c[e]) * upv[e];
                }
                *(u32x4*)(H + (size_t)row * FF + ff) = pack8(hv[0], hv[1]);
            }
        __syncthreads();
    }
};

struct EpiDown {
    static constexpr bool PERM = true, AFTER_DRAIN = false;
    float* out; const bf16_t* X1B; const float* RS; const float* gfin; float* part; unsigned* cnt; LAS float* lx;
    DI void operator()(const f32x4 (&acc_)[2][2][4][2], const pg8::Unit& u, int wr, int wc, int fr, int fq) const {
        f32x4 (&acc)[2][2][4][2] = const_cast<f32x4 (&)[2][2][4][2]>(acc_);
        const int row0 = u.pm * 256 + wr * 64 + fr, col0 = u.pn * 256 + wc * 32 + 8 * fq;
#pragma unroll
        for (int ai = 0; ai < 2; ++ai)
#pragma unroll
            for (int m = 0; m < 4; ++m) {
                const int row = row0 + ai * 128 + m * 16;
                const bf16_t* xrow = X1B + (size_t)row * D + col0;
                const float ir = 1.0f / RS[row];
                float q = 0.f;
#pragma unroll
                for (int bj = 0; bj < 2; ++bj) {
                    const u32x4 xw = *(const u32x4*)(xrow + bj * 128);
                    const f32x4 x0 = (f32x4){bflo(xw.x), bfhi(xw.x), bflo(xw.y), bfhi(xw.y)}, x1v = (f32x4){bflo(xw.z), bfhi(xw.z), bflo(xw.w), bfhi(xw.w)};
                    const f32x4 v0 = acc[ai][bj][m][0] + x0 * ir, v1 = acc[ai][bj][m][1] + x1v * ir;
                    acc[ai][bj][m][0] = v0; acc[ai][bj][m][1] = v1;
                    q += v0[0] * v0[0] + v0[1] * v0[1] + v0[2] * v0[2] + v0[3] * v0[3] + v1[0] * v1[0] + v1[1] * v1[1] + v1[2] * v1[2] + v1[3] * v1[3];
                }
                q = xsum4(q);
                if (fq == 0) lx[wc * 256 + ai * 128 + wr * 64 + m * 16 + fr] = q;
            }
        panel_rs(part, cnt, lx, u.pm, u.pn);
        f32x4 gv[2][2];
#pragma unroll
        for (int bj = 0; bj < 2; ++bj) { gv[bj][0] = *(const f32x4*)(gfin + col0 + bj * 128); gv[bj][1] = *(const f32x4*)(gfin + col0 + bj * 128 + 4); }
#pragma unroll
        for (int ai = 0; ai < 2; ++ai)
#pragma unroll
            for (int m = 0; m < 4; ++m) {
                float* orow = out + (size_t)(row0 + ai * 128 + m * 16) * D + col0;
                const float rs = lx[1024 + ai * 128 + wr * 64 + m * 16 + fr];
#pragma unroll
                for (int bj = 0; bj < 2; ++bj) { *(f32x4*)(orow + bj * 128) = acc[ai][bj][m][0] * rs * gv[bj][0]; *(f32x4*)(orow + bj * 128 + 4) = acc[ai][bj][m][1] * rs * gv[bj][1]; }
            }
    }
};


template <int K> DI f32x4 mini_tile_ks(const Frame& F, const bf16_t* __restrict__ A, const bf16_t* __restrict__ Bt, int row0, int col0) {
    constexpr int KS = K / 8, LDR = 68;
    const int lane = F.lane, fr = lane & 15, fq = lane >> 4;
    const bf16_t* ap = A + (size_t)(row0 + fr) * K + F.wave * KS + fq * 8;
    const bf16_t* bp = Bt + (size_t)(col0 + fr) * K + F.wave * KS + fq * 8;
    f32x4 acc[2][4];
#pragma unroll
    for (int mt = 0; mt < 2; ++mt)
#pragma unroll
        for (int nt = 0; nt < 4; ++nt) acc[mt][nt] = (f32x4){0.f, 0.f, 0.f, 0.f};
#pragma unroll 2
    for (int kk = 0; kk < KS / 32; ++kk) {
        bf16x8 xa[2], wb[4];
#pragma unroll
        for (int mt = 0; mt < 2; ++mt) xa[mt] = *(const bf16x8*)(ap + (size_t)mt * 16 * K + kk * 32);
#pragma unroll
        for (int nt = 0; nt < 4; ++nt) wb[nt] = *(const bf16x8*)(bp + (size_t)nt * 16 * K + kk * 32);
#pragma unroll
        for (int mt = 0; mt < 2; ++mt)
#pragma unroll
            for (int nt = 0; nt < 4; ++nt) acc[mt][nt] = MFMA16(wb[nt], xa[mt], acc[mt][nt]);
    }
    LAS float* red = (LAS float*)F.lds;
#pragma unroll
    for (int mt = 0; mt < 2; ++mt)
#pragma unroll
        for (int nt = 0; nt < 4; ++nt) *(LAS f32x4*)(red + F.wave * (32 * LDR) + (mt * 16 + fr) * LDR + nt * 16 + fq * 4) = acc[mt][nt];
    __syncthreads();
    f32x4 sum = (f32x4){0.f, 0.f, 0.f, 0.f};
#pragma unroll
    for (int w = 0; w < 8; ++w) sum += *(const LAS f32x4*)(red + w * (32 * LDR) + (F.tid >> 4) * LDR + (F.tid & 15) * 4);
    __syncthreads();
    return sum;
}
DI void p4_sample(const Frame& F) {
    float* PS = WSP(float, WS_PARTS); unsigned* cnt = WSP(unsigned, WS_CTL) + 3584 + 192;
    for (int t = F.bid; t < 256; t += F.G) {
        const int rg = t & 15, cg = t >> 4, rl = F.tid >> 4, row = MP + rg * 32 + rl, n0 = cg * 64 + (F.tid & 15) * 4;
        const f32x4 acc = mini_tile_ks<D>(F, WSP(bf16_t, WS_MIX), WSP(bf16_t, WS_WO), MP + rg * 32, cg * 64);
        const f32x4 v = acc + *(const f32x4*)(F.in[1] + (size_t)(row - MP) * D + n0);
        float q = v[0] * v[0] + v[1] * v[1] + v[2] * v[2] + v[3] * v[3];
        q += __shfl_xor(q, 1); q += __shfl_xor(q, 2); q += __shfl_xor(q, 4); q += __shfl_xor(q, 8);
        if ((F.tid & 15) == 0) st_agent(PS + (size_t)(rg * 16 + cg) * 32 + rl, q);
        asm volatile("s_waitcnt vmcnt(0)" ::: "memory");
        __syncthreads();
        if (F.tid == 0) arrive_and_wait(cnt + rg, 16u);
        __syncthreads();
        float tot = 0.f;
#pragma unroll
        for (int c = 0; c < 16; ++c) tot += ld_agent(PS + (size_t)(rg * 16 + c) * 32 + rl);
        const float rs = rsqrtf(tot * (1.0f / D) + EPS);
        *(f32x4*)(WSP(float, WS_X1F) + (size_t)row * D + n0) = v;
        u32x2 w; w.x = pk2(v[0] * rs, v[1] * rs); w.y = pk2(v[2] * rs, v[3] * rs); *(u32x2*)(WSP(bf16_t, WS_X1B) + (size_t)row * D + n0) = w;
    }
}
DI void p6_sample(const Frame& F) {
    float* PS = WSP(float, WS_PARTS); unsigned* cnt = WSP(unsigned, WS_CTL) + 3584 + 208;
    for (int t = F.bid; t < 256; t += F.G) {
        const int rg = t & 15, cg = t >> 4, rl = F.tid >> 4, row = MP + rg * 32 + rl, n0 = cg * 64 + (F.tid & 15) * 4;
        const f32x4 acc = mini_tile_ks<FF>(F, WSP(bf16_t, WS_H), WSP(bf16_t, WS_W2), MP + rg * 32, cg * 64);
        const f32x4 v = acc + *(const f32x4*)(WSP(float, WS_X1F) + (size_t)row * D + n0);
        float q = v[0] * v[0] + v[1] * v[1] + v[2] * v[2] + v[3] * v[3];
        q += __shfl_xor(q, 1); q += __shfl_xor(q, 2); q += __shfl_xor(q, 4); q += __shfl_xor(q, 8);
        if ((F.tid & 15) == 0) st_agent(PS + (size_t)(rg * 16 + cg) * 32 + rl, q);
        asm volatile("s_waitcnt vmcnt(0)" ::: "memory");
        __syncthreads();
        if (F.tid == 0) arrive_and_wait(cnt + rg, 16u);
        __syncthreads();
        float tot = 0.f;
#pragma unroll
        for (int c = 0; c < 16; ++c) tot += ld_agent(PS + (size_t)(rg * 16 + c) * 32 + rl);
        const float rs = rsqrtf(tot * (1.0f / D) + EPS);
        *(f32x4*)(F.out + (size_t)row * D + n0) = v * rs * *(const f32x4*)(F.in[29] + n0);
    }
}

#define RLX_AGENT __ATOMIC_RELAXED, __HIP_MEMORY_SCOPE_AGENT
#define XB_TMO      128
#define XB_XCNT(j)  (256  + 64 * (j))
#define XB_XSUB(j)  (1280 + 64 * (j))
#define XB_XGEN(j)  (2304 + 64 * (j))
#define XB_TOP      3328
#define XB_TOPGEN   3392
#define XCD_BAR_WORDS 3456
#define XB_SPIN_CAP (1u << 18)

__device__ __forceinline__ unsigned xb_ld(unsigned* p)              { return __hip_atomic_load(p, __ATOMIC_RELAXED, __HIP_MEMORY_SCOPE_AGENT); }
__device__ __forceinline__ unsigned xb_add(unsigned* p, unsigned v) { return __hip_atomic_fetch_add(p, v, __ATOMIC_RELAXED, __HIP_MEMORY_SCOPE_AGENT); }
__device__ __forceinline__ unsigned xb_xcc_id() { return (unsigned)__builtin_amdgcn_s_getreg((3 << 11) | 20) & 0xFu; }
#define XB_SPIN(cond, bar) do { unsigned _sp = 0; while (cond) { __builtin_amdgcn_s_sleep(1); \
    if ((++_sp & 255u) == 0u) { if (xb_ld(&(bar)[XB_TMO])) break; if (_sp > XB_SPIN_CAP) { atomicAdd(&(bar)[XB_TMO], 1u); break; } } } } while (0)

struct XcdBarrier {
    unsigned* bar; unsigned x;
    volatile LAS unsigned* st;
};

__device__ __forceinline__ XcdBarrier xcd_barrier_post(unsigned* bar, volatile LAS unsigned* st) {
    XcdBarrier b; b.bar = bar; b.x = xb_xcc_id(); b.st = st;
    if (threadIdx.x == 0) (void)xb_add(&bar[XB_XCNT(b.x)], 1u);
    return b;
}
__device__ __forceinline__ void xcd_barrier_complete(unsigned* bar, unsigned x, unsigned& nloc, unsigned& nx) {
    const unsigned G = gridDim.x * gridDim.y * gridDim.z;
    unsigned sum, cnt, mine, sp = 0u;
    for (;;) {
        sum = 0u; cnt = 0u; mine = 0u;
#pragma unroll
        for (unsigned j = 0; j < 16; ++j) { const unsigned c = xb_ld(&bar[XB_XCNT(j)]); sum += c; cnt += (c > 0u) ? 1u : 0u; mine = (j == x) ? c : mine; }
        if (sum == G) break;
        __builtin_amdgcn_s_sleep(1);
        if ((++sp & 255u) == 0u) { if (xb_ld(&bar[XB_TMO])) break; if (sp > XB_SPIN_CAP) { atomicAdd(&bar[XB_TMO], 1u); break; } }
    }
    nloc = mine > 0u ? mine : 1u; nx = cnt > 0u ? cnt : 1u;
}

__device__ __forceinline__ void xcd_barrier(const XcdBarrier& b) {
    asm volatile("s_waitcnt vmcnt(0)" ::: "memory");
    __syncthreads();
    if (threadIdx.x == 0) {
        unsigned* bar = b.bar;
        __builtin_amdgcn_s_waitcnt(0);
        unsigned nloc = b.st[0], nx = b.st[1];
        if (nloc == 0u) { xcd_barrier_complete(bar, b.x, nloc, nx); b.st[0] = nloc; b.st[1] = nx; }
        const unsigned old = xb_add(&bar[XB_XSUB(b.x)], 1u);
        const unsigned gen = old / nloc;
        if (old + 1u == (gen + 1u) * nloc) {
            __builtin_amdgcn_fence(__ATOMIC_RELEASE, "agent");
            asm volatile("s_waitcnt vmcnt(0)" ::: "memory");
            const unsigned og = xb_add(&bar[XB_TOP], 1u);
            const unsigned tg = og / nx;
            if (og + 1u == (tg + 1u) * nx) xb_add(&bar[XB_TOPGEN], 1u);
            else XB_SPIN(xb_ld(&bar[XB_TOPGEN]) == tg, bar);
            __builtin_amdgcn_fence(__ATOMIC_ACQUIRE, "agent");
            xb_add(&bar[XB_XGEN(b.x)], 1u);
            asm volatile("s_waitcnt vmcnt(0)" ::: "memory");
        } else {
            XB_SPIN(xb_ld(&bar[XB_XGEN(b.x)]) == gen, bar);
            __builtin_amdgcn_fence(__ATOMIC_ACQUIRE, "agent");
            asm volatile("s_waitcnt vmcnt(0)" ::: "memory");
        }
    }
    __syncthreads();
}

DI void grid_bar(unsigned* ctr, unsigned target) {
    asm volatile("s_waitcnt vmcnt(0)" ::: "memory");
    __syncthreads();
    if (threadIdx.x == 0) {
        __builtin_amdgcn_fence(__ATOMIC_RELEASE, "agent");
        asm volatile("s_waitcnt vmcnt(0)" ::: "memory");
        (void)__hip_atomic_fetch_add(ctr, 1u, __ATOMIC_RELAXED, __HIP_MEMORY_SCOPE_AGENT);
        while (__hip_atomic_load(ctr, __ATOMIC_RELAXED, __HIP_MEMORY_SCOPE_AGENT) < target) __builtin_amdgcn_s_sleep(1);
        __builtin_amdgcn_fence(__ATOMIC_ACQUIRE, "agent");
        asm volatile("s_waitcnt vmcnt(0)" ::: "memory");
    }
    __syncthreads();
}

#ifndef PH_MASK
#define PH_MASK 255
#endif
__global__ void __launch_bounds__(512, 2) mega_fwd(Args args) {
    extern __shared__ __attribute__((aligned(16))) unsigned char lds_raw[];
    cg::grid_group grid = cg::this_grid();
    Frame F;
    F.lds = (LAS unsigned char*)lds_raw; F.tid = threadIdx.x; F.lane = F.tid & 63; F.wave = __builtin_amdgcn_readfirstlane(F.tid >> 6);
    F.G = gridDim.x; F.bid = blockIdx.x; F.in = args.in; F.out = args.out; F.ws = args.ws;
    const int lo = args.ph_lo, hi = args.ph_hi;
#define IN(k) (((PH_MASK >> (k)) & 1) && lo <= (k) && (k) < hi)
    volatile LAS unsigned* xb_st = (volatile LAS unsigned*)(F.lds + LDS_BYTES - 64);
    if (F.tid < 2) xb_st[F.tid] = 0u;
    __syncthreads();
    XcdBarrier xbar; xbar.bar = WSP(unsigned, WS_CTL); xbar.x = 0; xbar.st = xb_st;
    if (lo + 1 < hi) xbar = xcd_barrier_post(WSP(unsigned, WS_CTL), xb_st);
    unsigned bar_n = 0;
#ifdef USE_CG_SYNC
#define SEAM(k) do { if (lo <= (k) && (k) + 1 < hi) grid.sync(); } while (0)
#else
#ifdef USE_CENTRAL_BAR
#define SEAM(k) do { if (lo <= (k) && (k) + 1 < hi) { bar_n += (unsigned)F.G; grid_bar(WSP(unsigned, WS_CTL) + 3520, bar_n); } } while (0)
#else
#define SEAM(k) do { if (lo <= (k) && (k) + 1 < hi) xcd_barrier(xbar); } while (0)
#endif
#endif
    if (hi > 8) grid.sync();
#ifndef REP_MASK
#define REP_MASK 0
#endif
#define REPS(k) for (int rep_ = 0; rep_ < 1 + ((REP_MASK >> (k)) & 1); ++rep_)
    if (IN(0)) { p0_prologue(F); } SEAM(0);
#ifdef EXTRA_SYNC
    for (int i_ = 0; i_ < EXTRA_SYNC; ++i_) SEAM(0);
#endif
#if (REP_MASK >> 0) & 1
    p0_prologue(F); grid.sync();
#endif
    if (IN(1)) {
        pg8::Gemm g{WSP(bf16_t, WS_XN), WSP(bf16_t, WS_WIN), M, INW, D}; pg8::StaticOrder S; S.init(M, INW, F.G, F.bid);
        EpiIn E{F.ws, F.out};
        pg8::gemm_phase<EpiIn, pg8::StaticOrder, true, true>(F.lds, g, S, E);
        p1_tail(F);
    } SEAM(1);
    if (IN(2)) { p23_phase(F); p3_loop(F); late_weights(F); }
#if (REP_MASK >> 2) & 1
    p2_phase(F); grid.sync();
#endif
    SEAM(2);
#if (REP_MASK >> 3) & 1
    for (int t = F.bid; t < 528; t += F.G) p3_task(F, t); grid.sync();
#endif
    if (IN(4)) {
        p4_sample(F);
        pg8::Gemm g{WSP(bf16_t, WS_MIX), WSP(bf16_t, WS_WO), MP, D, D}; pg8::StaticOrder S; S.init(MP, D, F.G, F.bid);
        EpiOut E{F.in[0], WSP(float, WS_SSQ), WSP(bf16_t, WS_X1B), WSP(float, WS_PART), WSP(unsigned, WS_CTL) + 3584 + 128, (LAS float*)(F.lds + LDS_X)};
        pg8::gemm_phase<EpiOut, pg8::StaticOrder, true, true>(F.lds, g, S, E);
    } SEAM(4);
    if (IN(5)) {
        pg8::Gemm g{WSP(bf16_t, WS_X1B), WSP(bf16_t, WS_W1), M, 2 * FF, D}; pg8::StaticOrder S; S.init(M, 2 * FF, F.G, F.bid);
        EpiFfn E{F.ws, F.in, F.out, (LAS float*)(F.lds + LDS_X)};
        pg8::gemm_phase<EpiFfn, pg8::StaticOrder, true, true>(F.lds, g, S, E);
    } SEAM(5);
    if (IN(6)) {
        p6_sample(F);
        pg8::Gemm g{WSP(bf16_t, WS_H), WSP(bf16_t, WS_W2), MP, D, FF}; pg8::StaticOrder S; S.init(MP, D, F.G, F.bid);
        EpiDown E{F.out, WSP(bf16_t, WS_X1B), WSP(float, WS_SSQ), F.in[29], WSP(float, WS_PART), WSP(unsigned, WS_CTL) + 3584 + 64, (LAS float*)(F.lds + LDS_X)};
        pg8::gemm_phase<EpiDown, pg8::StaticOrder, true, true>(F.lds, g, S, E);
    }
#undef IN
#undef SEAM
}

extern "C" void kernel_launch(void* const* d_in, const int* in_sizes, int n_in, void* d_out, int out_size, void* d_ws, size_t ws_size, hipStream_t stream) {
    static int grid = 0;
    if (grid == 0) {
        if (n_in != 30 || ws_size < WS_END) { fprintf(stderr, "kernel_launch: unexpected n_in %d / ws_size %zu (need %zu)\n", n_in, ws_size, (size_t)WS_END); grid = -1; return; }
        int dev = 0, cus = 0, per_cu = 0;
        (void)hipGetDevice(&dev); (void)hipDeviceGetAttribute(&cus, hipDeviceAttributeMultiprocessorCount, dev);
        if (hipFuncSetAttribute((const void*)mega_fwd, hipFuncAttributeMaxDynamicSharedMemorySize, LDS_BYTES) != hipSuccess) { fprintf(stderr, "hipFuncSetAttribute failed\n"); grid = -1; return; }
        if (hipOccupancyMaxActiveBlocksPerMultiprocessor(&per_cu, (const void*)mega_fwd, 512, LDS_BYTES) != hipSuccess || per_cu < 1) { fprintf(stderr, "occupancy query: %d\n", per_cu); per_cu = 1; }
        (void)hipGetLastError();
        grid = cus * (per_cu > 1 ? 1 : per_cu);
        if (grid <= 0) grid = 256;
    }
    if (grid < 0) return;
    Args a{};
    for (int i = 0; i < 30; ++i) a.in[i] = (const float*)d_in[i];
    a.out = (float*)d_out; a.ws = (unsigned char*)d_ws;
    (void)hipMemsetAsync((unsigned char*)d_ws + WS_CTL, 0, 16384, stream);
#if N_LAUNCHES == 1
    a.ph_lo = 0; a.ph_hi = 8;
    void* kargs[] = {&a};
    hipError_t e = hipLaunchCooperativeKernel((const void*)mega_fwd, dim3(grid), dim3(512), kargs, LDS_BYTES, stream);
    if (e != hipSuccess) fprintf(stderr, "cooperative launch failed: %s (grid %d)\n", hipGetErrorString(e), grid);
#else
    for (int p = 0; p < 8; ++p) { a.ph_lo = p; a.ph_hi = p + 1; for (int r = 0; r < 1 + ((HOST_REP >> p) & 1); ++r) hipLaunchKernelGGL(mega_fwd, dim3(grid), dim3(512), LDS_BYTES, stream, a); }
#endif
}
```

```cpp
#include <hip/hip_runtime.h>
#include <hip/hip_cooperative_groups.h>
#include <cstdio>
#include <cstdint>
namespace cg = cooperative_groups;

namespace pg8 {
#define PG8_LAS __attribute__((address_space(3)))
typedef unsigned short bf16_t;
typedef short bf16x8 __attribute__((ext_vector_type(8)));
typedef float f32x4 __attribute__((ext_vector_type(4)));
typedef unsigned u32x4 __attribute__((ext_vector_type(4)));
constexpr int BM = 256, BK = 64, HALF = 128, HTB = HALF * BK * 2  , STAGE_BYTES = 8 * HTB, NXCD = 8, WGM = 8;

__host__ __device__ __forceinline__ int lds_byte(int r, int c) { const int st = (r >> 4) * 2 + (c >> 5), rr = r & 15, cc = c & 31, ob = rr * 64 + cc * 2; return st * 1024 + (ob ^ (((ob >> 9) & 1) << 5)); }
__host__ __device__ __forceinline__ void stage_rc(int b, int& R, int& C) { const int st = b / 1024, sb = b % 1024, swz = sb ^ (((sb >> 9) & 1) << 5); R = (st >> 1) * 16 + swz / 64; C = (st & 1) * 32 + (swz % 64) / 2; }
__host__ __device__ __forceinline__ int perm32(int rho) { const int n = rho >> 4, i = rho & 15; return 8 * (i >> 2) + 4 * n + (i & 3); }

struct Unit { int pm, pn; };
struct Gemm { const bf16_t* A; const bf16_t* Bt; int M, N, K; };

struct StaticOrder {
    int nM, nN, nwg, G, c;
    __host__ __device__ void init(int M, int N, int G_, int c_) { nM = M / BM; nN = N / BM; nwg = nM * nN; G = G_; c = c_; }
    __host__ __device__ bool next(int i, Unit& u) const {
        const long L = (long)i * G + c; if (L >= nwg) return false;
        int wgid = (int)L; { const int q = nwg / NXCD, r = nwg % NXCD, xcd = wgid % NXCD, off = wgid / NXCD; wgid = (xcd < r ? xcd * (q + 1) : r * (q + 1) + (xcd - r) * q) + off; }
        const int nig = WGM * nN, gid = wgid / nig, fm = gid * WGM, gsz = (nM - fm) < WGM ? (nM - fm) : WGM;
        u.pm = fm + ((wgid % nig) % gsz); u.pn = (wgid % nig) / gsz; return true;
    }
    __device__ __forceinline__ void a_ready(const Unit&) const {}
    __device__ __forceinline__ void done(const Unit&) const {}
};

__device__ __forceinline__ unsigned cvt_pk_bf16(float lo, float hi) { unsigned r; asm volatile("v_cvt_pk_bf16_f32 %0, %1, %2" : "=v"(r) : "v"(lo), "v"(hi)); return r; }
template <class Epi, class Sched, bool ALIGN_EPI = false, bool SP2 = false>
__device__ __forceinline__ void gemm_phase(PG8_LAS unsigned char* lds, const Gemm g, const Sched& S, const Epi& E) {
    const int tid = threadIdx.x, wid = __builtin_amdgcn_readfirstlane(tid >> 6), lane = tid & 63, wr = wid >> 2, wc = wid & 3, fr = lane & 15, fq = lane >> 4;
    const int K = g.K, nt = K / BK;
    unsigned voffA[2], voffB[2];
#pragma unroll
    for (int i = 0; i < 2; ++i) { int R, C; stage_rc(tid * 16 + i * 8192, R, C); const int Rb = Epi::PERM ? ((R & ~31) + perm32(R & 31)) : R;
        voffA[i] = (unsigned)(R * K + C) * 2u; voffB[i] = (unsigned)(Rb * K + C) * 2u; }
    const size_t kstep = (size_t)(BK * 2);
    const size_t hstep = (size_t)HALF * K * 2;
    const size_t tstep = 2 * hstep;
    const unsigned ldsw = (unsigned)wid * 1024u;
    const int aoff = lds_byte(wr * 64 + fr, fq * 8), boff = lds_byte(wc * 32 + fr, fq * 8);
#define PG8_SA(b, h) (((b) * 2 + (h)) * HTB)
#define PG8_SB(b, h) ((4 + (b) * 2 + (h)) * HTB)
#define PG8_STAGE(bufoff, gbase, voff) do { _Pragma("unroll") for (int _i = 0; _i < 2; ++_i) \
        __builtin_amdgcn_global_load_lds((const unsigned*)((const char*)(gbase) + (voff)[_i]), (PG8_LAS unsigned*)(lds + (bufoff) + ldsw + _i * 8192), 16, 0, 0); } while (0)
#define PG8_LDA(dst, b, h) do { _Pragma("unroll") for (int m = 0; m < 4; ++m) _Pragma("unroll") for (int k = 0; k < 2; ++k) dst[m][k] = *(const PG8_LAS bf16x8*)(lds + PG8_SA(b, h) + aoff + m * 2048 + k * 1024); } while (0)
#define PG8_LDB(dst, b, h) do { _Pragma("unroll") for (int n = 0; n < 2; ++n) _Pragma("unroll") for (int k = 0; k < 2; ++k) dst[n][k] = *(const PG8_LAS bf16x8*)(lds + PG8_SB(b, h) + boff + n * 2048 + k * 1024); } while (0)
#define PG8_MMA(ai, bj, At, Bt) do { __builtin_amdgcn_s_setprio(1); _Pragma("unroll") for (int m = 0; m < 4; ++m) _Pragma("unroll") for (int n = 0; n < 2; ++n) _Pragma("unroll") for (int k = 0; k < 2; ++k) \
        acc[ai][bj][m][n] = __builtin_amdgcn_mfma_f32_16x16x32_bf16(Bt[n][k], At[m][k], acc[ai][bj][m][n], 0, 0, 0); __builtin_amdgcn_s_setprio(0); } while (0)
#define PG8_WAIT_V(n) asm volatile("s_waitcnt vmcnt(" #n ")" ::: "memory")
#define PG8_WAIT_L(n) asm volatile("s_waitcnt lgkmcnt(" #n ")" ::: "memory")
#define PG8_BAR __builtin_amdgcn_s_barrier()
#define PG8_SCHED __builtin_amdgcn_sched_barrier(0)
    Unit cur, nxt; int ui = 0;
    if (!S.next(0, cur)) return;
    f32x4 acc[2][2][4][2];
#pragma unroll
    for (int a = 0; a < 2; ++a)
#pragma unroll
        for (int b = 0; b < 2; ++b)
#pragma unroll
            for (int m = 0; m < 4; ++m)
#pragma unroll
                for (int n = 0; n < 2; ++n) acc[a][b][m][n] = (f32x4){0.f, 0.f, 0.f, 0.f};
    bf16x8 At[4][2], B0[2][2], B1[2][2];
    const char* cA = (const char*)g.A + (size_t)cur.pm * tstep; const char* cB = (const char*)g.Bt + (size_t)cur.pn * tstep;
    S.a_ready(cur);
    if constexpr (SP2) {
        PG8_STAGE(PG8_SB(0, 0), cB, voffB); PG8_STAGE(PG8_SB(0, 1), cB + hstep, voffB); PG8_STAGE(PG8_SA(0, 0), cA, voffA); PG8_STAGE(PG8_SA(0, 1), cA + hstep, voffA);
        if (wr == 1) PG8_BAR;
        PG8_WAIT_V(2); PG8_BAR;
        PG8_STAGE(PG8_SB(1, 0), cB + kstep, voffB); PG8_STAGE(PG8_SA(1, 0), cA + kstep, voffA); PG8_STAGE(PG8_SB(1, 1), cB + hstep + kstep, voffB);
        PG8_WAIT_V(6); PG8_BAR;
    } else {
        PG8_STAGE(PG8_SB(0, 0), cB, voffB); PG8_STAGE(PG8_SA(0, 0), cA, voffA); PG8_STAGE(PG8_SB(0, 1), cB + hstep, voffB); PG8_STAGE(PG8_SA(0, 1), cA + hstep, voffA);
        if (wr == 1) PG8_BAR;
        PG8_WAIT_V(4); PG8_BAR;
        PG8_STAGE(PG8_SB(1, 0), cB + kstep, voffB); PG8_STAGE(PG8_SA(1, 0), cA + kstep, voffA); PG8_STAGE(PG8_SB(1, 1), cB + hstep + kstep, voffB);
        PG8_WAIT_V(6); PG8_BAR;
    }
    for (;;) {
        const bool has_next = S.next(ui + 1, nxt);
        const char* nA = has_next ? (const char*)g.A + (size_t)nxt.pm * tstep : cA; const char* nB = has_next ? (const char*)g.Bt + (size_t)nxt.pn * tstep : cB;
        for (int t = 0; t < nt; t += 2) {
            const bool last = (t == nt - 2);
            const char* a1 = cA + (size_t)(t + 1) * kstep;
            const char* a2 = last ? nA : cA + (size_t)(t + 2) * kstep; const char* b2 = last ? nB : cB + (size_t)(t + 2) * kstep;
            const char* a3 = a2 + kstep; const char* b3 = b2 + kstep;
            if (last && has_next) S.a_ready(nxt);
            if constexpr (SP2) {
            PG8_LDB(B0, 0, 0); PG8_LDB(B1, 0, 1); PG8_SCHED; PG8_LDA(At, 0, 0); PG8_STAGE(PG8_SA(1, 1), a1 + hstep, voffA);
            PG8_WAIT_V(8); PG8_WAIT_L(0); PG8_BAR; PG8_MMA(0, 0, At, B0); PG8_MMA(0, 1, At, B1); PG8_BAR; PG8_SCHED;
            PG8_LDA(At, 0, 1); PG8_STAGE(PG8_SB(0, 0), b2, voffB); PG8_STAGE(PG8_SB(0, 1), b2 + hstep, voffB); PG8_STAGE(PG8_SA(0, 0), a2, voffA);
            PG8_WAIT_V(8); PG8_WAIT_L(0); PG8_BAR; PG8_MMA(1, 0, At, B0); PG8_MMA(1, 1, At, B1); PG8_BAR; PG8_SCHED;
            PG8_LDB(B0, 1, 0); PG8_LDB(B1, 1, 1); PG8_SCHED; PG8_LDA(At, 1, 0); PG8_STAGE(PG8_SA(0, 1), a2 + hstep, voffA);
            PG8_WAIT_V(8); PG8_WAIT_L(0); PG8_BAR; PG8_MMA(0, 0, At, B0); PG8_MMA(0, 1, At, B1); PG8_BAR; PG8_SCHED;
            PG8_LDA(At, 1, 1); PG8_STAGE(PG8_SB(1, 0), b3, voffB); PG8_STAGE(PG8_SB(1, 1), b3 + hstep, voffB); PG8_STAGE(PG8_SA(1, 0), a3, voffA);
            PG8_WAIT_V(8); PG8_WAIT_L(0); PG8_BAR; PG8_MMA(1, 0, At, B0); PG8_MMA(1, 1, At, B1); PG8_BAR; PG8_SCHED;
            } else {
            PG8_LDB(B0, 0, 0); PG8_SCHED; PG8_LDA(At, 0, 0); PG8_STAGE(PG8_SA(1, 1), a1 + hstep, voffA);
            PG8_WAIT_L(8); PG8_BAR; PG8_WAIT_L(0); PG8_MMA(0, 0, At, B0); PG8_BAR; PG8_SCHED;
            PG8_LDB(B1, 0, 1); PG8_STAGE(PG8_SB(0, 0), b2, voffB);
            PG8_BAR; PG8_WAIT_L(0); PG8_MMA(0, 1, At, B1); PG8_BAR;
            PG8_LDA(At, 0, 1); PG8_STAGE(PG8_SA(0, 0), a2, voffA);
            PG8_BAR; PG8_WAIT_L(0); PG8_MMA(1, 0, At, B0); PG8_BAR; PG8_SCHED;
            PG8_STAGE(PG8_SB(0, 1), b2 + hstep, voffB);
            PG8_WAIT_V(6); PG8_BAR; PG8_MMA(1, 1, At, B1); PG8_BAR;
            PG8_LDB(B0, 1, 0); PG8_SCHED; PG8_LDA(At, 1, 0); PG8_STAGE(PG8_SA(0, 1), a2 + hstep, voffA);
            PG8_WAIT_L(8); PG8_BAR; PG8_WAIT_L(0); PG8_MMA(0, 0, At, B0); PG8_BAR; PG8_SCHED;
            PG8_LDB(B1, 1, 1); PG8_STAGE(PG8_SB(1, 0), b3, voffB);
            PG8_BAR; PG8_WAIT_L(0); PG8_MMA(0, 1, At, B1); PG8_BAR;
            PG8_LDA(At, 1, 1); PG8_STAGE(PG8_SA(1, 0), a3, voffA);
            PG8_BAR; PG8_WAIT_L(0); PG8_MMA(1, 0, At, B0); PG8_BAR; PG8_SCHED;
            PG8_STAGE(PG8_SB(1, 1), b3 + hstep, voffB);
            PG8_WAIT_V(6); PG8_BAR; PG8_MMA(1, 1, At, B1); PG8_BAR;
            }
        }
        if constexpr (ALIGN_EPI) { if (wr == 0) PG8_BAR; }
        if constexpr (!Epi::AFTER_DRAIN) { E(acc, cur, wr, wc, fr, fq); S.done(cur); }
        if (!has_next) break;
#pragma unroll
        for (int a = 0; a < 2; ++a)
#pragma unroll
            for (int b = 0; b < 2; ++b)
#pragma unroll
                for (int m = 0; m < 4; ++m)
#pragma unroll
                    for (int n = 0; n < 2; ++n) acc[a][b][m][n] = (f32x4){0.f, 0.f, 0.f, 0.f};
        cur = nxt; cA = nA; cB = nB; ++ui;
        if constexpr (ALIGN_EPI) { if (wr == 1) PG8_BAR; }
    }
    PG8_WAIT_V(0);
    if constexpr (!ALIGN_EPI) { if (wr == 0) PG8_BAR; }
    PG8_BAR;
    if constexpr (Epi::AFTER_DRAIN) { E.fused(acc, cur, wr, wc, fr, fq, lds, wid, lane); S.done(cur); }
#undef PG8_SA
#undef PG8_SB
#undef PG8_STAGE
#undef PG8_LDA
#undef PG8_LDB
#undef PG8_MMA
#undef PG8_WAIT_V
#undef PG8_WAIT_L
#undef PG8_BAR
#undef PG8_SCHED
}
}

#ifndef HOST_REP
#define HOST_REP 0
#endif
#ifndef N_LAUNCHES
#define N_LAUNCHES 1
#endif
#define DI __device__ __forceinline__
#define LAS __attribute__((address_space(3)))
using pg8::bf16_t; using pg8::bf16x8; using pg8::f32x4; using pg8::u32x4;
typedef unsigned u32x2 __attribute__((ext_vector_type(2)));
typedef short s16x4 __attribute__((ext_vector_type(4)));
#define MFMA16(a, b, c) __builtin_amdgcn_mfma_f32_16x16x32_bf16((a), (b), (c), 0, 0, 0)

constexpr int D = 1024, MP = 16384, MS = 512, M = MP + MS, SEQ = 2048, INW = 1280, FF = 2816, NG = 32;
constexpr float EPS = 1e-6f;
constexpr size_t O_PRE = 17301504, O_PIM = 17317888, O_PK = 17334272, O_PV = 17465344, O_PCONV = 17596416,
                 O_SRE = 17641472, O_SIM = 17674240, O_SK = 17707008, O_SV = 17772544, O_SCONV = 17838080;
constexpr size_t WS_WIN = 0, WS_WGLU = WS_WIN + (size_t)INW * D * 2, WS_WO = WS_WGLU + 512 * 512 * 2, WS_W1 = WS_WO + (size_t)D * D * 2,
                 WS_W2 = WS_W1 + (size_t)2 * FF * D * 2, WS_KT = WS_W2 + (size_t)D * FF * 2, WS_WT = WS_KT + (size_t)NG * 32 * 256 * 2,
                 WS_PRE = WS_WT + (size_t)NG * 128 * 512 * 2, WS_PIM = WS_PRE + (size_t)NG * 4096 * 4, WS_A32 = WS_PIM + (size_t)NG * 32 * 64 * 4,
                 WS_CT = WS_A32 + (size_t)NG * 64 * 2 * 4, WS_SSQ = WS_CT + (size_t)NG * 16 * 128 * 2, WS_MIX = WS_SSQ + (size_t)M * 16 * 4,
                 WS_X1B = WS_MIX + (size_t)M * D * 2, WS_H = WS_X1B + (size_t)M * D * 2, WS_X1F = WS_H + (size_t)M * FF * 2, WS_PART = WS_X1F + (size_t)M * D * 4, WS_PARTS = WS_PART + (size_t)64 * 4 * 256 * 4, WS_CTL = WS_PARTS + (size_t)256 * 32 * 4, WS_END = WS_CTL + 16384;
constexpr size_t WS_XN = WS_H, WS_U = WS_XN + (size_t)M * D * 2, WS_Q = WS_U + (size_t)M * 512 * 2, WS_KB = WS_Q + (size_t)M * 512 * 2,
                 WS_VT = WS_KB + (size_t)M * 128 * 2, WS_KS = WS_VT + (size_t)MP * 128 * 2, WS_VTS = WS_KS + (size_t)16 * 160 * 128 * 2,
                 WS_HIN = WS_VTS + (size_t)16 * 160 * 128 * 2, WS_UF = WS_HIN + (size_t)512 * NG * 128 * 4, WS_ALIAS_END = WS_UF + (size_t)M * 512 * 2;
static_assert(WS_ALIAS_END <= WS_END && WS_END <= 268435456, "d_ws map");
constexpr int LDS_BYTES = 163840, LDS_X = 131072;

DI unsigned f2bf(float f) { unsigned u = __builtin_bit_cast(unsigned, f); return (u + 0x7fffu + ((u >> 16) & 1u)) >> 16; }
typedef float f32x2_t __attribute__((ext_vector_type(2)));
typedef __bf16 bf16x2_t __attribute__((ext_vector_type(2)));
DI unsigned pk2(float lo, float hi) { f32x2_t v = {lo, hi}; bf16x2_t b = __builtin_convertvector(v, bf16x2_t); return __builtin_bit_cast(unsigned, b); }
DI float bflo(unsigned w) { return __builtin_bit_cast(float, w << 16); }
DI float bfhi(unsigned w) { return __builtin_bit_cast(float, w & 0xffff0000u); }
DI u32x4 pack8(const f32x4& a, const f32x4& b) { u32x4 w; w.x = pk2(a[0], a[1]); w.y = pk2(a[2], a[3]); w.z = pk2(b[0], b[1]); w.w = pk2(b[2], b[3]); return w; }
DI float dot2bf(unsigned a, unsigned b, float c) { return __builtin_amdgcn_fdot2_f32_bf16(__builtin_bit_cast(bf16x2_t, a), __builtin_bit_cast(bf16x2_t, b), c, false); }
DI float sigm(float x) { return __builtin_amdgcn_rcpf(1.0f + __expf(-x)); }
DI float gelu_tanh(float x) { const float z = 0.7978845608f * (x + 0.044715f * x * x * x); return x * sigm(2.0f * z); }
template <int CTRL> DI float dpp_shr(float v) { return __builtin_bit_cast(float, __builtin_amdgcn_update_dpp(0, __builtin_bit_cast(int, v), CTRL, 0xF, 0xF, false)); }
#define GAS __attribute__((address_space(1)))
DI void st_agent(float* p, float v) { __hip_atomic_store((GAS unsigned*)p, __builtin_bit_cast(unsigned, v), __ATOMIC_RELAXED, __HIP_MEMORY_SCOPE_AGENT); }
DI float ld_agent(const float* p) { return __builtin_bit_cast(float, __hip_atomic_load((GAS unsigned*)p, __ATOMIC_RELAXED, __HIP_MEMORY_SCOPE_AGENT)); }
DI void arrive_and_wait(unsigned* cnt, unsigned target) {
    (void)__hip_atomic_fetch_add((GAS unsigned*)cnt, 1u, __ATOMIC_RELAXED, __HIP_MEMORY_SCOPE_AGENT);
    while (__hip_atomic_load((GAS unsigned*)cnt, __ATOMIC_RELAXED, __HIP_MEMORY_SCOPE_AGENT) < target) __builtin_amdgcn_s_sleep(1);
}
DI void wait_ge16(const unsigned* c) { while (__hip_atomic_load((GAS unsigned*)c, __ATOMIC_RELAXED, __HIP_MEMORY_SCOPE_AGENT) < 16u) __builtin_amdgcn_s_sleep(1); }
DI float xsum4(float v) { v += __shfl_xor(v, 16); v += __shfl_xor(v, 32); return v; }

struct Args { const float* in[30]; float* out; unsigned char* ws; int ph_lo, ph_hi; };

struct Frame {
    LAS unsigned char* lds; int tid, lane, wave, G, bid;
    const float* const* in; float* out; unsigned char* ws;
};
#define WSP(T, off) ((T*)(F.ws + (off)))

DI void p0_transpose(const float* __restrict__ W, int N, const float* __restrict__ gk, bf16_t* __restrict__ WT, int ldt, int k0, int n0, int dst0, LAS float* scr, int tid) {
    const int c = tid & 63, r0 = tid >> 6;
#pragma unroll
    for (int i = 0; i < 8; ++i) { const int r = r0 + 8 * i; float v = W[(size_t)(k0 + r) * N + n0 + c]; if (gk) v *= gk[k0 + r]; scr[r * 65 + c] = v; }
    __syncthreads();
#pragma unroll
    for (int i = 0; i < 8; ++i) { const int n = r0 + 8 * i; WT[(size_t)(dst0 + n) * ldt + k0 + c] = (bf16_t)f2bf(scr[c * 65 + n]); }
    __syncthreads();
}

DI void p0_ssm_tables(const Frame& F, int task) {
    const int tid = F.tid, g = task >> 2, part = task & 3;
    LAS float* pwr = (LAS float*)F.lds; LAS float* pwi = pwr + 33 * 64; LAS float* bbr = pwi + 33 * 64; LAS float* bbi = bbr + 1024;
    const float* a_re = F.in[9] + g * 64; const float* a_im = F.in[10] + g * 64;
    const float dt = expf(F.in[11][g]);
    for (int i = tid; i < 33 * 64; i += 512) {
        const int d = i >> 6, n = i & 63; const float fd = (float)d;
        const float mag = expf(a_re[n] * dt * fd), ang = a_im[n] * dt * fd;
        pwr[i] = mag * cosf(ang); pwi[i] = mag * sinf(ang);
    }
    __syncthreads();
    for (int i = tid; i < 1024; i += 512) {
        const int n = i >> 4;
        const float are = a_re[n], aim = a_im[n], nr = pwr[64 + n] - 1.0f, ni = pwi[64 + n], den = are * are + aim * aim;
        const float cr = (nr * are + ni * aim) / den, ci = (ni * are - nr * aim) / den;
        const float br = F.in[12][(size_t)g * 1024 + i], bi = F.in[13][(size_t)g * 1024 + i];
        bbr[i] = cr * br - ci * bi; bbi[i] = cr * bi + ci * br;
    }
    __syncthreads();
    if (part == 0) {
        const int d = tid >> 4, p = tid & 15;
        float acc[16];
#pragma unroll
        for (int q = 0; q < 16; ++q) acc[q] = 0.f;
        const float* cre = F.in[14] + (size_t)(g * 16 + p) * 64; const float* cim = F.in[15] + (size_t)(g * 16 + p) * 64;
        for (int n = 0; n < 64; ++n) {
            const float cr = cre[n], ci = cim[n], pr = pwr[d * 64 + n], pi = pwi[d * 64 + n];
            const float xr = cr * pr - ci * pi, xi = cr * pi + ci * pr;
#pragma unroll
            for (int q = 0; q < 16; ++q) acc[q] += xr * bbr[n * 16 + q] - xi * bbi[n * 16 + q];
        }
        const float dv = (d == 0) ? F.in[16][g * 16 + p] : 0.f;
        u32x4 w0, w1;
#pragma unroll
        for (int q = 0; q < 16; ++q) acc[q] += (q == p) ? dv : 0.f;
        w0.x = pk2(acc[0], acc[1]); w0.y = pk2(acc[2], acc[3]); w0.z = pk2(acc[4], acc[5]); w0.w = pk2(acc[6], acc[7]);
        w1.x = pk2(acc[8], acc[9]); w1.y = pk2(acc[10], acc[11]); w1.z = pk2(acc[12], acc[13]); w1.w = pk2(acc[14], acc[15]);
        bf16_t* dst = WSP(bf16_t, WS_KT) + ((size_t)(g * 16 + (d >> 1)) * 64 + (d & 1) * 32 + p) * 8;
        *(u32x4*)dst = w0; *(u32x4*)(dst + 128) = w1;
    }
    if (part == 1 || part == 2) {
        bf16_t* wt = WSP(bf16_t, WS_WT) + (size_t)g * 65536;
        for (int idx = (part - 1) * 32768 + tid; idx < part * 32768; idx += 512) {
            const int j = idx & 7, lane = (idx >> 3) & 63, kk = (idx >> 9) & 15, nb = idx >> 13;
            const int n2 = nb * 16 + (lane & 15), n = n2 & 63, sidx = 2 * kk + (lane >> 5), pp = ((lane >> 4) & 1) * 8 + j;
            const float pr = pwr[(31 - sidx) * 64 + n], pi = pwi[(31 - sidx) * 64 + n], br = bbr[n * 16 + pp], bi = bbi[n * 16 + pp];
            wt[idx] = (bf16_t)f2bf(n2 < 64 ? pr * br - pi * bi : pr * bi + pi * br);
        }
    }
    if (part == 3) {
    for (int i = tid; i < 4096; i += 512) {
        const int e = i & 3, lane = (i >> 2) & 63, half = (i >> 8) & 1, reim = (i >> 9) & 1, nh = (i >> 10) & 1, mt = i >> 11;
        const int t = mt * 16 + (lane & 15), n = nh * 32 + (lane >> 4) * 8 + half * 4 + e;
        WSP(float, WS_PRE)[(size_t)g * 4096 + i] = reim ? pwi[(t + 1) * 64 + n] : pwr[(t + 1) * 64 + n];
    }
    if (tid < 64) { WSP(float, WS_A32)[(g * 64 + tid) * 2] = pwr[32 * 64 + tid]; WSP(float, WS_A32)[(g * 64 + tid) * 2 + 1] = pwi[32 * 64 + tid]; }
    for (int i = tid; i < 2048; i += 512) {
        const int j = i & 7, lane = (i >> 3) & 63, kk2 = i >> 9, p = lane & 15, n2 = kk2 * 32 + (lane >> 4) * 8 + j;
        const float v = n2 < 64 ? F.in[14][(size_t)(g * 16 + p) * 64 + n2] : -F.in[15][(size_t)(g * 16 + p) * 64 + n2 - 64];
        WSP(bf16_t, WS_CT)[(size_t)g * 2048 + i] = (bf16_t)f2bf(v);
    }
    }
    __syncthreads();
}

DI void p0_prologue(const Frame& F) {
    constexpr int T_SSM = 128, T_WIN = 16 * 20, T_WGLU = 64, T_WO = 256, T_WA = 16 * 44, T_WD = 44 * 16, T_XN = M / 8, T_CK = 64, T_CV = 64;
    LAS float* scr = (LAS float*)F.lds;
    const int G = F.G;
    int r = F.bid;
#define P0_LOOP(COUNT) for (int i = r; i < (COUNT); i += G)
#define P0_NEXT(COUNT) r = (r + G - (COUNT) % G) % G
    P0_LOOP(T_XN) {
        const int row = i * 8 + F.wave;
        const float* xr = row < MP ? F.in[0] + (size_t)row * D : F.in[1] + (size_t)(row - MP) * D;
        f32x4 v[4]; float q = 0.f;
#pragma unroll
        for (int k = 0; k < 4; ++k) { v[k] = *(const f32x4*)(xr + k * 256 + F.lane * 4); q += v[k][0] * v[k][0] + v[k][1] * v[k][1] + v[k][2] * v[k][2] + v[k][3] * v[k][3]; }
#pragma unroll
        for (int o = 1; o < 64; o <<= 1) q += __shfl_xor(q, o);
        const float rr = rsqrtf(q * (1.0f / D) + EPS);
        bf16_t* dst = WSP(bf16_t, WS_XN) + (size_t)row * D;
#pragma unroll
        for (int k = 0; k < 4; ++k) { const f32x4 g = *(const f32x4*)(F.in[7] + k * 256 + F.lane * 4);
            u32x2 w; w.x = pk2(v[k][0] * rr * g[0], v[k][1] * rr * g[1]); w.y = pk2(v[k][2] * rr * g[2], v[k][3] * rr * g[3]); *(u32x2*)(dst + k * 256 + F.lane * 4) = w; }
    }
    P0_NEXT(T_XN);
    P0_LOOP(T_WIN) p0_transpose(F.in[8], INW, nullptr, WSP(bf16_t, WS_WIN), D, (i % 16) * 64, (i / 16) * 64, (i / 16) * 64, scr, F.tid);
    P0_NEXT(T_WIN);
#undef P0_LOOP
#undef P0_NEXT
}

DI void p1_tail(const Frame& F) {
    constexpr int T_SSM = 128, T_WGLU = 64, T_CK = 64, T_CV = 64;
    const int nbusy = (M / 256) * (INW / 256) - F.G;
    if (nbusy < 0 || nbusy >= F.G || F.bid < nbusy) return;
    const int G = F.G - nbusy;
    int r = F.bid - nbusy;
#define P0_LOOP(COUNT) for (int i = r; i < (COUNT); i += G)
#define P0_NEXT(COUNT) r = (r + G - (COUNT) % G) % G
    P0_LOOP(T_SSM) p0_ssm_tables(F, i);
    P0_NEXT(T_SSM);
    P0_LOOP(T_WGLU) {
        const int ch = i * 512 + F.tid, lane = ch & 63, kk = (ch >> 6) & 15, ntg = ch >> 10;
        const float* src = F.in[17] + (size_t)(kk * 32 + (lane >> 4) * 8) * 512 + ntg * 16 + (lane & 15);
        f32x4 a, b;
#pragma unroll
        for (int j = 0; j < 4; ++j) { a[j] = src[(size_t)j * 512]; b[j] = src[(size_t)(j + 4) * 512]; }
        *(u32x4*)(WSP(bf16_t, WS_WGLU) + (size_t)ch * 8) = pack8(a, b);
    }
    P0_NEXT(T_WGLU);
    P0_LOOP(T_CK) {
        const int ch = i * 512 + F.tid, lane = ch & 63, kk = (ch >> 6) & 1, kb = (ch >> 7) & 7, kvh = (ch >> 10) & 1, sb = ch >> 11;
        const float* src = F.in[4] + (((size_t)sb * 128 + kb * 16 + (lane & 15)) * 2 + kvh) * 64 + kk * 32 + (lane >> 4) * 8;
        *(u32x4*)(WSP(bf16_t, WS_KS) + (((size_t)(sb * 2 + kvh) * 10 + kb) * 2 + kk) * 512 + lane * 8) = pack8(*(const f32x4*)src, *(const f32x4*)(src + 4));
    }
    P0_NEXT(T_CK);
    P0_LOOP(T_CV) {
        const int ch = i * 512 + F.tid, lane = ch & 63, db = (ch >> 6) & 3, kb = (ch >> 8) & 3, kvh = (ch >> 10) & 1, sb = ch >> 11;
        const float* src = F.in[5] + (((size_t)sb * 128 + kb * 32 + (lane >> 4) * 4) * 2 + kvh) * 64 + db * 16 + (lane & 15);
        f32x4 a, b;
#pragma unroll
        for (int j = 0; j < 4; ++j) { a[j] = src[(size_t)j * 128]; b[j] = src[(size_t)(16 + j) * 128]; }
        *(u32x4*)(WSP(bf16_t, WS_VTS) + (((size_t)(sb * 2 + kvh) * 5 + kb) * 4 + db) * 512 + lane * 8) = pack8(a, b);
    }
#undef P0_LOOP
#undef P0_NEXT
}

struct EpiIn {
    static constexpr bool PERM = true, AFTER_DRAIN = false;
    unsigned char* ws; float* out;
    DI void operator()(const f32x4 (&acc)[2][2][4][2], const pg8::Unit& u, int wr, int wc, int fr, int fq) const {
        bf16_t* const U = (bf16_t*)(ws + WS_U); bf16_t* const Q = (bf16_t*)(ws + WS_Q); bf16_t* const KB = (bf16_t*)(ws + WS_KB); bf16_t* const VT = (bf16_t*)(ws + WS_VT);
        bf16_t* const KS = (bf16_t*)(ws + WS_KS); bf16_t* const VTS = (bf16_t*)(ws + WS_VTS); bf16_t* const UF = (bf16_t*)(ws + WS_UF);
        const int row0 = u.pm * 256 + wr * 64 + fr;
        if (u.pn < 2) {
            const int colt = u.pn * 256 + wc * 32 + 8 * fq;
#pragma unroll
            for (int ai = 0; ai < 2; ++ai)
#pragma unroll
                for (int m = 0; m < 4; ++m) { const int row = row0 + ai * 128 + m * 16; bf16_t* rp = U + (size_t)row * 512 + colt;
                    const int tq = row < MP ? (row & 2047) : ((row - MP) & 31), sq = tq & 31, chunk = row < MP ? (tq >> 5) : ((row - MP) >> 5);
#pragma unroll
                    for (int bj = 0; bj < 2; ++bj) { const u32x4 w = pack8(acc[ai][bj][m][0], acc[ai][bj][m][1]); *(u32x4*)(rp + bj * 128) = w;
                        const int c0 = colt + bj * 128, g = c0 >> 4, lf = (((sq & 1) * 2 + ((c0 >> 3) & 1)) * 16 + (chunk & 15)) * 8;
                        bf16_t* uf = row < MP ? UF + ((((size_t)((row >> 11) * 32 + g) * 16 + (sq >> 1)) * 4 + (chunk >> 4)) * 64) * 8 + lf
                                              : UF + (size_t)MP * 512 + ((size_t)(g * 16 + (sq >> 1)) * 64) * 8 + lf;
                        *(u32x4*)uf = w; } }
        } else if (u.pn < 4) {
#pragma unroll
            for (int ai = 0; ai < 2; ++ai)
#pragma unroll
                for (int m = 0; m < 4; ++m) { const int rb = (u.pm * 256 + wr * 64 + ai * 128 + m * 16) >> 4;
#pragma unroll
                    for (int bj = 0; bj < 2; ++bj) { const int c0 = (u.pn - 2) * 256 + bj * 128 + wc * 32, h = c0 >> 6, kk = (c0 >> 5) & 1;
                        *(u32x4*)(Q + (((size_t)h * (M / 16) + rb) * 2 + kk) * 512 + (fq * 16 + fr) * 8) = pack8(acc[ai][bj][m][0] * 0.125f, acc[ai][bj][m][1] * 0.125f); } }
        } else {
            const int c = wc * 32 + 8 * fq, kvh = wc >> 1, kk = wc & 1, db = (c >> 4) & 3, fr0 = c & 15;
#pragma unroll
            for (int ai = 0; ai < 2; ++ai)
#pragma unroll
                for (int m = 0; m < 4; ++m) {
                    const int row = row0 + ai * 128 + m * 16;
                    const f32x4 k0 = acc[ai][0][m][0], k1 = acc[ai][0][m][1], v0 = acc[ai][1][m][0], v1 = acc[ai][1][m][1];
                    if (row < MP) {
                        const int b = row >> 11, t = row & 2047;
                        *(u32x4*)(KB + (((size_t)kvh * (M / 16) + (row >> 4)) * 2 + kk) * 512 + (fq * 16 + fr) * 8) = pack8(k0, k1);
                        const int w = t & 31; bf16_t* vt = VT + ((((size_t)(b * 2 + kvh) * 64 + (t >> 5)) * 4 + db) * 64 + ((w & 15) >> 2) * 16 + fr0) * 8 + (w & 3) + 4 * (w >> 4);
#pragma unroll
                        for (int j = 0; j < 4; ++j) { vt[j * 8] = (bf16_t)f2bf(v0[j]); vt[(j + 4) * 8] = (bf16_t)f2bf(v1[j]); }
                        if (t >= 1920) { float* pk = out + O_PK + ((size_t)b * 128 + (t - 1920)) * 128 + c; *(f32x4*)pk = k0; *(f32x4*)(pk + 4) = k1;
                                         float* pv = out + O_PV + ((size_t)b * 128 + (t - 1920)) * 128 + c; *(f32x4*)pv = v0; *(f32x4*)(pv + 4) = v1; }
                    } else {
                        const int sb = (row - MP) >> 5, st = (row - MP) & 31, key = 128 + st;
                        *(u32x4*)(KS + ((((size_t)(sb * 2 + kvh) * 10 + (key >> 4)) * 2 + kk) * 64 + fq * 16 + (key & 15)) * 8) = pack8(k0, k1);
                        const int w = key & 31; bf16_t* vt = VTS + ((((size_t)(sb * 2 + kvh) * 5 + (key >> 5)) * 4 + db) * 64 + ((w & 15) >> 2) * 16 + fr0) * 8 + (w & 3) + 4 * (w >> 4);
#pragma unroll
                        for (int j = 0; j < 4; ++j) { vt[j * 8] = (bf16_t)f2bf(v0[j]); vt[(j + 4) * 8] = (bf16_t)f2bf(v1[j]); }
                        float* pk = out + O_SK + ((size_t)sb * 32 + st) * 128 + c; *(f32x4*)pk = k0; *(f32x4*)(pk + 4) = k1;
                        float* pv = out + O_SV + ((size_t)sb * 32 + st) * 128 + c; *(f32x4*)pv = v0; *(f32x4*)(pv + 4) = v1;
                    }
                }
        }
    }
};

constexpr int LDO = 520;
DI void attn_task(const bf16_t* __restrict__ Qp, int nqb, const bf16_t* __restrict__ Kp, int nkb, const bf16_t* __restrict__ Vtp, int vstride,
                  float sink, const float* __restrict__ gat, bf16_t* __restrict__ outp, LAS float* ob, int h, int wave, int lane) {
    const int fr = lane & 15, fq = lane >> 4;
#pragma unroll 1
    for (int qb = 0; qb < nqb; ++qb) {
        const bf16_t* qrow = Qp + (size_t)qb * 1024 + lane * 8;
        const bf16x8 q0 = *(const bf16x8*)qrow, q1 = *(const bf16x8*)(qrow + 512);
        f32x4 s[12];
#pragma unroll
        for (int kb = 0; kb < 12; ++kb) {
            s[kb] = (f32x4){-INFINITY, -INFINITY, -INFINITY, -INFINITY};
            if (kb < nkb) {
                const bf16_t* krow = Kp + (size_t)kb * 1024 + lane * 8;
                const bf16x8 k0 = *(const bf16x8*)krow, k1 = *(const bf16x8*)(krow + 512);
                f32x4 z = (f32x4){0.f, 0.f, 0.f, 0.f};
                z = MFMA16(k0, q0, z); z = MFMA16(k1, q1, z); s[kb] = z;
            }
        }
        float m = sink;
#pragma unroll
        for (int kb = 0; kb < 12; ++kb) m = fmaxf(fmaxf(m, fmaxf(s[kb][0], s[kb][1])), fmaxf(s[kb][2], s[kb][3]));
        m = fmaxf(m, __shfl_xor(m, 16)); m = fmaxf(m, __shfl_xor(m, 32));
        float sum = 0.f;
#pragma unroll
        for (int kb = 0; kb < 12; ++kb)
#pragma unroll
            for (int e = 0; e < 4; ++e) { const float p = __expf(s[kb][e] - m); s[kb][e] = p; sum += p; }
        sum = xsum4(sum);
        const float inv = 1.0f / (sum + __expf(sink - m));
        f32x4 o[4];
#pragma unroll
        for (int db = 0; db < 4; ++db) o[db] = (f32x4){0.f, 0.f, 0.f, 0.f};
#pragma unroll
        for (int ks = 0; ks < 6; ++ks) {
            if (2 * ks < nkb) {
                const bf16x8 pb = __builtin_bit_cast(bf16x8, pack8(s[2 * ks], s[2 * ks + 1]));
#pragma unroll
                for (int db = 0; db < 4; ++db) {
                    const bf16x8 vf = *(const bf16x8*)(Vtp + (size_t)(ks * 4 + db) * 512 + lane * 8);
                    o[db] = MFMA16(vf, pb, o[db]);
                }
                if (ks & 1) __builtin_amdgcn_sched_barrier(0);
            }
        }
#pragma unroll
        for (int db = 0; db < 4; ++db) *(LAS f32x4*)(ob + (qb * 16 + fr) * LDO + h * 64 + db * 16 + fq * 4) = o[db] * inv;
    }
    __syncthreads();
    const int rpw = nqb * 2;
    const f32x4 g0 = *(const f32x4*)(gat + lane * 8), g1 = *(const f32x4*)(gat + lane * 8 + 4);
#pragma unroll 1
    for (int i = 0; i < rpw; ++i) {
        const int r = wave * rpw + i;
        f32x4 v0 = *(const LAS f32x4*)(ob + r * LDO + lane * 8), v1 = *(const LAS f32x4*)(ob + r * LDO + lane * 8 + 4);
        float q = v0[0] * v0[0] + v0[1] * v0[1] + v0[2] * v0[2] + v0[3] * v0[3] + v1[0] * v1[0] + v1[1] * v1[1] + v1[2] * v1[2] + v1[3] * v1[3];
#pragma unroll
        for (int o2 = 1; o2 < 64; o2 <<= 1) q += __shfl_xor(q, o2);
        const float rs = rsqrtf(q * (1.0f / 512.0f) + EPS);
        *(u32x4*)(outp + (size_t)r * D + lane * 8) = pack8(v0 * rs * g0, v1 * rs * g1);
    }
    __syncthreads();
}

template <int MT, bool SAMPLE>
DI void ssm_state(const Frame& F, int b, int g) {
    const int lane = F.lane, fr = lane & 15, fq = lane >> 4;
    const bf16_t* Ub = WSP(bf16_t, WS_UF) + (SAMPLE ? (size_t)MP * 512 + (size_t)g * 16 * 512 : (size_t)(b * 32 + g) * 16 * 2048) + lane * 8;
    const bf16_t* Wg = WSP(bf16_t, WS_WT) + (size_t)g * 65536 + lane * 8;
    const float* A32 = WSP(float, WS_A32) + g * 128;
    float* HIN = WSP(float, WS_HIN);
#pragma unroll 1
    for (int h2 = 0; h2 < 2; ++h2) {
        f32x4 acc[MT][4];
#pragma unroll
        for (int mt = 0; mt < MT; ++mt)
#pragma unroll
            for (int j = 0; j < 4; ++j) acc[mt][j] = (f32x4){0.f, 0.f, 0.f, 0.f};
#pragma unroll 2
        for (int kk = 0; kk < 16; ++kk) {
            bf16x8 a[MT], w[4];
#pragma unroll
            for (int mt = 0; mt < MT; ++mt) a[mt] = *(const bf16x8*)(Ub + (size_t)kk * (SAMPLE ? 512 : 2048) + mt * 512);
#pragma unroll
            for (int j = 0; j < 4; ++j) { const int nb = (j < 2) ? 2 * h2 + j : 4 + 2 * h2 + (j - 2); w[j] = *(const bf16x8*)(Wg + (size_t)(nb * 16 + kk) * 512); }
#pragma unroll
            for (int mt = 0; mt < MT; ++mt)
#pragma unroll
                for (int j = 0; j < 4; ++j) acc[mt][j] = MFMA16(a[mt], w[j], acc[mt][j]);
        }
#pragma unroll
        for (int i = 0; i < 2; ++i) {
            const int n = (2 * h2 + i) * 16 + fr;
            const float ar = A32[n * 2], ai = A32[n * 2 + 1];
            if constexpr (SAMPLE) {
#pragma unroll
                for (int e = 0; e < 4; ++e) {
                    const int sb = fq * 4 + e; const size_t idx = ((size_t)sb * 32 + g) * 64 + n;
                    const float hr = F.in[2][idx], hi = F.in[3][idx];
                    F.out[O_SRE + idx] = ar * hr - ai * hi + acc[0][i][e]; F.out[O_SIM + idx] = ar * hi + ai * hr + acc[0][2 + i][e];
                }
            } else {
            const float a2r = ar * ar - ai * ai, a2i = 2.f * ar * ai, a3r = a2r * ar - a2i * ai, a3i = a2r * ai + a2i * ar, a4r = a2r * a2r - a2i * a2i, a4i = 2.f * a2r * a2i;
            float h1r[MT], h1i[MT], h2r[MT], h2i[MT], h3r[MT], h3i[MT], er[MT], ei[MT], cr[MT], ci[MT];
#pragma unroll
            for (int mt = 0; mt < MT; ++mt) {
                const f32x4 sr = acc[mt][i], si = acc[mt][2 + i];
                h1r[mt] = sr[0]; h1i[mt] = si[0];
                h2r[mt] = ar * h1r[mt] - ai * h1i[mt] + sr[1]; h2i[mt] = ar * h1i[mt] + ai * h1r[mt] + si[1];
                h3r[mt] = ar * h2r[mt] - ai * h2i[mt] + sr[2]; h3i[mt] = ar * h2i[mt] + ai * h2r[mt] + si[2];
                er[mt] = ar * h3r[mt] - ai * h3i[mt] + sr[3]; ei[mt] = ar * h3i[mt] + ai * h3r[mt] + si[3];
                cr[mt] = 0.f; ci[mt] = 0.f;
            }
            float kr = 0.f, ki = 0.f;
#pragma unroll
            for (int gi = 0; gi < 4 * MT; ++gi) {
                const int mt = gi >> 2, src = (gi & 3) * 16 + fr;
                const float xr = __shfl(er[mt], src), xi = __shfl(ei[mt], src);
                if ((gi & 3) == fq) { cr[mt] = kr; ci[mt] = ki; }
                const float nr = a4r * kr - a4i * ki + xr, ni = a4r * ki + a4i * kr + xi; kr = nr; ki = ni;
            }
            if (fq == 0) { F.out[O_PRE + ((size_t)b * 32 + g) * 64 + n] = kr; F.out[O_PIM + ((size_t)b * 32 + g) * 64 + n] = ki; }
#pragma unroll
            for (int mt = 0; mt < MT; ++mt) {
                const int c0 = mt * 16 + fq * 4;
                float* hp = HIN + (((size_t)b * 64 + c0) * 32 + g) * 128 + n;
                const float kr0 = cr[mt], ki0 = ci[mt];
                hp[0] = kr0; hp[64] = ki0;
                hp[4096] = ar * kr0 - ai * ki0 + h1r[mt]; hp[4096 + 64] = ar * ki0 + ai * kr0 + h1i[mt];
                hp[8192] = a2r * kr0 - a2i * ki0 + h2r[mt]; hp[8192 + 64] = a2r * ki0 + a2i * kr0 + h2i[mt];
                hp[12288] = a3r * kr0 - a3i * ki0 + h3r[mt]; hp[12288 + 64] = a3r * ki0 + a3i * kr0 + h3i[mt];
            }
            }
        }
    }
}

DI void p23_phase(const Frame& F) {
    constexpr int T_SSM = 36, T_ATT = 272, T_P3 = 528;
    unsigned* hc = WSP(unsigned, WS_CTL) + 3584 + 224;
    LAS float* ob = (LAS float*)F.lds;
    for (int t = F.bid; t < T_SSM; t += F.G) {
        const int wt = t * 8 + F.wave;
        if (wt < 256) ssm_state<4, false>(F, wt >> 5, wt & 31); else ssm_state<1, true>(F, 0, wt - 256);
        asm volatile("s_waitcnt vmcnt(0)" ::: "memory");
        __syncthreads();
        if (F.tid == 0 && t < 32) {
            __builtin_amdgcn_fence(__ATOMIC_RELEASE, "agent");
            asm volatile("s_waitcnt vmcnt(0)" ::: "memory");
            (void)__hip_atomic_fetch_add((GAS unsigned*)(hc + (t >> 2)), 1u, __ATOMIC_RELAXED, __HIP_MEMORY_SCOPE_AGENT);
        }
    }
    const int t0 = (F.bid >= T_SSM % F.G) ? F.bid - T_SSM % F.G : F.bid + F.G - T_SSM % F.G;
    for (int a = t0; a < T_ATT; a += F.G) {
        const int h = F.wave, kvh = h >> 2;
        const float sink = F.in[19][h]; const float* gat = F.in[21];
        if (a < 256) {
            const int b = a >> 5, c = a & 31, c0 = c < 2 ? 0 : c - 2, row0 = b * SEQ + c * 64;
            attn_task(WSP(bf16_t, WS_Q) + ((size_t)h * (M / 16) + (row0 >> 4)) * 1024, 4, WSP(bf16_t, WS_KB) + ((size_t)kvh * (M / 16) + ((b * SEQ + c0 * 64) >> 4)) * 1024, (c - c0 + 1) * 4,
                      WSP(bf16_t, WS_VT) + ((size_t)(b * 2 + kvh) * 64 + c0 * 2) * 2048, 0, sink, gat, WSP(bf16_t, WS_MIX) + (size_t)row0 * D + 512, ob, h, F.wave, F.lane);
        } else {
            const int sb = a - 256, row0 = MP + sb * 32;
            attn_task(WSP(bf16_t, WS_Q) + ((size_t)h * (M / 16) + (row0 >> 4)) * 1024, 2, WSP(bf16_t, WS_KS) + (size_t)(sb * 2 + kvh) * 10 * 1024, 10,
                      WSP(bf16_t, WS_VTS) + (size_t)(sb * 2 + kvh) * 5 * 2048, 0, sink, gat, WSP(bf16_t, WS_MIX) + (size_t)row0 * D + 512, ob, h, F.wave, F.lane);
        }
    }
}
constexpr int P3_LDY = 520, P3_LDU = 72, P3_UST = 36864;
DI void p3_zero(const Frame& F) {
    LAS u32x4* z = (LAS u32x4*)(F.lds + P3_UST + F.wave * (64 * P3_LDU * 2));
    for (int i = F.lane; i < 32 * P3_LDU * 2 / 16; i += 64) z[i] = (u32x4){0u, 0u, 0u, 0u};
}
DI void p3_task(const Frame& F, int ci) {
    const int lane = F.lane, fr = lane & 15, fq = lane >> 4, wave = F.wave;
    const int row0 = ci < 512 ? (ci >> 6) * SEQ + (ci & 63) * 32 : MP + (ci - 512) * 32;
    constexpr int LDY = P3_LDY, LDU = P3_LDU;
    LAS bf16_t* y1 = (LAS bf16_t*)F.lds; LAS float* ssq = (LAS float*)(F.lds + 32 * LDY * 2);
    LAS bf16_t* ust = (LAS bf16_t*)(F.lds + P3_UST) + wave * (64 * LDU);
    {
        const bf16_t* up = WSP(bf16_t, WS_U) + (size_t)(row0 + (lane >> 3)) * 512 + wave * 64 + (lane & 7) * 8;
#pragma unroll
        for (int i = 0; i < 4; ++i) *(LAS u32x4*)(ust + (32 + (lane >> 3) + 8 * i) * LDU + (lane & 7) * 8) = *(const u32x4*)(up + (size_t)i * 8 * 512);
    }
#pragma unroll 1
    for (int gi = 0; gi < 4; ++gi) {
        const int g = wave * 4 + gi;
        f32x4 acc0 = (f32x4){0.f, 0.f, 0.f, 0.f}, acc1 = acc0;
        const bf16_t* Kg = WSP(bf16_t, WS_KT) + (size_t)g * 8192 + lane * 8;
        const LAS bf16_t* ub = ust + (32 + fr - (fq >> 1)) * LDU + gi * 16 + (fq & 1) * 8;
#pragma unroll
        for (int kk = 0; kk < 16; ++kk) {
            const bf16x8 kf = *(const bf16x8*)(Kg + kk * 512);
            acc1 = MFMA16(kf, *(const LAS bf16x8*)(ub + (16 - 2 * kk) * LDU), acc1);
            if (kk < 8) acc0 = MFMA16(kf, *(const LAS bf16x8*)(ub - 2 * kk * LDU), acc0);
        }
        const float* hre; const float* him;
        if (ci < 512) { hre = WSP(float, WS_HIN) + ((size_t)ci * 32 + g) * 128; him = hre + 64; }
        else { hre = F.in[2] + ((size_t)(ci - 512) * 32 + g) * 64; him = F.in[3] + ((size_t)(ci - 512) * 32 + g) * 64; }
#pragma unroll
        for (int nh = 0; nh < 2; ++nh) {
            const int n0 = nh * 32 + fq * 8;
            const f32x4 hr0 = *(const f32x4*)(hre + n0), hr1 = *(const f32x4*)(hre + n0 + 4), hi0 = *(const f32x4*)(him + n0), hi1 = *(const f32x4*)(him + n0 + 4);
            const bf16_t* cp = WSP(bf16_t, WS_CT) + (size_t)g * 2048 + lane * 8;
            const bf16x8 cref = *(const bf16x8*)(cp + nh * 512), cimf = *(const bf16x8*)(cp + (2 + nh) * 512);
#pragma unroll
            for (int mt = 0; mt < 2; ++mt) {
                const float* pp = WSP(float, WS_PRE) + (size_t)g * 4096 + (mt * 2 + nh) * 1024 + lane * 4;
                const f32x4 pr0 = *(const f32x4*)pp, pr1 = *(const f32x4*)(pp + 256), pi0 = *(const f32x4*)(pp + 512), pi1 = *(const f32x4*)(pp + 768);
                const f32x4 gr0 = pr0 * hr0 - pi0 * hi0, gr1 = pr1 * hr1 - pi1 * hi1, gi0 = pr0 * hi0 + pi0 * hr0, gi1 = pr1 * hi1 + pi1 * hr1;
                const bf16x8 gre = __builtin_bit_cast(bf16x8, pack8(gr0, gr1)), gim = __builtin_bit_cast(bf16x8, pack8(gi0, gi1));
                if (mt == 0) { acc0 = MFMA16(cref, gre, acc0); acc0 = MFMA16(cimf, gim, acc0); }
                else         { acc1 = MFMA16(cref, gre, acc1); acc1 = MFMA16(cimf, gim, acc1); }
            }
        }
        {   u32x2 w; w.x = pk2(gelu_tanh(acc0[0]), gelu_tanh(acc0[1])); w.y = pk2(gelu_tanh(acc0[2]), gelu_tanh(acc0[3]));
            *(LAS u32x2*)(y1 + fr * LDY + g * 16 + fq * 4) = w;
            w.x = pk2(gelu_tanh(acc1[0]), gelu_tanh(acc1[1])); w.y = pk2(gelu_tanh(acc1[2]), gelu_tanh(acc1[3]));
            *(LAS u32x2*)(y1 + (16 + fr) * LDY + g * 16 + fq * 4) = w; }
    }
    __syncthreads();
    f32x4 a2[2][4];
#pragma unroll
    for (int mt = 0; mt < 2; ++mt)
#pragma unroll
        for (int nt = 0; nt < 4; ++nt) a2[mt][nt] = (f32x4){0.f, 0.f, 0.f, 0.f};
    const bf16_t* Wg = WSP(bf16_t, WS_WGLU) + (size_t)(wave * 4) * 8192 + lane * 8;
#pragma unroll 4
    for (int kk = 0; kk < 16; ++kk) {
        bf16x8 yf[2], wf[4];
#pragma unroll
        for (int mt = 0; mt < 2; ++mt) yf[mt] = *(const LAS bf16x8*)(y1 + (mt * 16 + fr) * LDY + kk * 32 + fq * 8);
#pragma unroll
        for (int nt = 0; nt < 4; ++nt) wf[nt] = *(const bf16x8*)(Wg + (size_t)nt * 8192 + kk * 512);
#pragma unroll
        for (int mt = 0; mt < 2; ++mt)
#pragma unroll
            for (int nt = 0; nt < 4; ++nt) a2[mt][nt] = MFMA16(wf[nt], yf[mt], a2[mt][nt]);
    }
    float q2[2] = {0.f, 0.f};
#pragma unroll
    for (int mt = 0; mt < 2; ++mt)
#pragma unroll
        for (int nt = 0; nt < 4; ++nt) {
            const int n = wave * 64 + nt * 16 + fq * 4;
            const f32x4 bias = *(const f32x4*)(F.in[18] + n);
            const u32x2 yw = *(const LAS u32x2*)(y1 + (mt * 16 + fr) * LDY + n);
            const float y0 = bflo(yw.x), y1v = bfhi(yw.x), y2v = bflo(yw.y), y3 = bfhi(yw.y);
            f32x4 r; r[0] = y0 * sigm(a2[mt][nt][0] + bias[0]); r[1] = y1v * sigm(a2[mt][nt][1] + bias[1]); r[2] = y2v * sigm(a2[mt][nt][2] + bias[2]); r[3] = y3 * sigm(a2[mt][nt][3] + bias[3]);
            a2[mt][nt] = r; q2[mt] += r[0] * r[0] + r[1] * r[1] + r[2] * r[2] + r[3] * r[3];
        }
    q2[0] = xsum4(q2[0]); q2[1] = xsum4(q2[1]);
    if (fq == 0) { ssq[wave * 32 + fr] = q2[0]; ssq[wave * 32 + 16 + fr] = q2[1]; }
    __syncthreads();
#pragma unroll
    for (int mt = 0; mt < 2; ++mt) {
        float tot = 0.f;
#pragma unroll
        for (int w = 0; w < 8; ++w) tot += ssq[w * 32 + mt * 16 + fr];
        const float rs = rsqrtf(tot * (1.0f / 512.0f) + EPS);
#pragma unroll
        for (int nt = 0; nt < 4; ++nt) {
            const int n = wave * 64 + nt * 16 + fq * 4;
            const f32x4 g = *(const f32x4*)(F.in[20] + n);
            u32x2 w; w.x = pk2(a2[mt][nt][0] * rs * g[0], a2[mt][nt][1] * rs * g[1]); w.y = pk2(a2[mt][nt][2] * rs * g[2], a2[mt][nt][3] * rs * g[3]);
            *(u32x2*)(WSP(bf16_t, WS_MIX) + (size_t)(row0 + mt * 16 + fr) * D + n) = w;
        }
    }
    __syncthreads();
}

DI void late_weights(const Frame& F) {
    constexpr int T_WO = 256, T_WA = 16 * 44, T_WD = 44 * 16;
    LAS float* scr = (LAS float*)F.lds;
    const int nskip = ((36 + 272 + 528) % F.G), G = F.G - nskip;
    if (F.bid < nskip || G <= 0) return;
    int r = F.bid - nskip;
#define P0_LOOP(COUNT) for (int i = r; i < (COUNT); i += G)
#define P0_NEXT(COUNT) r = (r + G - (COUNT) % G) % G
    P0_LOOP(T_WO) p0_transpose(F.in[22], D, nullptr, WSP(bf16_t, WS_WO), D, (i % 16) * 64, (i / 16) * 64, (i / 16) * 64, scr, F.tid);
    P0_NEXT(T_WO);
    P0_LOOP(T_WA) { const int n0 = (i / 16) * 64; p0_transpose(F.in[24], FF, F.in[23], WSP(bf16_t, WS_W1), D, (i % 16) * 64, n0, (n0 >> 7) * 256 + (n0 & 127), scr, F.tid); }
    P0_NEXT(T_WA);
    P0_LOOP(T_WA) { const int n0 = (i / 16) * 64; p0_transpose(F.in[25], FF, F.in[23], WSP(bf16_t, WS_W1), D, (i % 16) * 64, n0, (n0 >> 7) * 256 + 128 + (n0 & 127), scr, F.tid); }
    P0_NEXT(T_WA);
    P0_LOOP(T_WD) p0_transpose(F.in[28], D, nullptr, WSP(bf16_t, WS_W2), FF, (i % 44) * 64, (i / 44) * 64, (i / 44) * 64, scr, F.tid);
    P0_NEXT(T_WD);
#undef P0_LOOP
#undef P0_NEXT
}

DI void p3_loop(const Frame& F) {
    constexpr int T_PRE = 36 + 272, T_P3 = 528;
    unsigned* hc = WSP(unsigned, WS_CTL) + 3584 + 224;
    p3_zero(F);
    const int r0 = T_PRE % F.G, c0 = (F.bid >= r0) ? F.bid - r0 : F.bid + F.G - r0;
    for (int ci = c0; ci < T_P3; ci += F.G) {
        if (ci < 512) {
            if (F.tid == 0) {
                while (__hip_atomic_load((GAS unsigned*)(hc + (ci >> 6)), __ATOMIC_RELAXED, __HIP_MEMORY_SCOPE_AGENT) < 4u) __builtin_amdgcn_s_sleep(1);
                __builtin_amdgcn_fence(__ATOMIC_ACQUIRE, "agent");
                asm volatile("s_waitcnt vmcnt(0)" ::: "memory");
            }
            __syncthreads();
        }
        p3_task(F, ci);
    }
}

DI void panel_rs(float* part, unsigned* cnt, LAS float* lx, int pm, int pn, float* rs_out = nullptr) {
    const int tid = threadIdx.x;
    __syncthreads();
    if (tid < 256) st_agent(part + (size_t)(pm * 4 + pn) * 256 + tid, lx[tid] + lx[256 + tid] + lx[512 + tid] + lx[768 + tid]);
    asm volatile("s_waitcnt vmcnt(0)" ::: "memory");
    __syncthreads();
    if (tid == 0) arrive_and_wait(cnt + pm, 4u);
    __syncthreads();
    if (tid < 256) { const float* pp = part + (size_t)pm * 1024 + tid; const float r = rsqrtf((ld_agent(pp) + ld_agent(pp + 256) + ld_agent(pp + 512) + ld_agent(pp + 768)) * (1.0f / D) + EPS); lx[1024 + tid] = r;
        if (rs_out && pn == 0) rs_out[pm * 256 + tid] = r; }
    __syncthreads();
}
struct EpiOut {
    static constexpr bool PERM = true, AFTER_DRAIN = false;
    const float* xp; float* RS; bf16_t* X1B; float* part; unsigned* cnt; LAS float* lx;
    DI void operator()(const f32x4 (&acc_)[2][2][4][2], const pg8::Unit& u, int wr, int wc, int fr, int fq) const {
        f32x4 (&acc)[2][2][4][2] = const_cast<f32x4 (&)[2][2][4][2]>(acc_);
        const int row0 = u.pm * 256 + wr * 64 + fr, col0 = u.pn * 256 + wc * 32 + 8 * fq;
#pragma unroll
        for (int ai = 0; ai < 2; ++ai)
#pragma unroll
            for (int m = 0; m < 4; ++m) {
                const size_t ro = (size_t)(row0 + ai * 128 + m * 16) * D + col0;
                float q = 0.f;
#pragma unroll
                for (int bj = 0; bj < 2; ++bj) {
                    const f32x4 v0 = acc[ai][bj][m][0] + *(const f32x4*)(xp + ro + bj * 128), v1 = acc[ai][bj][m][1] + *(const f32x4*)(xp + ro + bj * 128 + 4);
                    acc[ai][bj][m][0] = v0; acc[ai][bj][m][1] = v1;
                    q += v0[0] * v0[0] + v0[1] * v0[1] + v0[2] * v0[2] + v0[3] * v0[3] + v1[0] * v1[0] + v1[1] * v1[1] + v1[2] * v1[2] + v1[3] * v1[3];
                }
                q = xsum4(q);
                if (fq == 0) lx[wc * 256 + ai * 128 + wr * 64 + m * 16 + fr] = q;
            }
        panel_rs(part, cnt, lx, u.pm, u.pn, RS);
#pragma unroll
        for (int ai = 0; ai < 2; ++ai)
#pragma unroll
            for (int m = 0; m < 4; ++m) {
                const float rs = lx[1024 + ai * 128 + wr * 64 + m * 16 + fr];
                const size_t ro = (size_t)(row0 + ai * 128 + m * 16) * D + col0;
#pragma unroll
                for (int bj = 0; bj < 2; ++bj) *(u32x4*)(X1B + ro + bj * 128) = pack8(acc[ai][bj][m][0] * rs, acc[ai][bj][m][1] * rs);
            }
    }
};

struct EpiFfn {
    static constexpr bool PERM = true, AFTER_DRAIN = false;
    unsigned char* ws; const float* const* in; float* out; LAS float* bnd;
    DI void operator()(const f32x4 (&acc)[2][2][4][2], const pg8::Unit& u, int wr, int wc, int fr, int fq) const {
        const bf16_t* const X1B = (const bf16_t*)(ws + WS_X1B); const bf16_t* const W1T = (const bf16_t*)(ws + WS_W1);
        bf16_t* const H = (bf16_t*)(ws + WS_H); const float* const cstate = in[6];
        const int pm = u.pm, pn = u.pn, rowt = pm * 256, wave = wr * 4 + wc, tid = threadIdx.x;
        const bool sample = pm >= 64;
        const int cl = wc * 32 + 8 * fq, ff = pn * 128 + cl;
        LAS float* cwl = bnd + 17 * 2 * 128;
        if (tid < 128) { const float* cw = in[26] + pn * 128 + tid; cwl[tid] = cw[0]; cwl[128 + tid] = cw[FF]; cwl[256 + tid] = cw[2 * FF]; cwl[384 + tid] = in[27][pn * 128 + tid]; }
#pragma unroll
        for (int ai = 0; ai < 2; ++ai)
#pragma unroll
            for (int m = 0; m < 4; ++m) {
                const int blk = 8 * ai + 4 * wr + m;
                if (fr >= 14) {
                    const f32x4 a0 = acc[ai][0][m][0], a1 = acc[ai][0][m][1];
                    if (!sample || (blk & 1) == 0) { LAS float* bp = bnd + ((blk + 1) * 2 + (fr - 14)) * 128 + cl; *(LAS f32x4*)bp = a0; *(LAS f32x4*)(bp + 4) = a1; }
                    if (sample && (blk & 1)) { float* sp = out + O_SCONV + ((size_t)((pm - 64) * 8 + (blk >> 1)) * 2 + (fr - 14)) * FF + ff; *(f32x4*)sp = a0; *(f32x4*)(sp + 4) = a1; }
                    if (!sample && (pm & 7) == 7 && blk == 15) { float* sp = out + O_PCONV + ((size_t)(pm >> 3) * 2 + (fr - 14)) * FF + ff; *(f32x4*)sp = a0; *(f32x4*)(sp + 4) = a1; }
                    if (sample && (blk & 1) == 0) {
                        const float* sp = cstate + ((size_t)((pm - 64) * 8 + (blk >> 1)) * 2 + (fr - 14)) * FF + ff;
                        LAS float* bp = bnd + (blk * 2 + (fr - 14)) * 128 + cl; *(LAS f32x4*)bp = *(const f32x4*)sp; *(LAS f32x4*)(bp + 4) = *(const f32x4*)(sp + 4);
                    }
                    if (!sample && (pm & 7) == 0 && blk == 0) { LAS float* bp = bnd + (fr - 14) * 128 + cl; *(LAS f32x4*)bp = (f32x4){0.f, 0.f, 0.f, 0.f}; *(LAS f32x4*)(bp + 4) = (f32x4){0.f, 0.f, 0.f, 0.f}; }
                }
            }
        if (!sample && (pm & 7) != 0) {
            const int lane = fq * 16 + fr;
            const bf16_t* xp = X1B + (size_t)(rowt - 2) * D + lane * 8;
            const u32x4 xa0 = *(const u32x4*)xp, xa1 = *(const u32x4*)(xp + 512), xb0 = *(const u32x4*)(xp + D), xb1 = *(const u32x4*)(xp + D + 512);
#pragma unroll 1
            for (int ps = 0; ps < 4; ++ps) {
                float p0[4], p1[4];
                const bf16_t* wp = W1T + (size_t)(pn * 256 + wave * 16 + ps * 4) * D + lane * 8;
#pragma unroll
                for (int c = 0; c < 4; ++c) {
                    const u32x4 a = *(const u32x4*)(wp + (size_t)c * D), b = *(const u32x4*)(wp + (size_t)c * D + 512);
                    float s0 = 0.f, s1 = 0.f;
#pragma unroll
                    for (int j = 0; j < 4; ++j) {
                        s0 = dot2bf(a[j], xa0[j], s0); s0 = dot2bf(b[j], xa1[j], s0);
                        s1 = dot2bf(a[j], xb0[j], s1); s1 = dot2bf(b[j], xb1[j], s1);
                    }
                    p0[c] = s0; p1[c] = s1;
                }
#define HALO_STEP(N, BIT) _Pragma("unroll") for (int c = 0; c < N; ++c) { const bool hi_ = (lane & BIT) != 0; \
                    const float s0_ = hi_ ? p0[c] : p0[c + N], s1_ = hi_ ? p1[c] : p1[c + N]; \
                    const float r0_ = __shfl_xor(s0_, BIT), r1_ = __shfl_xor(s1_, BIT); \
                    p0[c] = (hi_ ? p0[c + N] : p0[c]) + r0_; p1[c] = (hi_ ? p1[c + N] : p1[c]) + r1_; }
                HALO_STEP(2, 32) HALO_STEP(1, 16)
#undef HALO_STEP
                float t0 = p0[0], t1 = p1[0];
                t0 += __shfl_xor(t0, 8); t1 += __shfl_xor(t1, 8); t0 += __shfl_xor(t0, 4); t1 += __shfl_xor(t1, 4); t0 += __shfl_xor(t0, 2); t1 += __shfl_xor(t1, 2); t0 += __shfl_xor(t0, 1); t1 += __shfl_xor(t1, 1);
                if ((lane & 15) == 0) { const int col = wave * 16 + ps * 4 + ((lane >> 5) & 1) * 2 + ((lane >> 4) & 1);
                    bnd[col] = t0; bnd[128 + col] = t1; }
            }
        }
        __syncthreads();
#pragma unroll
        for (int ai = 0; ai < 2; ++ai)
#pragma unroll
            for (int m = 0; m < 4; ++m) {
                const int blk = 8 * ai + 4 * wr + m, row = rowt + ai * 128 + wr * 64 + m * 16 + fr;
                f32x4 hv[2];
#pragma unroll
                for (int n = 0; n < 2; ++n) {
                    const f32x4 cur = acc[ai][0][m][n], upv = acc[ai][1][m][n];
                    f32x4 p1, p2;
#pragma unroll
                    for (int e = 0; e < 4; ++e) { p1[e] = dpp_shr<0x111>(cur[e]); p2[e] = dpp_shr<0x112>(cur[e]); }
                    const f32x4 b0 = *(const LAS f32x4*)(bnd + (blk * 2 + 0) * 128 + cl + 4 * n), b1 = *(const LAS f32x4*)(bnd + (blk * 2 + 1) * 128 + cl + 4 * n);
                    if (fr == 0) { p1 = b1; p2 = b0; } else if (fr == 1) { p2 = b1; }
                    const LAS float* wl = cwl + cl + 4 * n;
                    const f32x4 c = *(const LAS f32x4*)(wl + 384) + *(const LAS f32x4*)wl * p2 + *(const LAS f32x4*)(wl + 128) * p1 + *(const LAS f32x4*)(wl + 256) * cur;
#pragma unroll
                    for (int e = 0; e < 4; ++e) hv[n][e] = c[e] * sigm(c[e]) * upv[e];
                }
                *(u32x4*)(H + (size_t)row * FF + ff) = pack8(hv[0], hv[1]);
            }
        __syncthreads();
    }
};

struct EpiDown {
    static constexpr bool PERM = true, AFTER_DRAIN = false;
    float* out; const bf16_t* X1B; const float* RS; const float* gfin; float* part; unsigned* cnt; LAS float* lx;
    DI void operator()(const f32x4 (&acc_)[2][2][4][2], const pg8::Unit& u, int wr, int wc, int fr, int fq) const {
        f32x4 (&acc)[2][2][4][2] = const_cast<f32x4 (&)[2][2][4][2]>(acc_);
        const int row0 = u.pm * 256 + wr * 64 + fr, col0 = u.pn * 256 + wc * 32 + 8 * fq;
#pragma unroll
        for (int ai = 0; ai < 2; ++ai)
#pragma unroll
            for (int m = 0; m < 4; ++m) {
                const int row = row0 + ai * 128 + m * 16;
                const bf16_t* xrow = X1B + (size_t)row * D + col0;
                const float ir = 1.0f / RS[row];
                float q = 0.f;
#pragma unroll
                for (int bj = 0; bj < 2; ++bj) {
                    const u32x4 xw = *(const u32x4*)(xrow + bj * 128);
                    const f32x4 x0 = (f32x4){bflo(xw.x), bfhi(xw.x), bflo(xw.y), bfhi(xw.y)}, x1v = (f32x4){bflo(xw.z), bfhi(xw.z), bflo(xw.w), bfhi(xw.w)};
                    const f32x4 v0 = acc[ai][bj][m][0] + x0 * ir, v1 = acc[ai][bj][m][1] + x1v * ir;
                    acc[ai][bj][m][0] = v0; acc[ai][bj][m][1] = v1;
                    q += v0[0] * v0[0] + v0[1] * v0[1] + v0[2] * v0[2] + v0[3] * v0[3] + v1[0] * v1[0] + v1[1] * v1[1] + v1[2] * v1[2] + v1[3] * v1[3];
                }
                q = xsum4(q);
                if (fq == 0) lx[wc * 256 + ai * 128 + wr * 64 + m * 16 + fr] = q;
            }
        panel_rs(part, cnt, lx, u.pm, u.pn);
        f32x4 gv[2][2];
#pragma unroll
        for (int bj = 0; bj < 2; ++bj) { gv[bj][0] = *(const f32x4*)(gfin + col0 + bj * 128); gv[bj][1] = *(const f32x4*)(gfin + col0 + bj * 128 + 4); }
#pragma unroll
        for (int ai = 0; ai < 2; ++ai)
#pragma unroll
            for (int m = 0; m < 4; ++m) {
                float* orow = out + (size_t)(row0 + ai * 128 + m * 16) * D + col0;
                const float rs = lx[1024 + ai * 128 + wr * 64 + m * 16 + fr];
#pragma unroll
                for (int bj = 0; bj < 2; ++bj) { *(f32x4*)(orow + bj * 128) = acc[ai][bj][m][0] * rs * gv[bj][0]; *(f32x4*)(orow + bj * 128 + 4) = acc[ai][bj][m][1] * rs * gv[bj][1]; }
            }
    }
};


template <int K> DI f32x4 mini_tile_ks(const Frame& F, const bf16_t* __restrict__ A, const bf16_t* __restrict__ Bt, int row0, int col0) {
    constexpr int KS = K / 8, LDR = 68;
    const int lane = F.lane, fr = lane & 15, fq = lane >> 4;
    const bf16_t* ap = A + (size_t)(row0 + fr) * K + F.wave * KS + fq * 8;
    const bf16_t* bp = Bt + (size_t)(col0 + fr) * K + F.wave * KS + fq * 8;
    f32x4 acc[2][4];
#pragma unroll
    for (int mt = 0; mt < 2; ++mt)
#pragma unroll
        for (int nt = 0; nt < 4; ++nt) acc[mt][nt] = (f32x4){0.f, 0.f, 0.f, 0.f};
#pragma unroll 2
    for (int kk = 0; kk < KS / 32; ++kk) {
        bf16x8 xa[2], wb[4];
#pragma unroll
        for (int mt = 0; mt < 2; ++mt) xa[mt] = *(const bf16x8*)(ap + (size_t)mt * 16 * K + kk * 32);
#pragma unroll
        for (int nt = 0; nt < 4; ++nt) wb[nt] = *(const bf16x8*)(bp + (size_t)nt * 16 * K + kk * 32);
#pragma unroll
        for (int mt = 0; mt < 2; ++mt)
#pragma unroll
            for (int nt = 0; nt < 4; ++nt) acc[mt][nt] = MFMA16(wb[nt], xa[mt], acc[mt][nt]);
    }
    LAS float* red = (LAS float*)F.lds;
#pragma unroll
    for (int mt = 0; mt < 2; ++mt)
#pragma unroll
        for (int nt = 0; nt < 4; ++nt) *(LAS f32x4*)(red + F.wave * (32 * LDR) + (mt * 16 + fr) * LDR + nt * 16 + fq * 4) = acc[mt][nt];
    __syncthreads();
    f32x4 sum = (f32x4){0.f, 0.f, 0.f, 0.f};
#pragma unroll
    for (int w = 0; w < 8; ++w) sum += *(const LAS f32x4*)(red + w * (32 * LDR) + (F.tid >> 4) * LDR + (F.tid & 15) * 4);
    __syncthreads();
    return sum;
}
constexpr int MINI_PARK = LDS_X + 8192;
DI void p4_sample_a(const Frame& F) {
    if (F.bid >= 256) return;
    float* PS = WSP(float, WS_PARTS); unsigned* cnt = WSP(unsigned, WS_CTL) + 3584 + 192;
    const int t = F.bid, rg = t & 15, cg = t >> 4, rl = F.tid >> 4, row = MP + rg * 32 + rl, n0 = cg * 64 + (F.tid & 15) * 4;
    const f32x4 acc = mini_tile_ks<D>(F, WSP(bf16_t, WS_MIX), WSP(bf16_t, WS_WO), MP + rg * 32, cg * 64);
    const f32x4 v = acc + *(const f32x4*)(F.in[1] + (size_t)(row - MP) * D + n0);
    float q = v[0] * v[0] + v[1] * v[1] + v[2] * v[2] + v[3] * v[3];
    q += __shfl_xor(q, 1); q += __shfl_xor(q, 2); q += __shfl_xor(q, 4); q += __shfl_xor(q, 8);
    if ((F.tid & 15) == 0) st_agent(PS + (size_t)(rg * 16 + cg) * 32 + rl, q);
    *(LAS f32x4*)(F.lds + MINI_PARK + F.tid * 16) = v;
    asm volatile("s_waitcnt vmcnt(0)" ::: "memory");
    __syncthreads();
    if (F.tid == 0) (void)__hip_atomic_fetch_add((GAS unsigned*)(cnt + rg), 1u, __ATOMIC_RELAXED, __HIP_MEMORY_SCOPE_AGENT);
}
DI void p4_sample_b(const Frame& F) {
    if (F.bid >= 256) return;
    float* PS = WSP(float, WS_PARTS); unsigned* cnt = WSP(unsigned, WS_CTL) + 3584 + 192;
    const int t = F.bid, rg = t & 15, cg = t >> 4, rl = F.tid >> 4, row = MP + rg * 32 + rl, n0 = cg * 64 + (F.tid & 15) * 4;
    if (F.tid == 0) wait_ge16(cnt + rg);
    __syncthreads();
    float tot = 0.f;
#pragma unroll
    for (int c = 0; c < 16; ++c) tot += ld_agent(PS + (size_t)(rg * 16 + c) * 32 + rl);
    const float rs = rsqrtf(tot * (1.0f / D) + EPS);
    const f32x4 v = *(const LAS f32x4*)(F.lds + MINI_PARK + F.tid * 16);
    *(f32x4*)(WSP(float, WS_X1F) + (size_t)row * D + n0) = v;
    u32x2 w; w.x = pk2(v[0] * rs, v[1] * rs); w.y = pk2(v[2] * rs, v[3] * rs); *(u32x2*)(WSP(bf16_t, WS_X1B) + (size_t)row * D + n0) = w;
}
DI void p6_sample_a(const Frame& F) {
    if (F.bid >= 256) return;
    float* PS = WSP(float, WS_PARTS); unsigned* cnt = WSP(unsigned, WS_CTL) + 3584 + 208;
    const int t = F.bid, rg = t & 15, cg = t >> 4, rl = F.tid >> 4, row = MP + rg * 32 + rl, n0 = cg * 64 + (F.tid & 15) * 4;
    const f32x4 acc = mini_tile_ks<FF>(F, WSP(bf16_t, WS_H), WSP(bf16_t, WS_W2), MP + rg * 32, cg * 64);
    const f32x4 v = acc + *(const f32x4*)(WSP(float, WS_X1F) + (size_t)row * D + n0);
    float q = v[0] * v[0] + v[1] * v[1] + v[2] * v[2] + v[3] * v[3];
    q += __shfl_xor(q, 1); q += __shfl_xor(q, 2); q += __shfl_xor(q, 4); q += __shfl_xor(q, 8);
    if ((F.tid & 15) == 0) st_agent(PS + (size_t)(rg * 16 + cg) * 32 + rl, q);
    *(LAS f32x4*)(F.lds + MINI_PARK + F.tid * 16) = v;
    asm volatile("s_waitcnt vmcnt(0)" ::: "memory");
    __syncthreads();
    if (F.tid == 0) (void)__hip_atomic_fetch_add((GAS unsigned*)(cnt + rg), 1u, __ATOMIC_RELAXED, __HIP_MEMORY_SCOPE_AGENT);
}
DI void p6_sample_b(const Frame& F) {
    if (F.bid >= 256) return;
    float* PS = WSP(float, WS_PARTS); unsigned* cnt = WSP(unsigned, WS_CTL) + 3584 + 208;
    const int t = F.bid, rg = t & 15, cg = t >> 4, rl = F.tid >> 4, row = MP + rg * 32 + rl, n0 = cg * 64 + (F.tid & 15) * 4;
    if (F.tid == 0) wait_ge16(cnt + rg);
    __syncthreads();
    float tot = 0.f;
#pragma unroll
    for (int c = 0; c < 16; ++c) tot += ld_agent(PS + (size_t)(rg * 16 + c) * 32 + rl);
    const float rs = rsqrtf(tot * (1.0f / D) + EPS);
    const f32x4 v = *(const LAS f32x4*)(F.lds + MINI_PARK + F.tid * 16);
    *(f32x4*)(F.out + (size_t)row * D + n0) = v * rs * *(const f32x4*)(F.in[29] + n0);
}

#define RLX_AGENT __ATOMIC_RELAXED, __HIP_MEMORY_SCOPE_AGENT
#define XB_TMO      128
#define XB_XCNT(j)  (256  + 64 * (j))
#define XB_XSUB(j)  (1280 + 64 * (j))
#define XB_XGEN(j)  (2304 + 64 * (j))
#define XB_TOP      3328
#define XB_TOPGEN   3392
#define XCD_BAR_WORDS 3456
#define XB_SPIN_CAP (1u << 18)

__device__ __forceinline__ unsigned xb_ld(unsigned* p)              { return __hip_atomic_load(p, __ATOMIC_RELAXED, __HIP_MEMORY_SCOPE_AGENT); }
__device__ __forceinline__ unsigned xb_add(unsigned* p, unsigned v) { return __hip_atomic_fetch_add(p, v, __ATOMIC_RELAXED, __HIP_MEMORY_SCOPE_AGENT); }
__device__ __forceinline__ unsigned xb_xcc_id() { return (unsigned)__builtin_amdgcn_s_getreg((3 << 11) | 20) & 0xFu; }
#define XB_SPIN(cond, bar) do { unsigned _sp = 0; while (cond) { __builtin_amdgcn_s_sleep(1); \
    if ((++_sp & 255u) == 0u) { if (xb_ld(&(bar)[XB_TMO])) break; if (_sp > XB_SPIN_CAP) { atomicAdd(&(bar)[XB_TMO], 1u); break; } } } } while (0)

struct XcdBarrier {
    unsigned* bar; unsigned x;
    volatile LAS unsigned* st;
};

__device__ __forceinline__ XcdBarrier xcd_barrier_post(unsigned* bar, volatile LAS unsigned* st) {
    XcdBarrier b; b.bar = bar; b.x = xb_xcc_id(); b.st = st;
    if (threadIdx.x == 0) (void)xb_add(&bar[XB_XCNT(b.x)], 1u);
    return b;
}
__device__ __forceinline__ void xcd_barrier_complete(unsigned* bar, unsigned x, unsigned& nloc, unsigned& nx) {
    const unsigned G = gridDim.x * gridDim.y * gridDim.z;
    unsigned sum, cnt, mine, sp = 0u;
    for (;;) {
        sum = 0u; cnt = 0u; mine = 0u;
#pragma unroll
        for (unsigned j = 0; j < 16; ++j) { const unsigned c = xb_ld(&bar[XB_XCNT(j)]); sum += c; cnt += (c > 0u) ? 1u : 0u; mine = (j == x) ? c : mine; }
        if (sum == G) break;
        __builtin_amdgcn_s_sleep(1);
        if ((++sp & 255u) == 0u) { if (xb_ld(&bar[XB_TMO])) break; if (sp > XB_SPIN_CAP) { atomicAdd(&bar[XB_TMO], 1u); break; } }
    }
    nloc = mine > 0u ? mine : 1u; nx = cnt > 0u ? cnt : 1u;
}

__device__ __forceinline__ void xcd_barrier(const XcdBarrier& b) {
    asm volatile("s_waitcnt vmcnt(0)" ::: "memory");
    __syncthreads();
    if (threadIdx.x == 0) {
        unsigned* bar = b.bar;
        __builtin_amdgcn_s_waitcnt(0);
        unsigned nloc = b.st[0], nx = b.st[1];
        if (nloc == 0u) { xcd_barrier_complete(bar, b.x, nloc, nx); b.st[0] = nloc; b.st[1] = nx; }
        const unsigned old = xb_add(&bar[XB_XSUB(b.x)], 1u);
        const unsigned gen = old / nloc;
        if (old + 1u == (gen + 1u) * nloc) {
            __builtin_amdgcn_fence(__ATOMIC_RELEASE, "agent");
            asm volatile("s_waitcnt vmcnt(0)" ::: "memory");
            const unsigned og = xb_add(&bar[XB_TOP], 1u);
            const unsigned tg = og / nx;
            if (og + 1u == (tg + 1u) * nx) xb_add(&bar[XB_TOPGEN], 1u);
            else XB_SPIN(xb_ld(&bar[XB_TOPGEN]) == tg, bar);
            __builtin_amdgcn_fence(__ATOMIC_ACQUIRE, "agent");
            xb_add(&bar[XB_XGEN(b.x)], 1u);
            asm volatile("s_waitcnt vmcnt(0)" ::: "memory");
        } else {
            XB_SPIN(xb_ld(&bar[XB_XGEN(b.x)]) == gen, bar);
            __builtin_amdgcn_fence(__ATOMIC_ACQUIRE, "agent");
            asm volatile("s_waitcnt vmcnt(0)" ::: "memory");
        }
    }
    __syncthreads();
}

DI void grid_bar(unsigned* ctr, unsigned target) {
    asm volatile("s_waitcnt vmcnt(0)" ::: "memory");
    __syncthreads();
    if (threadIdx.x == 0) {
        __builtin_amdgcn_fence(__ATOMIC_RELEASE, "agent");
        asm volatile("s_waitcnt vmcnt(0)" ::: "memory");
        (void)__hip_atomic_fetch_add(ctr, 1u, __ATOMIC_RELAXED, __HIP_MEMORY_SCOPE_AGENT);
        while (__hip_atomic_load(ctr, __ATOMIC_RELAXED, __HIP_MEMORY_SCOPE_AGENT) < target) __builtin_amdgcn_s_sleep(1);
        __builtin_amdgcn_fence(__ATOMIC_ACQUIRE, "agent");
        asm volatile("s_waitcnt vmcnt(0)" ::: "memory");
    }
    __syncthreads();
}

#ifndef PH_MASK
#define PH_MASK 255
#endif
__global__ void __launch_bounds__(512, 2) mega_fwd(Args args) {
    extern __shared__ __attribute__((aligned(16))) unsigned char lds_raw[];
    cg::grid_group grid = cg::this_grid();
    Frame F;
    F.lds = (LAS unsigned char*)lds_raw; F.tid = threadIdx.x; F.lane = F.tid & 63; F.wave = __builtin_amdgcn_readfirstlane(F.tid >> 6);
    F.G = gridDim.x; F.bid = blockIdx.x; F.in = args.in; F.out = args.out; F.ws = args.ws;
    const int lo = args.ph_lo, hi = args.ph_hi;
#define IN(k) (((PH_MASK >> (k)) & 1) && lo <= (k) && (k) < hi)
    volatile LAS unsigned* xb_st = (volatile LAS unsigned*)(F.lds + LDS_BYTES - 64);
    if (F.tid < 2) xb_st[F.tid] = 0u;
    __syncthreads();
    XcdBarrier xbar; xbar.bar = WSP(unsigned, WS_CTL); xbar.x = 0; xbar.st = xb_st;
    if (lo + 1 < hi) xbar = xcd_barrier_post(WSP(unsigned, WS_CTL), xb_st);
    unsigned bar_n = 0;
#ifdef USE_CG_SYNC
#define SEAM(k) do { if (lo <= (k) && (k) + 1 < hi) grid.sync(); } while (0)
#else
#ifdef USE_CENTRAL_BAR
#define SEAM(k) do { if (lo <= (k) && (k) + 1 < hi) { bar_n += (unsigned)F.G; grid_bar(WSP(unsigned, WS_CTL) + 3520, bar_n); } } while (0)
#else
#define SEAM(k) do { if (lo <= (k) && (k) + 1 < hi) xcd_barrier(xbar); } while (0)
#endif
#endif
    if (hi > 8) grid.sync();
#ifndef REP_MASK
#define REP_MASK 0
#endif
#define REPS(k) for (int rep_ = 0; rep_ < 1 + ((REP_MASK >> (k)) & 1); ++rep_)
    if (IN(0)) { p0_prologue(F); } SEAM(0);
#ifdef EXTRA_SYNC
    for (int i_ = 0; i_ < EXTRA_SYNC; ++i_) SEAM(0);
#endif
#if (REP_MASK >> 0) & 1
    p0_prologue(F); grid.sync();
#endif
    if (IN(1)) {
        pg8::Gemm g{WSP(bf16_t, WS_XN), WSP(bf16_t, WS_WIN), M, INW, D}; pg8::StaticOrder S; S.init(M, INW, F.G, F.bid);
        EpiIn E{F.ws, F.out};
        pg8::gemm_phase<EpiIn, pg8::StaticOrder, true, true>(F.lds, g, S, E);
        p1_tail(F);
    } SEAM(1);
    if (IN(2)) { p23_phase(F); p3_loop(F); late_weights(F); }
#if (REP_MASK >> 2) & 1
    p2_phase(F); grid.sync();
#endif
    SEAM(2);
#if (REP_MASK >> 3) & 1
    for (int t = F.bid; t < 528; t += F.G) p3_task(F, t); grid.sync();
#endif
    if (IN(4)) {
        p4_sample_a(F);
        pg8::Gemm g{WSP(bf16_t, WS_MIX), WSP(bf16_t, WS_WO), MP, D, D}; pg8::StaticOrder S; S.init(MP, D, F.G, F.bid);
        EpiOut E{F.in[0], WSP(float, WS_SSQ), WSP(bf16_t, WS_X1B), WSP(float, WS_PART), WSP(unsigned, WS_CTL) + 3584 + 128, (LAS float*)(F.lds + LDS_X)};
        pg8::gemm_phase<EpiOut, pg8::StaticOrder, true, true>(F.lds, g, S, E);
        p4_sample_b(F);
    } SEAM(4);
    if (IN(5)) {
        pg8::Gemm g{WSP(bf16_t, WS_X1B), WSP(bf16_t, WS_W1), M, 2 * FF, D}; pg8::StaticOrder S; S.init(M, 2 * FF, F.G, F.bid);
        EpiFfn E{F.ws, F.in, F.out, (LAS float*)(F.lds + LDS_X)};
        pg8::gemm_phase<EpiFfn, pg8::StaticOrder, true, true>(F.lds, g, S, E);
    } SEAM(5);
    if (IN(6)) {
        p6_sample_a(F);
        pg8::Gemm g{WSP(bf16_t, WS_H), WSP(bf16_t, WS_W2), MP, D, FF}; pg8::StaticOrder S; S.init(MP, D, F.G, F.bid);
        EpiDown E{F.out, WSP(bf16_t, WS_X1B), WSP(float, WS_SSQ), F.in[29], WSP(float, WS_PART), WSP(unsigned, WS_CTL) + 3584 + 64, (LAS float*)(F.lds + LDS_X)};
        pg8::gemm_phase<EpiDown, pg8::StaticOrder, true, true>(F.lds, g, S, E);
        p6_sample_b(F);
    }
#undef IN
#undef SEAM
}

extern "C" void kernel_launch(void* const* d_in, const int* in_sizes, int n_in, void* d_out, int out_size, void* d_ws, size_t ws_size, hipStream_t stream) {
    static int grid = 0;
    if (grid == 0) {
        if (n_in != 30 || ws_size < WS_END) { fprintf(stderr, "kernel_launch: unexpected n_in %d / ws_size %zu (need %zu)\n", n_in, ws_size, (size_t)WS_END); grid = -1; return; }
        int dev = 0, cus = 0, per_cu = 0;
        (void)hipGetDevice(&dev); (void)hipDeviceGetAttribute(&cus, hipDeviceAttributeMultiprocessorCount, dev);
        if (hipFuncSetAttribute((const void*)mega_fwd, hipFuncAttributeMaxDynamicSharedMemorySize, LDS_BYTES) != hipSuccess) { fprintf(stderr, "hipFuncSetAttribute failed\n"); grid = -1; return; }
        if (hipOccupancyMaxActiveBlocksPerMultiprocessor(&per_cu, (const void*)mega_fwd, 512, LDS_BYTES) != hipSuccess || per_cu < 1) { fprintf(stderr, "occupancy query: %d\n", per_cu); per_cu = 1; }
        (void)hipGetLastError();
        grid = cus * (per_cu > 1 ? 1 : per_cu);
        if (grid <= 0) grid = 256;
    }
    if (grid < 0) return;
    Args a{};
    for (int i = 0; i < 30; ++i) a.in[i] = (const float*)d_in[i];
    a.out = (float*)d_out; a.ws = (unsigned char*)d_ws;
    (void)hipMemsetAsync((unsigned char*)d_ws + WS_CTL, 0, 16384, stream);
#if N_LAUNCHES == 1
    a.ph_lo = 0; a.ph_hi = 8;
    void* kargs[] = {&a};
    hipError_t e = hipLaunchCooperativeKernel((const void*)mega_fwd, dim3(grid), dim3(512), kargs, LDS_BYTES, stream);
    if (e != hipSuccess) fprintf(stderr, "cooperative launch failed: %s (grid %d)\n", hipGetErrorString(e), grid);
#else
    for (int p = 0; p < 8; ++p) { a.ph_lo = p; a.ph_hi = p + 1; for (int r = 0; r < 1 + ((HOST_REP >> p) & 1); ++r) hipLaunchKernelGGL(mega_fwd, dim3(grid), dim3(512), LDS_BYTES, stream, a); }
#endif
}
```

```cpp
#include <hip/hip_runtime.h>
#include <hip/hip_cooperative_groups.h>
#include <cstdio>
#include <cstdint>
namespace cg = cooperative_groups;

namespace pg8 {
#define PG8_LAS __attribute__((address_space(3)))
typedef unsigned short bf16_t;
typedef short bf16x8 __attribute__((ext_vector_type(8)));
typedef float f32x4 __attribute__((ext_vector_type(4)));
typedef unsigned u32x4 __attribute__((ext_vector_type(4)));
constexpr int BM = 256, BK = 64, HALF = 128, HTB = HALF * BK * 2  , STAGE_BYTES = 8 * HTB, NXCD = 8, WGM = 8;

__host__ __device__ __forceinline__ int lds_byte(int r, int c) { const int st = (r >> 4) * 2 + (c >> 5), rr = r & 15, cc = c & 31, ob = rr * 64 + cc * 2; return st * 1024 + (ob ^ (((ob >> 9) & 1) << 5)); }
__host__ __device__ __forceinline__ void stage_rc(int b, int& R, int& C) { const int st = b / 1024, sb = b % 1024, swz = sb ^ (((sb >> 9) & 1) << 5); R = (st >> 1) * 16 + swz / 64; C = (st & 1) * 32 + (swz % 64) / 2; }
__host__ __device__ __forceinline__ int perm32(int rho) { const int n = rho >> 4, i = rho & 15; return 8 * (i >> 2) + 4 * n + (i & 3); }

struct Unit { int pm, pn; };
struct Gemm { const bf16_t* A; const bf16_t* Bt; int M, N, K; };

struct StaticOrder {
    int nM, nN, nwg, G, c;
    __host__ __device__ void init(int M, int N, int G_, int c_) { nM = M / BM; nN = N / BM; nwg = nM * nN; G = G_; c = c_; }
    __host__ __device__ bool next(int i, Unit& u) const {
        const long L = (long)i * G + c; if (L >= nwg) return false;
        int wgid = (int)L; { const int q = nwg / NXCD, r = nwg % NXCD, xcd = wgid % NXCD, off = wgid / NXCD; wgid = (xcd < r ? xcd * (q + 1) : r * (q + 1) + (xcd - r) * q) + off; }
        const int nig = WGM * nN, gid = wgid / nig, fm = gid * WGM, gsz = (nM - fm) < WGM ? (nM - fm) : WGM;
        u.pm = fm + ((wgid % nig) % gsz); u.pn = (wgid % nig) / gsz; return true;
    }
    __device__ __forceinline__ void a_ready(const Unit&) const {}
    __device__ __forceinline__ void done(const Unit&) const {}
};

__device__ __forceinline__ unsigned cvt_pk_bf16(float lo, float hi) { unsigned r; asm volatile("v_cvt_pk_bf16_f32 %0, %1, %2" : "=v"(r) : "v"(lo), "v"(hi)); return r; }
template <class Epi, class Sched, bool ALIGN_EPI = false, bool SP2 = false>
__device__ __forceinline__ void gemm_phase(PG8_LAS unsigned char* lds, const Gemm g, const Sched& S, const Epi& E) {
    const int tid = threadIdx.x, wid = __builtin_amdgcn_readfirstlane(tid >> 6), lane = tid & 63, wr = wid >> 2, wc = wid & 3, fr = lane & 15, fq = lane >> 4;
    const int K = g.K, nt = K / BK;
    unsigned voffA[2], voffB[2];
#pragma unroll
    for (int i = 0; i < 2; ++i) { int R, C; stage_rc(tid * 16 + i * 8192, R, C); const int Rb = Epi::PERM ? ((R & ~31) + perm32(R & 31)) : R;
        voffA[i] = (unsigned)(R * K + C) * 2u; voffB[i] = (unsigned)(Rb * K + C) * 2u; }
    const size_t kstep = (size_t)(BK * 2);
    const size_t hstep = (size_t)HALF * K * 2;
    const size_t tstep = 2 * hstep;
    const unsigned ldsw = (unsigned)wid * 1024u;
    const int aoff = lds_byte(wr * 64 + fr, fq * 8), boff = lds_byte(wc * 32 + fr, fq * 8);
#define PG8_SA(b, h) (((b) * 2 + (h)) * HTB)
#define PG8_SB(b, h) ((4 + (b) * 2 + (h)) * HTB)
#define PG8_STAGE(bufoff, gbase, voff) do { _Pragma("unroll") for (int _i = 0; _i < 2; ++_i) \
        __builtin_amdgcn_global_load_lds((const unsigned*)((const char*)(gbase) + (voff)[_i]), (PG8_LAS unsigned*)(lds + (bufoff) + ldsw + _i * 8192), 16, 0, 0); } while (0)
#define PG8_LDA(dst, b, h) do { _Pragma("unroll") for (int m = 0; m < 4; ++m) _Pragma("unroll") for (int k = 0; k < 2; ++k) dst[m][k] = *(const PG8_LAS bf16x8*)(lds + PG8_SA(b, h) + aoff + m * 2048 + k * 1024); } while (0)
#define PG8_LDB(dst, b, h) do { _Pragma("unroll") for (int n = 0; n < 2; ++n) _Pragma("unroll") for (int k = 0; k < 2; ++k) dst[n][k] = *(const PG8_LAS bf16x8*)(lds + PG8_SB(b, h) + boff + n * 2048 + k * 1024); } while (0)
#define PG8_MMA(ai, bj, At, Bt) do { __builtin_amdgcn_s_setprio(1); _Pragma("unroll") for (int m = 0; m < 4; ++m) _Pragma("unroll") for (int n = 0; n < 2; ++n) _Pragma("unroll") for (int k = 0; k < 2; ++k) \
        acc[ai][bj][m][n] = __builtin_amdgcn_mfma_f32_16x16x32_bf16(Bt[n][k], At[m][k], acc[ai][bj][m][n], 0, 0, 0); __builtin_amdgcn_s_setprio(0); } while (0)
#define PG8_WAIT_V(n) asm volatile("s_waitcnt vmcnt(" #n ")" ::: "memory")
#define PG8_WAIT_L(n) asm volatile("s_waitcnt lgkmcnt(" #n ")" ::: "memory")
#define PG8_BAR __builtin_amdgcn_s_barrier()
#define PG8_SCHED __builtin_amdgcn_sched_barrier(0)
    Unit cur, nxt; int ui = 0;
    if (!S.next(0, cur)) return;
    f32x4 acc[2][2][4][2];
#pragma unroll
    for (int a = 0; a < 2; ++a)
#pragma unroll
        for (int b = 0; b < 2; ++b)
#pragma unroll
            for (int m = 0; m < 4; ++m)
#pragma unroll
                for (int n = 0; n < 2; ++n) acc[a][b][m][n] = (f32x4){0.f, 0.f, 0.f, 0.f};
    bf16x8 At[4][2], B0[2][2], B1[2][2];
    const char* cA = (const char*)g.A + (size_t)cur.pm * tstep; const char* cB = (const char*)g.Bt + (size_t)cur.pn * tstep;
    S.a_ready(cur);
    if constexpr (SP2) {
        PG8_STAGE(PG8_SB(0, 0), cB, voffB); PG8_STAGE(PG8_SB(0, 1), cB + hstep, voffB); PG8_STAGE(PG8_SA(0, 0), cA, voffA); PG8_STAGE(PG8_SA(0, 1), cA + hstep, voffA);
        if (wr == 1) PG8_BAR;
        PG8_WAIT_V(2); PG8_BAR;
        PG8_STAGE(PG8_SB(1, 0), cB + kstep, voffB); PG8_STAGE(PG8_SA(1, 0), cA + kstep, voffA); PG8_STAGE(PG8_SB(1, 1), cB + hstep + kstep, voffB);
        PG8_WAIT_V(6); PG8_BAR;
    } else {
        PG8_STAGE(PG8_SB(0, 0), cB, voffB); PG8_STAGE(PG8_SA(0, 0), cA, voffA); PG8_STAGE(PG8_SB(0, 1), cB + hstep, voffB); PG8_STAGE(PG8_SA(0, 1), cA + hstep, voffA);
        if (wr == 1) PG8_BAR;
        PG8_WAIT_V(4); PG8_BAR;
        PG8_STAGE(PG8_SB(1, 0), cB + kstep, voffB); PG8_STAGE(PG8_SA(1, 0), cA + kstep, voffA); PG8_STAGE(PG8_SB(1, 1), cB + hstep + kstep, voffB);
        PG8_WAIT_V(6); PG8_BAR;
    }
    for (;;) {
        const bool has_next = S.next(ui + 1, nxt);
        const char* nA = has_next ? (const char*)g.A + (size_t)nxt.pm * tstep : cA; const char* nB = has_next ? (const char*)g.Bt + (size_t)nxt.pn * tstep : cB;
        for (int t = 0; t < nt; t += 2) {
            const bool last = (t == nt - 2);
            const char* a1 = cA + (size_t)(t + 1) * kstep;
            const char* a2 = last ? nA : cA + (size_t)(t + 2) * kstep; const char* b2 = last ? nB : cB + (size_t)(t + 2) * kstep;
            const char* a3 = a2 + kstep; const char* b3 = b2 + kstep;
            if (last && has_next) S.a_ready(nxt);
            if constexpr (SP2) {
            PG8_LDB(B0, 0, 0); PG8_LDB(B1, 0, 1); PG8_SCHED; PG8_LDA(At, 0, 0); PG8_STAGE(PG8_SA(1, 1), a1 + hstep, voffA);
            PG8_WAIT_V(8); PG8_WAIT_L(0); PG8_BAR; PG8_MMA(0, 0, At, B0); PG8_MMA(0, 1, At, B1); PG8_BAR; PG8_SCHED;
            PG8_LDA(At, 0, 1); PG8_STAGE(PG8_SB(0, 0), b2, voffB); PG8_STAGE(PG8_SB(0, 1), b2 + hstep, voffB); PG8_STAGE(PG8_SA(0, 0), a2, voffA);
            PG8_WAIT_V(8); PG8_WAIT_L(0); PG8_BAR; PG8_MMA(1, 0, At, B0); PG8_MMA(1, 1, At, B1); PG8_BAR; PG8_SCHED;
            PG8_LDB(B0, 1, 0); PG8_LDB(B1, 1, 1); PG8_SCHED; PG8_LDA(At, 1, 0); PG8_STAGE(PG8_SA(0, 1), a2 + hstep, voffA);
            PG8_WAIT_V(8); PG8_WAIT_L(0); PG8_BAR; PG8_MMA(0, 0, At, B0); PG8_MMA(0, 1, At, B1); PG8_BAR; PG8_SCHED;
            PG8_LDA(At, 1, 1); PG8_STAGE(PG8_SB(1, 0), b3, voffB); PG8_STAGE(PG8_SB(1, 1), b3 + hstep, voffB); PG8_STAGE(PG8_SA(1, 0), a3, voffA);
            PG8_WAIT_V(8); PG8_WAIT_L(0); PG8_BAR; PG8_MMA(1, 0, At, B0); PG8_MMA(1, 1, At, B1); PG8_BAR; PG8_SCHED;
            } else {
            PG8_LDB(B0, 0, 0); PG8_SCHED; PG8_LDA(At, 0, 0); PG8_STAGE(PG8_SA(1, 1), a1 + hstep, voffA);
            PG8_WAIT_L(8); PG8_BAR; PG8_WAIT_L(0); PG8_MMA(0, 0, At, B0); PG8_BAR; PG8_SCHED;
            PG8_LDB(B1, 0, 1); PG8_STAGE(PG8_SB(0, 0), b2, voffB);
            PG8_BAR; PG8_WAIT_L(0); PG8_MMA(0, 1, At, B1); PG8_BAR;
            PG8_LDA(At, 0, 1); PG8_STAGE(PG8_SA(0, 0), a2, voffA);
            PG8_BAR; PG8_WAIT_L(0); PG8_MMA(1, 0, At, B0); PG8_BAR; PG8_SCHED;
            PG8_STAGE(PG8_SB(0, 1), b2 + hstep, voffB);
            PG8_WAIT_V(6); PG8_BAR; PG8_MMA(1, 1, At, B1); PG8_BAR;
            PG8_LDB(B0, 1, 0); PG8_SCHED; PG8_LDA(At, 1, 0); PG8_STAGE(PG8_SA(0, 1), a2 + hstep, voffA);
            PG8_WAIT_L(8); PG8_BAR; PG8_WAIT_L(0); PG8_MMA(0, 0, At, B0); PG8_BAR; PG8_SCHED;
            PG8_LDB(B1, 1, 1); PG8_STAGE(PG8_SB(1, 0), b3, voffB);
            PG8_BAR; PG8_WAIT_L(0); PG8_MMA(0, 1, At, B1); PG8_BAR;
            PG8_LDA(At, 1, 1); PG8_STAGE(PG8_SA(1, 0), a3, voffA);
            PG8_BAR; PG8_WAIT_L(0); PG8_MMA(1, 0, At, B0); PG8_BAR; PG8_SCHED;
            PG8_STAGE(PG8_SB(1, 1), b3 + hstep, voffB);
            PG8_WAIT_V(6); PG8_BAR; PG8_MMA(1, 1, At, B1); PG8_BAR;
            }
        }
        if constexpr (ALIGN_EPI) { if (wr == 0) PG8_BAR; }
        if constexpr (!Epi::AFTER_DRAIN) { E(acc, cur, wr, wc, fr, fq); S.done(cur); }
        if (!has_next) break;
#pragma unroll
        for (int a = 0; a < 2; ++a)
#pragma unroll
            for (int b = 0; b < 2; ++b)
#pragma unroll
                for (int m = 0; m < 4; ++m)
#pragma unroll
                    for (int n = 0; n < 2; ++n) acc[a][b][m][n] = (f32x4){0.f, 0.f, 0.f, 0.f};
        cur = nxt; cA = nA; cB = nB; ++ui;
        if constexpr (ALIGN_EPI) { if (wr == 1) PG8_BAR; }
    }
    PG8_WAIT_V(0);
    if constexpr (!ALIGN_EPI) { if (wr == 0) PG8_BAR; }
    PG8_BAR;
    if constexpr (Epi::AFTER_DRAIN) { E.fused(acc, cur, wr, wc, fr, fq, lds, wid, lane); S.done(cur); }
#undef PG8_SA
#undef PG8_SB
#undef PG8_STAGE
#undef PG8_LDA
#undef PG8_LDB
#undef PG8_MMA
#undef PG8_WAIT_V
#undef PG8_WAIT_L
#undef PG8_BAR
#undef PG8_SCHED
}
}

#ifndef HOST_REP
#define HOST_REP 0
#endif
#ifndef N_LAUNCHES
#define N_LAUNCHES 1
#endif
#define DI __device__ __forceinline__
#define LAS __attribute__((address_space(3)))
using pg8::bf16_t; using pg8::bf16x8; using pg8::f32x4; using pg8::u32x4;
typedef unsigned u32x2 __attribute__((ext_vector_type(2)));
typedef short s16x4 __attribute__((ext_vector_type(4)));
#define MFMA16(a, b, c) __builtin_amdgcn_mfma_f32_16x16x32_bf16((a), (b), (c), 0, 0, 0)

constexpr int D = 1024, MP = 16384, MS = 512, M = MP + MS, SEQ = 2048, INW = 1280, FF = 2816, NG = 32;
constexpr float EPS = 1e-6f;
constexpr size_t O_PRE = 17301504, O_PIM = 17317888, O_PK = 17334272, O_PV = 17465344, O_PCONV = 17596416,
                 O_SRE = 17641472, O_SIM = 17674240, O_SK = 17707008, O_SV = 17772544, O_SCONV = 17838080;
constexpr size_t WS_WIN = 0, WS_WGLU = WS_WIN + (size_t)INW * D * 2, WS_WO = WS_WGLU + 512 * 512 * 2, WS_W1 = WS_WO + (size_t)D * D * 2,
                 WS_W2 = WS_W1 + (size_t)2 * FF * D * 2, WS_KT = WS_W2 + (size_t)D * FF * 2, WS_WT = WS_KT + (size_t)NG * 32 * 256 * 2,
                 WS_PRE = WS_WT + (size_t)NG * 128 * 512 * 2, WS_PIM = WS_PRE + (size_t)NG * 4096 * 4, WS_A32 = WS_PIM + (size_t)NG * 32 * 64 * 4,
                 WS_CT = WS_A32 + (size_t)NG * 64 * 2 * 4, WS_SSQ = WS_CT + (size_t)NG * 16 * 128 * 2, WS_MIX = WS_SSQ + (size_t)M * 16 * 4,
                 WS_X1B = WS_MIX + (size_t)M * D * 2, WS_H = WS_X1B + (size_t)M * D * 2, WS_X1F = WS_H + (size_t)M * FF * 2, WS_PART = WS_X1F + (size_t)M * D * 4, WS_PARTS = WS_PART + (size_t)64 * 4 * 256 * 4, WS_CTL = WS_PARTS + (size_t)256 * 32 * 4, WS_END = WS_CTL + 16384;
constexpr size_t WS_XN = WS_H, WS_U = WS_XN + (size_t)M * D * 2, WS_Q = WS_U + (size_t)M * 512 * 2, WS_KB = WS_Q + (size_t)M * 512 * 2,
                 WS_VT = WS_KB + (size_t)M * 128 * 2, WS_KS = WS_VT + (size_t)MP * 128 * 2, WS_VTS = WS_KS + (size_t)16 * 160 * 128 * 2,
                 WS_HIN = WS_VTS + (size_t)16 * 160 * 128 * 2, WS_UF = WS_HIN + (size_t)512 * NG * 128 * 4, WS_ALIAS_END = WS_UF + (size_t)M * 512 * 2;
static_assert(WS_ALIAS_END <= WS_END && WS_END <= 268435456, "d_ws map");
constexpr int LDS_BYTES = 163840, LDS_X = 131072;

DI unsigned f2bf(float f) { unsigned u = __builtin_bit_cast(unsigned, f); return (u + 0x7fffu + ((u >> 16) & 1u)) >> 16; }
typedef float f32x2_t __attribute__((ext_vector_type(2)));
typedef __bf16 bf16x2_t __attribute__((ext_vector_type(2)));
DI unsigned pk2(float lo, float hi) { f32x2_t v = {lo, hi}; bf16x2_t b = __builtin_convertvector(v, bf16x2_t); return __builtin_bit_cast(unsigned, b); }
DI float bflo(unsigned w) { return __builtin_bit_cast(float, w << 16); }
DI float bfhi(unsigned w) { return __builtin_bit_cast(float, w & 0xffff0000u); }
DI u32x4 pack8(const f32x4& a, const f32x4& b) { u32x4 w; w.x = pk2(a[0], a[1]); w.y = pk2(a[2], a[3]); w.z = pk2(b[0], b[1]); w.w = pk2(b[2], b[3]); return w; }
DI float dot2bf(unsigned a, unsigned b, float c) { return __builtin_amdgcn_fdot2_f32_bf16(__builtin_bit_cast(bf16x2_t, a), __builtin_bit_cast(bf16x2_t, b), c, false); }
DI float sigm(float x) { return __builtin_amdgcn_rcpf(1.0f + __expf(-x)); }
DI float gelu_tanh(float x) { const float z = 0.7978845608f * (x + 0.044715f * x * x * x); return x * sigm(2.0f * z); }
template <int CTRL> DI float dpp_shr(float v) { return __builtin_bit_cast(float, __builtin_amdgcn_update_dpp(0, __builtin_bit_cast(int, v), CTRL, 0xF, 0xF, false)); }
#define GAS __attribute__((address_space(1)))
DI void st_agent(float* p, float v) { __hip_atomic_store((GAS unsigned*)p, __builtin_bit_cast(unsigned, v), __ATOMIC_RELAXED, __HIP_MEMORY_SCOPE_AGENT); }
DI float ld_agent(const float* p) { return __builtin_bit_cast(float, __hip_atomic_load((GAS unsigned*)p, __ATOMIC_RELAXED, __HIP_MEMORY_SCOPE_AGENT)); }
DI void arrive_and_wait(unsigned* cnt, unsigned target) {
    (void)__hip_atomic_fetch_add((GAS unsigned*)cnt, 1u, __ATOMIC_RELAXED, __HIP_MEMORY_SCOPE_AGENT);
    while (__hip_atomic_load((GAS unsigned*)cnt, __ATOMIC_RELAXED, __HIP_MEMORY_SCOPE_AGENT) < target) __builtin_amdgcn_s_sleep(1);
}
DI void wait_ge16(const unsigned* c) { while (__hip_atomic_load((GAS unsigned*)c, __ATOMIC_RELAXED, __HIP_MEMORY_SCOPE_AGENT) < 16u) __builtin_amdgcn_s_sleep(1); }
DI float xsum4(float v) { v += __shfl_xor(v, 16); v += __shfl_xor(v, 32); return v; }

struct Args { const float* in[30]; float* out; unsigned char* ws; int ph_lo, ph_hi; };

struct Frame {
    LAS unsigned char* lds; int tid, lane, wave, G, bid;
    const float* const* in; float* out; unsigned char* ws;
};
#define WSP(T, off) ((T*)(F.ws + (off)))

DI void p0_transpose(const float* __restrict__ W, int N, const float* __restrict__ gk, bf16_t* __restrict__ WT, int ldt, int k0, int n0, int dst0, LAS float* scr, int tid) {
    const int c = tid & 63, r0 = tid >> 6;
#pragma unroll
    for (int i = 0; i < 8; ++i) { const int r = r0 + 8 * i; float v = W[(size_t)(k0 + r) * N + n0 + c]; if (gk) v *= gk[k0 + r]; scr[r * 65 + c] = v; }
    __syncthreads();
#pragma unroll
    for (int i = 0; i < 8; ++i) { const int n = r0 + 8 * i; WT[(size_t)(dst0 + n) * ldt + k0 + c] = (bf16_t)f2bf(scr[c * 65 + n]); }
    __syncthreads();
}

DI void p0_ssm_tables(const Frame& F, int task) {
    const int tid = F.tid, g = task >> 2, part = task & 3;
    LAS float* pwr = (LAS float*)F.lds; LAS float* pwi = pwr + 33 * 64; LAS float* bbr = pwi + 33 * 64; LAS float* bbi = bbr + 1024;
    const float* a_re = F.in[9] + g * 64; const float* a_im = F.in[10] + g * 64;
    const float dt = expf(F.in[11][g]);
    for (int i = tid; i < 33 * 64; i += 512) {
        const int d = i >> 6, n = i & 63; const float fd = (float)d;
        const float mag = expf(a_re[n] * dt * fd), ang = a_im[n] * dt * fd;
        pwr[i] = mag * cosf(ang); pwi[i] = mag * sinf(ang);
    }
    __syncthreads();
    for (int i = tid; i < 1024; i += 512) {
        const int n = i >> 4;
        const float are = a_re[n], aim = a_im[n], nr = pwr[64 + n] - 1.0f, ni = pwi[64 + n], den = are * are + aim * aim;
        const float cr = (nr * are + ni * aim) / den, ci = (ni * are - nr * aim) / den;
        const float br = F.in[12][(size_t)g * 1024 + i], bi = F.in[13][(size_t)g * 1024 + i];
        bbr[i] = cr * br - ci * bi; bbi[i] = cr * bi + ci * br;
    }
    __syncthreads();
    if (part == 0) {
        const int d = tid >> 4, p = tid & 15;
        float acc[16];
#pragma unroll
        for (int q = 0; q < 16; ++q) acc[q] = 0.f;
        const float* cre = F.in[14] + (size_t)(g * 16 + p) * 64; const float* cim = F.in[15] + (size_t)(g * 16 + p) * 64;
        for (int n = 0; n < 64; ++n) {
            const float cr = cre[n], ci = cim[n], pr = pwr[d * 64 + n], pi = pwi[d * 64 + n];
            const float xr = cr * pr - ci * pi, xi = cr * pi + ci * pr;
#pragma unroll
            for (int q = 0; q < 16; ++q) acc[q] += xr * bbr[n * 16 + q] - xi * bbi[n * 16 + q];
        }
        const float dv = (d == 0) ? F.in[16][g * 16 + p] : 0.f;
        u32x4 w0, w1;
#pragma unroll
        for (int q = 0; q < 16; ++q) acc[q] += (q == p) ? dv : 0.f;
        w0.x = pk2(acc[0], acc[1]); w0.y = pk2(acc[2], acc[3]); w0.z = pk2(acc[4], acc[5]); w0.w = pk2(acc[6], acc[7]);
        w1.x = pk2(acc[8], acc[9]); w1.y = pk2(acc[10], acc[11]); w1.z = pk2(acc[12], acc[13]); w1.w = pk2(acc[14], acc[15]);
        bf16_t* dst = WSP(bf16_t, WS_KT) + ((size_t)(g * 16 + (d >> 1)) * 64 + (d & 1) * 32 + p) * 8;
        *(u32x4*)dst = w0; *(u32x4*)(dst + 128) = w1;
    }
    if (part == 1 || part == 2) {
        bf16_t* wt = WSP(bf16_t, WS_WT) + (size_t)g * 65536;
        for (int idx = (part - 1) * 32768 + tid; idx < part * 32768; idx += 512) {
            const int j = idx & 7, lane = (idx >> 3) & 63, kk = (idx >> 9) & 15, nb = idx >> 13;
            const int n2 = nb * 16 + (lane & 15), n = n2 & 63, sidx = 2 * kk + (lane >> 5), pp = ((lane >> 4) & 1) * 8 + j;
            const float pr = pwr[(31 - sidx) * 64 + n], pi = pwi[(31 - sidx) * 64 + n], br = bbr[n * 16 + pp], bi = bbi[n * 16 + pp];
            wt[idx] = (bf16_t)f2bf(n2 < 64 ? pr * br - pi * bi : pr * bi + pi * br);
        }
    }
    if (part == 3) {
    for (int i = tid; i < 4096; i += 512) {
        const int e = i & 3, lane = (i >> 2) & 63, half = (i >> 8) & 1, reim = (i >> 9) & 1, nh = (i >> 10) & 1, mt = i >> 11;
        const int t = mt * 16 + (lane & 15), n = nh * 32 + (lane >> 4) * 8 + half * 4 + e;
        WSP(float, WS_PRE)[(size_t)g * 4096 + i] = reim ? pwi[(t + 1) * 64 + n] : pwr[(t + 1) * 64 + n];
    }
    if (tid < 64) { WSP(float, WS_A32)[(g * 64 + tid) * 2] = pwr[32 * 64 + tid]; WSP(float, WS_A32)[(g * 64 + tid) * 2 + 1] = pwi[32 * 64 + tid]; }
    for (int i = tid; i < 2048; i += 512) {
        const int j = i & 7, lane = (i >> 3) & 63, kk2 = i >> 9, p = lane & 15, n2 = kk2 * 32 + (lane >> 4) * 8 + j;
        const float v = n2 < 64 ? F.in[14][(size_t)(g * 16 + p) * 64 + n2] : -F.in[15][(size_t)(g * 16 + p) * 64 + n2 - 64];
        WSP(bf16_t, WS_CT)[(size_t)g * 2048 + i] = (bf16_t)f2bf(v);
    }
    }
    __syncthreads();
}

DI void p0_prologue(const Frame& F) {
    constexpr int T_SSM = 128, T_WIN = 16 * 20, T_WGLU = 64, T_WO = 256, T_WA = 16 * 44, T_WD = 44 * 16, T_XN = M / 16, T_CK = 64, T_CV = 64;
    LAS float* scr = (LAS float*)F.lds;
    const int G = F.G;
    int r = F.bid;
#define P0_LOOP(COUNT) for (int i = r; i < (COUNT); i += G)
#define P0_NEXT(COUNT) r = (r + G - (COUNT) % G) % G
    P0_LOOP(T_XN) {
        const int row = i * 16 + F.wave * 2;
        const float* xr = row < MP ? F.in[0] + (size_t)row * D : F.in[1] + (size_t)(row - MP) * D;
        f32x4 v[2][4]; float q0 = 0.f, q1 = 0.f;
#pragma unroll
        for (int k = 0; k < 4; ++k) { v[0][k] = *(const f32x4*)(xr + k * 256 + F.lane * 4); v[1][k] = *(const f32x4*)(xr + D + k * 256 + F.lane * 4); }
#pragma unroll
        for (int k = 0; k < 4; ++k) { q0 += v[0][k][0] * v[0][k][0] + v[0][k][1] * v[0][k][1] + v[0][k][2] * v[0][k][2] + v[0][k][3] * v[0][k][3];
                                      q1 += v[1][k][0] * v[1][k][0] + v[1][k][1] * v[1][k][1] + v[1][k][2] * v[1][k][2] + v[1][k][3] * v[1][k][3]; }
#pragma unroll
        for (int o = 1; o < 64; o <<= 1) { q0 += __shfl_xor(q0, o); q1 += __shfl_xor(q1, o); }
        const float rr0 = rsqrtf(q0 * (1.0f / D) + EPS), rr1 = rsqrtf(q1 * (1.0f / D) + EPS);
        bf16_t* dst = WSP(bf16_t, WS_XN) + (size_t)row * D;
#pragma unroll
        for (int k = 0; k < 4; ++k) { const f32x4 g = *(const f32x4*)(F.in[7] + k * 256 + F.lane * 4);
            u32x2 w; w.x = pk2(v[0][k][0] * rr0 * g[0], v[0][k][1] * rr0 * g[1]); w.y = pk2(v[0][k][2] * rr0 * g[2], v[0][k][3] * rr0 * g[3]); *(u32x2*)(dst + k * 256 + F.lane * 4) = w;
            w.x = pk2(v[1][k][0] * rr1 * g[0], v[1][k][1] * rr1 * g[1]); w.y = pk2(v[1][k][2] * rr1 * g[2], v[1][k][3] * rr1 * g[3]); *(u32x2*)(dst + D + k * 256 + F.lane * 4) = w; }
    }
    P0_NEXT(T_XN);
    P0_LOOP(T_WIN) p0_transpose(F.in[8], INW, nullptr, WSP(bf16_t, WS_WIN), D, (i % 16) * 64, (i / 16) * 64, (i / 16) * 64, scr, F.tid);
    P0_NEXT(T_WIN);
#undef P0_LOOP
#undef P0_NEXT
}

DI void p1_tail(const Frame& F) {
    constexpr int T_SSM = 128, T_WGLU = 64, T_CK = 64, T_CV = 64;
    const int nbusy = (M / 256) * (INW / 256) - F.G;
    if (nbusy < 0 || nbusy >= F.G || F.bid < nbusy) return;
    const int G = F.G - nbusy;
    int r = F.bid - nbusy;
#define P0_LOOP(COUNT) for (int i = r; i < (COUNT); i += G)
#define P0_NEXT(COUNT) r = (r + G - (COUNT) % G) % G
    P0_LOOP(T_SSM) p0_ssm_tables(F, i);
    P0_NEXT(T_SSM);
    P0_LOOP(T_WGLU) {
        const int ch = i * 512 + F.tid, lane = ch & 63, kk = (ch >> 6) & 15, ntg = ch >> 10;
        const float* src = F.in[17] + (size_t)(kk * 32 + (lane >> 4) * 8) * 512 + ntg * 16 + (lane & 15);
        f32x4 a, b;
#pragma unroll
        for (int j = 0; j < 4; ++j) { a[j] = src[(size_t)j * 512]; b[j] = src[(size_t)(j + 4) * 512]; }
        *(u32x4*)(WSP(bf16_t, WS_WGLU) + (size_t)ch * 8) = pack8(a, b);
    }
    P0_NEXT(T_WGLU);
    P0_LOOP(T_CK) {
        const int ch = i * 512 + F.tid, lane = ch & 63, kk = (ch >> 6) & 1, kb = (ch >> 7) & 7, kvh = (ch >> 10) & 1, sb = ch >> 11;
        const float* src = F.in[4] + (((size_t)sb * 128 + kb * 16 + (lane & 15)) * 2 + kvh) * 64 + kk * 32 + (lane >> 4) * 8;
        *(u32x4*)(WSP(bf16_t, WS_KS) + (((size_t)(sb * 2 + kvh) * 10 + kb) * 2 + kk) * 512 + lane * 8) = pack8(*(const f32x4*)src, *(const f32x4*)(src + 4));
    }
    P0_NEXT(T_CK);
    P0_LOOP(T_CV) {
        const int ch = i * 512 + F.tid, lane = ch & 63, db = (ch >> 6) & 3, kb = (ch >> 8) & 3, kvh = (ch >> 10) & 1, sb = ch >> 11;
        const float* src = F.in[5] + (((size_t)sb * 128 + kb * 32 + (lane >> 4) * 4) * 2 + kvh) * 64 + db * 16 + (lane & 15);
        f32x4 a, b;
#pragma unroll
        for (int j = 0; j < 4; ++j) { a[j] = src[(size_t)j * 128]; b[j] = src[(size_t)(16 + j) * 128]; }
        *(u32x4*)(WSP(bf16_t, WS_VTS) + (((size_t)(sb * 2 + kvh) * 5 + kb) * 4 + db) * 512 + lane * 8) = pack8(a, b);
    }
#undef P0_LOOP
#undef P0_NEXT
}

struct EpiIn {
    static constexpr bool PERM = true, AFTER_DRAIN = false;
    unsigned char* ws; float* out;
    DI void operator()(const f32x4 (&acc)[2][2][4][2], const pg8::Unit& u, int wr, int wc, int fr, int fq) const {
        bf16_t* const U = (bf16_t*)(ws + WS_U); bf16_t* const Q = (bf16_t*)(ws + WS_Q); bf16_t* const KB = (bf16_t*)(ws + WS_KB); bf16_t* const VT = (bf16_t*)(ws + WS_VT);
        bf16_t* const KS = (bf16_t*)(ws + WS_KS); bf16_t* const VTS = (bf16_t*)(ws + WS_VTS); bf16_t* const UF = (bf16_t*)(ws + WS_UF);
        const int row0 = u.pm * 256 + wr * 64 + fr;
        if (u.pn < 2) {
            const int colt = u.pn * 256 + wc * 32 + 8 * fq;
#pragma unroll
            for (int ai = 0; ai < 2; ++ai)
#pragma unroll
                for (int m = 0; m < 4; ++m) { const int row = row0 + ai * 128 + m * 16; bf16_t* rp = U + (size_t)row * 512 + colt;
                    const int tq = row < MP ? (row & 2047) : ((row - MP) & 31), sq = tq & 31, chunk = row < MP ? (tq >> 5) : ((row - MP) >> 5);
#pragma unroll
                    for (int bj = 0; bj < 2; ++bj) { const u32x4 w = pack8(acc[ai][bj][m][0], acc[ai][bj][m][1]); *(u32x4*)(rp + bj * 128) = w;
                        const int c0 = colt + bj * 128, g = c0 >> 4, lf = (((sq & 1) * 2 + ((c0 >> 3) & 1)) * 16 + (chunk & 15)) * 8;
                        bf16_t* uf = row < MP ? UF + ((((size_t)((row >> 11) * 32 + g) * 16 + (sq >> 1)) * 4 + (chunk >> 4)) * 64) * 8 + lf
                                              : UF + (size_t)MP * 512 + ((size_t)(g * 16 + (sq >> 1)) * 64) * 8 + lf;
                        *(u32x4*)uf = w; } }
        } else if (u.pn < 4) {
#pragma unroll
            for (int ai = 0; ai < 2; ++ai)
#pragma unroll
                for (int m = 0; m < 4; ++m) { const int rb = (u.pm * 256 + wr * 64 + ai * 128 + m * 16) >> 4;
#pragma unroll
                    for (int bj = 0; bj < 2; ++bj) { const int c0 = (u.pn - 2) * 256 + bj * 128 + wc * 32, h = c0 >> 6, kk = (c0 >> 5) & 1;
                        *(u32x4*)(Q + (((size_t)h * (M / 16) + rb) * 2 + kk) * 512 + (fq * 16 + fr) * 8) = pack8(acc[ai][bj][m][0] * 0.125f, acc[ai][bj][m][1] * 0.125f); } }
        } else {
            const int c = wc * 32 + 8 * fq, kvh = wc >> 1, kk = wc & 1, db = (c >> 4) & 3, fr0 = c & 15;
#pragma unroll
            for (int ai = 0; ai < 2; ++ai)
#pragma unroll
                for (int m = 0; m < 4; ++m) {
                    const int row = row0 + ai * 128 + m * 16;
                    const f32x4 k0 = acc[ai][0][m][0], k1 = acc[ai][0][m][1], v0 = acc[ai][1][m][0], v1 = acc[ai][1][m][1];
                    if (row < MP) {
                        const int b = row >> 11, t = row & 2047;
                        *(u32x4*)(KB + (((size_t)kvh * (M / 16) + (row >> 4)) * 2 + kk) * 512 + (fq * 16 + fr) * 8) = pack8(k0, k1);
                        const int w = t & 31; bf16_t* vt = VT + ((((size_t)(b * 2 + kvh) * 64 + (t >> 5)) * 4 + db) * 64 + ((w & 15) >> 2) * 16 + fr0) * 8 + (w & 3) + 4 * (w >> 4);
#pragma unroll
                        for (int j = 0; j < 4; ++j) { vt[j * 8] = (bf16_t)f2bf(v0[j]); vt[(j + 4) * 8] = (bf16_t)f2bf(v1[j]); }
                        if (t >= 1920) { float* pk = out + O_PK + ((size_t)b * 128 + (t - 1920)) * 128 + c; *(f32x4*)pk = k0; *(f32x4*)(pk + 4) = k1;
                                         float* pv = out + O_PV + ((size_t)b * 128 + (t - 1920)) * 128 + c; *(f32x4*)pv = v0; *(f32x4*)(pv + 4) = v1; }
                    } else {
                        const int sb = (row - MP) >> 5, st = (row - MP) & 31, key = 128 + st;
                        *(u32x4*)(KS + ((((size_t)(sb * 2 + kvh) * 10 + (key >> 4)) * 2 + kk) * 64 + fq * 16 + (key & 15)) * 8) = pack8(k0, k1);
                        const int w = key & 31; bf16_t* vt = VTS + ((((size_t)(sb * 2 + kvh) * 5 + (key >> 5)) * 4 + db) * 64 + ((w & 15) >> 2) * 16 + fr0) * 8 + (w & 3) + 4 * (w >> 4);
#pragma unroll
                        for (int j = 0; j < 4; ++j) { vt[j * 8] = (bf16_t)f2bf(v0[j]); vt[(j + 4) * 8] = (bf16_t)f2bf(v1[j]); }
                        float* pk = out + O_SK + ((size_t)sb * 32 + st) * 128 + c; *(f32x4*)pk = k0; *(f32x4*)(pk + 4) = k1;
                        float* pv = out + O_SV + ((size_t)sb * 32 + st) * 128 + c; *(f32x4*)pv = v0; *(f32x4*)(pv + 4) = v1;
                    }
                }
        }
    }
};

constexpr int LDO = 520;
DI void attn_task(const bf16_t* __restrict__ Qp, int nqb, const bf16_t* __restrict__ Kp, int nkb, const bf16_t* __restrict__ Vtp, int vstride,
                  float sink, const float* __restrict__ gat, bf16_t* __restrict__ outp, LAS float* ob, int h, int wave, int lane) {
    const int fr = lane & 15, fq = lane >> 4;
#pragma unroll 1
    for (int qb = 0; qb < nqb; ++qb) {
        const bf16_t* qrow = Qp + (size_t)qb * 1024 + lane * 8;
        const bf16x8 q0 = *(const bf16x8*)qrow, q1 = *(const bf16x8*)(qrow + 512);
        f32x4 s[12];
#pragma unroll
        for (int kb = 0; kb < 12; ++kb) {
            s[kb] = (f32x4){-INFINITY, -INFINITY, -INFINITY, -INFINITY};
            if (kb < nkb) {
                const bf16_t* krow = Kp + (size_t)kb * 1024 + lane * 8;
                const bf16x8 k0 = *(const bf16x8*)krow, k1 = *(const bf16x8*)(krow + 512);
                f32x4 z = (f32x4){0.f, 0.f, 0.f, 0.f};
                z = MFMA16(k0, q0, z); z = MFMA16(k1, q1, z); s[kb] = z;
            }
        }
        float m = sink;
#pragma unroll
        for (int kb = 0; kb < 12; ++kb) m = fmaxf(fmaxf(m, fmaxf(s[kb][0], s[kb][1])), fmaxf(s[kb][2], s[kb][3]));
        m = fmaxf(m, __shfl_xor(m, 16)); m = fmaxf(m, __shfl_xor(m, 32));
        float sum = 0.f;
#pragma unroll
        for (int kb = 0; kb < 12; ++kb)
#pragma unroll
            for (int e = 0; e < 4; ++e) { const float p = __expf(s[kb][e] - m); s[kb][e] = p; sum += p; }
        sum = xsum4(sum);
        const float inv = 1.0f / (sum + __expf(sink - m));
        f32x4 o[4];
#pragma unroll
        for (int db = 0; db < 4; ++db) o[db] = (f32x4){0.f, 0.f, 0.f, 0.f};
#pragma unroll
        for (int ks = 0; ks < 6; ++ks) {
            if (2 * ks < nkb) {
                const bf16x8 pb = __builtin_bit_cast(bf16x8, pack8(s[2 * ks], s[2 * ks + 1]));
#pragma unroll
                for (int db = 0; db < 4; ++db) {
                    const bf16x8 vf = *(const bf16x8*)(Vtp + (size_t)(ks * 4 + db) * 512 + lane * 8);
                    o[db] = MFMA16(vf, pb, o[db]);
                }
                if (ks & 1) __builtin_amdgcn_sched_barrier(0);
            }
        }
#pragma unroll
        for (int db = 0; db < 4; ++db) *(LAS f32x4*)(ob + (qb * 16 + fr) * LDO + h * 64 + db * 16 + fq * 4) = o[db] * inv;
    }
    __syncthreads();
    const int rpw = nqb * 2;
    const f32x4 g0 = *(const f32x4*)(gat + lane * 8), g1 = *(const f32x4*)(gat + lane * 8 + 4);
#pragma unroll 1
    for (int i = 0; i < rpw; ++i) {
        const int r = wave * rpw + i;
        f32x4 v0 = *(const LAS f32x4*)(ob + r * LDO + lane * 8), v1 = *(const LAS f32x4*)(ob + r * LDO + lane * 8 + 4);
        float q = v0[0] * v0[0] + v0[1] * v0[1] + v0[2] * v0[2] + v0[3] * v0[3] + v1[0] * v1[0] + v1[1] * v1[1] + v1[2] * v1[2] + v1[3] * v1[3];
#pragma unroll
        for (int o2 = 1; o2 < 64; o2 <<= 1) q += __shfl_xor(q, o2);
        const float rs = rsqrtf(q * (1.0f / 512.0f) + EPS);
        *(u32x4*)(outp + (size_t)r * D + lane * 8) = pack8(v0 * rs * g0, v1 * rs * g1);
    }
    __syncthreads();
}

template <int MT, bool SAMPLE>
DI void ssm_state(const Frame& F, int b, int g) {
    const int lane = F.lane, fr = lane & 15, fq = lane >> 4;
    const bf16_t* Ub = WSP(bf16_t, WS_UF) + (SAMPLE ? (size_t)MP * 512 + (size_t)g * 16 * 512 : (size_t)(b * 32 + g) * 16 * 2048) + lane * 8;
    const bf16_t* Wg = WSP(bf16_t, WS_WT) + (size_t)g * 65536 + lane * 8;
    const float* A32 = WSP(float, WS_A32) + g * 128;
    float* HIN = WSP(float, WS_HIN);
#pragma unroll 1
    for (int h2 = 0; h2 < 2; ++h2) {
        f32x4 acc[MT][4];
#pragma unroll
        for (int mt = 0; mt < MT; ++mt)
#pragma unroll
            for (int j = 0; j < 4; ++j) acc[mt][j] = (f32x4){0.f, 0.f, 0.f, 0.f};
#pragma unroll 2
        for (int kk = 0; kk < 16; ++kk) {
            bf16x8 a[MT], w[4];
#pragma unroll
            for (int mt = 0; mt < MT; ++mt) a[mt] = *(const bf16x8*)(Ub + (size_t)kk * (SAMPLE ? 512 : 2048) + mt * 512);
#pragma unroll
            for (int j = 0; j < 4; ++j) { const int nb = (j < 2) ? 2 * h2 + j : 4 + 2 * h2 + (j - 2); w[j] = *(const bf16x8*)(Wg + (size_t)(nb * 16 + kk) * 512); }
#pragma unroll
            for (int mt = 0; mt < MT; ++mt)
#pragma unroll
                for (int j = 0; j < 4; ++j) acc[mt][j] = MFMA16(a[mt], w[j], acc[mt][j]);
        }
#pragma unroll
        for (int i = 0; i < 2; ++i) {
            const int n = (2 * h2 + i) * 16 + fr;
            const float ar = A32[n * 2], ai = A32[n * 2 + 1];
            if constexpr (SAMPLE) {
#pragma unroll
                for (int e = 0; e < 4; ++e) {
                    const int sb = fq * 4 + e; const size_t idx = ((size_t)sb * 32 + g) * 64 + n;
                    const float hr = F.in[2][idx], hi = F.in[3][idx];
                    F.out[O_SRE + idx] = ar * hr - ai * hi + acc[0][i][e]; F.out[O_SIM + idx] = ar * hi + ai * hr + acc[0][2 + i][e];
                }
            } else {
            const float a2r = ar * ar - ai * ai, a2i = 2.f * ar * ai, a3r = a2r * ar - a2i * ai, a3i = a2r * ai + a2i * ar, a4r = a2r * a2r - a2i * a2i, a4i = 2.f * a2r * a2i;
            float h1r[MT], h1i[MT], h2r[MT], h2i[MT], h3r[MT], h3i[MT], er[MT], ei[MT], cr[MT], ci[MT];
#pragma unroll
            for (int mt = 0; mt < MT; ++mt) {
                const f32x4 sr = acc[mt][i], si = acc[mt][2 + i];
                h1r[mt] = sr[0]; h1i[mt] = si[0];
                h2r[mt] = ar * h1r[mt] - ai * h1i[mt] + sr[1]; h2i[mt] = ar * h1i[mt] + ai * h1r[mt] + si[1];
                h3r[mt] = ar * h2r[mt] - ai * h2i[mt] + sr[2]; h3i[mt] = ar * h2i[mt] + ai * h2r[mt] + si[2];
                er[mt] = ar * h3r[mt] - ai * h3i[mt] + sr[3]; ei[mt] = ar * h3i[mt] + ai * h3r[mt] + si[3];
                cr[mt] = 0.f; ci[mt] = 0.f;
            }
            float kr = 0.f, ki = 0.f;
#pragma unroll
            for (int gi = 0; gi < 4 * MT; ++gi) {
                const int mt = gi >> 2, src = (gi & 3) * 16 + fr;
                const float xr = __shfl(er[mt], src), xi = __shfl(ei[mt], src);
                if ((gi & 3) == fq) { cr[mt] = kr; ci[mt] = ki; }
                const float nr = a4r * kr - a4i * ki + xr, ni = a4r * ki + a4i * kr + xi; kr = nr; ki = ni;
            }
            if (fq == 0) { F.out[O_PRE + ((size_t)b * 32 + g) * 64 + n] = kr; F.out[O_PIM + ((size_t)b * 32 + g) * 64 + n] = ki; }
#pragma unroll
            for (int mt = 0; mt < MT; ++mt) {
                const int c0 = mt * 16 + fq * 4;
                float* hp = HIN + (((size_t)b * 64 + c0) * 32 + g) * 128 + n;
                const float kr0 = cr[mt], ki0 = ci[mt];
                hp[0] = kr0; hp[64] = ki0;
                hp[4096] = ar * kr0 - ai * ki0 + h1r[mt]; hp[4096 + 64] = ar * ki0 + ai * kr0 + h1i[mt];
                hp[8192] = a2r * kr0 - a2i * ki0 + h2r[mt]; hp[8192 + 64] = a2r * ki0 + a2i * kr0 + h2i[mt];
                hp[12288] = a3r * kr0 - a3i * ki0 + h3r[mt]; hp[12288 + 64] = a3r * ki0 + a3i * kr0 + h3i[mt];
            }
            }
        }
    }
}

DI void p23_phase(const Frame& F) {
    constexpr int T_SSM = 36, T_ATT = 272, T_P3 = 528;
    unsigned* hc = WSP(unsigned, WS_CTL) + 3584 + 224;
    LAS float* ob = (LAS float*)F.lds;
    for (int t = F.bid; t < T_SSM; t += F.G) {
        const int wt = t * 8 + F.wave;
        if (wt < 256) ssm_state<4, false>(F, wt >> 5, wt & 31); else ssm_state<1, true>(F, 0, wt - 256);
        asm volatile("s_waitcnt vmcnt(0)" ::: "memory");
        __syncthreads();
        if (F.tid == 0 && t < 32) {
            __builtin_amdgcn_fence(__ATOMIC_RELEASE, "agent");
            asm volatile("s_waitcnt vmcnt(0)" ::: "memory");
            (void)__hip_atomic_fetch_add((GAS unsigned*)(hc + (t >> 2)), 1u, __ATOMIC_RELAXED, __HIP_MEMORY_SCOPE_AGENT);
        }
    }
    const int t0 = (F.bid >= T_SSM % F.G) ? F.bid - T_SSM % F.G : F.bid + F.G - T_SSM % F.G;
    for (int a = t0; a < T_ATT; a += F.G) {
        const int h = F.wave, kvh = h >> 2;
        const float sink = F.in[19][h]; const float* gat = F.in[21];
        if (a < 256) {
            const int b = a >> 5, c = a & 31, c0 = c < 2 ? 0 : c - 2, row0 = b * SEQ + c * 64;
            attn_task(WSP(bf16_t, WS_Q) + ((size_t)h * (M / 16) + (row0 >> 4)) * 1024, 4, WSP(bf16_t, WS_KB) + ((size_t)kvh * (M / 16) + ((b * SEQ + c0 * 64) >> 4)) * 1024, (c - c0 + 1) * 4,
                      WSP(bf16_t, WS_VT) + ((size_t)(b * 2 + kvh) * 64 + c0 * 2) * 2048, 0, sink, gat, WSP(bf16_t, WS_MIX) + (size_t)row0 * D + 512, ob, h, F.wave, F.lane);
        } else {
            const int sb = a - 256, row0 = MP + sb * 32;
            attn_task(WSP(bf16_t, WS_Q) + ((size_t)h * (M / 16) + (row0 >> 4)) * 1024, 2, WSP(bf16_t, WS_KS) + (size_t)(sb * 2 + kvh) * 10 * 1024, 10,
                      WSP(bf16_t, WS_VTS) + (size_t)(sb * 2 + kvh) * 5 * 2048, 0, sink, gat, WSP(bf16_t, WS_MIX) + (size_t)row0 * D + 512, ob, h, F.wave, F.lane);
        }
    }
}
constexpr int P3_LDY = 520, P3_LDU = 72, P3_UST = 36864;
DI void p3_zero(const Frame& F) {
    LAS u32x4* z = (LAS u32x4*)(F.lds + P3_UST + F.wave * (64 * P3_LDU * 2));
    for (int i = F.lane; i < 32 * P3_LDU * 2 / 16; i += 64) z[i] = (u32x4){0u, 0u, 0u, 0u};
}
DI void p3_task(const Frame& F, int ci) {
    const int lane = F.lane, fr = lane & 15, fq = lane >> 4, wave = F.wave;
    const int row0 = ci < 512 ? (ci >> 6) * SEQ + (ci & 63) * 32 : MP + (ci - 512) * 32;
    constexpr int LDY = P3_LDY, LDU = P3_LDU;
    LAS bf16_t* y1 = (LAS bf16_t*)F.lds; LAS float* ssq = (LAS float*)(F.lds + 32 * LDY * 2);
    LAS bf16_t* ust = (LAS bf16_t*)(F.lds + P3_UST) + wave * (64 * LDU);
    {
        const bf16_t* up = WSP(bf16_t, WS_U) + (size_t)(row0 + (lane >> 3)) * 512 + wave * 64 + (lane & 7) * 8;
#pragma unroll
        for (int i = 0; i < 4; ++i) *(LAS u32x4*)(ust + (32 + (lane >> 3) + 8 * i) * LDU + (lane & 7) * 8) = *(const u32x4*)(up + (size_t)i * 8 * 512);
    }
#pragma unroll 1
    for (int gi = 0; gi < 4; ++gi) {
        const int g = wave * 4 + gi;
        f32x4 acc0 = (f32x4){0.f, 0.f, 0.f, 0.f}, acc1 = acc0;
        const bf16_t* Kg = WSP(bf16_t, WS_KT) + (size_t)g * 8192 + lane * 8;
        const LAS bf16_t* ub = ust + (32 + fr - (fq >> 1)) * LDU + gi * 16 + (fq & 1) * 8;
#pragma unroll
        for (int kk = 0; kk < 16; ++kk) {
            const bf16x8 kf = *(const bf16x8*)(Kg + kk * 512);
            acc1 = MFMA16(kf, *(const LAS bf16x8*)(ub + (16 - 2 * kk) * LDU), acc1);
            if (kk < 8) acc0 = MFMA16(kf, *(const LAS bf16x8*)(ub - 2 * kk * LDU), acc0);
        }
        const float* hre; const float* him;
        if (ci < 512) { hre = WSP(float, WS_HIN) + ((size_t)ci * 32 + g) * 128; him = hre + 64; }
        else { hre = F.in[2] + ((size_t)(ci - 512) * 32 + g) * 64; him = F.in[3] + ((size_t)(ci - 512) * 32 + g) * 64; }
#pragma unroll
        for (int nh = 0; nh < 2; ++nh) {
            const int n0 = nh * 32 + fq * 8;
            const f32x4 hr0 = *(const f32x4*)(hre + n0), hr1 = *(const f32x4*)(hre + n0 + 4), hi0 = *(const f32x4*)(him + n0), hi1 = *(const f32x4*)(him + n0 + 4);
            const bf16_t* cp = WSP(bf16_t, WS_CT) + (size_t)g * 2048 + lane * 8;
            const bf16x8 cref = *(const bf16x8*)(cp + nh * 512), cimf = *(const bf16x8*)(cp + (2 + nh) * 512);
#pragma unroll
            for (int mt = 0; mt < 2; ++mt) {
                const float* pp = WSP(float, WS_PRE) + (size_t)g * 4096 + (mt * 2 + nh) * 1024 + lane * 4;
                const f32x4 pr0 = *(const f32x4*)pp, pr1 = *(const f32x4*)(pp + 256), pi0 = *(const f32x4*)(pp + 512), pi1 = *(const f32x4*)(pp + 768);
                const f32x4 gr0 = pr0 * hr0 - pi0 * hi0, gr1 = pr1 * hr1 - pi1 * hi1, gi0 = pr0 * hi0 + pi0 * hr0, gi1 = pr1 * hi1 + pi1 * hr1;
                const bf16x8 gre = __builtin_bit_cast(bf16x8, pack8(gr0, gr1)), gim = __builtin_bit_cast(bf16x8, pack8(gi0, gi1));
                if (mt == 0) { acc0 = MFMA16(cref, gre, acc0); acc0 = MFMA16(cimf, gim, acc0); }
                else         { acc1 = MFMA16(cref, gre, acc1); acc1 = MFMA16(cimf, gim, acc1); }
            }
        }
        {   u32x2 w; w.x = pk2(gelu_tanh(acc0[0]), gelu_tanh(acc0[1])); w.y = pk2(gelu_tanh(acc0[2]), gelu_tanh(acc0[3]));
            *(LAS u32x2*)(y1 + fr * LDY + g * 16 + fq * 4) = w;
            w.x = pk2(gelu_tanh(acc1[0]), gelu_tanh(acc1[1])); w.y = pk2(gelu_tanh(acc1[2]), gelu_tanh(acc1[3]));
            *(LAS u32x2*)(y1 + (16 + fr) * LDY + g * 16 + fq * 4) = w; }
    }
    __syncthreads();
    f32x4 a2[2][4];
#pragma unroll
    for (int mt = 0; mt < 2; ++mt)
#pragma unroll
        for (int nt = 0; nt < 4; ++nt) a2[mt][nt] = (f32x4){0.f, 0.f, 0.f, 0.f};
    const bf16_t* Wg = WSP(bf16_t, WS_WGLU) + (size_t)(wave * 4) * 8192 + lane * 8;
#pragma unroll 4
    for (int kk = 0; kk < 16; ++kk) {
        bf16x8 yf[2], wf[4];
#pragma unroll
        for (int mt = 0; mt < 2; ++mt) yf[mt] = *(const LAS bf16x8*)(y1 + (mt * 16 + fr) * LDY + kk * 32 + fq * 8);
#pragma unroll
        for (int nt = 0; nt < 4; ++nt) wf[nt] = *(const bf16x8*)(Wg + (size_t)nt * 8192 + kk * 512);
#pragma unroll
        for (int mt = 0; mt < 2; ++mt)
#pragma unroll
            for (int nt = 0; nt < 4; ++nt) a2[mt][nt] = MFMA16(wf[nt], yf[mt], a2[mt][nt]);
    }
    float q2[2] = {0.f, 0.f};
#pragma unroll
    for (int mt = 0; mt < 2; ++mt)
#pragma unroll
        for (int nt = 0; nt < 4; ++nt) {
            const int n = wave * 64 + nt * 16 + fq * 4;
            const f32x4 bias = *(const f32x4*)(F.in[18] + n);
            const u32x2 yw = *(const LAS u32x2*)(y1 + (mt * 16 + fr) * LDY + n);
            const float y0 = bflo(yw.x), y1v = bfhi(yw.x), y2v = bflo(yw.y), y3 = bfhi(yw.y);
            f32x4 r; r[0] = y0 * sigm(a2[mt][nt][0] + bias[0]); r[1] = y1v * sigm(a2[mt][nt][1] + bias[1]); r[2] = y2v * sigm(a2[mt][nt][2] + bias[2]); r[3] = y3 * sigm(a2[mt][nt][3] + bias[3]);
            a2[mt][nt] = r; q2[mt] += r[0] * r[0] + r[1] * r[1] + r[2] * r[2] + r[3] * r[3];
        }
    q2[0] = xsum4(q2[0]); q2[1] = xsum4(q2[1]);
    if (fq == 0) { ssq[wave * 32 + fr] = q2[0]; ssq[wave * 32 + 16 + fr] = q2[1]; }
    __syncthreads();
#pragma unroll
    for (int mt = 0; mt < 2; ++mt) {
        float tot = 0.f;
#pragma unroll
        for (int w = 0; w < 8; ++w) tot += ssq[w * 32 + mt * 16 + fr];
        const float rs = rsqrtf(tot * (1.0f / 512.0f) + EPS);
#pragma unroll
        for (int nt = 0; nt < 4; ++nt) {
            const int n = wave * 64 + nt * 16 + fq * 4;
            const f32x4 g = *(const f32x4*)(F.in[20] + n);
            u32x2 w; w.x = pk2(a2[mt][nt][0] * rs * g[0], a2[mt][nt][1] * rs * g[1]); w.y = pk2(a2[mt][nt][2] * rs * g[2], a2[mt][nt][3] * rs * g[3]);
            *(u32x2*)(WSP(bf16_t, WS_MIX) + (size_t)(row0 + mt * 16 + fr) * D + n) = w;
        }
    }
    __syncthreads();
}

DI void late_weights(const Frame& F) {
    constexpr int T_WO = 256, T_WA = 16 * 44, T_WD = 44 * 16;
    LAS float* scr = (LAS float*)F.lds;
    const int nskip = ((36 + 272 + 528) % F.G), G = F.G - nskip;
    if (F.bid < nskip || G <= 0) return;
    int r = F.bid - nskip;
#define P0_LOOP(COUNT) for (int i = r; i < (COUNT); i += G)
#define P0_NEXT(COUNT) r = (r + G - (COUNT) % G) % G
    P0_LOOP(T_WO) p0_transpose(F.in[22], D, nullptr, WSP(bf16_t, WS_WO), D, (i % 16) * 64, (i / 16) * 64, (i / 16) * 64, scr, F.tid);
    P0_NEXT(T_WO);
    P0_LOOP(T_WA) { const int n0 = (i / 16) * 64; p0_transpose(F.in[24], FF, F.in[23], WSP(bf16_t, WS_W1), D, (i % 16) * 64, n0, (n0 >> 7) * 256 + (n0 & 127), scr, F.tid); }
    P0_NEXT(T_WA);
    P0_LOOP(T_WA) { const int n0 = (i / 16) * 64; p0_transpose(F.in[25], FF, F.in[23], WSP(bf16_t, WS_W1), D, (i % 16) * 64, n0, (n0 >> 7) * 256 + 128 + (n0 & 127), scr, F.tid); }
    P0_NEXT(T_WA);
    P0_LOOP(T_WD) p0_transpose(F.in[28], D, nullptr, WSP(bf16_t, WS_W2), FF, (i % 44) * 64, (i / 44) * 64, (i / 44) * 64, scr, F.tid);
    P0_NEXT(T_WD);
#undef P0_LOOP
#undef P0_NEXT
}

DI void p3_loop(const Frame& F) {
    constexpr int T_PRE = 36 + 272, T_P3 = 528;
    unsigned* hc = WSP(unsigned, WS_CTL) + 3584 + 224;
    p3_zero(F);
    const int r0 = T_PRE % F.G, c0 = (F.bid >= r0) ? F.bid - r0 : F.bid + F.G - r0;
    for (int ci = c0; ci < T_P3; ci += F.G) {
        if (ci < 512) {
            if (F.tid == 0) {
                while (__hip_atomic_load((GAS unsigned*)(hc + (ci >> 6)), __ATOMIC_RELAXED, __HIP_MEMORY_SCOPE_AGENT) < 4u) __builtin_amdgcn_s_sleep(1);
                __builtin_amdgcn_fence(__ATOMIC_ACQUIRE, "agent");
                asm volatile("s_waitcnt vmcnt(0)" ::: "memory");
            }
            __syncthreads();
        }
        p3_task(F, ci);
    }
}

DI void panel_rs(float* part, unsigned* cnt, LAS float* lx, int pm, int pn, float* rs_out = nullptr) {
    const int tid = threadIdx.x;
    __syncthreads();
    if (tid < 256) st_agent(part + (size_t)(pm * 4 + pn) * 256 + tid, lx[tid] + lx[256 + tid] + lx[512 + tid] + lx[768 + tid]);
    asm volatile("s_waitcnt vmcnt(0)" ::: "memory");
    __syncthreads();
    if (tid == 0) arrive_and_wait(cnt + pm, 4u);
    __syncthreads();
    if (tid < 256) { const float* pp = part + (size_t)pm * 1024 + tid; const float r = rsqrtf((ld_agent(pp) + ld_agent(pp + 256) + ld_agent(pp + 512) + ld_agent(pp + 768)) * (1.0f / D) + EPS); lx[1024 + tid] = r;
        if (rs_out && pn == 0) rs_out[pm * 256 + tid] = r; }
    __syncthreads();
}
struct EpiOut {
    static constexpr bool PERM = true, AFTER_DRAIN = false;
    const float* xp; float* RS; bf16_t* X1B; float* part; unsigned* cnt; LAS float* lx;
    DI void operator()(const f32x4 (&acc_)[2][2][4][2], const pg8::Unit& u, int wr, int wc, int fr, int fq) const {
        f32x4 (&acc)[2][2][4][2] = const_cast<f32x4 (&)[2][2][4][2]>(acc_);
        const int row0 = u.pm * 256 + wr * 64 + fr, col0 = u.pn * 256 + wc * 32 + 8 * fq;
#pragma unroll
        for (int ai = 0; ai < 2; ++ai)
#pragma unroll
            for (int m = 0; m < 4; ++m) {
                const size_t ro = (size_t)(row0 + ai * 128 + m * 16) * D + col0;
                float q = 0.f;
#pragma unroll
                for (int bj = 0; bj < 2; ++bj) {
                    const f32x4 v0 = acc[ai][bj][m][0] + *(const f32x4*)(xp + ro + bj * 128), v1 = acc[ai][bj][m][1] + *(const f32x4*)(xp + ro + bj * 128 + 4);
                    acc[ai][bj][m][0] = v0; acc[ai][bj][m][1] = v1;
                    q += v0[0] * v0[0] + v0[1] * v0[1] + v0[2] * v0[2] + v0[3] * v0[3] + v1[0] * v1[0] + v1[1] * v1[1] + v1[2] * v1[2] + v1[3] * v1[3];
                }
                q = xsum4(q);
                if (fq == 0) lx[wc * 256 + ai * 128 + wr * 64 + m * 16 + fr] = q;
            }
        panel_rs(part, cnt, lx, u.pm, u.pn, RS);
#pragma unroll
        for (int ai = 0; ai < 2; ++ai)
#pragma unroll
            for (int m = 0; m < 4; ++m) {
                const float rs = lx[1024 + ai * 128 + wr * 64 + m * 16 + fr];
                const size_t ro = (size_t)(row0 + ai * 128 + m * 16) * D + col0;
#pragma unroll
                for (int bj = 0; bj < 2; ++bj) *(u32x4*)(X1B + ro + bj * 128) = pack8(acc[ai][bj][m][0] * rs, acc[ai][bj][m][1] * rs);
            }
    }
};

struct EpiFfn {
    static constexpr bool PERM = true, AFTER_DRAIN = false;
    unsigned char* ws; const float* const* in; float* out; LAS float* bnd;
    DI void operator()(const f32x4 (&acc)[2][2][4][2], const pg8::Unit& u, int wr, int wc, int fr, int fq) const {
        const bf16_t* const X1B = (const bf16_t*)(ws + WS_X1B); const bf16_t* const W1T = (const bf16_t*)(ws + WS_W1);
        bf16_t* const H = (bf16_t*)(ws + WS_H); const float* const cstate = in[6];
        const int pm = u.pm, pn = u.pn, rowt = pm * 256, wave = wr * 4 + wc, tid = threadIdx.x;
        const bool sample = pm >= 64;
        const int cl = wc * 32 + 8 * fq, ff = pn * 128 + cl;
        LAS float* cwl = bnd + 17 * 2 * 128;
        if (tid < 128) { const float* cw = in[26] + pn * 128 + tid; cwl[tid] = cw[0]; cwl[128 + tid] = cw[FF]; cwl[256 + tid] = cw[2 * FF]; cwl[384 + tid] = in[27][pn * 128 + tid]; }
#pragma unroll
        for (int ai = 0; ai < 2; ++ai)
#pragma unroll
            for (int m = 0; m < 4; ++m) {
                const int blk = 8 * ai + 4 * wr + m;
                if (fr >= 14) {
                    const f32x4 a0 = acc[ai][0][m][0], a1 = acc[ai][0][m][1];
                    if (!sample || (blk & 1) == 0) { LAS float* bp = bnd + ((blk + 1) * 2 + (fr - 14)) * 128 + cl; *(LAS f32x4*)bp = a0; *(LAS f32x4*)(bp + 4) = a1; }
                    if (sample && (blk & 1)) { float* sp = out + O_SCONV + ((size_t)((pm - 64) * 8 + (blk >> 1)) * 2 + (fr - 14)) * FF + ff; *(f32x4*)sp = a0; *(f32x4*)(sp + 4) = a1; }
                    if (!sample && (pm & 7) == 7 && blk == 15) { float* sp = out + O_PCONV + ((size_t)(pm >> 3) * 2 + (fr - 14)) * FF + ff; *(f32x4*)sp = a0; *(f32x4*)(sp + 4) = a1; }
                    if (sample && (blk & 1) == 0) {
                        const float* sp = cstate + ((size_t)((pm - 64) * 8 + (blk >> 1)) * 2 + (fr - 14)) * FF + ff;
                        LAS float* bp = bnd + (blk * 2 + (fr - 14)) * 128 + cl; *(LAS f32x4*)bp = *(const f32x4*)sp; *(LAS f32x4*)(bp + 4) = *(const f32x4*)(sp + 4);
                    }
                    if (!sample && (pm & 7) == 0 && blk == 0) { LAS float* bp = bnd + (fr - 14) * 128 + cl; *(LAS f32x4*)bp = (f32x4){0.f, 0.f, 0.f, 0.f}; *(LAS f32x4*)(bp + 4) = (f32x4){0.f, 0.f, 0.f, 0.f}; }
                }
            }
        if (!sample && (pm & 7) != 0) {
            const int lane = fq * 16 + fr;
            const bf16_t* xp = X1B + (size_t)(rowt - 2) * D + lane * 8;
            const u32x4 xa0 = *(const u32x4*)xp, xa1 = *(const u32x4*)(xp + 512), xb0 = *(const u32x4*)(xp + D), xb1 = *(const u32x4*)(xp + D + 512);
#pragma unroll 1
            for (int ps = 0; ps < 4; ++ps) {
                float p0[4], p1[4];
                const bf16_t* wp = W1T + (size_t)(pn * 256 + wave * 16 + ps * 4) * D + lane * 8;
#pragma unroll
                for (int c = 0; c < 4; ++c) {
                    const u32x4 a = *(const u32x4*)(wp + (size_t)c * D), b = *(const u32x4*)(wp + (size_t)c * D + 512);
                    float s0 = 0.f, s1 = 0.f;
#pragma unroll
                    for (int j = 0; j < 4; ++j) {
                        s0 = dot2bf(a[j], xa0[j], s0); s0 = dot2bf(b[j], xa1[j], s0);
                        s1 = dot2bf(a[j], xb0[j], s1); s1 = dot2bf(b[j], xb1[j], s1);
                    }
                    p0[c] = s0; p1[c] = s1;
                }
#define HALO_STEP(N, BIT) _Pragma("unroll") for (int c = 0; c < N; ++c) { const bool hi_ = (lane & BIT) != 0; \
                    const float s0_ = hi_ ? p0[c] : p0[c + N], s1_ = hi_ ? p1[c] : p1[c + N]; \
                    const float r0_ = __shfl_xor(s0_, BIT), r1_ = __shfl_xor(s1_, BIT); \
                    p0[c] = (hi_ ? p0[c + N] : p0[c]) + r0_; p1[c] = (hi_ ? p1[c + N] : p1[c]) + r1_; }
                HALO_STEP(2, 32) HALO_STEP(1, 16)
#undef HALO_STEP
                float t0 = p0[0], t1 = p1[0];
                t0 += __shfl_xor(t0, 8); t1 += __shfl_xor(t1, 8); t0 += __shfl_xor(t0, 4); t1 += __shfl_xor(t1, 4); t0 += __shfl_xor(t0, 2); t1 += __shfl_xor(t1, 2); t0 += __shfl_xor(t0, 1); t1 += __shfl_xor(t1, 1);
                if ((lane & 15) == 0) { const int col = wave * 16 + ps * 4 + ((lane >> 5) & 1) * 2 + ((lane >> 4) & 1);
                    bnd[col] = t0; bnd[128 + col] = t1; }
            }
        }
        __syncthreads();
#pragma unroll
        for (int ai = 0; ai < 2; ++ai)
#pragma unroll
            for (int m = 0; m < 4; ++m) {
                const int blk = 8 * ai + 4 * wr + m, row = rowt + ai * 128 + wr * 64 + m * 16 + fr;
                f32x4 hv[2];
#pragma unroll
                for (int n = 0; n < 2; ++n) {
                    const f32x4 cur = acc[ai][0][m][n], upv = acc[ai][1][m][n];
                    f32x4 p1, p2;
#pragma unroll
                    for (int e = 0; e < 4; ++e) { p1[e] = dpp_shr<0x111>(cur[e]); p2[e] = dpp_shr<0x112>(cur[e]); }
                    const f32x4 b0 = *(const LAS f32x4*)(bnd + (blk * 2 + 0) * 128 + cl + 4 * n), b1 = *(const LAS f32x4*)(bnd + (blk * 2 + 1) * 128 + cl + 4 * n);
                    if (fr == 0) { p1 = b1; p2 = b0; } else if (fr == 1) { p2 = b1; }
                    const LAS float* wl = cwl + cl + 4 * n;
                    const f32x4 c = *(const LAS f32x4*)(wl + 384) + *(const LAS f32x4*)wl * p2 + *(const LAS f32x4*)(wl + 128) * p1 + *(const LAS f32x4*)(wl + 256) * cur;
#pragma unroll
                    for (int e = 0; e < 4; ++e) hv[n][e] = c[e] * sigm(c[e]) * upv[e];
                }
                *(u32x4*)(H + (size_t)row * FF + ff) = pack8(hv[0], hv[1]);
            }
        __syncthreads();
    }
};

struct EpiDown {
    static constexpr bool PERM = true, AFTER_DRAIN = false;
    float* out; const bf16_t* X1B; const float* RS; const float* gfin; float* part; unsigned* cnt; LAS float* lx;
    DI void operator()(const f32x4 (&acc_)[2][2][4][2], const pg8::Unit& u, int wr, int wc, int fr, int fq) const {
        f32x4 (&acc)[2][2][4][2] = const_cast<f32x4 (&)[2][2][4][2]>(acc_);
        const int row0 = u.pm * 256 + wr * 64 + fr, col0 = u.pn * 256 + wc * 32 + 8 * fq;
#pragma unroll
        for (int ai = 0; ai < 2; ++ai)
#pragma unroll
            for (int m = 0; m < 4; ++m) {
                const int row = row0 + ai * 128 + m * 16;
                const bf16_t* xrow = X1B + (size_t)row * D + col0;
                const float ir = 1.0f / RS[row];
                float q = 0.f;
#pragma unroll
                for (int bj = 0; bj < 2; ++bj) {
                    const u32x4 xw = *(const u32x4*)(xrow + bj * 128);
                    const f32x4 x0 = (f32x4){bflo(xw.x), bfhi(xw.x), bflo(xw.y), bfhi(xw.y)}, x1v = (f32x4){bflo(xw.z), bfhi(xw.z), bflo(xw.w), bfhi(xw.w)};
                    const f32x4 v0 = acc[ai][bj][m][0] + x0 * ir, v1 = acc[ai][bj][m][1] + x1v * ir;
                    acc[ai][bj][m][0] = v0; acc[ai][bj][m][1] = v1;
                    q += v0[0] * v0[0] + v0[1] * v0[1] + v0[2] * v0[2] + v0[3] * v0[3] + v1[0] * v1[0] + v1[1] * v1[1] + v1[2] * v1[2] + v1[3] * v1[3];
                }
                q = xsum4(q);
                if (fq == 0) lx[wc * 256 + ai * 128 + wr * 64 + m * 16 + fr] = q;
            }
        panel_rs(part, cnt, lx, u.pm, u.pn);
        f32x4 gv[2][2];
#pragma unroll
        for (int bj = 0; bj < 2; ++bj) { gv[bj][0] = *(const f32x4*)(gfin + col0 + bj * 128); gv[bj][1] = *(const f32x4*)(gfin + col0 + bj * 128 + 4); }
#pragma unroll
        for (int ai = 0; ai < 2; ++ai)
#pragma unroll
            for (int m = 0; m < 4; ++m) {
                float* orow = out + (size_t)(row0 + ai * 128 + m * 16) * D + col0;
                const float rs = lx[1024 + ai * 128 + wr * 64 + m * 16 + fr];
#pragma unroll
                for (int bj = 0; bj < 2; ++bj) { *(f32x4*)(orow + bj * 128) = acc[ai][bj][m][0] * rs * gv[bj][0]; *(f32x4*)(orow + bj * 128 + 4) = acc[ai][bj][m][1] * rs * gv[bj][1]; }
            }
    }
};


template <int K> DI f32x4 mini_tile_ks(const Frame& F, const bf16_t* __restrict__ A, const bf16_t* __restrict__ Bt, int row0, int col0) {
    constexpr int KS = K / 8, LDR = 68;
    const int lane = F.lane, fr = lane & 15, fq = lane >> 4;
    const bf16_t* ap = A + (size_t)(row0 + fr) * K + F.wave * KS + fq * 8;
    const bf16_t* bp = Bt + (size_t)(col0 + fr) * K + F.wave * KS + fq * 8;
    f32x4 acc[2][4];
#pragma unroll
    for (int mt = 0; mt < 2; ++mt)
#pragma unroll
        for (int nt = 0; nt < 4; ++nt) acc[mt][nt] = (f32x4){0.f, 0.f, 0.f, 0.f};
#pragma unroll 2
    for (int kk = 0; kk < KS / 32; ++kk) {
        bf16x8 xa[2], wb[4];
#pragma unroll
        for (int mt = 0; mt < 2; ++mt) xa[mt] = *(const bf16x8*)(ap + (size_t)mt * 16 * K + kk * 32);
#pragma unroll
        for (int nt = 0; nt < 4; ++nt) wb[nt] = *(const bf16x8*)(bp + (size_t)nt * 16 * K + kk * 32);
#pragma unroll
        for (int mt = 0; mt < 2; ++mt)
#pragma unroll
            for (int nt = 0; nt < 4; ++nt) acc[mt][nt] = MFMA16(wb[nt], xa[mt], acc[mt][nt]);
    }
    LAS float* red = (LAS float*)F.lds;
#pragma unroll
    for (int mt = 0; mt < 2; ++mt)
#pragma unroll
        for (int nt = 0; nt < 4; ++nt) *(LAS f32x4*)(red + F.wave * (32 * LDR) + (mt * 16 + fr) * LDR + nt * 16 + fq * 4) = acc[mt][nt];
    __syncthreads();
    f32x4 sum = (f32x4){0.f, 0.f, 0.f, 0.f};
#pragma unroll
    for (int w = 0; w < 8; ++w) sum += *(const LAS f32x4*)(red + w * (32 * LDR) + (F.tid >> 4) * LDR + (F.tid & 15) * 4);
    __syncthreads();
    return sum;
}
constexpr int MINI_PARK = LDS_X + 8192;
DI void p4_sample_a(const Frame& F) {
    if (F.bid >= 256) return;
    float* PS = WSP(float, WS_PARTS); unsigned* cnt = WSP(unsigned, WS_CTL) + 3584 + 192;
    const int t = F.bid, rg = t & 15, cg = t >> 4, rl = F.tid >> 4, row = MP + rg * 32 + rl, n0 = cg * 64 + (F.tid & 15) * 4;
    const f32x4 acc = mini_tile_ks<D>(F, WSP(bf16_t, WS_MIX), WSP(bf16_t, WS_WO), MP + rg * 32, cg * 64);
    const f32x4 v = acc + *(const f32x4*)(F.in[1] + (size_t)(row - MP) * D + n0);
    float q = v[0] * v[0] + v[1] * v[1] + v[2] * v[2] + v[3] * v[3];
    q += __shfl_xor(q, 1); q += __shfl_xor(q, 2); q += __shfl_xor(q, 4); q += __shfl_xor(q, 8);
    if ((F.tid & 15) == 0) st_agent(PS + (size_t)(rg * 16 + cg) * 32 + rl, q);
    *(LAS f32x4*)(F.lds + MINI_PARK + F.tid * 16) = v;
    asm volatile("s_waitcnt vmcnt(0)" ::: "memory");
    __syncthreads();
    if (F.tid == 0) (void)__hip_atomic_fetch_add((GAS unsigned*)(cnt + rg), 1u, __ATOMIC_RELAXED, __HIP_MEMORY_SCOPE_AGENT);
}
DI void p4_sample_b(const Frame& F) {
    if (F.bid >= 256) return;
    float* PS = WSP(float, WS_PARTS); unsigned* cnt = WSP(unsigned, WS_CTL) + 3584 + 192;
    const int t = F.bid, rg = t & 15, cg = t >> 4, rl = F.tid >> 4, row = MP + rg * 32 + rl, n0 = cg * 64 + (F.tid & 15) * 4;
    if (F.tid == 0) wait_ge16(cnt + rg);
    __syncthreads();
    float tot = 0.f;
#pragma unroll
    for (int c = 0; c < 16; ++c) tot += ld_agent(PS + (size_t)(rg * 16 + c) * 32 + rl);
    const float rs = rsqrtf(tot * (1.0f / D) + EPS);
    const f32x4 v = *(const LAS f32x4*)(F.lds + MINI_PARK + F.tid * 16);
    *(f32x4*)(WSP(float, WS_X1F) + (size_t)row * D + n0) = v;
    u32x2 w; w.x = pk2(v[0] * rs, v[1] * rs); w.y = pk2(v[2] * rs, v[3] * rs); *(u32x2*)(WSP(bf16_t, WS_X1B) + (size_t)row * D + n0) = w;
}
DI void p6_sample_a(const Frame& F) {
    if (F.bid >= 256) return;
    float* PS = WSP(float, WS_PARTS); unsigned* cnt = WSP(unsigned, WS_CTL) + 3584 + 208;
    const int t = F.bid, rg = t & 15, cg = t >> 4, rl = F.tid >> 4, row = MP + rg * 32 + rl, n0 = cg * 64 + (F.tid & 15) * 4;
    const f32x4 acc = mini_tile_ks<FF>(F, WSP(bf16_t, WS_H), WSP(bf16_t, WS_W2), MP + rg * 32, cg * 64);
    const f32x4 v = acc + *(const f32x4*)(WSP(float, WS_X1F) + (size_t)row * D + n0);
    float q = v[0] * v[0] + v[1] * v[1] + v[2] * v[2] + v[3] * v[3];
    q += __shfl_xor(q, 1); q += __shfl_xor(q, 2); q += __shfl_xor(q, 4); q += __shfl_xor(q, 8);
    if ((F.tid & 15) == 0) st_agent(PS + (size_t)(rg * 16 + cg) * 32 + rl, q);
    *(LAS f32x4*)(F.lds + MINI_PARK + F.tid * 16) = v;
    asm volatile("s_waitcnt vmcnt(0)" ::: "memory");
    __syncthreads();
    if (F.tid == 0) (void)__hip_atomic_fetch_add((GAS unsigned*)(cnt + rg), 1u, __ATOMIC_RELAXED, __HIP_MEMORY_SCOPE_AGENT);
}
DI void p6_sample_b(const Frame& F) {
    if (F.bid >= 256) return;
    float* PS = WSP(float, WS_PARTS); unsigned* cnt = WSP(unsigned, WS_CTL) + 3584 + 208;
    const int t = F.bid, rg = t & 15, cg = t >> 4, rl = F.tid >> 4, row = MP + rg * 32 + rl, n0 = cg * 64 + (F.tid & 15) * 4;
    if (F.tid == 0) wait_ge16(cnt + rg);
    __syncthreads();
    float tot = 0.f;
#pragma unroll
    for (int c = 0; c < 16; ++c) tot += ld_agent(PS + (size_t)(rg * 16 + c) * 32 + rl);
    const float rs = rsqrtf(tot * (1.0f / D) + EPS);
    const f32x4 v = *(const LAS f32x4*)(F.lds + MINI_PARK + F.tid * 16);
    *(f32x4*)(F.out + (size_t)row * D + n0) = v * rs * *(const f32x4*)(F.in[29] + n0);
}

#define RLX_AGENT __ATOMIC_RELAXED, __HIP_MEMORY_SCOPE_AGENT
#define XB_TMO      128
#define XB_XCNT(j)  (256  + 64 * (j))
#define XB_XSUB(j)  (1280 + 64 * (j))
#define XB_XGEN(j)  (2304 + 64 * (j))
#define XB_TOP      3328
#define XB_TOPGEN   3392
#define XCD_BAR_WORDS 3456
#define XB_SPIN_CAP (1u << 18)

__device__ __forceinline__ unsigned xb_ld(unsigned* p)              { return __hip_atomic_load(p, __ATOMIC_RELAXED, __HIP_MEMORY_SCOPE_AGENT); }
__device__ __forceinline__ unsigned xb_add(unsigned* p, unsigned v) { return __hip_atomic_fetch_add(p, v, __ATOMIC_RELAXED, __HIP_MEMORY_SCOPE_AGENT); }
__device__ __forceinline__ unsigned xb_xcc_id() { return (unsigned)__builtin_amdgcn_s_getreg((3 << 11) | 20) & 0xFu; }
#define XB_SPIN(cond, bar) do { unsigned _sp = 0; while (cond) { __builtin_amdgcn_s_sleep(1); \
    if ((++_sp & 255u) == 0u) { if (xb_ld(&(bar)[XB_TMO])) break; if (_sp > XB_SPIN_CAP) { atomicAdd(&(bar)[XB_TMO], 1u); break; } } } } while (0)

struct XcdBarrier {
    unsigned* bar; unsigned x;
    volatile LAS unsigned* st;
};

__device__ __forceinline__ XcdBarrier xcd_barrier_post(unsigned* bar, volatile LAS unsigned* st) {
    XcdBarrier b; b.bar = bar; b.x = xb_xcc_id(); b.st = st;
    if (threadIdx.x == 0) (void)xb_add(&bar[XB_XCNT(b.x)], 1u);
    return b;
}
__device__ __forceinline__ void xcd_barrier_complete(unsigned* bar, unsigned x, unsigned& nloc, unsigned& nx) {
    const unsigned G = gridDim.x * gridDim.y * gridDim.z;
    unsigned sum, cnt, mine, sp = 0u;
    for (;;) {
        sum = 0u; cnt = 0u; mine = 0u;
#pragma unroll
        for (unsigned j = 0; j < 16; ++j) { const unsigned c = xb_ld(&bar[XB_XCNT(j)]); sum += c; cnt += (c > 0u) ? 1u : 0u; mine = (j == x) ? c : mine; }
        if (sum == G) break;
        __builtin_amdgcn_s_sleep(1);
        if ((++sp & 255u) == 0u) { if (xb_ld(&bar[XB_TMO])) break; if (sp > XB_SPIN_CAP) { atomicAdd(&bar[XB_TMO], 1u); break; } }
    }
    nloc = mine > 0u ? mine : 1u; nx = cnt > 0u ? cnt : 1u;
}

__device__ __forceinline__ void xcd_barrier(const XcdBarrier& b) {
    asm volatile("s_waitcnt vmcnt(0)" ::: "memory");
    __syncthreads();
    if (threadIdx.x == 0) {
        unsigned* bar = b.bar;
        __builtin_amdgcn_s_waitcnt(0);
        unsigned nloc = b.st[0], nx = b.st[1];
        if (nloc == 0u) { xcd_barrier_complete(bar, b.x, nloc, nx); b.st[0] = nloc; b.st[1] = nx; }
        const unsigned old = xb_add(&bar[XB_XSUB(b.x)], 1u);
        const unsigned gen = old / nloc;
        if (old + 1u == (gen + 1u) * nloc) {
            __builtin_amdgcn_fence(__ATOMIC_RELEASE, "agent");
            asm volatile("s_waitcnt vmcnt(0)" ::: "memory");
            const unsigned og = xb_add(&bar[XB_TOP], 1u);
            const unsigned tg = og / nx;
            if (og + 1u == (tg + 1u) * nx) xb_add(&bar[XB_TOPGEN], 1u);
            else XB_SPIN(xb_ld(&bar[XB_TOPGEN]) == tg, bar);
            __builtin_amdgcn_fence(__ATOMIC_ACQUIRE, "agent");
            xb_add(&bar[XB_XGEN(b.x)], 1u);
            asm volatile("s_waitcnt vmcnt(0)" ::: "memory");
        } else {
            XB_SPIN(xb_ld(&bar[XB_XGEN(b.x)]) == gen, bar);
            __builtin_amdgcn_fence(__ATOMIC_ACQUIRE, "agent");
            asm volatile("s_waitcnt vmcnt(0)" ::: "memory");
        }
    }
    __syncthreads();
}

DI void grid_bar(unsigned* ctr, unsigned target) {
    asm volatile("s_waitcnt vmcnt(0)" ::: "memory");
    __syncthreads();
    if (threadIdx.x == 0) {
        __builtin_amdgcn_fence(__ATOMIC_RELEASE, "agent");
        asm volatile("s_waitcnt vmcnt(0)" ::: "memory");
        (void)__hip_atomic_fetch_add(ctr, 1u, __ATOMIC_RELAXED, __HIP_MEMORY_SCOPE_AGENT);
        while (__hip_atomic_load(ctr, __ATOMIC_RELAXED, __HIP_MEMORY_SCOPE_AGENT) < target) __builtin_amdgcn_s_sleep(1);
        __builtin_amdgcn_fence(__ATOMIC_ACQUIRE, "agent");
        asm volatile("s_waitcnt vmcnt(0)" ::: "memory");
    }
    __syncthreads();
}

#ifndef PH_MASK
#define PH_MASK 255
#endif
__global__ void __launch_bounds__(512, 2) mega_fwd(Args args) {
    extern __shared__ __attribute__((aligned(16))) unsigned char lds_raw[];
    cg::grid_group grid = cg::this_grid();
    Frame F;
    F.lds = (LAS unsigned char*)lds_raw; F.tid = threadIdx.x; F.lane = F.tid & 63; F.wave = __builtin_amdgcn_readfirstlane(F.tid >> 6);
    F.G = gridDim.x; F.bid = blockIdx.x; F.in = args.in; F.out = args.out; F.ws = args.ws;
    const int lo = args.ph_lo, hi = args.ph_hi;
#define IN(k) (((PH_MASK >> (k)) & 1) && lo <= (k) && (k) < hi)
    volatile LAS unsigned* xb_st = (volatile LAS unsigned*)(F.lds + LDS_BYTES - 64);
    if (F.tid < 2) xb_st[F.tid] = 0u;
    __syncthreads();
    XcdBarrier xbar; xbar.bar = WSP(unsigned, WS_CTL); xbar.x = 0; xbar.st = xb_st;
    if (lo + 1 < hi) xbar = xcd_barrier_post(WSP(unsigned, WS_CTL), xb_st);
    unsigned bar_n = 0;
#ifdef USE_CG_SYNC
#define SEAM(k) do { if (lo <= (k) && (k) + 1 < hi) grid.sync(); } while (0)
#else
#ifdef USE_CENTRAL_BAR
#define SEAM(k) do { if (lo <= (k) && (k) + 1 < hi) { bar_n += (unsigned)F.G; grid_bar(WSP(unsigned, WS_CTL) + 3520, bar_n); } } while (0)
#else
#define SEAM(k) do { if (lo <= (k) && (k) + 1 < hi) xcd_barrier(xbar); } while (0)
#endif
#endif
    if (hi > 8) grid.sync();
#ifndef REP_MASK
#define REP_MASK 0
#endif
#define REPS(k) for (int rep_ = 0; rep_ < 1 + ((REP_MASK >> (k)) & 1); ++rep_)
    if (IN(0)) { p0_prologue(F); } SEAM(0);
#ifdef EXTRA_SYNC
    for (int i_ = 0; i_ < EXTRA_SYNC; ++i_) SEAM(0);
#endif
#if (REP_MASK >> 0) & 1
    p0_prologue(F); grid.sync();
#endif
    if (IN(1)) {
        pg8::Gemm g{WSP(bf16_t, WS_XN), WSP(bf16_t, WS_WIN), M, INW, D}; pg8::StaticOrder S; S.init(M, INW, F.G, F.bid);
        EpiIn E{F.ws, F.out};
        pg8::gemm_phase<EpiIn, pg8::StaticOrder, true, true>(F.lds, g, S, E);
        p1_tail(F);
    } SEAM(1);
    if (IN(2)) { p23_phase(F); p3_loop(F); late_weights(F); }
#if (REP_MASK >> 2) & 1
    p2_phase(F); grid.sync();
#endif
    SEAM(2);
#if (REP_MASK >> 3) & 1
    for (int t = F.bid; t < 528; t += F.G) p3_task(F, t); grid.sync();
#endif
    if (IN(4)) {
        p4_sample_a(F);
        pg8::Gemm g{WSP(bf16_t, WS_MIX), WSP(bf16_t, WS_WO), MP, D, D}; pg8::StaticOrder S; S.init(MP, D, F.G, F.bid);
        EpiOut E{F.in[0], WSP(float, WS_SSQ), WSP(bf16_t, WS_X1B), WSP(float, WS_PART), WSP(unsigned, WS_CTL) + 3584 + 128, (LAS float*)(F.lds + LDS_X)};
        pg8::gemm_phase<EpiOut, pg8::StaticOrder, true, true>(F.lds, g, S, E);
        p4_sample_b(F);
    } SEAM(4);
    if (IN(5)) {
        pg8::Gemm g{WSP(bf16_t, WS_X1B), WSP(bf16_t, WS_W1), M, 2 * FF, D}; pg8::StaticOrder S; S.init(M, 2 * FF, F.G, F.bid);
        EpiFfn E{F.ws, F.in, F.out, (LAS float*)(F.lds + LDS_X)};
        pg8::gemm_phase<EpiFfn, pg8::StaticOrder, true, true>(F.lds, g, S, E);
    } SEAM(5);
    if (IN(6)) {
        p6_sample_a(F);
        pg8::Gemm g{WSP(bf16_t, WS_H), WSP(bf16_t, WS_W2), MP, D, FF}; pg8::StaticOrder S; S.init(MP, D, F.G, F.bid);
        EpiDown E{F.out, WSP(bf16_t, WS_X1B), WSP(float, WS_SSQ), F.in[29], WSP(float, WS_PART), WSP(unsigned, WS_CTL) + 3584 + 64, (LAS float*)(F.lds + LDS_X)};
        pg8::gemm_phase<EpiDown, pg8::StaticOrder, true, true>(F.lds, g, S, E);
        p6_sample_b(F);
    }
#undef IN
#undef SEAM
}

extern "C" void kernel_launch(void* const* d_in, const int* in_sizes, int n_in, void* d_out, int out_size, void* d_ws, size_t ws_size, hipStream_t stream) {
    static int grid = 0;
    if (grid == 0) {
        if (n_in != 30 || ws_size < WS_END) { fprintf(stderr, "kernel_launch: unexpected n_in %d / ws_size %zu (need %zu)\n", n_in, ws_size, (size_t)WS_END); grid = -1; return; }
        int dev = 0, cus = 0, per_cu = 0;
        (void)hipGetDevice(&dev); (void)hipDeviceGetAttribute(&cus, hipDeviceAttributeMultiprocessorCount, dev);
        if (hipFuncSetAttribute((const void*)mega_fwd, hipFuncAttributeMaxDynamicSharedMemorySize, LDS_BYTES) != hipSuccess) { fprintf(stderr, "hipFuncSetAttribute failed\n"); grid = -1; return; }
        if (hipOccupancyMaxActiveBlocksPerMultiprocessor(&per_cu, (const void*)mega_fwd, 512, LDS_BYTES) != hipSuccess || per_cu < 1) { fprintf(stderr, "occupancy query: %d\n", per_cu); per_cu = 1; }
        (void)hipGetLastError();
        grid = cus * (per_cu > 1 ? 1 : per_cu);
        if (grid <= 0) grid = 256;
    }
    if (grid < 0) return;
    Args a{};
    for (int i = 0; i < 30; ++i) a.in[i] = (const float*)d_in[i];
    a.out = (float*)d_out; a.ws = (unsigned char*)d_ws;
    (void)hipMemsetAsync((unsigned char*)d_ws + WS_CTL, 0, 16384, stream);
#if N_LAUNCHES == 1
    a.ph_lo = 0; a.ph_hi = 8;
    void* kargs[] = {&a};
    hipError_t e = hipLaunchCooperativeKernel((const void*)mega_fwd, dim3(grid), dim3(512), kargs, LDS_BYTES, stream);
    if (e != hipSuccess) fprintf(stderr, "cooperative launch failed: %s (grid %d)\n", hipGetErrorString(e), grid);
#else
    for (int p = 0; p < 8; ++p) { a.ph_lo = p; a.ph_hi = p + 1; for (int r = 0; r < 1 + ((HOST_REP >> p) & 1); ++r) hipLaunchKernelGGL(mega_fwd, dim3(grid), dim3(512), LDS_BYTES, stream, a); }
#endif
}
```

```cpp
#include <hip/hip_runtime.h>
#include <hip/hip_cooperative_groups.h>
#include <cstdio>
#include <cstdint>
namespace cg = cooperative_groups;

namespace pg8 {
#define PG8_LAS __attribute__((address_space(3)))
typedef unsigned short bf16_t;
typedef short bf16x8 __attribute__((ext_vector_type(8)));
typedef float f32x4 __attribute__((ext_vector_type(4)));
typedef unsigned u32x4 __attribute__((ext_vector_type(4)));
constexpr int BM = 256, BK = 64, HALF = 128, HTB = HALF * BK * 2  , STAGE_BYTES = 8 * HTB, NXCD = 8, WGM = 8;

__host__ __device__ __forceinline__ int lds_byte(int r, int c) { const int st = (r >> 4) * 2 + (c >> 5), rr = r & 15, cc = c & 31, ob = rr * 64 + cc * 2; return st * 1024 + (ob ^ (((ob >> 9) & 1) << 5)); }
__host__ __device__ __forceinline__ void stage_rc(int b, int& R, int& C) { const int st = b / 1024, sb = b % 1024, swz = sb ^ (((sb >> 9) & 1) << 5); R = (st >> 1) * 16 + swz / 64; C = (st & 1) * 32 + (swz % 64) / 2; }
__host__ __device__ __forceinline__ int perm32(int rho) { const int n = rho >> 4, i = rho & 15; return 8 * (i >> 2) + 4 * n + (i & 3); }

struct Unit { int pm, pn; };
struct Gemm { const bf16_t* A; const bf16_t* Bt; int M, N, K; };

struct StaticOrder {
    int nM, nN, nwg, G, c;
    __host__ __device__ void init(int M, int N, int G_, int c_) { nM = M / BM; nN = N / BM; nwg = nM * nN; G = G_; c = c_; }
    __host__ __device__ bool next(int i, Unit& u) const {
        const long L = (long)i * G + c; if (L >= nwg) return false;
        int wgid = (int)L; { const int q = nwg / NXCD, r = nwg % NXCD, xcd = wgid % NXCD, off = wgid / NXCD; wgid = (xcd < r ? xcd * (q + 1) : r * (q + 1) + (xcd - r) * q) + off; }
        const int nig = WGM * nN, gid = wgid / nig, fm = gid * WGM, gsz = (nM - fm) < WGM ? (nM - fm) : WGM;
        u.pm = fm + ((wgid % nig) % gsz); u.pn = (wgid % nig) / gsz; return true;
    }
    __device__ __forceinline__ void a_ready(const Unit&) const {}
    __device__ __forceinline__ void done(const Unit&) const {}
};

__device__ __forceinline__ unsigned cvt_pk_bf16(float lo, float hi) { unsigned r; asm volatile("v_cvt_pk_bf16_f32 %0, %1, %2" : "=v"(r) : "v"(lo), "v"(hi)); return r; }
template <class Epi, class Sched, bool ALIGN_EPI = false, bool SP2 = false>
__device__ __forceinline__ void gemm_phase(PG8_LAS unsigned char* lds, const Gemm g, const Sched& S, const Epi& E) {
    const int tid = threadIdx.x, wid = __builtin_amdgcn_readfirstlane(tid >> 6), lane = tid & 63, wr = wid >> 2, wc = wid & 3, fr = lane & 15, fq = lane >> 4;
    const int K = g.K, nt = K / BK;
    unsigned voffA[2], voffB[2];
#pragma unroll
    for (int i = 0; i < 2; ++i) { int R, C; stage_rc(tid * 16 + i * 8192, R, C); const int Rb = Epi::PERM ? ((R & ~31) + perm32(R & 31)) : R;
        voffA[i] = (unsigned)(R * K + C) * 2u; voffB[i] = (unsigned)(Rb * K + C) * 2u; }
    const size_t kstep = (size_t)(BK * 2);
    const size_t hstep = (size_t)HALF * K * 2;
    const size_t tstep = 2 * hstep;
    const unsigned ldsw = (unsigned)wid * 1024u;
    const int aoff = lds_byte(wr * 64 + fr, fq * 8), boff = lds_byte(wc * 32 + fr, fq * 8);
#define PG8_SA(b, h) (((b) * 2 + (h)) * HTB)
#define PG8_SB(b, h) ((4 + (b) * 2 + (h)) * HTB)
#define PG8_STAGE(bufoff, gbase, voff) do { _Pragma("unroll") for (int _i = 0; _i < 2; ++_i) \
        __builtin_amdgcn_global_load_lds((const unsigned*)((const char*)(gbase) + (voff)[_i]), (PG8_LAS unsigned*)(lds + (bufoff) + ldsw + _i * 8192), 16, 0, 0); } while (0)
#define PG8_LDA(dst, b, h) do { _Pragma("unroll") for (int m = 0; m < 4; ++m) _Pragma("unroll") for (int k = 0; k < 2; ++k) dst[m][k] = *(const PG8_LAS bf16x8*)(lds + PG8_SA(b, h) + aoff + m * 2048 + k * 1024); } while (0)
#define PG8_LDB(dst, b, h) do { _Pragma("unroll") for (int n = 0; n < 2; ++n) _Pragma("unroll") for (int k = 0; k < 2; ++k) dst[n][k] = *(const PG8_LAS bf16x8*)(lds + PG8_SB(b, h) + boff + n * 2048 + k * 1024); } while (0)
#define PG8_MMA(ai, bj, At, Bt) do { __builtin_amdgcn_s_setprio(1); _Pragma("unroll") for (int m = 0; m < 4; ++m) _Pragma("unroll") for (int n = 0; n < 2; ++n) _Pragma("unroll") for (int k = 0; k < 2; ++k) \
        acc[ai][bj][m][n] = __builtin_amdgcn_mfma_f32_16x16x32_bf16(Bt[n][k], At[m][k], acc[ai][bj][m][n], 0, 0, 0); __builtin_amdgcn_s_setprio(0); } while (0)
#define PG8_WAIT_V(n) asm volatile("s_waitcnt vmcnt(" #n ")" ::: "memory")
#define PG8_WAIT_L(n) asm volatile("s_waitcnt lgkmcnt(" #n ")" ::: "memory")
#define PG8_BAR __builtin_amdgcn_s_barrier()
#define PG8_SCHED __builtin_amdgcn_sched_barrier(0)
    Unit cur, nxt; int ui = 0;
    if (!S.next(0, cur)) return;
    f32x4 acc[2][2][4][2];
#pragma unroll
    for (int a = 0; a < 2; ++a)
#pragma unroll
        for (int b = 0; b < 2; ++b)
#pragma unroll
            for (int m = 0; m < 4; ++m)
#pragma unroll
                for (int n = 0; n < 2; ++n) acc[a][b][m][n] = (f32x4){0.f, 0.f, 0.f, 0.f};
    bf16x8 At[4][2], B0[2][2], B1[2][2];
    const char* cA = (const char*)g.A + (size_t)cur.pm * tstep; const char* cB = (const char*)g.Bt + (size_t)cur.pn * tstep;
    S.a_ready(cur);
    if constexpr (SP2) {
        PG8_STAGE(PG8_SB(0, 0), cB, voffB); PG8_STAGE(PG8_SB(0, 1), cB + hstep, voffB); PG8_STAGE(PG8_SA(0, 0), cA, voffA); PG8_STAGE(PG8_SA(0, 1), cA + hstep, voffA);
        if (wr == 1) PG8_BAR;
        PG8_WAIT_V(2); PG8_BAR;
        PG8_STAGE(PG8_SB(1, 0), cB + kstep, voffB); PG8_STAGE(PG8_SA(1, 0), cA + kstep, voffA); PG8_STAGE(PG8_SB(1, 1), cB + hstep + kstep, voffB);
        PG8_WAIT_V(6); PG8_BAR;
    } else {
        PG8_STAGE(PG8_SB(0, 0), cB, voffB); PG8_STAGE(PG8_SA(0, 0), cA, voffA); PG8_STAGE(PG8_SB(0, 1), cB + hstep, voffB); PG8_STAGE(PG8_SA(0, 1), cA + hstep, voffA);
        if (wr == 1) PG8_BAR;
        PG8_WAIT_V(4); PG8_BAR;
        PG8_STAGE(PG8_SB(1, 0), cB + kstep, voffB); PG8_STAGE(PG8_SA(1, 0), cA + kstep, voffA); PG8_STAGE(PG8_SB(1, 1), cB + hstep + kstep, voffB);
        PG8_WAIT_V(6); PG8_BAR;
    }
    for (;;) {
        const bool has_next = S.next(ui + 1, nxt);
        const char* nA = has_next ? (const char*)g.A + (size_t)nxt.pm * tstep : cA; const char* nB = has_next ? (const char*)g.Bt + (size_t)nxt.pn * tstep : cB;
        for (int t = 0; t < nt; t += 2) {
            const bool last = (t == nt - 2);
            const char* a1 = cA + (size_t)(t + 1) * kstep;
            const char* a2 = last ? nA : cA + (size_t)(t + 2) * kstep; const char* b2 = last ? nB : cB + (size_t)(t + 2) * kstep;
            const char* a3 = a2 + kstep; const char* b3 = b2 + kstep;
            if (last && has_next) S.a_ready(nxt);
            if constexpr (SP2) {
            PG8_LDB(B0, 0, 0); PG8_LDB(B1, 0, 1); PG8_SCHED; PG8_LDA(At, 0, 0); PG8_STAGE(PG8_SA(1, 1), a1 + hstep, voffA);
            PG8_WAIT_V(8); PG8_WAIT_L(0); PG8_BAR; PG8_MMA(0, 0, At, B0); PG8_MMA(0, 1, At, B1); PG8_BAR; PG8_SCHED;
            PG8_LDA(At, 0, 1); PG8_STAGE(PG8_SB(0, 0), b2, voffB); PG8_STAGE(PG8_SB(0, 1), b2 + hstep, voffB); PG8_STAGE(PG8_SA(0, 0), a2, voffA);
            PG8_WAIT_V(8); PG8_WAIT_L(0); PG8_BAR; PG8_MMA(1, 0, At, B0); PG8_MMA(1, 1, At, B1); PG8_BAR; PG8_SCHED;
            PG8_LDB(B0, 1, 0); PG8_LDB(B1, 1, 1); PG8_SCHED; PG8_LDA(At, 1, 0); PG8_STAGE(PG8_SA(0, 1), a2 + hstep, voffA);
            PG8_WAIT_V(8); PG8_WAIT_L(0); PG8_BAR; PG8_MMA(0, 0, At, B0); PG8_MMA(0, 1, At, B1); PG8_BAR; PG8_SCHED;
            PG8_LDA(At, 1, 1); PG8_STAGE(PG8_SB(1, 0), b3, voffB); PG8_STAGE(PG8_SB(1, 1), b3 + hstep, voffB); PG8_STAGE(PG8_SA(1, 0), a3, voffA);
            PG8_WAIT_V(8); PG8_WAIT_L(0); PG8_BAR; PG8_MMA(1, 0, At, B0); PG8_MMA(1, 1, At, B1); PG8_BAR; PG8_SCHED;
            } else {
            PG8_LDB(B0, 0, 0); PG8_SCHED; PG8_LDA(At, 0, 0); PG8_STAGE(PG8_SA(1, 1), a1 + hstep, voffA);
            PG8_WAIT_L(8); PG8_BAR; PG8_WAIT_L(0); PG8_MMA(0, 0, At, B0); PG8_BAR; PG8_SCHED;
            PG8_LDB(B1, 0, 1); PG8_STAGE(PG8_SB(0, 0), b2, voffB);
            PG8_BAR; PG8_WAIT_L(0); PG8_MMA(0, 1, At, B1); PG8_BAR;
            PG8_LDA(At, 0, 1); PG8_STAGE(PG8_SA(0, 0), a2, voffA);
            PG8_BAR; PG8_WAIT_L(0); PG8_MMA(1, 0, At, B0); PG8_BAR; PG8_SCHED;
            PG8_STAGE(PG8_SB(0, 1), b2 + hstep, voffB);
            PG8_WAIT_V(6); PG8_BAR; PG8_MMA(1, 1, At, B1); PG8_BAR;
            PG8_LDB(B0, 1, 0); PG8_SCHED; PG8_LDA(At, 1, 0); PG8_STAGE(PG8_SA(0, 1), a2 + hstep, voffA);
            PG8_WAIT_L(8); PG8_BAR; PG8_WAIT_L(0); PG8_MMA(0, 0, At, B0); PG8_BAR; PG8_SCHED;
            PG8_LDB(B1, 1, 1); PG8_STAGE(PG8_SB(1, 0), b3, voffB);
            PG8_BAR; PG8_WAIT_L(0); PG8_MMA(0, 1, At, B1); PG8_BAR;
            PG8_LDA(At, 1, 1); PG8_STAGE(PG8_SA(1, 0), a3, voffA);
            PG8_BAR; PG8_WAIT_L(0); PG8_MMA(1, 0, At, B0); PG8_BAR; PG8_SCHED;
            PG8_STAGE(PG8_SB(1, 1), b3 + hstep, voffB);
            PG8_WAIT_V(6); PG8_BAR; PG8_MMA(1, 1, At, B1); PG8_BAR;
            }
        }
        if constexpr (ALIGN_EPI) { if (wr == 0) PG8_BAR; }
        if constexpr (!Epi::AFTER_DRAIN) { E(acc, cur, wr, wc, fr, fq); S.done(cur); }
        if (!has_next) break;
#pragma unroll
        for (int a = 0; a < 2; ++a)
#pragma unroll
            for (int b = 0; b < 2; ++b)
#pragma unroll
                for (int m = 0; m < 4; ++m)
#pragma unroll
                    for (int n = 0; n < 2; ++n) acc[a][b][m][n] = (f32x4){0.f, 0.f, 0.f, 0.f};
        cur = nxt; cA = nA; cB = nB; ++ui;
        if constexpr (ALIGN_EPI) { if (wr == 1) PG8_BAR; }
    }
    PG8_WAIT_V(0);
    if constexpr (!ALIGN_EPI) { if (wr == 0) PG8_BAR; }
    PG8_BAR;
    if constexpr (Epi::AFTER_DRAIN) { E.fused(acc, cur, wr, wc, fr, fq, lds, wid, lane); S.done(cur); }
#undef PG8_SA
#undef PG8_SB
#undef PG8_STAGE
#undef PG8_LDA
#undef PG8_LDB
#undef PG8_MMA
#undef PG8_WAIT_V
#undef PG8_WAIT_L
#undef PG8_BAR
#undef PG8_SCHED
}
}

#ifndef HOST_REP
#define HOST_REP 0
#endif
#ifndef N_LAUNCHES
#define N_LAUNCHES 1
#endif
#define DI __device__ __forceinline__
#define LAS __attribute__((address_space(3)))
using pg8::bf16_t; using pg8::bf16x8; using pg8::f32x4; using pg8::u32x4;
typedef unsigned u32x2 __attribute__((ext_vector_type(2)));
typedef short s16x4 __attribute__((ext_vector_type(4)));
#define MFMA16(a, b, c) __builtin_amdgcn_mfma_f32_16x16x32_bf16((a), (b), (c), 0, 0, 0)

constexpr int D = 1024, MP = 16384, MS = 512, M = MP + MS, SEQ = 2048, INW = 1280, FF = 2816, NG = 32;
constexpr float EPS = 1e-6f;
constexpr size_t O_PRE = 17301504, O_PIM = 17317888, O_PK = 17334272, O_PV = 17465344, O_PCONV = 17596416,
                 O_SRE = 17641472, O_SIM = 17674240, O_SK = 17707008, O_SV = 17772544, O_SCONV = 17838080;
constexpr size_t WS_WIN = 0, WS_WGLU = WS_WIN + (size_t)INW * D * 2, WS_WO = WS_WGLU + 512 * 512 * 2, WS_W1 = WS_WO + (size_t)D * D * 2,
                 WS_W2 = WS_W1 + (size_t)2 * FF * D * 2, WS_KT = WS_W2 + (size_t)D * FF * 2, WS_WT = WS_KT + (size_t)NG * 32 * 256 * 2,
                 WS_PRE = WS_WT + (size_t)NG * 128 * 512 * 2, WS_PIM = WS_PRE + (size_t)NG * 4096 * 4, WS_A32 = WS_PIM + (size_t)NG * 32 * 64 * 4,
                 WS_CT = WS_A32 + (size_t)NG * 64 * 2 * 4, WS_SSQ = WS_CT + (size_t)NG * 16 * 128 * 2, WS_MIX = WS_SSQ + (size_t)M * 16 * 4,
                 WS_X1B = WS_MIX + (size_t)M * D * 2, WS_H = WS_X1B + (size_t)M * D * 2, WS_X1F = WS_H + (size_t)M * FF * 2, WS_PART = WS_X1F + (size_t)M * D * 4, WS_PARTS = WS_PART + (size_t)64 * 4 * 256 * 4, WS_CTL = WS_PARTS + (size_t)256 * 32 * 4, WS_END = WS_CTL + 16384;
constexpr size_t WS_XN = WS_H, WS_U = WS_XN + (size_t)M * D * 2, WS_Q = WS_U + (size_t)M * 512 * 2, WS_KB = WS_Q + (size_t)M * 512 * 2,
                 WS_VT = WS_KB + (size_t)M * 128 * 2, WS_KS = WS_VT + (size_t)MP * 128 * 2, WS_VTS = WS_KS + (size_t)16 * 160 * 128 * 2,
                 WS_HIN = WS_VTS + (size_t)16 * 160 * 128 * 2, WS_UF = WS_HIN + (size_t)512 * NG * 128 * 4, WS_ALIAS_END = WS_UF + (size_t)M * 512 * 2;
static_assert(WS_ALIAS_END <= WS_END && WS_END <= 268435456, "d_ws map");
constexpr int LDS_BYTES = 163840, LDS_X = 131072;

DI unsigned f2bf(float f) { unsigned u = __builtin_bit_cast(unsigned, f); return (u + 0x7fffu + ((u >> 16) & 1u)) >> 16; }
typedef float f32x2_t __attribute__((ext_vector_type(2)));
typedef __bf16 bf16x2_t __attribute__((ext_vector_type(2)));
DI unsigned pk2(float lo, float hi) { f32x2_t v = {lo, hi}; bf16x2_t b = __builtin_convertvector(v, bf16x2_t); return __builtin_bit_cast(unsigned, b); }
DI float bflo(unsigned w) { return __builtin_bit_cast(float, w << 16); }
DI float bfhi(unsigned w) { return __builtin_bit_cast(float, w & 0xffff0000u); }
DI u32x4 pack8(const f32x4& a, const f32x4& b) { u32x4 w; w.x = pk2(a[0], a[1]); w.y = pk2(a[2], a[3]); w.z = pk2(b[0], b[1]); w.w = pk2(b[2], b[3]); return w; }
DI float dot2bf(unsigned a, unsigned b, float c) { return __builtin_amdgcn_fdot2_f32_bf16(__builtin_bit_cast(bf16x2_t, a), __builtin_bit_cast(bf16x2_t, b), c, false); }
DI float sigm(float x) { return __builtin_amdgcn_rcpf(1.0f + __expf(-x)); }
DI float gelu_tanh(float x) { const float z = 0.7978845608f * (x + 0.044715f * x * x * x); return x * sigm(2.0f * z); }
template <int CTRL> DI float dpp_shr(float v) { return __builtin_bit_cast(float, __builtin_amdgcn_update_dpp(0, __builtin_bit_cast(int, v), CTRL, 0xF, 0xF, false)); }
#define GAS __attribute__((address_space(1)))
DI void st_agent(float* p, float v) { __hip_atomic_store((GAS unsigned*)p, __builtin_bit_cast(unsigned, v), __ATOMIC_RELAXED, __HIP_MEMORY_SCOPE_AGENT); }
DI float ld_agent(const float* p) { return __builtin_bit_cast(float, __hip_atomic_load((GAS unsigned*)p, __ATOMIC_RELAXED, __HIP_MEMORY_SCOPE_AGENT)); }
DI void arrive_and_wait(unsigned* cnt, unsigned target) {
    (void)__hip_atomic_fetch_add((GAS unsigned*)cnt, 1u, __ATOMIC_RELAXED, __HIP_MEMORY_SCOPE_AGENT);
    while (__hip_atomic_load((GAS unsigned*)cnt, __ATOMIC_RELAXED, __HIP_MEMORY_SCOPE_AGENT) < target) __builtin_amdgcn_s_sleep(1);
}
DI void wait_ge16(const unsigned* c) { while (__hip_atomic_load((GAS unsigned*)c, __ATOMIC_RELAXED, __HIP_MEMORY_SCOPE_AGENT) < 16u) __builtin_amdgcn_s_sleep(1); }
DI float xsum4(float v) { v += __shfl_xor(v, 16); v += __shfl_xor(v, 32); return v; }

struct Args { const float* in[30]; float* out; unsigned char* ws; int ph_lo, ph_hi; };

struct Frame {
    LAS unsigned char* lds; int tid, lane, wave, G, bid;
    const float* const* in; float* out; unsigned char* ws;
};
#define WSP(T, off) ((T*)(F.ws + (off)))

DI void p0_transpose(const float* __restrict__ W, int N, const float* __restrict__ gk, bf16_t* __restrict__ WT, int ldt, int k0, int n0, int dst0, LAS float* scr, int tid) {
    const int c = tid & 63, r0 = tid >> 6;
#pragma unroll
    for (int i = 0; i < 8; ++i) { const int r = r0 + 8 * i; float v = W[(size_t)(k0 + r) * N + n0 + c]; if (gk) v *= gk[k0 + r]; scr[r * 65 + c] = v; }
    __syncthreads();
#pragma unroll
    for (int i = 0; i < 8; ++i) { const int n = r0 + 8 * i; WT[(size_t)(dst0 + n) * ldt + k0 + c] = (bf16_t)f2bf(scr[c * 65 + n]); }
    __syncthreads();
}

DI void p0_ssm_tables(const Frame& F, int task) {
    const int tid = F.tid, g = task >> 2, part = task & 3;
    LAS float* pwr = (LAS float*)F.lds; LAS float* pwi = pwr + 33 * 64; LAS float* bbr = pwi + 33 * 64; LAS float* bbi = bbr + 1024;
    const float* a_re = F.in[9] + g * 64; const float* a_im = F.in[10] + g * 64;
    const float dt = expf(F.in[11][g]);
    for (int i = tid; i < 33 * 64; i += 512) {
        const int d = i >> 6, n = i & 63; const float fd = (float)d;
        const float mag = expf(a_re[n] * dt * fd), ang = a_im[n] * dt * fd;
        pwr[i] = mag * cosf(ang); pwi[i] = mag * sinf(ang);
    }
    __syncthreads();
    for (int i = tid; i < 1024; i += 512) {
        const int n = i >> 4;
        const float are = a_re[n], aim = a_im[n], nr = pwr[64 + n] - 1.0f, ni = pwi[64 + n], den = are * are + aim * aim;
        const float cr = (nr * are + ni * aim) / den, ci = (ni * are - nr * aim) / den;
        const float br = F.in[12][(size_t)g * 1024 + i], bi = F.in[13][(size_t)g * 1024 + i];
        bbr[i] = cr * br - ci * bi; bbi[i] = cr * bi + ci * br;
    }
    __syncthreads();
    if (part == 0) {
        const int d = tid >> 4, p = tid & 15;
        float acc[16];
#pragma unroll
        for (int q = 0; q < 16; ++q) acc[q] = 0.f;
        const float* cre = F.in[14] + (size_t)(g * 16 + p) * 64; const float* cim = F.in[15] + (size_t)(g * 16 + p) * 64;
        for (int n = 0; n < 64; ++n) {
            const float cr = cre[n], ci = cim[n], pr = pwr[d * 64 + n], pi = pwi[d * 64 + n];
            const float xr = cr * pr - ci * pi, xi = cr * pi + ci * pr;
#pragma unroll
            for (int q = 0; q < 16; ++q) acc[q] += xr * bbr[n * 16 + q] - xi * bbi[n * 16 + q];
        }
        const float dv = (d == 0) ? F.in[16][g * 16 + p] : 0.f;
        u32x4 w0, w1;
#pragma unroll
        for (int q = 0; q < 16; ++q) acc[q] += (q == p) ? dv : 0.f;
        w0.x = pk2(acc[0], acc[1]); w0.y = pk2(acc[2], acc[3]); w0.z = pk2(acc[4], acc[5]); w0.w = pk2(acc[6], acc[7]);
        w1.x = pk2(acc[8], acc[9]); w1.y = pk2(acc[10], acc[11]); w1.z = pk2(acc[12], acc[13]); w1.w = pk2(acc[14], acc[15]);
        bf16_t* dst = WSP(bf16_t, WS_KT) + ((size_t)(g * 16 + (d >> 1)) * 64 + (d & 1) * 32 + p) * 8;
        *(u32x4*)dst = w0; *(u32x4*)(dst + 128) = w1;
    }
    if (part == 1 || part == 2) {
        bf16_t* wt = WSP(bf16_t, WS_WT) + (size_t)g * 65536;
        for (int idx = (part - 1) * 32768 + tid; idx < part * 32768; idx += 512) {
            const int j = idx & 7, lane = (idx >> 3) & 63, kk = (idx >> 9) & 15, nb = idx >> 13;
            const int n2 = nb * 16 + (lane & 15), n = n2 & 63, sidx = 2 * kk + (lane >> 5), pp = ((lane >> 4) & 1) * 8 + j;
            const float pr = pwr[(31 - sidx) * 64 + n], pi = pwi[(31 - sidx) * 64 + n], br = bbr[n * 16 + pp], bi = bbi[n * 16 + pp];
            wt[idx] = (bf16_t)f2bf(n2 < 64 ? pr * br - pi * bi : pr * bi + pi * br);
        }
    }
    if (part == 3) {
    for (int i = tid; i < 4096; i += 512) {
        const int e = i & 3, lane = (i >> 2) & 63, half = (i >> 8) & 1, reim = (i >> 9) & 1, nh = (i >> 10) & 1, mt = i >> 11;
        const int t = mt * 16 + (lane & 15), n = nh * 32 + (lane >> 4) * 8 + half * 4 + e;
        WSP(float, WS_PRE)[(size_t)g * 4096 + i] = reim ? pwi[(t + 1) * 64 + n] : pwr[(t + 1) * 64 + n];
    }
    if (tid < 64) { WSP(float, WS_A32)[(g * 64 + tid) * 2] = pwr[32 * 64 + tid]; WSP(float, WS_A32)[(g * 64 + tid) * 2 + 1] = pwi[32 * 64 + tid]; }
    for (int i = tid; i < 2048; i += 512) {
        const int j = i & 7, lane = (i >> 3) & 63, kk2 = i >> 9, p = lane & 15, n2 = kk2 * 32 + (lane >> 4) * 8 + j;
        const float v = n2 < 64 ? F.in[14][(size_t)(g * 16 + p) * 64 + n2] : -F.in[15][(size_t)(g * 16 + p) * 64 + n2 - 64];
        WSP(bf16_t, WS_CT)[(size_t)g * 2048 + i] = (bf16_t)f2bf(v);
    }
    }
    __syncthreads();
}

DI void p0_prologue(const Frame& F) {
    constexpr int T_SSM = 128, T_WIN = 16 * 20, T_WGLU = 64, T_WO = 256, T_WA = 16 * 44, T_WD = 44 * 16, T_XN = M / 16, T_CK = 64, T_CV = 64;
    LAS float* scr = (LAS float*)F.lds;
    const int G = F.G;
    int r = F.bid;
#define P0_LOOP(COUNT) for (int i = r; i < (COUNT); i += G)
#define P0_NEXT(COUNT) r = (r + G - (COUNT) % G) % G
    P0_LOOP(T_XN) {
        const int row = i * 16 + F.wave * 2;
        const float* xr = row < MP ? F.in[0] + (size_t)row * D : F.in[1] + (size_t)(row - MP) * D;
        f32x4 v[2][4]; float q0 = 0.f, q1 = 0.f;
#pragma unroll
        for (int k = 0; k < 4; ++k) { v[0][k] = *(const f32x4*)(xr + k * 256 + F.lane * 4); v[1][k] = *(const f32x4*)(xr + D + k * 256 + F.lane * 4); }
#pragma unroll
        for (int k = 0; k < 4; ++k) { q0 += v[0][k][0] * v[0][k][0] + v[0][k][1] * v[0][k][1] + v[0][k][2] * v[0][k][2] + v[0][k][3] * v[0][k][3];
                                      q1 += v[1][k][0] * v[1][k][0] + v[1][k][1] * v[1][k][1] + v[1][k][2] * v[1][k][2] + v[1][k][3] * v[1][k][3]; }
#pragma unroll
        for (int o = 1; o < 64; o <<= 1) { q0 += __shfl_xor(q0, o); q1 += __shfl_xor(q1, o); }
        const float rr0 = rsqrtf(q0 * (1.0f / D) + EPS), rr1 = rsqrtf(q1 * (1.0f / D) + EPS);
        bf16_t* dst = WSP(bf16_t, WS_XN) + (size_t)row * D;
#pragma unroll
        for (int k = 0; k < 4; ++k) { const f32x4 g = *(const f32x4*)(F.in[7] + k * 256 + F.lane * 4);
            u32x2 w; w.x = pk2(v[0][k][0] * rr0 * g[0], v[0][k][1] * rr0 * g[1]); w.y = pk2(v[0][k][2] * rr0 * g[2], v[0][k][3] * rr0 * g[3]); *(u32x2*)(dst + k * 256 + F.lane * 4) = w;
            w.x = pk2(v[1][k][0] * rr1 * g[0], v[1][k][1] * rr1 * g[1]); w.y = pk2(v[1][k][2] * rr1 * g[2], v[1][k][3] * rr1 * g[3]); *(u32x2*)(dst + D + k * 256 + F.lane * 4) = w; }
    }
    P0_NEXT(T_XN);
    P0_LOOP(T_WIN) p0_transpose(F.in[8], INW, nullptr, WSP(bf16_t, WS_WIN), D, (i % 16) * 64, (i / 16) * 64, (i / 16) * 64, scr, F.tid);
    P0_NEXT(T_WIN);
#undef P0_LOOP
#undef P0_NEXT
}

DI void p1_tail(const Frame& F) {
    constexpr int T_SSM = 128, T_WGLU = 64, T_CK = 64, T_CV = 64;
    const int nbusy = (M / 256) * (INW / 256) - F.G;
    if (nbusy < 0 || nbusy >= F.G || F.bid < nbusy) return;
    const int G = F.G - nbusy;
    int r = F.bid - nbusy;
#define P0_LOOP(COUNT) for (int i = r; i < (COUNT); i += G)
#define P0_NEXT(COUNT) r = (r + G - (COUNT) % G) % G
    P0_LOOP(T_SSM) p0_ssm_tables(F, i);
    P0_NEXT(T_SSM);
    P0_LOOP(T_WGLU) {
        const int ch = i * 512 + F.tid, lane = ch & 63, kk = (ch >> 6) & 15, ntg = ch >> 10;
        const float* src = F.in[17] + (size_t)(kk * 32 + (lane >> 4) * 8) * 512 + ntg * 16 + (lane & 15);
        f32x4 a, b;
#pragma unroll
        for (int j = 0; j < 4; ++j) { a[j] = src[(size_t)j * 512]; b[j] = src[(size_t)(j + 4) * 512]; }
        *(u32x4*)(WSP(bf16_t, WS_WGLU) + (size_t)ch * 8) = pack8(a, b);
    }
    P0_NEXT(T_WGLU);
    P0_LOOP(T_CK) {
        const int ch = i * 512 + F.tid, lane = ch & 63, kk = (ch >> 6) & 1, kb = (ch >> 7) & 7, kvh = (ch >> 10) & 1, sb = ch >> 11;
        const float* src = F.in[4] + (((size_t)sb * 128 + kb * 16 + (lane & 15)) * 2 + kvh) * 64 + kk * 32 + (lane >> 4) * 8;
        *(u32x4*)(WSP(bf16_t, WS_KS) + (((size_t)(sb * 2 + kvh) * 10 + kb) * 2 + kk) * 512 + lane * 8) = pack8(*(const f32x4*)src, *(const f32x4*)(src + 4));
    }
    P0_NEXT(T_CK);
    P0_LOOP(T_CV) {
        const int ch = i * 512 + F.tid, lane = ch & 63, db = (ch >> 6) & 3, kb = (ch >> 8) & 3, kvh = (ch >> 10) & 1, sb = ch >> 11;
        const float* src = F.in[5] + (((size_t)sb * 128 + kb * 32 + (lane >> 4) * 4) * 2 + kvh) * 64 + db * 16 + (lane & 15);
        f32x4 a, b;
#pragma unroll
        for (int j = 0; j < 4; ++j) { a[j] = src[(size_t)j * 128]; b[j] = src[(size_t)(16 + j) * 128]; }
        *(u32x4*)(WSP(bf16_t, WS_VTS) + (((size_t)(sb * 2 + kvh) * 5 + kb) * 4 + db) * 512 + lane * 8) = pack8(a, b);
    }
#undef P0_LOOP
#undef P0_NEXT
}

struct EpiIn {
    static constexpr bool PERM = true, AFTER_DRAIN = false;
    unsigned char* ws; float* out;
    DI void operator()(const f32x4 (&acc)[2][2][4][2], const pg8::Unit& u, int wr, int wc, int fr, int fq) const {
        bf16_t* const U = (bf16_t*)(ws + WS_U); bf16_t* const Q = (bf16_t*)(ws + WS_Q); bf16_t* const KB = (bf16_t*)(ws + WS_KB); bf16_t* const VT = (bf16_t*)(ws + WS_VT);
        bf16_t* const KS = (bf16_t*)(ws + WS_KS); bf16_t* const VTS = (bf16_t*)(ws + WS_VTS); bf16_t* const UF = (bf16_t*)(ws + WS_UF);
        const int row0 = u.pm * 256 + wr * 64 + fr;
        if (u.pn < 2) {
            const int colt = u.pn * 256 + wc * 32 + 8 * fq;
#pragma unroll
            for (int ai = 0; ai < 2; ++ai)
#pragma unroll
                for (int m = 0; m < 4; ++m) { const int row = row0 + ai * 128 + m * 16; bf16_t* rp = U + (size_t)row * 512 + colt;
                    const int tq = row < MP ? (row & 2047) : ((row - MP) & 31), sq = tq & 31, chunk = row < MP ? (tq >> 5) : ((row - MP) >> 5);
#pragma unroll
                    for (int bj = 0; bj < 2; ++bj) { const u32x4 w = pack8(acc[ai][bj][m][0], acc[ai][bj][m][1]); *(u32x4*)(rp + bj * 128) = w;
                        const int c0 = colt + bj * 128, g = c0 >> 4, lf = (((sq & 1) * 2 + ((c0 >> 3) & 1)) * 16 + (chunk & 15)) * 8;
                        bf16_t* uf = row < MP ? UF + ((((size_t)((row >> 11) * 32 + g) * 16 + (sq >> 1)) * 4 + (chunk >> 4)) * 64) * 8 + lf
                                              : UF + (size_t)MP * 512 + ((size_t)(g * 16 + (sq >> 1)) * 64) * 8 + lf;
                        *(u32x4*)uf = w; } }
        } else if (u.pn < 4) {
#pragma unroll
            for (int ai = 0; ai < 2; ++ai)
#pragma unroll
                for (int m = 0; m < 4; ++m) { const int rb = (u.pm * 256 + wr * 64 + ai * 128 + m * 16) >> 4;
#pragma unroll
                    for (int bj = 0; bj < 2; ++bj) { const int c0 = (u.pn - 2) * 256 + bj * 128 + wc * 32, h = c0 >> 6, kk = (c0 >> 5) & 1;
                        *(u32x4*)(Q + (((size_t)h * (M / 16) + rb) * 2 + kk) * 512 + (fq * 16 + fr) * 8) = pack8(acc[ai][bj][m][0] * 0.125f, acc[ai][bj][m][1] * 0.125f); } }
        } else {
            const int c = wc * 32 + 8 * fq, kvh = wc >> 1, kk = wc & 1, db = (c >> 4) & 3, fr0 = c & 15;
#pragma unroll
            for (int ai = 0; ai < 2; ++ai)
#pragma unroll
                for (int m = 0; m < 4; ++m) {
                    const int row = row0 + ai * 128 + m * 16;
                    const f32x4 k0 = acc[ai][0][m][0], k1 = acc[ai][0][m][1], v0 = acc[ai][1][m][0], v1 = acc[ai][1][m][1];
                    if (row < MP) {
                        const int b = row >> 11, t = row & 2047;
                        *(u32x4*)(KB + (((size_t)kvh * (M / 16) + (row >> 4)) * 2 + kk) * 512 + (fq * 16 + fr) * 8) = pack8(k0, k1);
                        const int w = t & 31; bf16_t* vt = VT + ((((size_t)(b * 2 + kvh) * 64 + (t >> 5)) * 4 + db) * 64 + ((w & 15) >> 2) * 16 + fr0) * 8 + (w & 3) + 4 * (w >> 4);
#pragma unroll
                        for (int j = 0; j < 4; ++j) { vt[j * 8] = (bf16_t)f2bf(v0[j]); vt[(j + 4) * 8] = (bf16_t)f2bf(v1[j]); }
                        if (t >= 1920) { float* pk = out + O_PK + ((size_t)b * 128 + (t - 1920)) * 128 + c; *(f32x4*)pk = k0; *(f32x4*)(pk + 4) = k1;
                                         float* pv = out + O_PV + ((size_t)b * 128 + (t - 1920)) * 128 + c; *(f32x4*)pv = v0; *(f32x4*)(pv + 4) = v1; }
                    } else {
                        const int sb = (row - MP) >> 5, st = (row - MP) & 31, key = 128 + st;
                        *(u32x4*)(KS + ((((size_t)(sb * 2 + kvh) * 10 + (key >> 4)) * 2 + kk) * 64 + fq * 16 + (key & 15)) * 8) = pack8(k0, k1);
                        const int w = key & 31; bf16_t* vt = VTS + ((((size_t)(sb * 2 + kvh) * 5 + (key >> 5)) * 4 + db) * 64 + ((w & 15) >> 2) * 16 + fr0) * 8 + (w & 3) + 4 * (w >> 4);
#pragma unroll
                        for (int j = 0; j < 4; ++j) { vt[j * 8] = (bf16_t)f2bf(v0[j]); vt[(j + 4) * 8] = (bf16_t)f2bf(v1[j]); }
                        float* pk = out + O_SK + ((size_t)sb * 32 + st) * 128 + c; *(f32x4*)pk = k0; *(f32x4*)(pk + 4) = k1;
                        float* pv = out + O_SV + ((size_t)sb * 32 + st) * 128 + c; *(f32x4*)pv = v0; *(f32x4*)(pv + 4) = v1;
                    }
                }
        }
    }
};

constexpr int LDO = 520;
DI void attn_task(const bf16_t* __restrict__ Qp, int nqb, const bf16_t* __restrict__ Kp, int nkb, const bf16_t* __restrict__ Vtp, int vstride,
                  float sink, const float* __restrict__ gat, bf16_t* __restrict__ outp, LAS float* ob, int h, int wave, int lane) {
    const int fr = lane & 15, fq = lane >> 4;
#pragma unroll 1
    for (int qb = 0; qb < nqb; ++qb) {
        const bf16_t* qrow = Qp + (size_t)qb * 1024 + lane * 8;
        const bf16x8 q0 = *(const bf16x8*)qrow, q1 = *(const bf16x8*)(qrow + 512);
        f32x4 s[12];
#pragma unroll
        for (int kb = 0; kb < 12; ++kb) {
            s[kb] = (f32x4){-INFINITY, -INFINITY, -INFINITY, -INFINITY};
            if (kb < nkb) {
                const bf16_t* krow = Kp + (size_t)kb * 1024 + lane * 8;
                const bf16x8 k0 = *(const bf16x8*)krow, k1 = *(const bf16x8*)(krow + 512);
                f32x4 z = (f32x4){0.f, 0.f, 0.f, 0.f};
                z = MFMA16(k0, q0, z); z = MFMA16(k1, q1, z); s[kb] = z;
            }
        }
        float m = sink;
#pragma unroll
        for (int kb = 0; kb < 12; ++kb) m = fmaxf(fmaxf(m, fmaxf(s[kb][0], s[kb][1])), fmaxf(s[kb][2], s[kb][3]));
        m = fmaxf(m, __shfl_xor(m, 16)); m = fmaxf(m, __shfl_xor(m, 32));
        float sum = 0.f;
#pragma unroll
        for (int kb = 0; kb < 12; ++kb)
#pragma unroll
            for (int e = 0; e < 4; ++e) { const float p = __expf(s[kb][e] - m); s[kb][e] = p; sum += p; }
        sum = xsum4(sum);
        const float inv = 1.0f / (sum + __expf(sink - m));
        f32x4 o[4];
#pragma unroll
        for (int db = 0; db < 4; ++db) o[db] = (f32x4){0.f, 0.f, 0.f, 0.f};
#pragma unroll
        for (int ks = 0; ks < 6; ++ks) {
            if (2 * ks < nkb) {
                const bf16x8 pb = __builtin_bit_cast(bf16x8, pack8(s[2 * ks], s[2 * ks + 1]));
#pragma unroll
                for (int db = 0; db < 4; ++db) {
                    const bf16x8 vf = *(const bf16x8*)(Vtp + (size_t)(ks * 4 + db) * 512 + lane * 8);
                    o[db] = MFMA16(vf, pb, o[db]);
                }
                if (ks & 1) __builtin_amdgcn_sched_barrier(0);
            }
        }
#pragma unroll
        for (int db = 0; db < 4; ++db) *(LAS f32x4*)(ob + (qb * 16 + fr) * LDO + h * 64 + db * 16 + fq * 4) = o[db] * inv;
    }
    __syncthreads();
    const int rpw = nqb * 2;
    const f32x4 g0 = *(const f32x4*)(gat + lane * 8), g1 = *(const f32x4*)(gat + lane * 8 + 4);
#pragma unroll 1
    for (int i = 0; i < rpw; ++i) {
        const int r = wave * rpw + i;
        f32x4 v0 = *(const LAS f32x4*)(ob + r * LDO + lane * 8), v1 = *(const LAS f32x4*)(ob + r * LDO + lane * 8 + 4);
        float q = v0[0] * v0[0] + v0[1] * v0[1] + v0[2] * v0[2] + v0[3] * v0[3] + v1[0] * v1[0] + v1[1] * v1[1] + v1[2] * v1[2] + v1[3] * v1[3];
#pragma unroll
        for (int o2 = 1; o2 < 64; o2 <<= 1) q += __shfl_xor(q, o2);
        const float rs = rsqrtf(q * (1.0f / 512.0f) + EPS);
        *(u32x4*)(outp + (size_t)r * D + lane * 8) = pack8(v0 * rs * g0, v1 * rs * g1);
    }
    __syncthreads();
}

template <int MT, bool SAMPLE>
DI void ssm_state(const Frame& F, int b, int g) {
    const int lane = F.lane, fr = lane & 15, fq = lane >> 4;
    const bf16_t* Ub = WSP(bf16_t, WS_UF) + (SAMPLE ? (size_t)MP * 512 + (size_t)g * 16 * 512 : (size_t)(b * 32 + g) * 16 * 2048) + lane * 8;
    const bf16_t* Wg = WSP(bf16_t, WS_WT) + (size_t)g * 65536 + lane * 8;
    const float* A32 = WSP(float, WS_A32) + g * 128;
    float* HIN = WSP(float, WS_HIN);
#pragma unroll 1
    for (int h2 = 0; h2 < 2; ++h2) {
        f32x4 acc[MT][4];
#pragma unroll
        for (int mt = 0; mt < MT; ++mt)
#pragma unroll
            for (int j = 0; j < 4; ++j) acc[mt][j] = (f32x4){0.f, 0.f, 0.f, 0.f};
#pragma unroll 2
        for (int kk = 0; kk < 16; ++kk) {
            bf16x8 a[MT], w[4];
#pragma unroll
            for (int mt = 0; mt < MT; ++mt) a[mt] = *(const bf16x8*)(Ub + (size_t)kk * (SAMPLE ? 512 : 2048) + mt * 512);
#pragma unroll
            for (int j = 0; j < 4; ++j) { const int nb = (j < 2) ? 2 * h2 + j : 4 + 2 * h2 + (j - 2); w[j] = *(const bf16x8*)(Wg + (size_t)(nb * 16 + kk) * 512); }
#pragma unroll
            for (int mt = 0; mt < MT; ++mt)
#pragma unroll
                for (int j = 0; j < 4; ++j) acc[mt][j] = MFMA16(a[mt], w[j], acc[mt][j]);
        }
#pragma unroll
        for (int i = 0; i < 2; ++i) {
            const int n = (2 * h2 + i) * 16 + fr;
            const float ar = A32[n * 2], ai = A32[n * 2 + 1];
            if constexpr (SAMPLE) {
#pragma unroll
                for (int e = 0; e < 4; ++e) {
                    const int sb = fq * 4 + e; const size_t idx = ((size_t)sb * 32 + g) * 64 + n;
                    const float hr = F.in[2][idx], hi = F.in[3][idx];
                    F.out[O_SRE + idx] = ar * hr - ai * hi + acc[0][i][e]; F.out[O_SIM + idx] = ar * hi + ai * hr + acc[0][2 + i][e];
                }
            } else {
            const float a2r = ar * ar - ai * ai, a2i = 2.f * ar * ai, a3r = a2r * ar - a2i * ai, a3i = a2r * ai + a2i * ar, a4r = a2r * a2r - a2i * a2i, a4i = 2.f * a2r * a2i;
            float h1r[MT], h1i[MT], h2r[MT], h2i[MT], h3r[MT], h3i[MT], er[MT], ei[MT], cr[MT], ci[MT];
#pragma unroll
            for (int mt = 0; mt < MT; ++mt) {
                const f32x4 sr = acc[mt][i], si = acc[mt][2 + i];
                h1r[mt] = sr[0]; h1i[mt] = si[0];
                h2r[mt] = ar * h1r[mt] - ai * h1i[mt] + sr[1]; h2i[mt] = ar * h1i[mt] + ai * h1r[mt] + si[1];
                h3r[mt] = ar * h2r[mt] - ai * h2i[mt] + sr[2]; h3i[mt] = ar * h2i[mt] + ai * h2r[mt] + si[2];
                er[mt] = ar * h3r[mt] - ai * h3i[mt] + sr[3]; ei[mt] = ar * h3i[mt] + ai * h3r[mt] + si[3];
                cr[mt] = 0.f; ci[mt] = 0.f;
            }
            float kr = 0.f, ki = 0.f;
#pragma unroll
            for (int gi = 0; gi < 4 * MT; ++gi) {
                const int mt = gi >> 2, src = (gi & 3) * 16 + fr;
                const float xr = __shfl(er[mt], src), xi = __shfl(ei[mt], src);
                if ((gi & 3) == fq) { cr[mt] = kr; ci[mt] = ki; }
                const float nr = a4r * kr - a4i * ki + xr, ni = a4r * ki + a4i * kr + xi; kr = nr; ki = ni;
            }
            if (fq == 0) { F.out[O_PRE + ((size_t)b * 32 + g) * 64 + n] = kr; F.out[O_PIM + ((size_t)b * 32 + g) * 64 + n] = ki; }
#pragma unroll
            for (int mt = 0; mt < MT; ++mt) {
                const int c0 = mt * 16 + fq * 4;
                float* hp = HIN + (((size_t)b * 64 + c0) * 32 + g) * 128 + n;
                const float kr0 = cr[mt], ki0 = ci[mt];
                hp[0] = kr0; hp[64] = ki0;
                hp[4096] = ar * kr0 - ai * ki0 + h1r[mt]; hp[4096 + 64] = ar * ki0 + ai * kr0 + h1i[mt];
                hp[8192] = a2r * kr0 - a2i * ki0 + h2r[mt]; hp[8192 + 64] = a2r * ki0 + a2i * kr0 + h2i[mt];
                hp[12288] = a3r * kr0 - a3i * ki0 + h3r[mt]; hp[12288 + 64] = a3r * ki0 + a3i * kr0 + h3i[mt];
            }
            }
        }
    }
}

DI void p23_phase(const Frame& F) {
    constexpr int T_SSM = 36, T_ATT = 272, T_P3 = 528;
    unsigned* hc = WSP(unsigned, WS_CTL) + 3584 + 224;
    LAS float* ob = (LAS float*)F.lds;
    for (int t = F.bid; t < T_SSM; t += F.G) {
        const int wt = t * 8 + F.wave;
        if (wt < 256) ssm_state<4, false>(F, wt >> 5, wt & 31); else ssm_state<1, true>(F, 0, wt - 256);
        asm volatile("s_waitcnt vmcnt(0)" ::: "memory");
        __syncthreads();
        if (F.tid == 0 && t < 32) {
            __builtin_amdgcn_fence(__ATOMIC_RELEASE, "agent");
            asm volatile("s_waitcnt vmcnt(0)" ::: "memory");
            (void)__hip_atomic_fetch_add((GAS unsigned*)(hc + (t >> 2)), 1u, __ATOMIC_RELAXED, __HIP_MEMORY_SCOPE_AGENT);
        }
    }
    const int t0 = (F.bid >= T_SSM % F.G) ? F.bid - T_SSM % F.G : F.bid + F.G - T_SSM % F.G;
    for (int a = t0; a < T_ATT; a += F.G) {
        const int h = F.wave, kvh = h >> 2;
        const float sink = F.in[19][h]; const float* gat = F.in[21];
        if (a < 256) {
            const int b = a >> 5, c = a & 31, c0 = c < 2 ? 0 : c - 2, row0 = b * SEQ + c * 64;
            attn_task(WSP(bf16_t, WS_Q) + ((size_t)h * (M / 16) + (row0 >> 4)) * 1024, 4, WSP(bf16_t, WS_KB) + ((size_t)kvh * (M / 16) + ((b * SEQ + c0 * 64) >> 4)) * 1024, (c - c0 + 1) * 4,
                      WSP(bf16_t, WS_VT) + ((size_t)(b * 2 + kvh) * 64 + c0 * 2) * 2048, 0, sink, gat, WSP(bf16_t, WS_MIX) + (size_t)row0 * D + 512, ob, h, F.wave, F.lane);
        } else {
            const int sb = a - 256, row0 = MP + sb * 32;
            attn_task(WSP(bf16_t, WS_Q) + ((size_t)h * (M / 16) + (row0 >> 4)) * 1024, 2, WSP(bf16_t, WS_KS) + (size_t)(sb * 2 + kvh) * 10 * 1024, 10,
                      WSP(bf16_t, WS_VTS) + (size_t)(sb * 2 + kvh) * 5 * 2048, 0, sink, gat, WSP(bf16_t, WS_MIX) + (size_t)row0 * D + 512, ob, h, F.wave, F.lane);
        }
    }
}
constexpr int P3_LDY = 520, P3_LDU = 72, P3_UST = 36864;
DI void p3_zero(const Frame& F) {
    LAS u32x4* z = (LAS u32x4*)(F.lds + P3_UST + F.wave * (64 * P3_LDU * 2));
    for (int i = F.lane; i < 32 * P3_LDU * 2 / 16; i += 64) z[i] = (u32x4){0u, 0u, 0u, 0u};
}
DI void p3_task(const Frame& F, int ci) {
    const int lane = F.lane, fr = lane & 15, fq = lane >> 4, wave = F.wave;
    const int row0 = ci < 512 ? (ci >> 6) * SEQ + (ci & 63) * 32 : MP + (ci - 512) * 32;
    constexpr int LDY = P3_LDY, LDU = P3_LDU;
    LAS bf16_t* y1 = (LAS bf16_t*)F.lds; LAS float* ssq = (LAS float*)(F.lds + 32 * LDY * 2);
    LAS bf16_t* ust = (LAS bf16_t*)(F.lds + P3_UST) + wave * (64 * LDU);
    {
        const bf16_t* up = WSP(bf16_t, WS_U) + (size_t)(row0 + (lane >> 3)) * 512 + wave * 64 + (lane & 7) * 8;
#pragma unroll
        for (int i = 0; i < 4; ++i) *(LAS u32x4*)(ust + (32 + (lane >> 3) + 8 * i) * LDU + (lane & 7) * 8) = *(const u32x4*)(up + (size_t)i * 8 * 512);
    }
#pragma unroll 1
    for (int gi = 0; gi < 4; ++gi) {
        const int g = wave * 4 + gi;
        f32x4 acc0 = (f32x4){0.f, 0.f, 0.f, 0.f}, acc1 = acc0;
        const bf16_t* Kg = WSP(bf16_t, WS_KT) + (size_t)g * 8192 + lane * 8;
        const LAS bf16_t* ub = ust + (32 + fr - (fq >> 1)) * LDU + gi * 16 + (fq & 1) * 8;
#pragma unroll
        for (int kk = 0; kk < 16; ++kk) {
            const bf16x8 kf = *(const bf16x8*)(Kg + kk * 512);
            acc1 = MFMA16(kf, *(const LAS bf16x8*)(ub + (16 - 2 * kk) * LDU), acc1);
            if (kk < 8) acc0 = MFMA16(kf, *(const LAS bf16x8*)(ub - 2 * kk * LDU), acc0);
        }
        const float* hre; const float* him;
        if (ci < 512) { hre = WSP(float, WS_HIN) + ((size_t)ci * 32 + g) * 128; him = hre + 64; }
        else { hre = F.in[2] + ((size_t)(ci - 512) * 32 + g) * 64; him = F.in[3] + ((size_t)(ci - 512) * 32 + g) * 64; }
#pragma unroll
        for (int nh = 0; nh < 2; ++nh) {
            const int n0 = nh * 32 + fq * 8;
            const f32x4 hr0 = *(const f32x4*)(hre + n0), hr1 = *(const f32x4*)(hre + n0 + 4), hi0 = *(const f32x4*)(him + n0), hi1 = *(const f32x4*)(him + n0 + 4);
            const bf16_t* cp = WSP(bf16_t, WS_CT) + (size_t)g * 2048 + lane * 8;
            const bf16x8 cref = *(const bf16x8*)(cp + nh * 512), cimf = *(const bf16x8*)(cp + (2 + nh) * 512);
#pragma unroll
            for (int mt = 0; mt < 2; ++mt) {
                const float* pp = WSP(float, WS_PRE) + (size_t)g * 4096 + (mt * 2 + nh) * 1024 + lane * 4;
                const f32x4 pr0 = *(const f32x4*)pp, pr1 = *(const f32x4*)(pp + 256), pi0 = *(const f32x4*)(pp + 512), pi1 = *(const f32x4*)(pp + 768);
                const f32x4 gr0 = pr0 * hr0 - pi0 * hi0, gr1 = pr1 * hr1 - pi1 * hi1, gi0 = pr0 * hi0 + pi0 * hr0, gi1 = pr1 * hi1 + pi1 * hr1;
                const bf16x8 gre = __builtin_bit_cast(bf16x8, pack8(gr0, gr1)), gim = __builtin_bit_cast(bf16x8, pack8(gi0, gi1));
                if (mt == 0) { acc0 = MFMA16(cref, gre, acc0); acc0 = MFMA16(cimf, gim, acc0); }
                else         { acc1 = MFMA16(cref, gre, acc1); acc1 = MFMA16(cimf, gim, acc1); }
            }
        }
        {   u32x2 w; w.x = pk2(gelu_tanh(acc0[0]), gelu_tanh(acc0[1])); w.y = pk2(gelu_tanh(acc0[2]), gelu_tanh(acc0[3]));
            *(LAS u32x2*)(y1 + fr * LDY + g * 16 + fq * 4) = w;
            w.x = pk2(gelu_tanh(acc1[0]), gelu_tanh(acc1[1])); w.y = pk2(gelu_tanh(acc1[2]), gelu_tanh(acc1[3]));
            *(LAS u32x2*)(y1 + (16 + fr) * LDY + g * 16 + fq * 4) = w; }
    }
    __syncthreads();
    f32x4 a2[2][4];
#pragma unroll
    for (int mt = 0; mt < 2; ++mt)
#pragma unroll
        for (int nt = 0; nt < 4; ++nt) a2[mt][nt] = (f32x4){0.f, 0.f, 0.f, 0.f};
    const bf16_t* Wg = WSP(bf16_t, WS_WGLU) + (size_t)(wave * 4) * 8192 + lane * 8;
#pragma unroll 4
    for (int kk = 0; kk < 16; ++kk) {
        bf16x8 yf[2], wf[4];
#pragma unroll
        for (int mt = 0; mt < 2; ++mt) yf[mt] = *(const LAS bf16x8*)(y1 + (mt * 16 + fr) * LDY + kk * 32 + fq * 8);
#pragma unroll
        for (int nt = 0; nt < 4; ++nt) wf[nt] = *(const bf16x8*)(Wg + (size_t)nt * 8192 + kk * 512);
#pragma unroll
        for (int mt = 0; mt < 2; ++mt)
#pragma unroll
            for (int nt = 0; nt < 4; ++nt) a2[mt][nt] = MFMA16(wf[nt], yf[mt], a2[mt][nt]);
    }
    float q2[2] = {0.f, 0.f};
#pragma unroll
    for (int mt = 0; mt < 2; ++mt)
#pragma unroll
        for (int nt = 0; nt < 4; ++nt) {
            const int n = wave * 64 + nt * 16 + fq * 4;
            const f32x4 bias = *(const f32x4*)(F.in[18] + n);
            const u32x2 yw = *(const LAS u32x2*)(y1 + (mt * 16 + fr) * LDY + n);
            const float y0 = bflo(yw.x), y1v = bfhi(yw.x), y2v = bflo(yw.y), y3 = bfhi(yw.y);
            f32x4 r; r[0] = y0 * sigm(a2[mt][nt][0] + bias[0]); r[1] = y1v * sigm(a2[mt][nt][1] + bias[1]); r[2] = y2v * sigm(a2[mt][nt][2] + bias[2]); r[3] = y3 * sigm(a2[mt][nt][3] + bias[3]);
            a2[mt][nt] = r; q2[mt] += r[0] * r[0] + r[1] * r[1] + r[2] * r[2] + r[3] * r[3];
        }
    q2[0] = xsum4(q2[0]); q2[1] = xsum4(q2[1]);
    if (fq == 0) { ssq[wave * 32 + fr] = q2[0]; ssq[wave * 32 + 16 + fr] = q2[1]; }
    __syncthreads();
#pragma unroll
    for (int mt = 0; mt < 2; ++mt) {
        float tot = 0.f;
#pragma unroll
        for (int w = 0; w < 8; ++w) tot += ssq[w * 32 + mt * 16 + fr];
        const float rs = rsqrtf(tot * (1.0f / 512.0f) + EPS);
#pragma unroll
        for (int nt = 0; nt < 4; ++nt) {
            const int n = wave * 64 + nt * 16 + fq * 4;
            const f32x4 g = *(const f32x4*)(F.in[20] + n);
            u32x2 w; w.x = pk2(a2[mt][nt][0] * rs * g[0], a2[mt][nt][1] * rs * g[1]); w.y = pk2(a2[mt][nt][2] * rs * g[2], a2[mt][nt][3] * rs * g[3]);
            *(u32x2*)(WSP(bf16_t, WS_MIX) + (size_t)(row0 + mt * 16 + fr) * D + n) = w;
        }
    }
    __syncthreads();
}

DI void late_weights(const Frame& F) {
    constexpr int T_WO = 256, T_WA = 16 * 44, T_WD = 44 * 16;
    LAS float* scr = (LAS float*)F.lds;
    const int nskip = ((36 + 272 + 528) % F.G), G = F.G - nskip;
    if (F.bid < nskip || G <= 0) return;
    int r = F.bid - nskip;
#define P0_LOOP(COUNT) for (int i = r; i < (COUNT); i += G)
#define P0_NEXT(COUNT) r = (r + G - (COUNT) % G) % G
    P0_LOOP(T_WO) p0_transpose(F.in[22], D, nullptr, WSP(bf16_t, WS_WO), D, (i % 16) * 64, (i / 16) * 64, (i / 16) * 64, scr, F.tid);
    P0_NEXT(T_WO);
    P0_LOOP(T_WA) { const int n0 = (i / 16) * 64; p0_transpose(F.in[24], FF, F.in[23], WSP(bf16_t, WS_W1), D, (i % 16) * 64, n0, (n0 >> 7) * 256 + (n0 & 127), scr, F.tid); }
    P0_NEXT(T_WA);
    P0_LOOP(T_WA) { const int n0 = (i / 16) * 64; p0_transpose(F.in[25], FF, F.in[23], WSP(bf16_t, WS_W1), D, (i % 16) * 64, n0, (n0 >> 7) * 256 + 128 + (n0 & 127), scr, F.tid); }
    P0_NEXT(T_WA);
    P0_LOOP(T_WD) p0_transpose(F.in[28], D, nullptr, WSP(bf16_t, WS_W2), FF, (i % 44) * 64, (i / 44) * 64, (i / 44) * 64, scr, F.tid);
    P0_NEXT(T_WD);
#undef P0_LOOP
#undef P0_NEXT
}

DI void p3_loop(const Frame& F) {
    constexpr int T_PRE = 36 + 272, T_P3 = 528;
    unsigned* hc = WSP(unsigned, WS_CTL) + 3584 + 224;
    p3_zero(F);
    const int r0 = T_PRE % F.G, c0 = (F.bid >= r0) ? F.bid - r0 : F.bid + F.G - r0;
    for (int ci = c0; ci < T_P3; ci += F.G) {
        if (ci < 512) {
            if (F.tid == 0) {
                while (__hip_atomic_load((GAS unsigned*)(hc + (ci >> 6)), __ATOMIC_RELAXED, __HIP_MEMORY_SCOPE_AGENT) < 4u) __builtin_amdgcn_s_sleep(1);
                __builtin_amdgcn_fence(__ATOMIC_ACQUIRE, "agent");
                asm volatile("s_waitcnt vmcnt(0)" ::: "memory");
            }
            __syncthreads();
        }
        p3_task(F, ci);
    }
}

DI void panel_rs(float* part, unsigned* cnt, LAS float* lx, int pm, int pn, float* rs_out = nullptr) {
    const int tid = threadIdx.x;
    __syncthreads();
    if (tid < 256) st_agent(part + (size_t)(pm * 4 + pn) * 256 + tid, lx[tid] + lx[256 + tid] + lx[512 + tid] + lx[768 + tid]);
    asm volatile("s_waitcnt vmcnt(0)" ::: "memory");
    __syncthreads();
    if (tid == 0) arrive_and_wait(cnt + pm, 4u);
    __syncthreads();
    if (tid < 256) { const float* pp = part + (size_t)pm * 1024 + tid; const float r = rsqrtf((ld_agent(pp) + ld_agent(pp + 256) + ld_agent(pp + 512) + ld_agent(pp + 768)) * (1.0f / D) + EPS); lx[1024 + tid] = r;
        if (rs_out && pn == 0) rs_out[pm * 256 + tid] = r; }
    __syncthreads();
}
struct EpiOut {
    static constexpr bool PERM = true, AFTER_DRAIN = false;
    const float* xp; float* RS; bf16_t* X1B; float* part; unsigned* cnt; LAS float* lx;
    DI void operator()(const f32x4 (&acc_)[2][2][4][2], const pg8::Unit& u, int wr, int wc, int fr, int fq) const {
        f32x4 (&acc)[2][2][4][2] = const_cast<f32x4 (&)[2][2][4][2]>(acc_);
        const int row0 = u.pm * 256 + wr * 64 + fr, col0 = u.pn * 256 + wc * 32 + 8 * fq;
#pragma unroll
        for (int ai = 0; ai < 2; ++ai)
#pragma unroll
            for (int m = 0; m < 4; ++m) {
                const size_t ro = (size_t)(row0 + ai * 128 + m * 16) * D + col0;
                float q = 0.f;
#pragma unroll
                for (int bj = 0; bj < 2; ++bj) {
                    const f32x4 v0 = acc[ai][bj][m][0] + *(const f32x4*)(xp + ro + bj * 128), v1 = acc[ai][bj][m][1] + *(const f32x4*)(xp + ro + bj * 128 + 4);
                    acc[ai][bj][m][0] = v0; acc[ai][bj][m][1] = v1;
                    q += v0[0] * v0[0] + v0[1] * v0[1] + v0[2] * v0[2] + v0[3] * v0[3] + v1[0] * v1[0] + v1[1] * v1[1] + v1[2] * v1[2] + v1[3] * v1[3];
                }
                q = xsum4(q);
                if (fq == 0) lx[wc * 256 + ai * 128 + wr * 64 + m * 16 + fr] = q;
            }
        panel_rs(part, cnt, lx, u.pm, u.pn, RS);
#pragma unroll
        for (int ai = 0; ai < 2; ++ai)
#pragma unroll
            for (int m = 0; m < 4; ++m) {
                const float rs = lx[1024 + ai * 128 + wr * 64 + m * 16 + fr];
                const size_t ro = (size_t)(row0 + ai * 128 + m * 16) * D + col0;
#pragma unroll
                for (int bj = 0; bj < 2; ++bj) *(u32x4*)(X1B + ro + bj * 128) = pack8(acc[ai][bj][m][0] * rs, acc[ai][bj][m][1] * rs);
            }
    }
};

struct EpiFfn {
    static constexpr bool PERM = true, AFTER_DRAIN = false;
    unsigned char* ws; const float* const* in; float* out; LAS float* bnd;
    DI void operator()(const f32x4 (&acc)[2][2][4][2], const pg8::Unit& u, int wr, int wc, int fr, int fq) const {
        const bf16_t* const X1B = (const bf16_t*)(ws + WS_X1B); const bf16_t* const W1T = (const bf16_t*)(ws + WS_W1);
        bf16_t* const H = (bf16_t*)(ws + WS_H); const float* const cstate = in[6];
        const int pm = u.pm, pn = u.pn, rowt = pm * 256, wave = wr * 4 + wc, tid = threadIdx.x;
        const bool sample = pm >= 64;
        const int cl = wc * 32 + 8 * fq, ff = pn * 128 + cl;
        LAS float* cwl = bnd + 17 * 2 * 128;
        if (tid < 128) { const float* cw = in[26] + pn * 128 + tid; cwl[tid] = cw[0]; cwl[128 + tid] = cw[FF]; cwl[256 + tid] = cw[2 * FF]; cwl[384 + tid] = in[27][pn * 128 + tid]; }
#pragma unroll
        for (int ai = 0; ai < 2; ++ai)
#pragma unroll
            for (int m = 0; m < 4; ++m) {
                const int blk = 8 * ai + 4 * wr + m;
                if (fr >= 14) {
                    const f32x4 a0 = acc[ai][0][m][0], a1 = acc[ai][0][m][1];
                    if (!sample || (blk & 1) == 0) { LAS float* bp = bnd + ((blk + 1) * 2 + (fr - 14)) * 128 + cl; *(LAS f32x4*)bp = a0; *(LAS f32x4*)(bp + 4) = a1; }
                    if (sample && (blk & 1)) { float* sp = out + O_SCONV + ((size_t)((pm - 64) * 8 + (blk >> 1)) * 2 + (fr - 14)) * FF + ff; *(f32x4*)sp = a0; *(f32x4*)(sp + 4) = a1; }
                    if (!sample && (pm & 7) == 7 && blk == 15) { float* sp = out + O_PCONV + ((size_t)(pm >> 3) * 2 + (fr - 14)) * FF + ff; *(f32x4*)sp = a0; *(f32x4*)(sp + 4) = a1; }
                    if (sample && (blk & 1) == 0) {
                        const float* sp = cstate + ((size_t)((pm - 64) * 8 + (blk >> 1)) * 2 + (fr - 14)) * FF + ff;
                        LAS float* bp = bnd + (blk * 2 + (fr - 14)) * 128 + cl; *(LAS f32x4*)bp = *(const f32x4*)sp; *(LAS f32x4*)(bp + 4) = *(const f32x4*)(sp + 4);
                    }
                    if (!sample && (pm & 7) == 0 && blk == 0) { LAS float* bp = bnd + (fr - 14) * 128 + cl; *(LAS f32x4*)bp = (f32x4){0.f, 0.f, 0.f, 0.f}; *(LAS f32x4*)(bp + 4) = (f32x4){0.f, 0.f, 0.f, 0.f}; }
                }
            }
        if (!sample && (pm & 7) != 0) {
            const int lane = fq * 16 + fr;
            const bf16_t* xp = X1B + (size_t)(rowt - 2) * D + lane * 8;
            const u32x4 xa0 = *(const u32x4*)xp, xa1 = *(const u32x4*)(xp + 512), xb0 = *(const u32x4*)(xp + D), xb1 = *(const u32x4*)(xp + D + 512);
#pragma unroll 1
            for (int ps = 0; ps < 4; ++ps) {
                float p0[4], p1[4];
                const bf16_t* wp = W1T + (size_t)(pn * 256 + wave * 16 + ps * 4) * D + lane * 8;
#pragma unroll
                for (int c = 0; c < 4; ++c) {
                    const u32x4 a = *(const u32x4*)(wp + (size_t)c * D), b = *(const u32x4*)(wp + (size_t)c * D + 512);
                    float s0 = 0.f, s1 = 0.f;
#pragma unroll
                    for (int j = 0; j < 4; ++j) {
                        s0 = dot2bf(a[j], xa0[j], s0); s0 = dot2bf(b[j], xa1[j], s0);
                        s1 = dot2bf(a[j], xb0[j], s1); s1 = dot2bf(b[j], xb1[j], s1);
                    }
                    p0[c] = s0; p1[c] = s1;
                }
#define HALO_STEP(N, BIT) _Pragma("unroll") for (int c = 0; c < N; ++c) { const bool hi_ = (lane & BIT) != 0; \
                    const float s0_ = hi_ ? p0[c] : p0[c + N], s1_ = hi_ ? p1[c] : p1[c + N]; \
                    const float r0_ = __shfl_xor(s0_, BIT), r1_ = __shfl_xor(s1_, BIT); \
                    p0[c] = (hi_ ? p0[c + N] : p0[c]) + r0_; p1[c] = (hi_ ? p1[c + N] : p1[c]) + r1_; }
                HALO_STEP(2, 32) HALO_STEP(1, 16)
#undef HALO_STEP
                float t0 = p0[0], t1 = p1[0];
                t0 += __shfl_xor(t0, 8); t1 += __shfl_xor(t1, 8); t0 += __shfl_xor(t0, 4); t1 += __shfl_xor(t1, 4); t0 += __shfl_xor(t0, 2); t1 += __shfl_xor(t1, 2); t0 += __shfl_xor(t0, 1); t1 += __shfl_xor(t1, 1);
                if ((lane & 15) == 0) { const int col = wave * 16 + ps * 4 + ((lane >> 5) & 1) * 2 + ((lane >> 4) & 1);
                    bnd[col] = t0; bnd[128 + col] = t1; }
            }
        }
        __syncthreads();
#pragma unroll
        for (int ai = 0; ai < 2; ++ai)
#pragma unroll
            for (int m = 0; m < 4; ++m) {
                const int blk = 8 * ai + 4 * wr + m, row = rowt + ai * 128 + wr * 64 + m * 16 + fr;
                f32x4 hv[2];
#pragma unroll
                for (int n = 0; n < 2; ++n) {
                    const f32x4 cur = acc[ai][0][m][n], upv = acc[ai][1][m][n];
                    f32x4 p1, p2;
#pragma unroll
                    for (int e = 0; e < 4; ++e) { p1[e] = dpp_shr<0x111>(cur[e]); p2[e] = dpp_shr<0x112>(cur[e]); }
                    const f32x4 b0 = *(const LAS f32x4*)(bnd + (blk * 2 + 0) * 128 + cl + 4 * n), b1 = *(const LAS f32x4*)(bnd + (blk * 2 + 1) * 128 + cl + 4 * n);
                    if (fr == 0) { p1 = b1; p2 = b0; } else if (fr == 1) { p2 = b1; }
                    const LAS float* wl = cwl + cl + 4 * n;
                    const f32x4 c = *(const LAS f32x4*)(wl + 384) + *(const LAS f32x4*)wl * p2 + *(const LAS f32x4*)(wl + 128) * p1 + *(const LAS f32x4*)(wl + 256) * cur;
#pragma unroll
                    for (int e = 0; e < 4; ++e) hv[n][e] = c[e] * sigm(c[e]) * upv[e];
                }
                *(u32x4*)(H + (size_t)row * FF + ff) = pack8(hv[0], hv[1]);
            }
        __syncthreads();
    }
};

struct EpiDown {
    static constexpr bool PERM = true, AFTER_DRAIN = false;
    float* out; const bf16_t* X1B; const float* RS; const float* gfin; float* part; unsigned* cnt; LAS float* lx;
    DI void operator()(const f32x4 (&acc_)[2][2][4][2], const pg8::Unit& u, int wr, int wc, int fr, int fq) const {
        f32x4 (&acc)[2][2][4][2] = const_cast<f32x4 (&)[2][2][4][2]>(acc_);
        const int row0 = u.pm * 256 + wr * 64 + fr, col0 = u.pn * 256 + wc * 32 + 8 * fq;
#pragma unroll
        for (int ai = 0; ai < 2; ++ai)
#pragma unroll
            for (int m = 0; m < 4; ++m) {
                const int row = row0 + ai * 128 + m * 16;
                const bf16_t* xrow = X1B + (size_t)row * D + col0;
                const float ir = 1.0f / RS[row];
                float q = 0.f;
#pragma unroll
                for (int bj = 0; bj < 2; ++bj) {
                    const u32x4 xw = *(const u32x4*)(xrow + bj * 128);
                    const f32x4 x0 = (f32x4){bflo(xw.x), bfhi(xw.x), bflo(xw.y), bfhi(xw.y)}, x1v = (f32x4){bflo(xw.z), bfhi(xw.z), bflo(xw.w), bfhi(xw.w)};
                    const f32x4 v0 = acc[ai][bj][m][0] + x0 * ir, v1 = acc[ai][bj][m][1] + x1v * ir;
                    acc[ai][bj][m][0] = v0; acc[ai][bj][m][1] = v1;
                    q += v0[0] * v0[0] + v0[1] * v0[1] + v0[2] * v0[2] + v0[3] * v0[3] + v1[0] * v1[0] + v1[1] * v1[1] + v1[2] * v1[2] + v1[3] * v1[3];
                }
                q = xsum4(q);
                if (fq == 0) lx[wc * 256 + ai * 128 + wr * 64 + m * 16 + fr] = q;
            }
        panel_rs(part, cnt, lx, u.pm, u.pn);
        f32x4 gv[2][2];
#pragma unroll
        for (int bj = 0; bj < 2; ++bj) { gv[bj][0] = *(const f32x4*)(gfin + col0 + bj * 128); gv[bj][1] = *(const f32x4*)(gfin + col0 + bj * 128 + 4); }
#pragma unroll
        for (int ai = 0; ai < 2; ++ai)
#pragma unroll
            for (int m = 0; m < 4; ++m) {
                float* orow = out + (size_t)(row0 + ai * 128 + m * 16) * D + col0;
                const float rs = lx[1024 + ai * 128 + wr * 64 + m * 16 + fr];
#pragma unroll
                for (int bj = 0; bj < 2; ++bj) { *(f32x4*)(orow + bj * 128) = acc[ai][bj][m][0] * rs * gv[bj][0]; *(f32x4*)(orow + bj * 128 + 4) = acc[ai][bj][m][1] * rs * gv[bj][1]; }
            }
    }
};


template <int K> DI f32x4 mini_tile_ks(const Frame& F, const bf16_t* __restrict__ A, const bf16_t* __restrict__ Bt, int row0, int col0) {
    constexpr int KC = 256, LDT = 264, NCH = K / KC, LDR = 68;
    const int tid = F.tid, lane = F.lane, fr = lane & 15, fq = lane >> 4, mt = F.wave & 1, nt = F.wave >> 1;
    LAS bf16_t* tile = (LAS bf16_t*)F.lds;
    const bf16_t* src[6]; int dst[6];
#pragma unroll
    for (int j = 0; j < 6; ++j) { const int p = tid + 512 * j, r = p >> 5, c = (p & 31) * 8;
        src[j] = (r < 32 ? A + (size_t)(row0 + r) * K : Bt + (size_t)(col0 + r - 32) * K) + c; dst[j] = r * LDT + c; }
    u32x4 pre[6];
#pragma unroll
    for (int j = 0; j < 6; ++j) pre[j] = *(const u32x4*)src[j];
    f32x4 acc = (f32x4){0.f, 0.f, 0.f, 0.f};
#pragma unroll 1
    for (int ch = 0; ch < NCH; ++ch) {
#pragma unroll
        for (int j = 0; j < 6; ++j) *(LAS u32x4*)(tile + dst[j]) = pre[j];
        __syncthreads();
        if (ch + 1 < NCH) {
#pragma unroll
            for (int j = 0; j < 6; ++j) pre[j] = *(const u32x4*)(src[j] + (size_t)(ch + 1) * KC);
        }
        const LAS bf16_t* xa = tile + (mt * 16 + fr) * LDT + fq * 8;
        const LAS bf16_t* wb = tile + (32 + nt * 16 + fr) * LDT + fq * 8;
#pragma unroll
        for (int ks = 0; ks < KC / 32; ++ks) acc = MFMA16(*(const LAS bf16x8*)(wb + ks * 32), *(const LAS bf16x8*)(xa + ks * 32), acc);
        __syncthreads();
    }
    LAS float* red = (LAS float*)F.lds;
    *(LAS f32x4*)(red + (mt * 16 + fr) * LDR + nt * 16 + fq * 4) = acc;
    __syncthreads();
    const f32x4 out = *(const LAS f32x4*)(red + (tid >> 4) * LDR + (tid & 15) * 4);
    __syncthreads();
    return out;
}
constexpr int MINI_PARK = LDS_X + 8192;
DI void p4_sample_a(const Frame& F) {
    if (F.bid >= 256) return;
    float* PS = WSP(float, WS_PARTS); unsigned* cnt = WSP(unsigned, WS_CTL) + 3584 + 192;
    const int t = F.bid, rg = t & 15, cg = t >> 4, rl = F.tid >> 4, row = MP + rg * 32 + rl, n0 = cg * 64 + (F.tid & 15) * 4;
    const f32x4 acc = mini_tile_ks<D>(F, WSP(bf16_t, WS_MIX), WSP(bf16_t, WS_WO), MP + rg * 32, cg * 64);
    const f32x4 v = acc + *(const f32x4*)(F.in[1] + (size_t)(row - MP) * D + n0);
    float q = v[0] * v[0] + v[1] * v[1] + v[2] * v[2] + v[3] * v[3];
    q += __shfl_xor(q, 1); q += __shfl_xor(q, 2); q += __shfl_xor(q, 4); q += __shfl_xor(q, 8);
    if ((F.tid & 15) == 0) st_agent(PS + (size_t)(rg * 16 + cg) * 32 + rl, q);
    *(LAS f32x4*)(F.lds + MINI_PARK + F.tid * 16) = v;
    asm volatile("s_waitcnt vmcnt(0)" ::: "memory");
    __syncthreads();
    if (F.tid == 0) (void)__hip_atomic_fetch_add((GAS unsigned*)(cnt + rg), 1u, __ATOMIC_RELAXED, __HIP_MEMORY_SCOPE_AGENT);
}
DI void p4_sample_b(const Frame& F) {
    if (F.bid >= 256) return;
    float* PS = WSP(float, WS_PARTS); unsigned* cnt = WSP(unsigned, WS_CTL) + 3584 + 192;
    const int t = F.bid, rg = t & 15, cg = t >> 4, rl = F.tid >> 4, row = MP + rg * 32 + rl, n0 = cg * 64 + (F.tid & 15) * 4;
    if (F.tid == 0) wait_ge16(cnt + rg);
    __syncthreads();
    float tot = 0.f;
#pragma unroll
    for (int c = 0; c < 16; ++c) tot += ld_agent(PS + (size_t)(rg * 16 + c) * 32 + rl);
    const float rs = rsqrtf(tot * (1.0f / D) + EPS);
    const f32x4 v = *(const LAS f32x4*)(F.lds + MINI_PARK + F.tid * 16);
    *(f32x4*)(WSP(float, WS_X1F) + (size_t)row * D + n0) = v;
    u32x2 w; w.x = pk2(v[0] * rs, v[1] * rs); w.y = pk2(v[2] * rs, v[3] * rs); *(u32x2*)(WSP(bf16_t, WS_X1B) + (size_t)row * D + n0) = w;
}
DI void p6_sample_a(const Frame& F) {
    if (F.bid >= 256) return;
    float* PS = WSP(float, WS_PARTS); unsigned* cnt = WSP(unsigned, WS_CTL) + 3584 + 208;
    const int t = F.bid, rg = t & 15, cg = t >> 4, rl = F.tid >> 4, row = MP + rg * 32 + rl, n0 = cg * 64 + (F.tid & 15) * 4;
    const f32x4 acc = mini_tile_ks<FF>(F, WSP(bf16_t, WS_H), WSP(bf16_t, WS_W2), MP + rg * 32, cg * 64);
    const f32x4 v = acc + *(const f32x4*)(WSP(float, WS_X1F) + (size_t)row * D + n0);
    float q = v[0] * v[0] + v[1] * v[1] + v[2] * v[2] + v[3] * v[3];
    q += __shfl_xor(q, 1); q += __shfl_xor(q, 2); q += __shfl_xor(q, 4); q += __shfl_xor(q, 8);
    if ((F.tid & 15) == 0) st_agent(PS + (size_t)(rg * 16 + cg) * 32 + rl, q);
    *(LAS f32x4*)(F.lds + MINI_PARK + F.tid * 16) = v;
    asm volatile("s_waitcnt vmcnt(0)" ::: "memory");
    __syncthreads();
    if (F.tid == 0) (void)__hip_atomic_fetch_add((GAS unsigned*)(cnt + rg), 1u, __ATOMIC_RELAXED, __HIP_MEMORY_SCOPE_AGENT);
}
DI void p6_sample_b(const Frame& F) {
    if (F.bid >= 256) return;
    float* PS = WSP(float, WS_PARTS); unsigned* cnt = WSP(unsigned, WS_CTL) + 3584 + 208;
    const int t = F.bid, rg = t & 15, cg = t >> 4, rl = F.tid >> 4, row = MP + rg * 32 + rl, n0 = cg * 64 + (F.tid & 15) * 4;
    if (F.tid == 0) wait_ge16(cnt + rg);
    __syncthreads();
    float tot = 0.f;
#pragma unroll
    for (int c = 0; c < 16; ++c) tot += ld_agent(PS + (size_t)(rg * 16 + c) * 32 + rl);
    const float rs = rsqrtf(tot * (1.0f / D) + EPS);
    const f32x4 v = *(const LAS f32x4*)(F.lds + MINI_PARK + F.tid * 16);
    *(f32x4*)(F.out + (size_t)row * D + n0) = v * rs * *(const f32x4*)(F.in[29] + n0);
}

#define RLX_AGENT __ATOMIC_RELAXED, __HIP_MEMORY_SCOPE_AGENT
#define XB_TMO      128
#define XB_XCNT(j)  (256  + 64 * (j))
#define XB_XSUB(j)  (1280 + 64 * (j))
#define XB_XGEN(j)  (2304 + 64 * (j))
#define XB_TOP      3328
#define XB_TOPGEN   3392
#define XCD_BAR_WORDS 3456
#define XB_SPIN_CAP (1u << 18)

__device__ __forceinline__ unsigned xb_ld(unsigned* p)              { return __hip_atomic_load(p, __ATOMIC_RELAXED, __HIP_MEMORY_SCOPE_AGENT); }
__device__ __forceinline__ unsigned xb_add(unsigned* p, unsigned v) { return __hip_atomic_fetch_add(p, v, __ATOMIC_RELAXED, __HIP_MEMORY_SCOPE_AGENT); }
__device__ __forceinline__ unsigned xb_xcc_id() { return (unsigned)__builtin_amdgcn_s_getreg((3 << 11) | 20) & 0xFu; }
#define XB_SPIN(cond, bar) do { unsigned _sp = 0; while (cond) { __builtin_amdgcn_s_sleep(1); \
    if ((++_sp & 255u) == 0u) { if (xb_ld(&(bar)[XB_TMO])) break; if (_sp > XB_SPIN_CAP) { atomicAdd(&(bar)[XB_TMO], 1u); break; } } } } while (0)

struct XcdBarrier {
    unsigned* bar; unsigned x;
    volatile LAS unsigned* st;
};

__device__ __forceinline__ XcdBarrier xcd_barrier_post(unsigned* bar, volatile LAS unsigned* st) {
    XcdBarrier b; b.bar = bar; b.x = xb_xcc_id(); b.st = st;
    if (threadIdx.x == 0) (void)xb_add(&bar[XB_XCNT(b.x)], 1u);
    return b;
}
__device__ __forceinline__ void xcd_barrier_complete(unsigned* bar, unsigned x, unsigned& nloc, unsigned& nx) {
    const unsigned G = gridDim.x * gridDim.y * gridDim.z;
    unsigned sum, cnt, mine, sp = 0u;
    for (;;) {
        sum = 0u; cnt = 0u; mine = 0u;
#pragma unroll
        for (unsigned j = 0; j < 16; ++j) { const unsigned c = xb_ld(&bar[XB_XCNT(j)]); sum += c; cnt += (c > 0u) ? 1u : 0u; mine = (j == x) ? c : mine; }
        if (sum == G) break;
        __builtin_amdgcn_s_sleep(1);
        if ((++sp & 255u) == 0u) { if (xb_ld(&bar[XB_TMO])) break; if (sp > XB_SPIN_CAP) { atomicAdd(&bar[XB_TMO], 1u); break; } }
    }
    nloc = mine > 0u ? mine : 1u; nx = cnt > 0u ? cnt : 1u;
}

__device__ __forceinline__ void xcd_barrier(const XcdBarrier& b) {
    asm volatile("s_waitcnt vmcnt(0)" ::: "memory");
    __syncthreads();
    if (threadIdx.x == 0) {
        unsigned* bar = b.bar;
        __builtin_amdgcn_s_waitcnt(0);
        unsigned nloc = b.st[0], nx = b.st[1];
        if (nloc == 0u) { xcd_barrier_complete(bar, b.x, nloc, nx); b.st[0] = nloc; b.st[1] = nx; }
        const unsigned old = xb_add(&bar[XB_XSUB(b.x)], 1u);
        const unsigned gen = old / nloc;
        if (old + 1u == (gen + 1u) * nloc) {
            __builtin_amdgcn_fence(__ATOMIC_RELEASE, "agent");
            asm volatile("s_waitcnt vmcnt(0)" ::: "memory");
            const unsigned og = xb_add(&bar[XB_TOP], 1u);
            const unsigned tg = og / nx;
            if (og + 1u == (tg + 1u) * nx) xb_add(&bar[XB_TOPGEN], 1u);
            else XB_SPIN(xb_ld(&bar[XB_TOPGEN]) == tg, bar);
            __builtin_amdgcn_fence(__ATOMIC_ACQUIRE, "agent");
            xb_add(&bar[XB_XGEN(b.x)], 1u);
            asm volatile("s_waitcnt vmcnt(0)" ::: "memory");
        } else {
            XB_SPIN(xb_ld(&bar[XB_XGEN(b.x)]) == gen, bar);
            __builtin_amdgcn_fence(__ATOMIC_ACQUIRE, "agent");
            asm volatile("s_waitcnt vmcnt(0)" ::: "memory");
        }
    }
    __syncthreads();
}

DI void grid_bar(unsigned* ctr, unsigned target) {
    asm volatile("s_waitcnt vmcnt(0)" ::: "memory");
    __syncthreads();
    if (threadIdx.x == 0) {
        __builtin_amdgcn_fence(__ATOMIC_RELEASE, "agent");
        asm volatile("s_waitcnt vmcnt(0)" ::: "memory");
        (void)__hip_atomic_fetch_add(ctr, 1u, __ATOMIC_RELAXED, __HIP_MEMORY_SCOPE_AGENT);
        while (__hip_atomic_load(ctr, __ATOMIC_RELAXED, __HIP_MEMORY_SCOPE_AGENT) < target) __builtin_amdgcn_s_sleep(1);
        __builtin_amdgcn_fence(__ATOMIC_ACQUIRE, "agent");
        asm volatile("s_waitcnt vmcnt(0)" ::: "memory");
    }
    __syncthreads();
}

#ifndef PH_MASK
#define PH_MASK 255
#endif
__global__ void __launch_bounds__(512, 2) mega_fwd(Args args) {
    extern __shared__ __attribute__((aligned(16))) unsigned char lds_raw[];
    cg::grid_group grid = cg::this_grid();
    Frame F;
    F.lds = (LAS unsigned char*)lds_raw; F.tid = threadIdx.x; F.lane = F.tid & 63; F.wave = __builtin_amdgcn_readfirstlane(F.tid >> 6);
    F.G = gridDim.x; F.bid = blockIdx.x; F.in = args.in; F.out = args.out; F.ws = args.ws;
    const int lo = args.ph_lo, hi = args.ph_hi;
#define IN(k) (((PH_MASK >> (k)) & 1) && lo <= (k) && (k) < hi)
    volatile LAS unsigned* xb_st = (volatile LAS unsigned*)(F.lds + LDS_BYTES - 64);
    if (F.tid < 2) xb_st[F.tid] = 0u;
    __syncthreads();
    XcdBarrier xbar; xbar.bar = WSP(unsigned, WS_CTL); xbar.x = 0; xbar.st = xb_st;
    if (lo + 1 < hi) xbar = xcd_barrier_post(WSP(unsigned, WS_CTL), xb_st);
    unsigned bar_n = 0;
#ifdef USE_CG_SYNC
#define SEAM(k) do { if (lo <= (k) && (k) + 1 < hi) grid.sync(); } while (0)
#else
#ifdef USE_CENTRAL_BAR
#define SEAM(k) do { if (lo <= (k) && (k) + 1 < hi) { bar_n += (unsigned)F.G; grid_bar(WSP(unsigned, WS_CTL) + 3520, bar_n); } } while (0)
#else
#define SEAM(k) do { if (lo <= (k) && (k) + 1 < hi) xcd_barrier(xbar); } while (0)
#endif
#endif
    if (hi > 8) grid.sync();
#ifndef REP_MASK
#define REP_MASK 0
#endif
#define REPS(k) for (int rep_ = 0; rep_ < 1 + ((REP_MASK >> (k)) & 1); ++rep_)
    if (IN(0)) { p0_prologue(F); } SEAM(0);
#ifdef EXTRA_SYNC
    for (int i_ = 0; i_ < EXTRA_SYNC; ++i_) SEAM(0);
#endif
#if (REP_MASK >> 0) & 1
    p0_prologue(F); grid.sync();
#endif
    if (IN(1)) {
        pg8::Gemm g{WSP(bf16_t, WS_XN), WSP(bf16_t, WS_WIN), M, INW, D}; pg8::StaticOrder S; S.init(M, INW, F.G, F.bid);
        EpiIn E{F.ws, F.out};
        pg8::gemm_phase<EpiIn, pg8::StaticOrder, true, true>(F.lds, g, S, E);
        p1_tail(F);
    } SEAM(1);
    if (IN(2)) { p23_phase(F); p3_loop(F); late_weights(F); }
#if (REP_MASK >> 2) & 1
    p2_phase(F); grid.sync();
#endif
    SEAM(2);
#if (REP_MASK >> 3) & 1
    for (int t = F.bid; t < 528; t += F.G) p3_task(F, t); grid.sync();
#endif
    if (IN(4)) {
        p4_sample_a(F);
        pg8::Gemm g{WSP(bf16_t, WS_MIX), WSP(bf16_t, WS_WO), MP, D, D}; pg8::StaticOrder S; S.init(MP, D, F.G, F.bid);
        EpiOut E{F.in[0], WSP(float, WS_SSQ), WSP(bf16_t, WS_X1B), WSP(float, WS_PART), WSP(unsigned, WS_CTL) + 3584 + 128, (LAS float*)(F.lds + LDS_X)};
        pg8::gemm_phase<EpiOut, pg8::StaticOrder, true, true>(F.lds, g, S, E);
        p4_sample_b(F);
    } SEAM(4);
    if (IN(5)) {
        pg8::Gemm g{WSP(bf16_t, WS_X1B), WSP(bf16_t, WS_W1), M, 2 * FF, D}; pg8::StaticOrder S; S.init(M, 2 * FF, F.G, F.bid);
        EpiFfn E{F.ws, F.in, F.out, (LAS float*)(F.lds + LDS_X)};
        pg8::gemm_phase<EpiFfn, pg8::StaticOrder, true, true>(F.lds, g, S, E);
    } SEAM(5);
    if (IN(6)) {
        p6_sample_a(F);
        pg8::Gemm g{WSP(bf16_t, WS_H), WSP(bf16_t, WS_W2), MP, D, FF}; pg8::StaticOrder S; S.init(MP, D, F.G, F.bid);
        EpiDown E{F.out, WSP(bf16_t, WS_X1B), WSP(float, WS_SSQ), F.in[29], WSP(float, WS_PART), WSP(unsigned, WS_CTL) + 3584 + 64, (LAS float*)(F.lds + LDS_X)};
        pg8::gemm_phase<EpiDown, pg8::StaticOrder, true, true>(F.lds, g, S, E);
        p6_sample_b(F);
    }
#undef IN
#undef SEAM
}

extern "C" void kernel_launch(void* const* d_in, const int* in_sizes, int n_in, void* d_out, int out_size, void* d_ws, size_t ws_size, hipStream_t stream) {
    static int grid = 0;
    if (grid == 0) {
        if (n_in != 30 || ws_size < WS_END) { fprintf(stderr, "kernel_launch: unexpected n_in %d / ws_size %zu (need %zu)\n", n_in, ws_size, (size_t)WS_END); grid = -1; return; }
        int dev = 0, cus = 0, per_cu = 0;
        (void)hipGetDevice(&dev); (void)hipDeviceGetAttribute(&cus, hipDeviceAttributeMultiprocessorCount, dev);
        if (hipFuncSetAttribute((const void*)mega_fwd, hipFuncAttributeMaxDynamicSharedMemorySize, LDS_BYTES) != hipSuccess) { fprintf(stderr, "hipFuncSetAttribute failed\n"); grid = -1; return; }
        if (hipOccupancyMaxActiveBlocksPerMultiprocessor(&per_cu, (const void*)mega_fwd, 512, LDS_BYTES) != hipSuccess || per_cu < 1) { fprintf(stderr, "occupancy query: %d\n", per_cu); per_cu = 1; }
        (void)hipGetLastError();
        grid = cus * (per_cu > 1 ? 1 : per_cu);
        if (grid <= 0) grid = 256;
    }
    if (grid < 0) return;
    Args a{};
    for (int i = 0; i < 30; ++i) a.in[i] = (const float*)d_in[i];
    a.out = (float*)d_out; a.ws = (unsigned char*)d_ws;
    (void)hipMemsetAsync((unsigned char*)d_ws + WS_CTL, 0, 16384, stream);
#if N_LAUNCHES == 1
    a.ph_lo = 0; a.ph_hi = 8;
    void* kargs[] = {&a};
    hipError_t e = hipLaunchCooperativeKernel((const void*)mega_fwd, dim3(grid), dim3(512), kargs, LDS_BYTES, stream);
    if (e != hipSuccess) fprintf(stderr, "cooperative launch failed: %s (grid %d)\n", hipGetErrorString(e), grid);
#else
    for (int p = 0; p < 8; ++p) { a.ph_lo = p; a.ph_hi = p + 1; for (int r = 0; r < 1 + ((HOST_REP >> p) & 1); ++r) hipLaunchKernelGGL(mega_fwd, dim3(grid), dim3(512), LDS_BYTES, stream, a); }
#endif
}
```

```cpp
#include <hip/hip_runtime.h>
#include <hip/hip_cooperative_groups.h>
#include <cstdio>
#include <cstdint>
namespace cg = cooperative_groups;

namespace pg8 {
#define PG8_LAS __attribute__((address_space(3)))
typedef unsigned short bf16_t;
typedef short bf16x8 __attribute__((ext_vector_type(8)));
typedef float f32x4 __attribute__((ext_vector_type(4)));
typedef unsigned u32x4 __attribute__((ext_vector_type(4)));
constexpr int BM = 256, BK = 64, HALF = 128, HTB = HALF * BK * 2  , STAGE_BYTES = 8 * HTB, NXCD = 8, WGM = 8;

__host__ __device__ __forceinline__ int lds_byte(int r, int c) { const int st = (r >> 4) * 2 + (c >> 5), rr = r & 15, cc = c & 31, ob = rr * 64 + cc * 2; return st * 1024 + (ob ^ (((ob >> 9) & 1) << 5)); }
__host__ __device__ __forceinline__ void stage_rc(int b, int& R, int& C) { const int st = b / 1024, sb = b % 1024, swz = sb ^ (((sb >> 9) & 1) << 5); R = (st >> 1) * 16 + swz / 64; C = (st & 1) * 32 + (swz % 64) / 2; }
__host__ __device__ __forceinline__ int perm32(int rho) { const int n = rho >> 4, i = rho & 15; return 8 * (i >> 2) + 4 * n + (i & 3); }

struct Unit { int pm, pn; };
struct Gemm { const bf16_t* A; const bf16_t* Bt; int M, N, K; };

struct StaticOrder {
    int nM, nN, nwg, G, c;
    __host__ __device__ void init(int M, int N, int G_, int c_) { nM = M / BM; nN = N / BM; nwg = nM * nN; G = G_; c = c_; }
    __host__ __device__ bool next(int i, Unit& u) const {
        const long L = (long)i * G + c; if (L >= nwg) return false;
        int wgid = (int)L; { const int q = nwg / NXCD, r = nwg % NXCD, xcd = wgid % NXCD, off = wgid / NXCD; wgid = (xcd < r ? xcd * (q + 1) : r * (q + 1) + (xcd - r) * q) + off; }
        const int nig = WGM * nN, gid = wgid / nig, fm = gid * WGM, gsz = (nM - fm) < WGM ? (nM - fm) : WGM;
        u.pm = fm + ((wgid % nig) % gsz); u.pn = (wgid % nig) / gsz; return true;
    }
    __device__ __forceinline__ void a_ready(const Unit&) const {}
    __device__ __forceinline__ void done(const Unit&) const {}
};

__device__ __forceinline__ unsigned cvt_pk_bf16(float lo, float hi) { unsigned r; asm volatile("v_cvt_pk_bf16_f32 %0, %1, %2" : "=v"(r) : "v"(lo), "v"(hi)); return r; }
template <class Epi, class Sched, bool ALIGN_EPI = false, bool SP2 = false>
__device__ __forceinline__ void gemm_phase(PG8_LAS unsigned char* lds, const Gemm g, const Sched& S, const Epi& E) {
    const int tid = threadIdx.x, wid = __builtin_amdgcn_readfirstlane(tid >> 6), lane = tid & 63, wr = wid >> 2, wc = wid & 3, fr = lane & 15, fq = lane >> 4;
    const int K = g.K, nt = K / BK;
    unsigned voffA[2], voffB[2];
#pragma unroll
    for (int i = 0; i < 2; ++i) { int R, C; stage_rc(tid * 16 + i * 8192, R, C); const int Rb = Epi::PERM ? ((R & ~31) + perm32(R & 31)) : R;
        voffA[i] = (unsigned)(R * K + C) * 2u; voffB[i] = (unsigned)(Rb * K + C) * 2u; }
    const size_t kstep = (size_t)(BK * 2);
    const size_t hstep = (size_t)HALF * K * 2;
    const size_t tstep = 2 * hstep;
    const unsigned ldsw = (unsigned)wid * 1024u;
    const int aoff = lds_byte(wr * 64 + fr, fq * 8), boff = lds_byte(wc * 32 + fr, fq * 8);
#define PG8_SA(b, h) (((b) * 2 + (h)) * HTB)
#define PG8_SB(b, h) ((4 + (b) * 2 + (h)) * HTB)
#define PG8_STAGE(bufoff, gbase, voff) do { _Pragma("unroll") for (int _i = 0; _i < 2; ++_i) \
        __builtin_amdgcn_global_load_lds((const unsigned*)((const char*)(gbase) + (voff)[_i]), (PG8_LAS unsigned*)(lds + (bufoff) + ldsw + _i * 8192), 16, 0, 0); } while (0)
#define PG8_LDA(dst, b, h) do { _Pragma("unroll") for (int m = 0; m < 4; ++m) _Pragma("unroll") for (int k = 0; k < 2; ++k) dst[m][k] = *(const PG8_LAS bf16x8*)(lds + PG8_SA(b, h) + aoff + m * 2048 + k * 1024); } while (0)
#define PG8_LDB(dst, b, h) do { _Pragma("unroll") for (int n = 0; n < 2; ++n) _Pragma("unroll") for (int k = 0; k < 2; ++k) dst[n][k] = *(const PG8_LAS bf16x8*)(lds + PG8_SB(b, h) + boff + n * 2048 + k * 1024); } while (0)
#define PG8_MMA(ai, bj, At, Bt) do { __builtin_amdgcn_s_setprio(1); _Pragma("unroll") for (int m = 0; m < 4; ++m) _Pragma("unroll") for (int n = 0; n < 2; ++n) _Pragma("unroll") for (int k = 0; k < 2; ++k) \
        acc[ai][bj][m][n] = __builtin_amdgcn_mfma_f32_16x16x32_bf16(Bt[n][k], At[m][k], acc[ai][bj][m][n], 0, 0, 0); __builtin_amdgcn_s_setprio(0); } while (0)
#define PG8_WAIT_V(n) asm volatile("s_waitcnt vmcnt(" #n ")" ::: "memory")
#define PG8_WAIT_L(n) asm volatile("s_waitcnt lgkmcnt(" #n ")" ::: "memory")
#define PG8_BAR __builtin_amdgcn_s_barrier()
#define PG8_SCHED __builtin_amdgcn_sched_barrier(0)
    Unit cur, nxt; int ui = 0;
    if (!S.next(0, cur)) return;
    f32x4 acc[2][2][4][2];
#pragma unroll
    for (int a = 0; a < 2; ++a)
#pragma unroll
        for (int b = 0; b < 2; ++b)
#pragma unroll
            for (int m = 0; m < 4; ++m)
#pragma unroll
                for (int n = 0; n < 2; ++n) acc[a][b][m][n] = (f32x4){0.f, 0.f, 0.f, 0.f};
    bf16x8 At[4][2], B0[2][2], B1[2][2];
    const char* cA = (const char*)g.A + (size_t)cur.pm * tstep; const char* cB = (const char*)g.Bt + (size_t)cur.pn * tstep;
    S.a_ready(cur);
    if constexpr (SP2) {
        PG8_STAGE(PG8_SB(0, 0), cB, voffB); PG8_STAGE(PG8_SB(0, 1), cB + hstep, voffB); PG8_STAGE(PG8_SA(0, 0), cA, voffA); PG8_STAGE(PG8_SA(0, 1), cA + hstep, voffA);
        if (wr == 1) PG8_BAR;
        PG8_WAIT_V(2); PG8_BAR;
        PG8_STAGE(PG8_SB(1, 0), cB + kstep, voffB); PG8_STAGE(PG8_SA(1, 0), cA + kstep, voffA); PG8_STAGE(PG8_SB(1, 1), cB + hstep + kstep, voffB);
        PG8_WAIT_V(6); PG8_BAR;
    } else {
        PG8_STAGE(PG8_SB(0, 0), cB, voffB); PG8_STAGE(PG8_SA(0, 0), cA, voffA); PG8_STAGE(PG8_SB(0, 1), cB + hstep, voffB); PG8_STAGE(PG8_SA(0, 1), cA + hstep, voffA);
        if (wr == 1) PG8_BAR;
        PG8_WAIT_V(4); PG8_BAR;
        PG8_STAGE(PG8_SB(1, 0), cB + kstep, voffB); PG8_STAGE(PG8_SA(1, 0), cA + kstep, voffA); PG8_STAGE(PG8_SB(1, 1), cB + hstep + kstep, voffB);
        PG8_WAIT_V(6); PG8_BAR;
    }
    for (;;) {
        const bool has_next = S.next(ui + 1, nxt);
        const char* nA = has_next ? (const char*)g.A + (size_t)nxt.pm * tstep : cA; const char* nB = has_next ? (const char*)g.Bt + (size_t)nxt.pn * tstep : cB;
        for (int t = 0; t < nt; t += 2) {
            const bool last = (t == nt - 2);
            const char* a1 = cA + (size_t)(t + 1) * kstep;
            const char* a2 = last ? nA : cA + (size_t)(t + 2) * kstep; const char* b2 = last ? nB : cB + (size_t)(t + 2) * kstep;
            const char* a3 = a2 + kstep; const char* b3 = b2 + kstep;
            if (last && has_next) S.a_ready(nxt);
            if constexpr (SP2) {
            PG8_LDB(B0, 0, 0); PG8_LDB(B1, 0, 1); PG8_SCHED; PG8_LDA(At, 0, 0); PG8_STAGE(PG8_SA(1, 1), a1 + hstep, voffA);
            PG8_WAIT_V(8); PG8_WAIT_L(0); PG8_BAR; PG8_MMA(0, 0, At, B0); PG8_MMA(0, 1, At, B1); PG8_BAR; PG8_SCHED;
            PG8_LDA(At, 0, 1); PG8_STAGE(PG8_SB(0, 0), b2, voffB); PG8_STAGE(PG8_SB(0, 1), b2 + hstep, voffB); PG8_STAGE(PG8_SA(0, 0), a2, voffA);
            PG8_WAIT_V(8); PG8_WAIT_L(0); PG8_BAR; PG8_MMA(1, 0, At, B0); PG8_MMA(1, 1, At, B1); PG8_BAR; PG8_SCHED;
            PG8_LDB(B0, 1, 0); PG8_LDB(B1, 1, 1); PG8_SCHED; PG8_LDA(At, 1, 0); PG8_STAGE(PG8_SA(0, 1), a2 + hstep, voffA);
            PG8_WAIT_V(8); PG8_WAIT_L(0); PG8_BAR; PG8_MMA(0, 0, At, B0); PG8_MMA(0, 1, At, B1); PG8_BAR; PG8_SCHED;
            PG8_LDA(At, 1, 1); PG8_STAGE(PG8_SB(1, 0), b3, voffB); PG8_STAGE(PG8_SB(1, 1), b3 + hstep, voffB); PG8_STAGE(PG8_SA(1, 0), a3, voffA);
            PG8_WAIT_V(8); PG8_WAIT_L(0); PG8_BAR; PG8_MMA(1, 0, At, B0); PG8_MMA(1, 1, At, B1); PG8_BAR; PG8_SCHED;
            } else {
            PG8_LDB(B0, 0, 0); PG8_SCHED; PG8_LDA(At, 0, 0); PG8_STAGE(PG8_SA(1, 1), a1 + hstep, voffA);
            PG8_WAIT_L(8); PG8_BAR; PG8_WAIT_L(0); PG8_MMA(0, 0, At, B0); PG8_BAR; PG8_SCHED;
            PG8_LDB(B1, 0, 1); PG8_STAGE(PG8_SB(0, 0), b2, voffB);
            PG8_BAR; PG8_WAIT_L(0); PG8_MMA(0, 1, At, B1); PG8_BAR;
            PG8_LDA(At, 0, 1); PG8_STAGE(PG8_SA(0, 0), a2, voffA);
            PG8_BAR; PG8_WAIT_L(0); PG8_MMA(1, 0, At, B0); PG8_BAR; PG8_SCHED;
            PG8_STAGE(PG8_SB(0, 1), b2 + hstep, voffB);
            PG8_WAIT_V(6); PG8_BAR; PG8_MMA(1, 1, At, B1); PG8_BAR;
            PG8_LDB(B0, 1, 0); PG8_SCHED; PG8_LDA(At, 1, 0); PG8_STAGE(PG8_SA(0, 1), a2 + hstep, voffA);
            PG8_WAIT_L(8); PG8_BAR; PG8_WAIT_L(0); PG8_MMA(0, 0, At, B0); PG8_BAR; PG8_SCHED;
            PG8_LDB(B1, 1, 1); PG8_STAGE(PG8_SB(1, 0), b3, voffB);
            PG8_BAR; PG8_WAIT_L(0); PG8_MMA(0, 1, At, B1); PG8_BAR;
            PG8_LDA(At, 1, 1); PG8_STAGE(PG8_SA(1, 0), a3, voffA);
            PG8_BAR; PG8_WAIT_L(0); PG8_MMA(1, 0, At, B0); PG8_BAR; PG8_SCHED;
            PG8_STAGE(PG8_SB(1, 1), b3 + hstep, voffB);
            PG8_WAIT_V(6); PG8_BAR; PG8_MMA(1, 1, At, B1); PG8_BAR;
            }
        }
        if constexpr (ALIGN_EPI) { if (wr == 0) PG8_BAR; }
        if constexpr (!Epi::AFTER_DRAIN) { E(acc, cur, wr, wc, fr, fq); S.done(cur); }
        if (!has_next) break;
#pragma unroll
        for (int a = 0; a < 2; ++a)
#pragma unroll
            for (int b = 0; b < 2; ++b)
#pragma unroll
                for (int m = 0; m < 4; ++m)
#pragma unroll
                    for (int n = 0; n < 2; ++n) acc[a][b][m][n] = (f32x4){0.f, 0.f, 0.f, 0.f};
        cur = nxt; cA = nA; cB = nB; ++ui;
        if constexpr (ALIGN_EPI) { if (wr == 1) PG8_BAR; }
    }
    PG8_WAIT_V(0);
    if constexpr (!ALIGN_EPI) { if (wr == 0) PG8_BAR; }
    PG8_BAR;
    if constexpr (Epi::AFTER_DRAIN) { E.fused(acc, cur, wr, wc, fr, fq, lds, wid, lane); S.done(cur); }
#undef PG8_SA
#undef PG8_SB
#undef PG8_STAGE
#undef PG8_LDA
#undef PG8_LDB
#undef PG8_MMA
#undef PG8_WAIT_V
#undef PG8_WAIT_L
#undef PG8_BAR
#undef PG8_SCHED
}
}

#ifndef HOST_REP
#define HOST_REP 0
#endif
#ifndef N_LAUNCHES
#define N_LAUNCHES 1
#endif
#define DI __device__ __forceinline__
#define LAS __attribute__((address_space(3)))
using pg8::bf16_t; using pg8::bf16x8; using pg8::f32x4; using pg8::u32x4;
typedef unsigned u32x2 __attribute__((ext_vector_type(2)));
typedef short s16x4 __attribute__((ext_vector_type(4)));
#define MFMA16(a, b, c) __builtin_amdgcn_mfma_f32_16x16x32_bf16((a), (b), (c), 0, 0, 0)

constexpr int D = 1024, MP = 16384, MS = 512, M = MP + MS, SEQ = 2048, INW = 1280, FF = 2816, NG = 32;
constexpr float EPS = 1e-6f;
constexpr size_t O_PRE = 17301504, O_PIM = 17317888, O_PK = 17334272, O_PV = 17465344, O_PCONV = 17596416,
                 O_SRE = 17641472, O_SIM = 17674240, O_SK = 17707008, O_SV = 17772544, O_SCONV = 17838080;
constexpr size_t WS_WIN = 0, WS_WGLU = WS_WIN + (size_t)INW * D * 2, WS_WO = WS_WGLU + 512 * 512 * 2, WS_W1 = WS_WO + (size_t)D * D * 2,
                 WS_W2 = WS_W1 + (size_t)2 * FF * D * 2, WS_KT = WS_W2 + (size_t)D * FF * 2, WS_WT = WS_KT + (size_t)NG * 32 * 256 * 2,
                 WS_PRE = WS_WT + (size_t)NG * 128 * 512 * 2, WS_PIM = WS_PRE + (size_t)NG * 4096 * 4, WS_A32 = WS_PIM + (size_t)NG * 32 * 64 * 4,
                 WS_CT = WS_A32 + (size_t)NG * 64 * 2 * 4, WS_SSQ = WS_CT + (size_t)NG * 16 * 128 * 2, WS_MIX = WS_SSQ + (size_t)M * 16 * 4,
                 WS_X1B = WS_MIX + (size_t)M * D * 2, WS_H = WS_X1B + (size_t)M * D * 2, WS_X1F = WS_H + (size_t)M * FF * 2, WS_PART = WS_X1F + (size_t)M * D * 4, WS_PARTS = WS_PART + (size_t)64 * 4 * 256 * 4, WS_CTL = WS_PARTS + (size_t)256 * 32 * 4, WS_END = WS_CTL + 16384;
constexpr size_t WS_XN = WS_H, WS_U = WS_XN + (size_t)M * D * 2, WS_Q = WS_U + (size_t)M * 512 * 2, WS_KB = WS_Q + (size_t)M * 512 * 2,
                 WS_VT = WS_KB + (size_t)M * 128 * 2, WS_KS = WS_VT + (size_t)MP * 128 * 2, WS_VTS = WS_KS + (size_t)16 * 160 * 128 * 2,
                 WS_HIN = WS_VTS + (size_t)16 * 160 * 128 * 2, WS_UF = WS_HIN + (size_t)512 * NG * 128 * 4, WS_ALIAS_END = WS_UF + (size_t)M * 512 * 2;
static_assert(WS_ALIAS_END <= WS_END && WS_END <= 268435456, "d_ws map");
constexpr int LDS_BYTES = 163840, LDS_X = 131072;

DI unsigned f2bf(float f) { unsigned u = __builtin_bit_cast(unsigned, f); return (u + 0x7fffu + ((u >> 16) & 1u)) >> 16; }
typedef float f32x2_t __attribute__((ext_vector_type(2)));
typedef __bf16 bf16x2_t __attribute__((ext_vector_type(2)));
DI unsigned pk2(float lo, float hi) { f32x2_t v = {lo, hi}; bf16x2_t b = __builtin_convertvector(v, bf16x2_t); return __builtin_bit_cast(unsigned, b); }
DI float bflo(unsigned w) { return __builtin_bit_cast(float, w << 16); }
DI float bfhi(unsigned w) { return __builtin_bit_cast(float, w & 0xffff0000u); }
DI u32x4 pack8(const f32x4& a, const f32x4& b) { u32x4 w; w.x = pk2(a[0], a[1]); w.y = pk2(a[2], a[3]); w.z = pk2(b[0], b[1]); w.w = pk2(b[2], b[3]); return w; }
DI float dot2bf(unsigned a, unsigned b, float c) { return __builtin_amdgcn_fdot2_f32_bf16(__builtin_bit_cast(bf16x2_t, a), __builtin_bit_cast(bf16x2_t, b), c, false); }
DI float sigm(float x) { return __builtin_amdgcn_rcpf(1.0f + __expf(-x)); }
DI float gelu_tanh(float x) { const float z = 0.7978845608f * (x + 0.044715f * x * x * x); return x * sigm(2.0f * z); }
template <int CTRL> DI float dpp_shr(float v) { return __builtin_bit_cast(float, __builtin_amdgcn_update_dpp(0, __builtin_bit_cast(int, v), CTRL, 0xF, 0xF, false)); }
#define GAS __attribute__((address_space(1)))
DI void st_agent(float* p, float v) { __hip_atomic_store((GAS unsigned*)p, __builtin_bit_cast(unsigned, v), __ATOMIC_RELAXED, __HIP_MEMORY_SCOPE_AGENT); }
DI float ld_agent(const float* p) { return __builtin_bit_cast(float, __hip_atomic_load((GAS unsigned*)p, __ATOMIC_RELAXED, __HIP_MEMORY_SCOPE_AGENT)); }
DI void arrive_and_wait(unsigned* cnt, unsigned target) {
    (void)__hip_atomic_fetch_add((GAS unsigned*)cnt, 1u, __ATOMIC_RELAXED, __HIP_MEMORY_SCOPE_AGENT);
    while (__hip_atomic_load((GAS unsigned*)cnt, __ATOMIC_RELAXED, __HIP_MEMORY_SCOPE_AGENT) < target) __builtin_amdgcn_s_sleep(1);
}
DI void wait_ge16(const unsigned* c) { while (__hip_atomic_load((GAS unsigned*)c, __ATOMIC_RELAXED, __HIP_MEMORY_SCOPE_AGENT) < 16u) __builtin_amdgcn_s_sleep(1); }
DI float xsum4(float v) { v += __shfl_xor(v, 16); v += __shfl_xor(v, 32); return v; }

struct Args { const float* in[30]; float* out; unsigned char* ws; int ph_lo, ph_hi; };

struct Frame {
    LAS unsigned char* lds; int tid, lane, wave, G, bid;
    const float* const* in; float* out; unsigned char* ws;
};
#define WSP(T, off) ((T*)(F.ws + (off)))

DI void p0_transpose(const float* __restrict__ W, int N, const float* __restrict__ gk, bf16_t* __restrict__ WT, int ldt, int k0, int n0, int dst0, LAS float* scr, int tid) {
    const int c = tid & 63, r0 = tid >> 6;
    float v[16];
#pragma unroll
    for (int i = 0; i < 16; ++i) { const int r = r0 + 8 * i; v[i] = W[(size_t)(k0 + r) * N + n0 + c]; }
#pragma unroll
    for (int i = 0; i < 16; ++i) { const int r = r0 + 8 * i; float x = v[i]; if (gk) x *= gk[k0 + r]; scr[r * 65 + c] = x; }
    __syncthreads();
#pragma unroll
    for (int i = 0; i < 8; ++i) { const int n = r0 + 8 * i; bf16_t* o = WT + (size_t)(dst0 + n) * ldt + k0 + c;
        o[0] = (bf16_t)f2bf(scr[c * 65 + n]); o[64] = (bf16_t)f2bf(scr[(64 + c) * 65 + n]); }
    __syncthreads();
}

DI void p0_ssm_tables(const Frame& F, int task) {
    const int tid = F.tid, g = task >> 2, part = task & 3;
    LAS float* pwr = (LAS float*)F.lds; LAS float* pwi = pwr + 33 * 64; LAS float* bbr = pwi + 33 * 64; LAS float* bbi = bbr + 1024;
    const float* a_re = F.in[9] + g * 64; const float* a_im = F.in[10] + g * 64;
    const float dt = expf(F.in[11][g]);
    for (int i = tid; i < 33 * 64; i += 512) {
        const int d = i >> 6, n = i & 63; const float fd = (float)d;
        const float mag = expf(a_re[n] * dt * fd), ang = a_im[n] * dt * fd;
        pwr[i] = mag * cosf(ang); pwi[i] = mag * sinf(ang);
    }
    __syncthreads();
    for (int i = tid; i < 1024; i += 512) {
        const int n = i >> 4;
        const float are = a_re[n], aim = a_im[n], nr = pwr[64 + n] - 1.0f, ni = pwi[64 + n], den = are * are + aim * aim;
        const float cr = (nr * are + ni * aim) / den, ci = (ni * are - nr * aim) / den;
        const float br = F.in[12][(size_t)g * 1024 + i], bi = F.in[13][(size_t)g * 1024 + i];
        bbr[i] = cr * br - ci * bi; bbi[i] = cr * bi + ci * br;
    }
    __syncthreads();
    if (part == 0) {
        const int d = tid >> 4, p = tid & 15;
        float acc[16];
#pragma unroll
        for (int q = 0; q < 16; ++q) acc[q] = 0.f;
        const float* cre = F.in[14] + (size_t)(g * 16 + p) * 64; const float* cim = F.in[15] + (size_t)(g * 16 + p) * 64;
        for (int n = 0; n < 64; ++n) {
            const float cr = cre[n], ci = cim[n], pr = pwr[d * 64 + n], pi = pwi[d * 64 + n];
            const float xr = cr * pr - ci * pi, xi = cr * pi + ci * pr;
#pragma unroll
            for (int q = 0; q < 16; ++q) acc[q] += xr * bbr[n * 16 + q] - xi * bbi[n * 16 + q];
        }
        const float dv = (d == 0) ? F.in[16][g * 16 + p] : 0.f;
        u32x4 w0, w1;
#pragma unroll
        for (int q = 0; q < 16; ++q) acc[q] += (q == p) ? dv : 0.f;
        w0.x = pk2(acc[0], acc[1]); w0.y = pk2(acc[2], acc[3]); w0.z = pk2(acc[4], acc[5]); w0.w = pk2(acc[6], acc[7]);
        w1.x = pk2(acc[8], acc[9]); w1.y = pk2(acc[10], acc[11]); w1.z = pk2(acc[12], acc[13]); w1.w = pk2(acc[14], acc[15]);
        bf16_t* dst = WSP(bf16_t, WS_KT) + ((size_t)(g * 16 + (d >> 1)) * 64 + (d & 1) * 32 + p) * 8;
        *(u32x4*)dst = w0; *(u32x4*)(dst + 128) = w1;
    }
    if (part == 1 || part == 2) {
        bf16_t* wt = WSP(bf16_t, WS_WT) + (size_t)g * 65536;
        for (int idx = (part - 1) * 32768 + tid; idx < part * 32768; idx += 512) {
            const int j = idx & 7, lane = (idx >> 3) & 63, kk = (idx >> 9) & 15, nb = idx >> 13;
            const int n2 = nb * 16 + (lane & 15), n = n2 & 63, sidx = 2 * kk + (lane >> 5), pp = ((lane >> 4) & 1) * 8 + j;
            const float pr = pwr[(31 - sidx) * 64 + n], pi = pwi[(31 - sidx) * 64 + n], br = bbr[n * 16 + pp], bi = bbi[n * 16 + pp];
            wt[idx] = (bf16_t)f2bf(n2 < 64 ? pr * br - pi * bi : pr * bi + pi * br);
        }
    }
    if (part == 3) {
    for (int i = tid; i < 4096; i += 512) {
        const int e = i & 3, lane = (i >> 2) & 63, half = (i >> 8) & 1, reim = (i >> 9) & 1, nh = (i >> 10) & 1, mt = i >> 11;
        const int t = mt * 16 + (lane & 15), n = nh * 32 + (lane >> 4) * 8 + half * 4 + e;
        WSP(float, WS_PRE)[(size_t)g * 4096 + i] = reim ? pwi[(t + 1) * 64 + n] : pwr[(t + 1) * 64 + n];
    }
    if (tid < 64) { WSP(float, WS_A32)[(g * 64 + tid) * 2] = pwr[32 * 64 + tid]; WSP(float, WS_A32)[(g * 64 + tid) * 2 + 1] = pwi[32 * 64 + tid]; }
    for (int i = tid; i < 2048; i += 512) {
        const int j = i & 7, lane = (i >> 3) & 63, kk2 = i >> 9, p = lane & 15, n2 = kk2 * 32 + (lane >> 4) * 8 + j;
        const float v = n2 < 64 ? F.in[14][(size_t)(g * 16 + p) * 64 + n2] : -F.in[15][(size_t)(g * 16 + p) * 64 + n2 - 64];
        WSP(bf16_t, WS_CT)[(size_t)g * 2048 + i] = (bf16_t)f2bf(v);
    }
    }
    __syncthreads();
}

DI void p0_prologue(const Frame& F) {
    constexpr int T_SSM = 128, T_WIN = 8 * 20, T_WGLU = 64, T_WO = 128, T_WA = 8 * 44, T_WD = 22 * 16, T_XN = M / 16, T_CK = 64, T_CV = 64;
    LAS float* scr = (LAS float*)F.lds;
    const int G = F.G;
    int r = F.bid;
#define P0_LOOP(COUNT) for (int i = r; i < (COUNT); i += G)
#define P0_NEXT(COUNT) r = (r + G - (COUNT) % G) % G
    P0_LOOP(T_XN) {
        const int row = i * 16 + F.wave * 2;
        const float* xr = row < MP ? F.in[0] + (size_t)row * D : F.in[1] + (size_t)(row - MP) * D;
        f32x4 v[2][4]; float q0 = 0.f, q1 = 0.f;
#pragma unroll
        for (int k = 0; k < 4; ++k) { v[0][k] = *(const f32x4*)(xr + k * 256 + F.lane * 4); v[1][k] = *(const f32x4*)(xr + D + k * 256 + F.lane * 4); }
#pragma unroll
        for (int k = 0; k < 4; ++k) { q0 += v[0][k][0] * v[0][k][0] + v[0][k][1] * v[0][k][1] + v[0][k][2] * v[0][k][2] + v[0][k][3] * v[0][k][3];
                                      q1 += v[1][k][0] * v[1][k][0] + v[1][k][1] * v[1][k][1] + v[1][k][2] * v[1][k][2] + v[1][k][3] * v[1][k][3]; }
#pragma unroll
        for (int o = 1; o < 64; o <<= 1) { q0 += __shfl_xor(q0, o); q1 += __shfl_xor(q1, o); }
        const float rr0 = rsqrtf(q0 * (1.0f / D) + EPS), rr1 = rsqrtf(q1 * (1.0f / D) + EPS);
        bf16_t* dst = WSP(bf16_t, WS_XN) + (size_t)row * D;
#pragma unroll
        for (int k = 0; k < 4; ++k) { const f32x4 g = *(const f32x4*)(F.in[7] + k * 256 + F.lane * 4);
            u32x2 w; w.x = pk2(v[0][k][0] * rr0 * g[0], v[0][k][1] * rr0 * g[1]); w.y = pk2(v[0][k][2] * rr0 * g[2], v[0][k][3] * rr0 * g[3]); *(u32x2*)(dst + k * 256 + F.lane * 4) = w;
            w.x = pk2(v[1][k][0] * rr1 * g[0], v[1][k][1] * rr1 * g[1]); w.y = pk2(v[1][k][2] * rr1 * g[2], v[1][k][3] * rr1 * g[3]); *(u32x2*)(dst + D + k * 256 + F.lane * 4) = w; }
    }
    P0_NEXT(T_XN);
    P0_LOOP(T_WIN) p0_transpose(F.in[8], INW, nullptr, WSP(bf16_t, WS_WIN), D, (i % 8) * 128, (i / 8) * 64, (i / 8) * 64, scr, F.tid);
    P0_NEXT(T_WIN);
#undef P0_LOOP
#undef P0_NEXT
}

DI void p1_tail(const Frame& F) {
    constexpr int T_SSM = 128, T_WGLU = 64, T_CK = 64, T_CV = 64;
    const int nbusy = (M / 256) * (INW / 256) - F.G;
    if (nbusy < 0 || nbusy >= F.G || F.bid < nbusy) return;
    const int G = F.G - nbusy;
    int r = F.bid - nbusy;
#define P0_LOOP(COUNT) for (int i = r; i < (COUNT); i += G)
#define P0_NEXT(COUNT) r = (r + G - (COUNT) % G) % G
    P0_LOOP(T_SSM) p0_ssm_tables(F, i);
    P0_NEXT(T_SSM);
    P0_LOOP(T_WGLU) {
        const int ch = i * 512 + F.tid, lane = ch & 63, kk = (ch >> 6) & 15, ntg = ch >> 10;
        const float* src = F.in[17] + (size_t)(kk * 32 + (lane >> 4) * 8) * 512 + ntg * 16 + (lane & 15);
        f32x4 a, b;
#pragma unroll
        for (int j = 0; j < 4; ++j) { a[j] = src[(size_t)j * 512]; b[j] = src[(size_t)(j + 4) * 512]; }
        *(u32x4*)(WSP(bf16_t, WS_WGLU) + (size_t)ch * 8) = pack8(a, b);
    }
    P0_NEXT(T_WGLU);
    P0_LOOP(T_CK) {
        const int ch = i * 512 + F.tid, lane = ch & 63, kk = (ch >> 6) & 1, kb = (ch >> 7) & 7, kvh = (ch >> 10) & 1, sb = ch >> 11;
        const float* src = F.in[4] + (((size_t)sb * 128 + kb * 16 + (lane & 15)) * 2 + kvh) * 64 + kk * 32 + (lane >> 4) * 8;
        *(u32x4*)(WSP(bf16_t, WS_KS) + (((size_t)(sb * 2 + kvh) * 10 + kb) * 2 + kk) * 512 + lane * 8) = pack8(*(const f32x4*)src, *(const f32x4*)(src + 4));
    }
    P0_NEXT(T_CK);
    P0_LOOP(T_CV) {
        const int ch = i * 512 + F.tid, lane = ch & 63, db = (ch >> 6) & 3, kb = (ch >> 8) & 3, kvh = (ch >> 10) & 1, sb = ch >> 11;
        const float* src = F.in[5] + (((size_t)sb * 128 + kb * 32 + (lane >> 4) * 4) * 2 + kvh) * 64 + db * 16 + (lane & 15);
        f32x4 a, b;
#pragma unroll
        for (int j = 0; j < 4; ++j) { a[j] = src[(size_t)j * 128]; b[j] = src[(size_t)(16 + j) * 128]; }
        *(u32x4*)(WSP(bf16_t, WS_VTS) + (((size_t)(sb * 2 + kvh) * 5 + kb) * 4 + db) * 512 + lane * 8) = pack8(a, b);
    }
#undef P0_LOOP
#undef P0_NEXT
}

struct EpiIn {
    static constexpr bool PERM = true, AFTER_DRAIN = false;
    unsigned char* ws; float* out;
    DI void operator()(const f32x4 (&acc)[2][2][4][2], const pg8::Unit& u, int wr, int wc, int fr, int fq) const {
        bf16_t* const U = (bf16_t*)(ws + WS_U); bf16_t* const Q = (bf16_t*)(ws + WS_Q); bf16_t* const KB = (bf16_t*)(ws + WS_KB); bf16_t* const VT = (bf16_t*)(ws + WS_VT);
        bf16_t* const KS = (bf16_t*)(ws + WS_KS); bf16_t* const VTS = (bf16_t*)(ws + WS_VTS); bf16_t* const UF = (bf16_t*)(ws + WS_UF);
        const int row0 = u.pm * 256 + wr * 64 + fr;
        if (u.pn < 2) {
            const int colt = u.pn * 256 + wc * 32 + 8 * fq;
#pragma unroll
            for (int ai = 0; ai < 2; ++ai)
#pragma unroll
                for (int m = 0; m < 4; ++m) { const int row = row0 + ai * 128 + m * 16; bf16_t* rp = U + (size_t)row * 512 + colt;
                    const int tq = row < MP ? (row & 2047) : ((row - MP) & 31), sq = tq & 31, chunk = row < MP ? (tq >> 5) : ((row - MP) >> 5);
#pragma unroll
                    for (int bj = 0; bj < 2; ++bj) { const u32x4 w = pack8(acc[ai][bj][m][0], acc[ai][bj][m][1]); *(u32x4*)(rp + bj * 128) = w;
                        const int c0 = colt + bj * 128, g = c0 >> 4, lf = (((sq & 1) * 2 + ((c0 >> 3) & 1)) * 16 + (chunk & 15)) * 8;
                        bf16_t* uf = row < MP ? UF + ((((size_t)((row >> 11) * 32 + g) * 16 + (sq >> 1)) * 4 + (chunk >> 4)) * 64) * 8 + lf
                                              : UF + (size_t)MP * 512 + ((size_t)(g * 16 + (sq >> 1)) * 64) * 8 + lf;
                        *(u32x4*)uf = w; } }
        } else if (u.pn < 4) {
#pragma unroll
            for (int ai = 0; ai < 2; ++ai)
#pragma unroll
                for (int m = 0; m < 4; ++m) { const int rb = (u.pm * 256 + wr * 64 + ai * 128 + m * 16) >> 4;
#pragma unroll
                    for (int bj = 0; bj < 2; ++bj) { const int c0 = (u.pn - 2) * 256 + bj * 128 + wc * 32, h = c0 >> 6, kk = (c0 >> 5) & 1;
                        *(u32x4*)(Q + (((size_t)h * (M / 16) + rb) * 2 + kk) * 512 + (fq * 16 + fr) * 8) = pack8(acc[ai][bj][m][0] * 0.125f, acc[ai][bj][m][1] * 0.125f); } }
        } else {
            const int c = wc * 32 + 8 * fq, kvh = wc >> 1, kk = wc & 1, db = (c >> 4) & 3, fr0 = c & 15;
#pragma unroll
            for (int ai = 0; ai < 2; ++ai)
#pragma unroll
                for (int m = 0; m < 4; ++m) {
                    const int row = row0 + ai * 128 + m * 16;
                    const f32x4 k0 = acc[ai][0][m][0], k1 = acc[ai][0][m][1], v0 = acc[ai][1][m][0], v1 = acc[ai][1][m][1];
                    if (row < MP) {
                        const int b = row >> 11, t = row & 2047;
                        *(u32x4*)(KB + (((size_t)kvh * (M / 16) + (row >> 4)) * 2 + kk) * 512 + (fq * 16 + fr) * 8) = pack8(k0, k1);
                        const int w = t & 31; bf16_t* vt = VT + ((((size_t)(b * 2 + kvh) * 64 + (t >> 5)) * 4 + db) * 64 + ((w & 15) >> 2) * 16 + fr0) * 8 + (w & 3) + 4 * (w >> 4);
#pragma unroll
                        for (int j = 0; j < 4; ++j) { vt[j * 8] = (bf16_t)f2bf(v0[j]); vt[(j + 4) * 8] = (bf16_t)f2bf(v1[j]); }
                        if (t >= 1920) { float* pk = out + O_PK + ((size_t)b * 128 + (t - 1920)) * 128 + c; *(f32x4*)pk = k0; *(f32x4*)(pk + 4) = k1;
                                         float* pv = out + O_PV + ((size_t)b * 128 + (t - 1920)) * 128 + c; *(f32x4*)pv = v0; *(f32x4*)(pv + 4) = v1; }
                    } else {
                        const int sb = (row - MP) >> 5, st = (row - MP) & 31, key = 128 + st;
                        *(u32x4*)(KS + ((((size_t)(sb * 2 + kvh) * 10 + (key >> 4)) * 2 + kk) * 64 + fq * 16 + (key & 15)) * 8) = pack8(k0, k1);
                        const int w = key & 31; bf16_t* vt = VTS + ((((size_t)(sb * 2 + kvh) * 5 + (key >> 5)) * 4 + db) * 64 + ((w & 15) >> 2) * 16 + fr0) * 8 + (w & 3) + 4 * (w >> 4);
#pragma unroll
                        for (int j = 0; j < 4; ++j) { vt[j * 8] = (bf16_t)f2bf(v0[j]); vt[(j + 4) * 8] = (bf16_t)f2bf(v1[j]); }
                        float* pk = out + O_SK + ((size_t)sb * 32 + st) * 128 + c; *(f32x4*)pk = k0; *(f32x4*)(pk + 4) = k1;
                        float* pv = out + O_SV + ((size_t)sb * 32 + st) * 128 + c; *(f32x4*)pv = v0; *(f32x4*)(pv + 4) = v1;
                    }
                }
        }
    }
};

constexpr int LDO = 520;
DI void attn_task(const bf16_t* __restrict__ Qp, int nqb, const bf16_t* __restrict__ Kp, int nkb, const bf16_t* __restrict__ Vtp, int vstride,
                  float sink, const float* __restrict__ gat, bf16_t* __restrict__ outp, LAS float* ob, int h, int wave, int lane) {
    const int fr = lane & 15, fq = lane >> 4;
#pragma unroll 1
    for (int qb = 0; qb < nqb; ++qb) {
        const bf16_t* qrow = Qp + (size_t)qb * 1024 + lane * 8;
        const bf16x8 q0 = *(const bf16x8*)qrow, q1 = *(const bf16x8*)(qrow + 512);
        f32x4 s[12];
#pragma unroll
        for (int kb = 0; kb < 12; ++kb) {
            s[kb] = (f32x4){-INFINITY, -INFINITY, -INFINITY, -INFINITY};
            if (kb < nkb) {
                const bf16_t* krow = Kp + (size_t)kb * 1024 + lane * 8;
                const bf16x8 k0 = *(const bf16x8*)krow, k1 = *(const bf16x8*)(krow + 512);
                f32x4 z = (f32x4){0.f, 0.f, 0.f, 0.f};
                z = MFMA16(k0, q0, z); z = MFMA16(k1, q1, z); s[kb] = z;
            }
        }
        float m = sink;
#pragma unroll
        for (int kb = 0; kb < 12; ++kb) m = fmaxf(fmaxf(m, fmaxf(s[kb][0], s[kb][1])), fmaxf(s[kb][2], s[kb][3]));
        m = fmaxf(m, __shfl_xor(m, 16)); m = fmaxf(m, __shfl_xor(m, 32));
        float sum = 0.f;
#pragma unroll
        for (int kb = 0; kb < 12; ++kb)
#pragma unroll
            for (int e = 0; e < 4; ++e) { const float p = __expf(s[kb][e] - m); s[kb][e] = p; sum += p; }
        sum = xsum4(sum);
        const float inv = 1.0f / (sum + __expf(sink - m));
        f32x4 o[4];
#pragma unroll
        for (int db = 0; db < 4; ++db) o[db] = (f32x4){0.f, 0.f, 0.f, 0.f};
#pragma unroll
        for (int ks = 0; ks < 6; ++ks) {
            if (2 * ks < nkb) {
                const bf16x8 pb = __builtin_bit_cast(bf16x8, pack8(s[2 * ks], s[2 * ks + 1]));
#pragma unroll
                for (int db = 0; db < 4; ++db) {
                    const bf16x8 vf = *(const bf16x8*)(Vtp + (size_t)(ks * 4 + db) * 512 + lane * 8);
                    o[db] = MFMA16(vf, pb, o[db]);
                }
                if (ks & 1) __builtin_amdgcn_sched_barrier(0);
            }
        }
#pragma unroll
        for (int db = 0; db < 4; ++db) *(LAS f32x4*)(ob + (qb * 16 + fr) * LDO + h * 64 + db * 16 + fq * 4) = o[db] * inv;
    }
    __syncthreads();
    const int rpw = nqb * 2;
    const f32x4 g0 = *(const f32x4*)(gat + lane * 8), g1 = *(const f32x4*)(gat + lane * 8 + 4);
#pragma unroll 1
    for (int i = 0; i < rpw; ++i) {
        const int r = wave * rpw + i;
        f32x4 v0 = *(const LAS f32x4*)(ob + r * LDO + lane * 8), v1 = *(const LAS f32x4*)(ob + r * LDO + lane * 8 + 4);
        float q = v0[0] * v0[0] + v0[1] * v0[1] + v0[2] * v0[2] + v0[3] * v0[3] + v1[0] * v1[0] + v1[1] * v1[1] + v1[2] * v1[2] + v1[3] * v1[3];
#pragma unroll
        for (int o2 = 1; o2 < 64; o2 <<= 1) q += __shfl_xor(q, o2);
        const float rs = rsqrtf(q * (1.0f / 512.0f) + EPS);
        *(u32x4*)(outp + (size_t)r * D + lane * 8) = pack8(v0 * rs * g0, v1 * rs * g1);
    }
    __syncthreads();
}

template <int MT, bool SAMPLE>
DI void ssm_state(const Frame& F, int b, int g) {
    const int lane = F.lane, fr = lane & 15, fq = lane >> 4;
    const bf16_t* Ub = WSP(bf16_t, WS_UF) + (SAMPLE ? (size_t)MP * 512 + (size_t)g * 16 * 512 : (size_t)(b * 32 + g) * 16 * 2048) + lane * 8;
    const bf16_t* Wg = WSP(bf16_t, WS_WT) + (size_t)g * 65536 + lane * 8;
    const float* A32 = WSP(float, WS_A32) + g * 128;
    float* HIN = WSP(float, WS_HIN);
#pragma unroll 1
    for (int h2 = 0; h2 < 2; ++h2) {
        f32x4 acc[MT][4];
#pragma unroll
        for (int mt = 0; mt < MT; ++mt)
#pragma unroll
            for (int j = 0; j < 4; ++j) acc[mt][j] = (f32x4){0.f, 0.f, 0.f, 0.f};
#pragma unroll 2
        for (int kk = 0; kk < 16; ++kk) {
            bf16x8 a[MT], w[4];
#pragma unroll
            for (int mt = 0; mt < MT; ++mt) a[mt] = *(const bf16x8*)(Ub + (size_t)kk * (SAMPLE ? 512 : 2048) + mt * 512);
#pragma unroll
            for (int j = 0; j < 4; ++j) { const int nb = (j < 2) ? 2 * h2 + j : 4 + 2 * h2 + (j - 2); w[j] = *(const bf16x8*)(Wg + (size_t)(nb * 16 + kk) * 512); }
#pragma unroll
            for (int mt = 0; mt < MT; ++mt)
#pragma unroll
                for (int j = 0; j < 4; ++j) acc[mt][j] = MFMA16(a[mt], w[j], acc[mt][j]);
        }
#pragma unroll
        for (int i = 0; i < 2; ++i) {
            const int n = (2 * h2 + i) * 16 + fr;
            const float ar = A32[n * 2], ai = A32[n * 2 + 1];
            if constexpr (SAMPLE) {
#pragma unroll
                for (int e = 0; e < 4; ++e) {
                    const int sb = fq * 4 + e; const size_t idx = ((size_t)sb * 32 + g) * 64 + n;
                    const float hr = F.in[2][idx], hi = F.in[3][idx];
                    F.out[O_SRE + idx] = ar * hr - ai * hi + acc[0][i][e]; F.out[O_SIM + idx] = ar * hi + ai * hr + acc[0][2 + i][e];
                }
            } else {
            const float a2r = ar * ar - ai * ai, a2i = 2.f * ar * ai, a3r = a2r * ar - a2i * ai, a3i = a2r * ai + a2i * ar, a4r = a2r * a2r - a2i * a2i, a4i = 2.f * a2r * a2i;
            float h1r[MT], h1i[MT], h2r[MT], h2i[MT], h3r[MT], h3i[MT], er[MT], ei[MT], cr[MT], ci[MT];
#pragma unroll
            for (int mt = 0; mt < MT; ++mt) {
                const f32x4 sr = acc[mt][i], si = acc[mt][2 + i];
                h1r[mt] = sr[0]; h1i[mt] = si[0];
                h2r[mt] = ar * h1r[mt] - ai * h1i[mt] + sr[1]; h2i[mt] = ar * h1i[mt] + ai * h1r[mt] + si[1];
                h3r[mt] = ar * h2r[mt] - ai * h2i[mt] + sr[2]; h3i[mt] = ar * h2i[mt] + ai * h2r[mt] + si[2];
                er[mt] = ar * h3r[mt] - ai * h3i[mt] + sr[3]; ei[mt] = ar * h3i[mt] + ai * h3r[mt] + si[3];
                cr[mt] = 0.f; ci[mt] = 0.f;
            }
            float kr = 0.f, ki = 0.f;
#pragma unroll
            for (int gi = 0; gi < 4 * MT; ++gi) {
                const int mt = gi >> 2, src = (gi & 3) * 16 + fr;
                const float xr = __shfl(er[mt], src), xi = __shfl(ei[mt], src);
                if ((gi & 3) == fq) { cr[mt] = kr; ci[mt] = ki; }
                const float nr = a4r * kr - a4i * ki + xr, ni = a4r * ki + a4i * kr + xi; kr = nr; ki = ni;
            }
            if (fq == 0) { F.out[O_PRE + ((size_t)b * 32 + g) * 64 + n] = kr; F.out[O_PIM + ((size_t)b * 32 + g) * 64 + n] = ki; }
#pragma unroll
            for (int mt = 0; mt < MT; ++mt) {
                const int c0 = mt * 16 + fq * 4;
                float* hp = HIN + (((size_t)b * 64 + c0) * 32 + g) * 128 + n;
                const float kr0 = cr[mt], ki0 = ci[mt];
                hp[0] = kr0; hp[64] = ki0;
                hp[4096] = ar * kr0 - ai * ki0 + h1r[mt]; hp[4096 + 64] = ar * ki0 + ai * kr0 + h1i[mt];
                hp[8192] = a2r * kr0 - a2i * ki0 + h2r[mt]; hp[8192 + 64] = a2r * ki0 + a2i * kr0 + h2i[mt];
                hp[12288] = a3r * kr0 - a3i * ki0 + h3r[mt]; hp[12288 + 64] = a3r * ki0 + a3i * kr0 + h3i[mt];
            }
            }
        }
    }
}

DI void p23_phase(const Frame& F) {
    constexpr int T_SSM = 36, T_ATT = 272, T_P3 = 528;
    unsigned* hc = WSP(unsigned, WS_CTL) + 3584 + 224;
    LAS float* ob = (LAS float*)F.lds;
    for (int t = F.bid; t < T_SSM; t += F.G) {
        const int wt = t * 8 + F.wave;
        if (wt < 256) ssm_state<4, false>(F, wt >> 5, wt & 31); else ssm_state<1, true>(F, 0, wt - 256);
        asm volatile("s_waitcnt vmcnt(0)" ::: "memory");
        __syncthreads();
        if (F.tid == 0 && t < 32) {
            __builtin_amdgcn_fence(__ATOMIC_RELEASE, "agent");
            asm volatile("s_waitcnt vmcnt(0)" ::: "memory");
            (void)__hip_atomic_fetch_add((GAS unsigned*)(hc + (t >> 2)), 1u, __ATOMIC_RELAXED, __HIP_MEMORY_SCOPE_AGENT);
        }
    }
    const int t0 = (F.bid >= T_SSM % F.G) ? F.bid - T_SSM % F.G : F.bid + F.G - T_SSM % F.G;
    for (int a = t0; a < T_ATT; a += F.G) {
        const int h = F.wave, kvh = h >> 2;
        const float sink = F.in[19][h]; const float* gat = F.in[21];
        if (a < 256) {
            const int b = a >> 5, c = a & 31, c0 = c < 2 ? 0 : c - 2, row0 = b * SEQ + c * 64;
            attn_task(WSP(bf16_t, WS_Q) + ((size_t)h * (M / 16) + (row0 >> 4)) * 1024, 4, WSP(bf16_t, WS_KB) + ((size_t)kvh * (M / 16) + ((b * SEQ + c0 * 64) >> 4)) * 1024, (c - c0 + 1) * 4,
                      WSP(bf16_t, WS_VT) + ((size_t)(b * 2 + kvh) * 64 + c0 * 2) * 2048, 0, sink, gat, WSP(bf16_t, WS_MIX) + (size_t)row0 * D + 512, ob, h, F.wave, F.lane);
        } else {
            const int sb = a - 256, row0 = MP + sb * 32;
            attn_task(WSP(bf16_t, WS_Q) + ((size_t)h * (M / 16) + (row0 >> 4)) * 1024, 2, WSP(bf16_t, WS_KS) + (size_t)(sb * 2 + kvh) * 10 * 1024, 10,
                      WSP(bf16_t, WS_VTS) + (size_t)(sb * 2 + kvh) * 5 * 2048, 0, sink, gat, WSP(bf16_t, WS_MIX) + (size_t)row0 * D + 512, ob, h, F.wave, F.lane);
        }
    }
}
constexpr int P3_LDY = 520, P3_LDU = 72, P3_UST = 36864;
DI void p3_zero(const Frame& F) {
    LAS u32x4* z = (LAS u32x4*)(F.lds + P3_UST + F.wave * (64 * P3_LDU * 2));
    for (int i = F.lane; i < 32 * P3_LDU * 2 / 16; i += 64) z[i] = (u32x4){0u, 0u, 0u, 0u};
}
DI void p3_task(const Frame& F, int ci) {
    const int lane = F.lane, fr = lane & 15, fq = lane >> 4, wave = F.wave;
    const int row0 = ci < 512 ? (ci >> 6) * SEQ + (ci & 63) * 32 : MP + (ci - 512) * 32;
    constexpr int LDY = P3_LDY, LDU = P3_LDU;
    LAS bf16_t* y1 = (LAS bf16_t*)F.lds; LAS float* ssq = (LAS float*)(F.lds + 32 * LDY * 2);
    LAS bf16_t* ust = (LAS bf16_t*)(F.lds + P3_UST) + wave * (64 * LDU);
    {
        const bf16_t* up = WSP(bf16_t, WS_U) + (size_t)(row0 + (lane >> 3)) * 512 + wave * 64 + (lane & 7) * 8;
#pragma unroll
        for (int i = 0; i < 4; ++i) *(LAS u32x4*)(ust + (32 + (lane >> 3) + 8 * i) * LDU + (lane & 7) * 8) = *(const u32x4*)(up + (size_t)i * 8 * 512);
    }
#pragma unroll 1
    for (int gi = 0; gi < 4; ++gi) {
        const int g = wave * 4 + gi;
        f32x4 acc0 = (f32x4){0.f, 0.f, 0.f, 0.f}, acc1 = acc0;
        const bf16_t* Kg = WSP(bf16_t, WS_KT) + (size_t)g * 8192 + lane * 8;
        const LAS bf16_t* ub = ust + (32 + fr - (fq >> 1)) * LDU + gi * 16 + (fq & 1) * 8;
#pragma unroll
        for (int kk = 0; kk < 16; ++kk) {
            const bf16x8 kf = *(const bf16x8*)(Kg + kk * 512);
            acc1 = MFMA16(kf, *(const LAS bf16x8*)(ub + (16 - 2 * kk) * LDU), acc1);
            if (kk < 8) acc0 = MFMA16(kf, *(const LAS bf16x8*)(ub - 2 * kk * LDU), acc0);
        }
        const float* hre; const float* him;
        if (ci < 512) { hre = WSP(float, WS_HIN) + ((size_t)ci * 32 + g) * 128; him = hre + 64; }
        else { hre = F.in[2] + ((size_t)(ci - 512) * 32 + g) * 64; him = F.in[3] + ((size_t)(ci - 512) * 32 + g) * 64; }
#pragma unroll
        for (int nh = 0; nh < 2; ++nh) {
            const int n0 = nh * 32 + fq * 8;
            const f32x4 hr0 = *(const f32x4*)(hre + n0), hr1 = *(const f32x4*)(hre + n0 + 4), hi0 = *(const f32x4*)(him + n0), hi1 = *(const f32x4*)(him + n0 + 4);
            const bf16_t* cp = WSP(bf16_t, WS_CT) + (size_t)g * 2048 + lane * 8;
            const bf16x8 cref = *(const bf16x8*)(cp + nh * 512), cimf = *(const bf16x8*)(cp + (2 + nh) * 512);
#pragma unroll
            for (int mt = 0; mt < 2; ++mt) {
                const float* pp = WSP(float, WS_PRE) + (size_t)g * 4096 + (mt * 2 + nh) * 1024 + lane * 4;
                const f32x4 pr0 = *(const f32x4*)pp, pr1 = *(const f32x4*)(pp + 256), pi0 = *(const f32x4*)(pp + 512), pi1 = *(const f32x4*)(pp + 768);
                const f32x4 gr0 = pr0 * hr0 - pi0 * hi0, gr1 = pr1 * hr1 - pi1 * hi1, gi0 = pr0 * hi0 + pi0 * hr0, gi1 = pr1 * hi1 + pi1 * hr1;
                const bf16x8 gre = __builtin_bit_cast(bf16x8, pack8(gr0, gr1)), gim = __builtin_bit_cast(bf16x8, pack8(gi0, gi1));
                if (mt == 0) { acc0 = MFMA16(cref, gre, acc0); acc0 = MFMA16(cimf, gim, acc0); }
                else         { acc1 = MFMA16(cref, gre, acc1); acc1 = MFMA16(cimf, gim, acc1); }
            }
        }
        {   u32x2 w; w.x = pk2(gelu_tanh(acc0[0]), gelu_tanh(acc0[1])); w.y = pk2(gelu_tanh(acc0[2]), gelu_tanh(acc0[3]));
            *(LAS u32x2*)(y1 + fr * LDY + g * 16 + fq * 4) = w;
            w.x = pk2(gelu_tanh(acc1[0]), gelu_tanh(acc1[1])); w.y = pk2(gelu_tanh(acc1[2]), gelu_tanh(acc1[3]));
            *(LAS u32x2*)(y1 + (16 + fr) * LDY + g * 16 + fq * 4) = w; }
    }
    __syncthreads();
    f32x4 a2[2][4];
#pragma unroll
    for (int mt = 0; mt < 2; ++mt)
#pragma unroll
        for (int nt = 0; nt < 4; ++nt) a2[mt][nt] = (f32x4){0.f, 0.f, 0.f, 0.f};
    const bf16_t* Wg = WSP(bf16_t, WS_WGLU) + (size_t)(wave * 4) * 8192 + lane * 8;
#pragma unroll 4
    for (int kk = 0; kk < 16; ++kk) {
        bf16x8 yf[2], wf[4];
#pragma unroll
        for (int mt = 0; mt < 2; ++mt) yf[mt] = *(const LAS bf16x8*)(y1 + (mt * 16 + fr) * LDY + kk * 32 + fq * 8);
#pragma unroll
        for (int nt = 0; nt < 4; ++nt) wf[nt] = *(const bf16x8*)(Wg + (size_t)nt * 8192 + kk * 512);
#pragma unroll
        for (int mt = 0; mt < 2; ++mt)
#pragma unroll
            for (int nt = 0; nt < 4; ++nt) a2[mt][nt] = MFMA16(wf[nt], yf[mt], a2[mt][nt]);
    }
    float q2[2] = {0.f, 0.f};
#pragma unroll
    for (int mt = 0; mt < 2; ++mt)
#pragma unroll
        for (int nt = 0; nt < 4; ++nt) {
            const int n = wave * 64 + nt * 16 + fq * 4;
            const f32x4 bias = *(const f32x4*)(F.in[18] + n);
            const u32x2 yw = *(const LAS u32x2*)(y1 + (mt * 16 + fr) * LDY + n);
            const float y0 = bflo(yw.x), y1v = bfhi(yw.x), y2v = bflo(yw.y), y3 = bfhi(yw.y);
            f32x4 r; r[0] = y0 * sigm(a2[mt][nt][0] + bias[0]); r[1] = y1v * sigm(a2[mt][nt][1] + bias[1]); r[2] = y2v * sigm(a2[mt][nt][2] + bias[2]); r[3] = y3 * sigm(a2[mt][nt][3] + bias[3]);
            a2[mt][nt] = r; q2[mt] += r[0] * r[0] + r[1] * r[1] + r[2] * r[2] + r[3] * r[3];
        }
    q2[0] = xsum4(q2[0]); q2[1] = xsum4(q2[1]);
    if (fq == 0) { ssq[wave * 32 + fr] = q2[0]; ssq[wave * 32 + 16 + fr] = q2[1]; }
    __syncthreads();
#pragma unroll
    for (int mt = 0; mt < 2; ++mt) {
        float tot = 0.f;
#pragma unroll
        for (int w = 0; w < 8; ++w) tot += ssq[w * 32 + mt * 16 + fr];
        const float rs = rsqrtf(tot * (1.0f / 512.0f) + EPS);
#pragma unroll
        for (int nt = 0; nt < 4; ++nt) {
            const int n = wave * 64 + nt * 16 + fq * 4;
            const f32x4 g = *(const f32x4*)(F.in[20] + n);
            u32x2 w; w.x = pk2(a2[mt][nt][0] * rs * g[0], a2[mt][nt][1] * rs * g[1]); w.y = pk2(a2[mt][nt][2] * rs * g[2], a2[mt][nt][3] * rs * g[3]);
            *(u32x2*)(WSP(bf16_t, WS_MIX) + (size_t)(row0 + mt * 16 + fr) * D + n) = w;
        }
    }
    __syncthreads();
}

DI void late_weights(const Frame& F) {
    constexpr int T_WO = 128, T_WA = 8 * 44, T_WD = 22 * 16;
    LAS float* scr = (LAS float*)F.lds;
    const int nskip = ((36 + 272 + 528) % F.G), G = F.G - nskip;
    if (F.bid < nskip || G <= 0) return;
    int r = F.bid - nskip;
#define P0_LOOP(COUNT) for (int i = r; i < (COUNT); i += G)
#define P0_NEXT(COUNT) r = (r + G - (COUNT) % G) % G
    P0_LOOP(T_WO) p0_transpose(F.in[22], D, nullptr, WSP(bf16_t, WS_WO), D, (i % 8) * 128, (i / 8) * 64, (i / 8) * 64, scr, F.tid);
    P0_NEXT(T_WO);
    P0_LOOP(T_WA) { const int n0 = (i / 8) * 64; p0_transpose(F.in[24], FF, F.in[23], WSP(bf16_t, WS_W1), D, (i % 8) * 128, n0, (n0 >> 7) * 256 + (n0 & 127), scr, F.tid); }
    P0_NEXT(T_WA);
    P0_LOOP(T_WA) { const int n0 = (i / 8) * 64; p0_transpose(F.in[25], FF, F.in[23], WSP(bf16_t, WS_W1), D, (i % 8) * 128, n0, (n0 >> 7) * 256 + 128 + (n0 & 127), scr, F.tid); }
    P0_NEXT(T_WA);
    P0_LOOP(T_WD) p0_transpose(F.in[28], D, nullptr, WSP(bf16_t, WS_W2), FF, (i % 22) * 128, (i / 22) * 64, (i / 22) * 64, scr, F.tid);
    P0_NEXT(T_WD);
#undef P0_LOOP
#undef P0_NEXT
}

DI void p3_loop(const Frame& F) {
    constexpr int T_PRE = 36 + 272, T_P3 = 528;
    unsigned* hc = WSP(unsigned, WS_CTL) + 3584 + 224;
    p3_zero(F);
    const int r0 = T_PRE % F.G, c0 = (F.bid >= r0) ? F.bid - r0 : F.bid + F.G - r0;
    for (int ci = c0; ci < T_P3; ci += F.G) {
        if (ci < 512) {
            if (F.tid == 0) {
                while (__hip_atomic_load((GAS unsigned*)(hc + (ci >> 6)), __ATOMIC_RELAXED, __HIP_MEMORY_SCOPE_AGENT) < 4u) __builtin_amdgcn_s_sleep(1);
                __builtin_amdgcn_fence(__ATOMIC_ACQUIRE, "agent");
                asm volatile("s_waitcnt vmcnt(0)" ::: "memory");
            }
            __syncthreads();
        }
        p3_task(F, ci);
    }
}

DI void panel_rs(float* part, unsigned* cnt, LAS float* lx, int pm, int pn, float* rs_out = nullptr) {
    const int tid = threadIdx.x;
    __syncthreads();
    if (tid < 256) st_agent(part + (size_t)(pm * 4 + pn) * 256 + tid, lx[tid] + lx[256 + tid] + lx[512 + tid] + lx[768 + tid]);
    asm volatile("s_waitcnt vmcnt(0)" ::: "memory");
    __syncthreads();
    if (tid == 0) arrive_and_wait(cnt + pm, 4u);
    __syncthreads();
    if (tid < 256) { const float* pp = part + (size_t)pm * 1024 + tid; const float r = rsqrtf((ld_agent(pp) + ld_agent(pp + 256) + ld_agent(pp + 512) + ld_agent(pp + 768)) * (1.0f / D) + EPS); lx[1024 + tid] = r;
        if (rs_out && pn == 0) rs_out[pm * 256 + tid] = r; }
    __syncthreads();
}
struct EpiOut {
    static constexpr bool PERM = true, AFTER_DRAIN = false;
    const float* xp; float* RS; bf16_t* X1B; float* part; unsigned* cnt; LAS float* lx;
    DI void operator()(const f32x4 (&acc_)[2][2][4][2], const pg8::Unit& u, int wr, int wc, int fr, int fq) const {
        f32x4 (&acc)[2][2][4][2] = const_cast<f32x4 (&)[2][2][4][2]>(acc_);
        const int row0 = u.pm * 256 + wr * 64 + fr, col0 = u.pn * 256 + wc * 32 + 8 * fq;
#pragma unroll
        for (int ai = 0; ai < 2; ++ai)
#pragma unroll
            for (int m = 0; m < 4; ++m) {
                const size_t ro = (size_t)(row0 + ai * 128 + m * 16) * D + col0;
                float q = 0.f;
#pragma unroll
                for (int bj = 0; bj < 2; ++bj) {
                    const f32x4 v0 = acc[ai][bj][m][0] + *(const f32x4*)(xp + ro + bj * 128), v1 = acc[ai][bj][m][1] + *(const f32x4*)(xp + ro + bj * 128 + 4);
                    acc[ai][bj][m][0] = v0; acc[ai][bj][m][1] = v1;
                    q += v0[0] * v0[0] + v0[1] * v0[1] + v0[2] * v0[2] + v0[3] * v0[3] + v1[0] * v1[0] + v1[1] * v1[1] + v1[2] * v1[2] + v1[3] * v1[3];
                }
                q = xsum4(q);
                if (fq == 0) lx[wc * 256 + ai * 128 + wr * 64 + m * 16 + fr] = q;
            }
        panel_rs(part, cnt, lx, u.pm, u.pn, RS);
#pragma unroll
        for (int ai = 0; ai < 2; ++ai)
#pragma unroll
            for (int m = 0; m < 4; ++m) {
                const float rs = lx[1024 + ai * 128 + wr * 64 + m * 16 + fr];
                const size_t ro = (size_t)(row0 + ai * 128 + m * 16) * D + col0;
#pragma unroll
                for (int bj = 0; bj < 2; ++bj) *(u32x4*)(X1B + ro + bj * 128) = pack8(acc[ai][bj][m][0] * rs, acc[ai][bj][m][1] * rs);
            }
    }
};

struct EpiFfn {
    static constexpr bool PERM = true, AFTER_DRAIN = false;
    unsigned char* ws; const float* const* in; float* out; LAS float* bnd;
    DI void operator()(const f32x4 (&acc)[2][2][4][2], const pg8::Unit& u, int wr, int wc, int fr, int fq) const {
        const bf16_t* const X1B = (const bf16_t*)(ws + WS_X1B); const bf16_t* const W1T = (const bf16_t*)(ws + WS_W1);
        bf16_t* const H = (bf16_t*)(ws + WS_H); const float* const cstate = in[6];
        const int pm = u.pm, pn = u.pn, rowt = pm * 256, wave = wr * 4 + wc, tid = threadIdx.x;
        const bool sample = pm >= 64;
        const int cl = wc * 32 + 8 * fq, ff = pn * 128 + cl;
        LAS float* cwl = bnd + 17 * 2 * 128;
        if (tid < 128) { const float* cw = in[26] + pn * 128 + tid; cwl[tid] = cw[0]; cwl[128 + tid] = cw[FF]; cwl[256 + tid] = cw[2 * FF]; cwl[384 + tid] = in[27][pn * 128 + tid]; }
#pragma unroll
        for (int ai = 0; ai < 2; ++ai)
#pragma unroll
            for (int m = 0; m < 4; ++m) {
                const int blk = 8 * ai + 4 * wr + m;
                if (fr >= 14) {
                    const f32x4 a0 = acc[ai][0][m][0], a1 = acc[ai][0][m][1];
                    if (!sample || (blk & 1) == 0) { LAS float* bp = bnd + ((blk + 1) * 2 + (fr - 14)) * 128 + cl; *(LAS f32x4*)bp = a0; *(LAS f32x4*)(bp + 4) = a1; }
                    if (sample && (blk & 1)) { float* sp = out + O_SCONV + ((size_t)((pm - 64) * 8 + (blk >> 1)) * 2 + (fr - 14)) * FF + ff; *(f32x4*)sp = a0; *(f32x4*)(sp + 4) = a1; }
                    if (!sample && (pm & 7) == 7 && blk == 15) { float* sp = out + O_PCONV + ((size_t)(pm >> 3) * 2 + (fr - 14)) * FF + ff; *(f32x4*)sp = a0; *(f32x4*)(sp + 4) = a1; }
                    if (sample && (blk & 1) == 0) {
                        const float* sp = cstate + ((size_t)((pm - 64) * 8 + (blk >> 1)) * 2 + (fr - 14)) * FF + ff;
                        LAS float* bp = bnd + (blk * 2 + (fr - 14)) * 128 + cl; *(LAS f32x4*)bp = *(const f32x4*)sp; *(LAS f32x4*)(bp + 4) = *(const f32x4*)(sp + 4);
                    }
                    if (!sample && (pm & 7) == 0 && blk == 0) { LAS float* bp = bnd + (fr - 14) * 128 + cl; *(LAS f32x4*)bp = (f32x4){0.f, 0.f, 0.f, 0.f}; *(LAS f32x4*)(bp + 4) = (f32x4){0.f, 0.f, 0.f, 0.f}; }
                }
            }
        if (!sample && (pm & 7) != 0) {
            const int lane = fq * 16 + fr;
            const bf16_t* xp = X1B + (size_t)(rowt - 2) * D + lane * 8;
            const u32x4 xa0 = *(const u32x4*)xp, xa1 = *(const u32x4*)(xp + 512), xb0 = *(const u32x4*)(xp + D), xb1 = *(const u32x4*)(xp + D + 512);
#pragma unroll 1
            for (int ps = 0; ps < 4; ++ps) {
                float p0[4], p1[4];
                const bf16_t* wp = W1T + (size_t)(pn * 256 + wave * 16 + ps * 4) * D + lane * 8;
#pragma unroll
                for (int c = 0; c < 4; ++c) {
                    const u32x4 a = *(const u32x4*)(wp + (size_t)c * D), b = *(const u32x4*)(wp + (size_t)c * D + 512);
                    float s0 = 0.f, s1 = 0.f;
#pragma unroll
                    for (int j = 0; j < 4; ++j) {
                        s0 = dot2bf(a[j], xa0[j], s0); s0 = dot2bf(b[j], xa1[j], s0);
                        s1 = dot2bf(a[j], xb0[j], s1); s1 = dot2bf(b[j], xb1[j], s1);
                    }
                    p0[c] = s0; p1[c] = s1;
                }
#define HALO_STEP(N, BIT) _Pragma("unroll") for (int c = 0; c < N; ++c) { const bool hi_ = (lane & BIT) != 0; \
                    const float s0_ = hi_ ? p0[c] : p0[c + N], s1_ = hi_ ? p1[c] : p1[c + N]; \
                    const float r0_ = __shfl_xor(s0_, BIT), r1_ = __shfl_xor(s1_, BIT); \
                    p0[c] = (hi_ ? p0[c + N] : p0[c]) + r0_; p1[c] = (hi_ ? p1[c + N] : p1[c]) + r1_; }
                HALO_STEP(2, 32) HALO_STEP(1, 16)
#undef HALO_STEP
                float t0 = p0[0], t1 = p1[0];
                t0 += __shfl_xor(t0, 8); t1 += __shfl_xor(t1, 8); t0 += __shfl_xor(t0, 4); t1 += __shfl_xor(t1, 4); t0 += __shfl_xor(t0, 2); t1 += __shfl_xor(t1, 2); t0 += __shfl_xor(t0, 1); t1 += __shfl_xor(t1, 1);
                if ((lane & 15) == 0) { const int col = wave * 16 + ps * 4 + ((lane >> 5) & 1) * 2 + ((lane >> 4) & 1);
                    bnd[col] = t0; bnd[128 + col] = t1; }
            }
        }
        __syncthreads();
#pragma unroll
        for (int ai = 0; ai < 2; ++ai)
#pragma unroll
            for (int m = 0; m < 4; ++m) {
                const int blk = 8 * ai + 4 * wr + m, row = rowt + ai * 128 + wr * 64 + m * 16 + fr;
                f32x4 hv[2];
#pragma unroll
                for (int n = 0; n < 2; ++n) {
                    const f32x4 cur = acc[ai][0][m][n], upv = acc[ai][1][m][n];
                    f32x4 p1, p2;
#pragma unroll
                    for (int e = 0; e < 4; ++e) { p1[e] = dpp_shr<0x111>(cur[e]); p2[e] = dpp_shr<0x112>(cur[e]); }
                    const f32x4 b0 = *(const LAS f32x4*)(bnd + (blk * 2 + 0) * 128 + cl + 4 * n), b1 = *(const LAS f32x4*)(bnd + (blk * 2 + 1) * 128 + cl + 4 * n);
                    if (fr == 0) { p1 = b1; p2 = b0; } else if (fr == 1) { p2 = b1; }
                    const LAS float* wl = cwl + cl + 4 * n;
                    const f32x4 c = *(const LAS f32x4*)(wl + 384) + *(const LAS f32x4*)wl * p2 + *(const LAS f32x4*)(wl + 128) * p1 + *(const LAS f32x4*)(wl + 256) * cur;
#pragma unroll
                    for (int e = 0; e < 4; ++e) hv[n][e] = c[e] * sigm(c[e]) * upv[e];
                }
                *(u32x4*)(H + (size_t)row * FF + ff) = pack8(hv[0], hv[1]);
            }
        __syncthreads();
    }
};

struct EpiDown {
    static constexpr bool PERM = true, AFTER_DRAIN = false;
    float* out; const bf16_t* X1B; const float* RS; const float* gfin; float* part; unsigned* cnt; LAS float* lx;
    DI void operator()(const f32x4 (&acc_)[2][2][4][2], const pg8::Unit& u, int wr, int wc, int fr, int fq) const {
        f32x4 (&acc)[2][2][4][2] = const_cast<f32x4 (&)[2][2][4][2]>(acc_);
        const int row0 = u.pm * 256 + wr * 64 + fr, col0 = u.pn * 256 + wc * 32 + 8 * fq;
#pragma unroll
        for (int ai = 0; ai < 2; ++ai)
#pragma unroll
            for (int m = 0; m < 4; ++m) {
                const int row = row0 + ai * 128 + m * 16;
                const bf16_t* xrow = X1B + (size_t)row * D + col0;
                const float ir = 1.0f / RS[row];
                float q = 0.f;
#pragma unroll
                for (int bj = 0; bj < 2; ++bj) {
                    const u32x4 xw = *(const u32x4*)(xrow + bj * 128);
                    const f32x4 x0 = (f32x4){bflo(xw.x), bfhi(xw.x), bflo(xw.y), bfhi(xw.y)}, x1v = (f32x4){bflo(xw.z), bfhi(xw.z), bflo(xw.w), bfhi(xw.w)};
                    const f32x4 v0 = acc[ai][bj][m][0] + x0 * ir, v1 = acc[ai][bj][m][1] + x1v * ir;
                    acc[ai][bj][m][0] = v0; acc[ai][bj][m][1] = v1;
                    q += v0[0] * v0[0] + v0[1] * v0[1] + v0[2] * v0[2] + v0[3] * v0[3] + v1[0] * v1[0] + v1[1] * v1[1] + v1[2] * v1[2] + v1[3] * v1[3];
                }
                q = xsum4(q);
                if (fq == 0) lx[wc * 256 + ai * 128 + wr * 64 + m * 16 + fr] = q;
            }
        panel_rs(part, cnt, lx, u.pm, u.pn);
        f32x4 gv[2][2];
#pragma unroll
        for (int bj = 0; bj < 2; ++bj) { gv[bj][0] = *(const f32x4*)(gfin + col0 + bj * 128); gv[bj][1] = *(const f32x4*)(gfin + col0 + bj * 128 + 4); }
#pragma unroll
        for (int ai = 0; ai < 2; ++ai)
#pragma unroll
            for (int m = 0; m < 4; ++m) {
                float* orow = out + (size_t)(row0 + ai * 128 + m * 16) * D + col0;
                const float rs = lx[1024 + ai * 128 + wr * 64 + m * 16 + fr];
#pragma unroll
                for (int bj = 0; bj < 2; ++bj) { *(f32x4*)(orow + bj * 128) = acc[ai][bj][m][0] * rs * gv[bj][0]; *(f32x4*)(orow + bj * 128 + 4) = acc[ai][bj][m][1] * rs * gv[bj][1]; }
            }
    }
};


template <int K> DI f32x4 mini_tile_ks(const Frame& F, const bf16_t* __restrict__ A, const bf16_t* __restrict__ Bt, int row0, int col0) {
    constexpr int KC = 256, LDT = 264, NCH = K / KC, LDR = 68;
    const int tid = F.tid, lane = F.lane, fr = lane & 15, fq = lane >> 4, mt = F.wave & 1, nt = F.wave >> 1;
    LAS bf16_t* tile = (LAS bf16_t*)F.lds;
    const bf16_t* src[6]; int dst[6];
#pragma unroll
    for (int j = 0; j < 6; ++j) { const int p = tid + 512 * j, r = p >> 5, c = (p & 31) * 8;
        src[j] = (r < 32 ? A + (size_t)(row0 + r) * K : Bt + (size_t)(col0 + r - 32) * K) + c; dst[j] = r * LDT + c; }
    u32x4 pre[6];
#pragma unroll
    for (int j = 0; j < 6; ++j) pre[j] = *(const u32x4*)src[j];
    f32x4 acc = (f32x4){0.f, 0.f, 0.f, 0.f};
#pragma unroll 1
    for (int ch = 0; ch < NCH; ++ch) {
#pragma unroll
        for (int j = 0; j < 6; ++j) *(LAS u32x4*)(tile + dst[j]) = pre[j];
        __syncthreads();
        if (ch + 1 < NCH) {
#pragma unroll
            for (int j = 0; j < 6; ++j) pre[j] = *(const u32x4*)(src[j] + (size_t)(ch + 1) * KC);
        }
        const LAS bf16_t* xa = tile + (mt * 16 + fr) * LDT + fq * 8;
        const LAS bf16_t* wb = tile + (32 + nt * 16 + fr) * LDT + fq * 8;
#pragma unroll
        for (int ks = 0; ks < KC / 32; ++ks) acc = MFMA16(*(const LAS bf16x8*)(wb + ks * 32), *(const LAS bf16x8*)(xa + ks * 32), acc);
        __syncthreads();
    }
    LAS float* red = (LAS float*)F.lds;
    *(LAS f32x4*)(red + (mt * 16 + fr) * LDR + nt * 16 + fq * 4) = acc;
    __syncthreads();
    const f32x4 out = *(const LAS f32x4*)(red + (tid >> 4) * LDR + (tid & 15) * 4);
    __syncthreads();
    return out;
}
constexpr int MINI_PARK = LDS_X + 8192;
DI void p4_sample_a(const Frame& F) {
    if (F.bid >= 256) return;
    float* PS = WSP(float, WS_PARTS); unsigned* cnt = WSP(unsigned, WS_CTL) + 3584 + 192;
    const int t = F.bid, rg = t & 15, cg = t >> 4, rl = F.tid >> 4, row = MP + rg * 32 + rl, n0 = cg * 64 + (F.tid & 15) * 4;
    const f32x4 acc = mini_tile_ks<D>(F, WSP(bf16_t, WS_MIX), WSP(bf16_t, WS_WO), MP + rg * 32, cg * 64);
    const f32x4 v = acc + *(const f32x4*)(F.in[1] + (size_t)(row - MP) * D + n0);
    float q = v[0] * v[0] + v[1] * v[1] + v[2] * v[2] + v[3] * v[3];
    q += __shfl_xor(q, 1); q += __shfl_xor(q, 2); q += __shfl_xor(q, 4); q += __shfl_xor(q, 8);
    if ((F.tid & 15) == 0) st_agent(PS + (size_t)(rg * 16 + cg) * 32 + rl, q);
    *(LAS f32x4*)(F.lds + MINI_PARK + F.tid * 16) = v;
    asm volatile("s_waitcnt vmcnt(0)" ::: "memory");
    __syncthreads();
    if (F.tid == 0) (void)__hip_atomic_fetch_add((GAS unsigned*)(cnt + rg), 1u, __ATOMIC_RELAXED, __HIP_MEMORY_SCOPE_AGENT);
}
DI void p4_sample_b(const Frame& F) {
    if (F.bid >= 256) return;
    float* PS = WSP(float, WS_PARTS); unsigned* cnt = WSP(unsigned, WS_CTL) + 3584 + 192;
    const int t = F.bid, rg = t & 15, cg = t >> 4, rl = F.tid >> 4, row = MP + rg * 32 + rl, n0 = cg * 64 + (F.tid & 15) * 4;
    if (F.tid == 0) wait_ge16(cnt + rg);
    __syncthreads();
    float tot = 0.f;
#pragma unroll
    for (int c = 0; c < 16; ++c) tot += ld_agent(PS + (size_t)(rg * 16 + c) * 32 + rl);
    const float rs = rsqrtf(tot * (1.0f / D) + EPS);
    const f32x4 v = *(const LAS f32x4*)(F.lds + MINI_PARK + F.tid * 16);
    *(f32x4*)(WSP(float, WS_X1F) + (size_t)row * D + n0) = v;
    u32x2 w; w.x = pk2(v[0] * rs, v[1] * rs); w.y = pk2(v[2] * rs, v[3] * rs); *(u32x2*)(WSP(bf16_t, WS_X1B) + (size_t)row * D + n0) = w;
}
DI void p6_sample_a(const Frame& F) {
    if (F.bid >= 256) return;
    float* PS = WSP(float, WS_PARTS); unsigned* cnt = WSP(unsigned, WS_CTL) + 3584 + 208;
    const int t = F.bid, rg = t & 15, cg = t >> 4, rl = F.tid >> 4, row = MP + rg * 32 + rl, n0 = cg * 64 + (F.tid & 15) * 4;
    const f32x4 acc = mini_tile_ks<FF>(F, WSP(bf16_t, WS_H), WSP(bf16_t, WS_W2), MP + rg * 32, cg * 64);
    const f32x4 v = acc + *(const f32x4*)(WSP(float, WS_X1F) + (size_t)row * D + n0);
    float q = v[0] * v[0] + v[1] * v[1] + v[2] * v[2] + v[3] * v[3];
    q += __shfl_xor(q, 1); q += __shfl_xor(q, 2); q += __shfl_xor(q, 4); q += __shfl_xor(q, 8);
    if ((F.tid & 15) == 0) st_agent(PS + (size_t)(rg * 16 + cg) * 32 + rl, q);
    *(LAS f32x4*)(F.lds + MINI_PARK + F.tid * 16) = v;
    asm volatile("s_waitcnt vmcnt(0)" ::: "memory");
    __syncthreads();
    if (F.tid == 0) (void)__hip_atomic_fetch_add((GAS unsigned*)(cnt + rg), 1u, __ATOMIC_RELAXED, __HIP_MEMORY_SCOPE_AGENT);
}
DI void p6_sample_b(const Frame& F) {
    if (F.bid >= 256) return;
    float* PS = WSP(float, WS_PARTS); unsigned* cnt = WSP(unsigned, WS_CTL) + 3584 + 208;
    const int t = F.bid, rg = t & 15, cg = t >> 4, rl = F.tid >> 4, row = MP + rg * 32 + rl, n0 = cg * 64 + (F.tid & 15) * 4;
    if (F.tid == 0) wait_ge16(cnt + rg);
    __syncthreads();
    float tot = 0.f;
#pragma unroll
    for (int c = 0; c < 16; ++c) tot += ld_agent(PS + (size_t)(rg * 16 + c) * 32 + rl);
    const float rs = rsqrtf(tot * (1.0f / D) + EPS);
    const f32x4 v = *(const LAS f32x4*)(F.lds + MINI_PARK + F.tid * 16);
    *(f32x4*)(F.out + (size_t)row * D + n0) = v * rs * *(const f32x4*)(F.in[29] + n0);
}

#define RLX_AGENT __ATOMIC_RELAXED, __HIP_MEMORY_SCOPE_AGENT
#define XB_TMO      128
#define XB_XCNT(j)  (256  + 64 * (j))
#define XB_XSUB(j)  (1280 + 64 * (j))
#define XB_XGEN(j)  (2304 + 64 * (j))
#define XB_TOP      3328
#define XB_TOPGEN   3392
#define XCD_BAR_WORDS 3456
#define XB_SPIN_CAP (1u << 18)

__device__ __forceinline__ unsigned xb_ld(unsigned* p)              { return __hip_atomic_load(p, __ATOMIC_RELAXED, __HIP_MEMORY_SCOPE_AGENT); }
__device__ __forceinline__ unsigned xb_add(unsigned* p, unsigned v) { return __hip_atomic_fetch_add(p, v, __ATOMIC_RELAXED, __HIP_MEMORY_SCOPE_AGENT); }
__device__ __forceinline__ unsigned xb_xcc_id() { return (unsigned)__builtin_amdgcn_s_getreg((3 << 11) | 20) & 0xFu; }
#define XB_SPIN(cond, bar) do { unsigned _sp = 0; while (cond) { __builtin_amdgcn_s_sleep(1); \
    if ((++_sp & 255u) == 0u) { if (xb_ld(&(bar)[XB_TMO])) break; if (_sp > XB_SPIN_CAP) { atomicAdd(&(bar)[XB_TMO], 1u); break; } } } } while (0)

struct XcdBarrier {
    unsigned* bar; unsigned x;
    volatile LAS unsigned* st;
};

__device__ __forceinline__ XcdBarrier xcd_barrier_post(unsigned* bar, volatile LAS unsigned* st) {
    XcdBarrier b; b.bar = bar; b.x = xb_xcc_id(); b.st = st;
    if (threadIdx.x == 0) (void)xb_add(&bar[XB_XCNT(b.x)], 1u);
    return b;
}
__device__ __forceinline__ void xcd_barrier_complete(unsigned* bar, unsigned x, unsigned& nloc, unsigned& nx) {
    const unsigned G = gridDim.x * gridDim.y * gridDim.z;
    unsigned sum, cnt, mine, sp = 0u;
    for (;;) {
        sum = 0u; cnt = 0u; mine = 0u;
#pragma unroll
        for (unsigned j = 0; j < 16; ++j) { const unsigned c = xb_ld(&bar[XB_XCNT(j)]); sum += c; cnt += (c > 0u) ? 1u : 0u; mine = (j == x) ? c : mine; }
        if (sum == G) break;
        __builtin_amdgcn_s_sleep(1);
        if ((++sp & 255u) == 0u) { if (xb_ld(&bar[XB_TMO])) break; if (sp > XB_SPIN_CAP) { atomicAdd(&bar[XB_TMO], 1u); break; } }
    }
    nloc = mine > 0u ? mine : 1u; nx = cnt > 0u ? cnt : 1u;
}

__device__ __forceinline__ void xcd_barrier(const XcdBarrier& b) {
    asm volatile("s_waitcnt vmcnt(0)" ::: "memory");
    __syncthreads();
    if (threadIdx.x == 0) {
        unsigned* bar = b.bar;
        __builtin_amdgcn_s_waitcnt(0);
        unsigned nloc = b.st[0], nx = b.st[1];
        if (nloc == 0u) { xcd_barrier_complete(bar, b.x, nloc, nx); b.st[0] = nloc; b.st[1] = nx; }
        const unsigned old = xb_add(&bar[XB_XSUB(b.x)], 1u);
        const unsigned gen = old / nloc;
        if (old + 1u == (gen + 1u) * nloc) {
            __builtin_amdgcn_fence(__ATOMIC_RELEASE, "agent");
            asm volatile("s_waitcnt vmcnt(0)" ::: "memory");
            const unsigned og = xb_add(&bar[XB_TOP], 1u);
            const unsigned tg = og / nx;
            if (og + 1u == (tg + 1u) * nx) xb_add(&bar[XB_TOPGEN], 1u);
            else XB_SPIN(xb_ld(&bar[XB_TOPGEN]) == tg, bar);
            __builtin_amdgcn_fence(__ATOMIC_ACQUIRE, "agent");
            xb_add(&bar[XB_XGEN(b.x)], 1u);
            asm volatile("s_waitcnt vmcnt(0)" ::: "memory");
        } else {
            XB_SPIN(xb_ld(&bar[XB_XGEN(b.x)]) == gen, bar);
            __builtin_amdgcn_fence(__ATOMIC_ACQUIRE, "agent");
            asm volatile("s_waitcnt vmcnt(0)" ::: "memory");
        }
    }
    __syncthreads();
}

DI void grid_bar(unsigned* ctr, unsigned target) {
    asm volatile("s_waitcnt vmcnt(0)" ::: "memory");
    __syncthreads();
    if (threadIdx.x == 0) {
        __builtin_amdgcn_fence(__ATOMIC_RELEASE, "agent");
        asm volatile("s_waitcnt vmcnt(0)" ::: "memory");
        (void)__hip_atomic_fetch_add(ctr, 1u, __ATOMIC_RELAXED, __HIP_MEMORY_SCOPE_AGENT);
        while (__hip_atomic_load(ctr, __ATOMIC_RELAXED, __HIP_MEMORY_SCOPE_AGENT) < target) __builtin_amdgcn_s_sleep(1);
        __builtin_amdgcn_fence(__ATOMIC_ACQUIRE, "agent");
        asm volatile("s_waitcnt vmcnt(0)" ::: "memory");
    }
    __syncthreads();
}

#ifndef PH_MASK
#define PH_MASK 255
#endif
__global__ void __launch_bounds__(512, 2) mega_fwd(Args args) {
    extern __shared__ __attribute__((aligned(16))) unsigned char lds_raw[];
    cg::grid_group grid = cg::this_grid();
    Frame F;
    F.lds = (LAS unsigned char*)lds_raw; F.tid = threadIdx.x; F.lane = F.tid & 63; F.wave = __builtin_amdgcn_readfirstlane(F.tid >> 6);
    F.G = gridDim.x; F.bid = blockIdx.x; F.in = args.in; F.out = args.out; F.ws = args.ws;
    const int lo = args.ph_lo, hi = args.ph_hi;
#define IN(k) (((PH_MASK >> (k)) & 1) && lo <= (k) && (k) < hi)
    volatile LAS unsigned* xb_st = (volatile LAS unsigned*)(F.lds + LDS_BYTES - 64);
    if (F.tid < 2) xb_st[F.tid] = 0u;
    __syncthreads();
    XcdBarrier xbar; xbar.bar = WSP(unsigned, WS_CTL); xbar.x = 0; xbar.st = xb_st;
    if (lo + 1 < hi) xbar = xcd_barrier_post(WSP(unsigned, WS_CTL), xb_st);
    unsigned bar_n = 0;
#ifdef USE_CG_SYNC
#define SEAM(k) do { if (lo <= (k) && (k) + 1 < hi) grid.sync(); } while (0)
#else
#ifdef USE_CENTRAL_BAR
#define SEAM(k) do { if (lo <= (k) && (k) + 1 < hi) { bar_n += (unsigned)F.G; grid_bar(WSP(unsigned, WS_CTL) + 3520, bar_n); } } while (0)
#else
#define SEAM(k) do { if (lo <= (k) && (k) + 1 < hi) xcd_barrier(xbar); } while (0)
#endif
#endif
    if (hi > 8) grid.sync();
#ifndef REP_MASK
#define REP_MASK 0
#endif
#define REPS(k) for (int rep_ = 0; rep_ < 1 + ((REP_MASK >> (k)) & 1); ++rep_)
    if (IN(0)) { p0_prologue(F); } SEAM(0);
#ifdef EXTRA_SYNC
    for (int i_ = 0; i_ < EXTRA_SYNC; ++i_) SEAM(0);
#endif
#if (REP_MASK >> 0) & 1
    p0_prologue(F); grid.sync();
#endif
    if (IN(1)) {
        pg8::Gemm g{WSP(bf16_t, WS_XN), WSP(bf16_t, WS_WIN), M, INW, D}; pg8::StaticOrder S; S.init(M, INW, F.G, F.bid);
        EpiIn E{F.ws, F.out};
        pg8::gemm_phase<EpiIn, pg8::StaticOrder, true, true>(F.lds, g, S, E);
        p1_tail(F);
    } SEAM(1);
    if (IN(2)) { p23_phase(F); p3_loop(F); late_weights(F); }
#if (REP_MASK >> 2) & 1
    p2_phase(F); grid.sync();
#endif
    SEAM(2);
#if (REP_MASK >> 3) & 1
    for (int t = F.bid; t < 528; t += F.G) p3_task(F, t); grid.sync();
#endif
    if (IN(4)) {
        p4_sample_a(F);
        pg8::Gemm g{WSP(bf16_t, WS_MIX), WSP(bf16_t, WS_WO), MP, D, D}; pg8::StaticOrder S; S.init(MP, D, F.G, F.bid);
        EpiOut E{F.in[0], WSP(float, WS_SSQ), WSP(bf16_t, WS_X1B), WSP(float, WS_PART), WSP(unsigned, WS_CTL) + 3584 + 128, (LAS float*)(F.lds + LDS_X)};
        pg8::gemm_phase<EpiOut, pg8::StaticOrder, true, true>(F.lds, g, S, E);
        p4_sample_b(F);
    } SEAM(4);
    if (IN(5)) {
        pg8::Gemm g{WSP(bf16_t, WS_X1B), WSP(bf16_t, WS_W1), M, 2 * FF, D}; pg8::StaticOrder S; S.init(M, 2 * FF, F.G, F.bid);
        EpiFfn E{F.ws, F.in, F.out, (LAS float*)(F.lds + LDS_X)};
        pg8::gemm_phase<EpiFfn, pg8::StaticOrder, true, true>(F.lds, g, S, E);
    } SEAM(5);
    if (IN(6)) {
        p6_sample_a(F);
        pg8::Gemm g{WSP(bf16_t, WS_H), WSP(bf16_t, WS_W2), MP, D, FF}; pg8::StaticOrder S; S.init(MP, D, F.G, F.bid);
        EpiDown E{F.out, WSP(bf16_t, WS_X1B), WSP(float, WS_SSQ), F.in[29], WSP(float, WS_PART), WSP(unsigned, WS_CTL) + 3584 + 64, (LAS float*)(F.lds + LDS_X)};
        pg8::gemm_phase<EpiDown, pg8::StaticOrder, true, true>(F.lds, g, S, E);
        p6_sample_b(F);
    }
#undef IN
#undef SEAM
}

extern "C" void kernel_launch(void* const* d_in, const int* in_sizes, int n_in, void* d_out, int out_size, void* d_ws, size_t ws_size, hipStream_t stream) {
    static int grid = 0;
    if (grid == 0) {
        if (n_in != 30 || ws_size < WS_END) { fprintf(stderr, "kernel_launch: unexpected n_in %d / ws_size %zu (need %zu)\n", n_in, ws_size, (size_t)WS_END); grid = -1; return; }
        int dev = 0, cus = 0, per_cu = 0;
        (void)hipGetDevice(&dev); (void)hipDeviceGetAttribute(&cus, hipDeviceAttributeMultiprocessorCount, dev);
        if (hipFuncSetAttribute((const void*)mega_fwd, hipFuncAttributeMaxDynamicSharedMemorySize, LDS_BYTES) != hipSuccess) { fprintf(stderr, "hipFuncSetAttribute failed\n"); grid = -1; return; }
        if (hipOccupancyMaxActiveBlocksPerMultiprocessor(&per_cu, (const void*)mega_fwd, 512, LDS_BYTES) != hipSuccess || per_cu < 1) { fprintf(stderr, "occupancy query: %d\n", per_cu); per_cu = 1; }
        (void)hipGetLastError();
        grid = cus * (per_cu > 1 ? 1 : per_cu);
        if (grid <= 0) grid = 256;
    }
    if (grid < 0) return;
    Args a{};
    for (int i = 0; i < 30; ++i) a.in[i] = (const float*)d_in[i];
    a.out = (float*)d_out; a.ws = (unsigned char*)d_ws;
    (void)hipMemsetAsync((unsigned char*)d_ws + WS_CTL, 0, 16384, stream);
#if N_LAUNCHES == 1
    a.ph_lo = 0; a.ph_hi = 8;
    void* kargs[] = {&a};
    hipError_t e = hipLaunchCooperativeKernel((const void*)mega_fwd, dim3(grid), dim3(512), kargs, LDS_BYTES, stream);
    if (e != hipSuccess) fprintf(stderr, "cooperative launch failed: %s (grid %d)\n", hipGetErrorString(e), grid);
#else
    for (int p = 0; p < 8; ++p) { a.ph_lo = p; a.ph_hi = p + 1; for (int r = 0; r < 1 + ((HOST_REP >> p) & 1); ++r) hipLaunchKernelGGL(mega_fwd, dim3(grid), dim3(512), LDS_BYTES, stream, a); }
#endif
}
```

```cpp
#include <hip/hip_runtime.h>
#include <hip/hip_cooperative_groups.h>
#include <cstdio>
#include <cstdint>
namespace cg = cooperative_groups;

namespace pg8 {
#define PG8_LAS __attribute__((address_space(3)))
typedef unsigned short bf16_t;
typedef short bf16x8 __attribute__((ext_vector_type(8)));
typedef float f32x4 __attribute__((ext_vector_type(4)));
typedef unsigned u32x4 __attribute__((ext_vector_type(4)));
constexpr int BM = 256, BK = 64, HALF = 128, HTB = HALF * BK * 2  , STAGE_BYTES = 8 * HTB, NXCD = 8, WGM = 8;

__host__ __device__ __forceinline__ int lds_byte(int r, int c) { const int st = (r >> 4) * 2 + (c >> 5), rr = r & 15, cc = c & 31, ob = rr * 64 + cc * 2; return st * 1024 + (ob ^ (((ob >> 9) & 1) << 5)); }
__host__ __device__ __forceinline__ void stage_rc(int b, int& R, int& C) { const int st = b / 1024, sb = b % 1024, swz = sb ^ (((sb >> 9) & 1) << 5); R = (st >> 1) * 16 + swz / 64; C = (st & 1) * 32 + (swz % 64) / 2; }
__host__ __device__ __forceinline__ int perm32(int rho) { const int n = rho >> 4, i = rho & 15; return 8 * (i >> 2) + 4 * n + (i & 3); }

struct Unit { int pm, pn; };
struct Gemm { const bf16_t* A; const bf16_t* Bt; int M, N, K; };

struct StaticOrder {
    int nM, nN, nwg, G, c;
    __host__ __device__ void init(int M, int N, int G_, int c_) { nM = M / BM; nN = N / BM; nwg = nM * nN; G = G_; c = c_; }
    __host__ __device__ bool next(int i, Unit& u) const {
        const long L = (long)i * G + c; if (L >= nwg) return false;
        int wgid = (int)L; { const int q = nwg / NXCD, r = nwg % NXCD, xcd = wgid % NXCD, off = wgid / NXCD; wgid = (xcd < r ? xcd * (q + 1) : r * (q + 1) + (xcd - r) * q) + off; }
        const int nig = WGM * nN, gid = wgid / nig, fm = gid * WGM, gsz = (nM - fm) < WGM ? (nM - fm) : WGM;
        u.pm = fm + ((wgid % nig) % gsz); u.pn = (wgid % nig) / gsz; return true;
    }
    __device__ __forceinline__ void a_ready(const Unit&) const {}
    __device__ __forceinline__ void done(const Unit&) const {}
};

__device__ __forceinline__ unsigned cvt_pk_bf16(float lo, float hi) { unsigned r; asm volatile("v_cvt_pk_bf16_f32 %0, %1, %2" : "=v"(r) : "v"(lo), "v"(hi)); return r; }
template <class Epi, class Sched, bool ALIGN_EPI = false, bool SP2 = false>
__device__ __forceinline__ void gemm_phase(PG8_LAS unsigned char* lds, const Gemm g, const Sched& S, const Epi& E) {
    const int tid = threadIdx.x, wid = __builtin_amdgcn_readfirstlane(tid >> 6), lane = tid & 63, wr = wid >> 2, wc = wid & 3, fr = lane & 15, fq = lane >> 4;
    const int K = g.K, nt = K / BK;
    unsigned voffA[2], voffB[2];
#pragma unroll
    for (int i = 0; i < 2; ++i) { int R, C; stage_rc(tid * 16 + i * 8192, R, C); const int Rb = Epi::PERM ? ((R & ~31) + perm32(R & 31)) : R;
        voffA[i] = (unsigned)(R * K + C) * 2u; voffB[i] = (unsigned)(Rb * K + C) * 2u; }
    const size_t kstep = (size_t)(BK * 2);
    const size_t hstep = (size_t)HALF * K * 2;
    const size_t tstep = 2 * hstep;
    const unsigned ldsw = (unsigned)wid * 1024u;
    const int aoff = lds_byte(wr * 64 + fr, fq * 8), boff = lds_byte(wc * 32 + fr, fq * 8);
#define PG8_SA(b, h) (((b) * 2 + (h)) * HTB)
#define PG8_SB(b, h) ((4 + (b) * 2 + (h)) * HTB)
#define PG8_STAGE(bufoff, gbase, voff) do { _Pragma("unroll") for (int _i = 0; _i < 2; ++_i) \
        __builtin_amdgcn_global_load_lds((const unsigned*)((const char*)(gbase) + (voff)[_i]), (PG8_LAS unsigned*)(lds + (bufoff) + ldsw + _i * 8192), 16, 0, 0); } while (0)
#define PG8_LDA(dst, b, h) do { _Pragma("unroll") for (int m = 0; m < 4; ++m) _Pragma("unroll") for (int k = 0; k < 2; ++k) dst[m][k] = *(const PG8_LAS bf16x8*)(lds + PG8_SA(b, h) + aoff + m * 2048 + k * 1024); } while (0)
#define PG8_LDB(dst, b, h) do { _Pragma("unroll") for (int n = 0; n < 2; ++n) _Pragma("unroll") for (int k = 0; k < 2; ++k) dst[n][k] = *(const PG8_LAS bf16x8*)(lds + PG8_SB(b, h) + boff + n * 2048 + k * 1024); } while (0)
#define PG8_MMA(ai, bj, At, Bt) do { __builtin_amdgcn_s_setprio(1); _Pragma("unroll") for (int m = 0; m < 4; ++m) _Pragma("unroll") for (int n = 0; n < 2; ++n) _Pragma("unroll") for (int k = 0; k < 2; ++k) \
        acc[ai][bj][m][n] = __builtin_amdgcn_mfma_f32_16x16x32_bf16(Bt[n][k], At[m][k], acc[ai][bj][m][n], 0, 0, 0); __builtin_amdgcn_s_setprio(0); } while (0)
#define PG8_WAIT_V(n) asm volatile("s_waitcnt vmcnt(" #n ")" ::: "memory")
#define PG8_WAIT_L(n) asm volatile("s_waitcnt lgkmcnt(" #n ")" ::: "memory")
#define PG8_BAR __builtin_amdgcn_s_barrier()
#define PG8_SCHED __builtin_amdgcn_sched_barrier(0)
    Unit cur, nxt; int ui = 0;
    if (!S.next(0, cur)) return;
    f32x4 acc[2][2][4][2];
#pragma unroll
    for (int a = 0; a < 2; ++a)
#pragma unroll
        for (int b = 0; b < 2; ++b)
#pragma unroll
            for (int m = 0; m < 4; ++m)
#pragma unroll
                for (int n = 0; n < 2; ++n) acc[a][b][m][n] = (f32x4){0.f, 0.f, 0.f, 0.f};
    bf16x8 At[4][2], B0[2][2], B1[2][2];
    const char* cA = (const char*)g.A + (size_t)cur.pm * tstep; const char* cB = (const char*)g.Bt + (size_t)cur.pn * tstep;
    S.a_ready(cur);
    if constexpr (SP2) {
        PG8_STAGE(PG8_SB(0, 0), cB, voffB); PG8_STAGE(PG8_SB(0, 1), cB + hstep, voffB); PG8_STAGE(PG8_SA(0, 0), cA, voffA); PG8_STAGE(PG8_SA(0, 1), cA + hstep, voffA);
        if (wr == 1) PG8_BAR;
        PG8_WAIT_V(2); PG8_BAR;
        PG8_STAGE(PG8_SB(1, 0), cB + kstep, voffB); PG8_STAGE(PG8_SA(1, 0), cA + kstep, voffA); PG8_STAGE(PG8_SB(1, 1), cB + hstep + kstep, voffB);
        PG8_WAIT_V(6); PG8_BAR;
    } else {
        PG8_STAGE(PG8_SB(0, 0), cB, voffB); PG8_STAGE(PG8_SA(0, 0), cA, voffA); PG8_STAGE(PG8_SB(0, 1), cB + hstep, voffB); PG8_STAGE(PG8_SA(0, 1), cA + hstep, voffA);
        if (wr == 1) PG8_BAR;
        PG8_WAIT_V(4); PG8_BAR;
        PG8_STAGE(PG8_SB(1, 0), cB + kstep, voffB); PG8_STAGE(PG8_SA(1, 0), cA + kstep, voffA); PG8_STAGE(PG8_SB(1, 1), cB + hstep + kstep, voffB);
        PG8_WAIT_V(6); PG8_BAR;
    }
    for (;;) {
        const bool has_next = S.next(ui + 1, nxt);
        const char* nA = has_next ? (const char*)g.A + (size_t)nxt.pm * tstep : cA; const char* nB = has_next ? (const char*)g.Bt + (size_t)nxt.pn * tstep : cB;
        for (int t = 0; t < nt; t += 2) {
            const bool last = (t == nt - 2);
            const char* a1 = cA + (size_t)(t + 1) * kstep;
            const char* a2 = last ? nA : cA + (size_t)(t + 2) * kstep; const char* b2 = last ? nB : cB + (size_t)(t + 2) * kstep;
            const char* a3 = a2 + kstep; const char* b3 = b2 + kstep;
            if (last && has_next) S.a_ready(nxt);
            if constexpr (SP2) {
            PG8_LDB(B0, 0, 0); PG8_LDB(B1, 0, 1); PG8_SCHED; PG8_LDA(At, 0, 0); PG8_STAGE(PG8_SA(1, 1), a1 + hstep, voffA);
            PG8_WAIT_V(8); PG8_WAIT_L(0); PG8_BAR; PG8_MMA(0, 0, At, B0); PG8_MMA(0, 1, At, B1); PG8_BAR; PG8_SCHED;
            PG8_LDA(At, 0, 1); PG8_STAGE(PG8_SB(0, 0), b2, voffB); PG8_STAGE(PG8_SB(0, 1), b2 + hstep, voffB); PG8_STAGE(PG8_SA(0, 0), a2, voffA);
            PG8_WAIT_V(8); PG8_WAIT_L(0); PG8_BAR; PG8_MMA(1, 0, At, B0); PG8_MMA(1, 1, At, B1); PG8_BAR; PG8_SCHED;
            PG8_LDB(B0, 1, 0); PG8_LDB(B1, 1, 1); PG8_SCHED; PG8_LDA(At, 1, 0); PG8_STAGE(PG8_SA(0, 1), a2 + hstep, voffA);
            PG8_WAIT_V(8); PG8_WAIT_L(0); PG8_BAR; PG8_MMA(0, 0, At, B0); PG8_MMA(0, 1, At, B1); PG8_BAR; PG8_SCHED;
            PG8_LDA(At, 1, 1); PG8_STAGE(PG8_SB(1, 0), b3, voffB); PG8_STAGE(PG8_SB(1, 1), b3 + hstep, voffB); PG8_STAGE(PG8_SA(1, 0), a3, voffA);
            PG8_WAIT_V(8); PG8_WAIT_L(0); PG8_BAR; PG8_MMA(1, 0, At, B0); PG8_MMA(1, 1, At, B1); PG8_BAR; PG8_SCHED;
            } else {
            PG8_LDB(B0, 0, 0); PG8_SCHED; PG8_LDA(At, 0, 0); PG8_STAGE(PG8_SA(1, 1), a1 + hstep, voffA);
            PG8_WAIT_L(8); PG8_BAR; PG8_WAIT_L(0); PG8_MMA(0, 0, At, B0); PG8_BAR; PG8_SCHED;
            PG8_LDB(B1, 0, 1); PG8_STAGE(PG8_SB(0, 0), b2, voffB);
            PG8_BAR; PG8_WAIT_L(0); PG8_MMA(0, 1, At, B1); PG8_BAR;
            PG8_LDA(At, 0, 1); PG8_STAGE(PG8_SA(0, 0), a2, voffA);
            PG8_BAR; PG8_WAIT_L(0); PG8_MMA(1, 0, At, B0); PG8_BAR; PG8_SCHED;
            PG8_STAGE(PG8_SB(0, 1), b2 + hstep, voffB);
            PG8_WAIT_V(6); PG8_BAR; PG8_MMA(1, 1, At, B1); PG8_BAR;
            PG8_LDB(B0, 1, 0); PG8_SCHED; PG8_LDA(At, 1, 0); PG8_STAGE(PG8_SA(0, 1), a2 + hstep, voffA);
            PG8_WAIT_L(8); PG8_BAR; PG8_WAIT_L(0); PG8_MMA(0, 0, At, B0); PG8_BAR; PG8_SCHED;
            PG8_LDB(B1, 1, 1); PG8_STAGE(PG8_SB(1, 0), b3, voffB);
            PG8_BAR; PG8_WAIT_L(0); PG8_MMA(0, 1, At, B1); PG8_BAR;
            PG8_LDA(At, 1, 1); PG8_STAGE(PG8_SA(1, 0), a3, voffA);
            PG8_BAR; PG8_WAIT_L(0); PG8_MMA(1, 0, At, B0); PG8_BAR; PG8_SCHED;
            PG8_STAGE(PG8_SB(1, 1), b3 + hstep, voffB);
            PG8_WAIT_V(6); PG8_BAR; PG8_MMA(1, 1, At, B1); PG8_BAR;
            }
        }
        if constexpr (ALIGN_EPI) { if (wr == 0) PG8_BAR; }
        if constexpr (!Epi::AFTER_DRAIN) { E(acc, cur, wr, wc, fr, fq); S.done(cur); }
        if (!has_next) break;
#pragma unroll
        for (int a = 0; a < 2; ++a)
#pragma unroll
            for (int b = 0; b < 2; ++b)
#pragma unroll
                for (int m = 0; m < 4; ++m)
#pragma unroll
                    for (int n = 0; n < 2; ++n) acc[a][b][m][n] = (f32x4){0.f, 0.f, 0.f, 0.f};
        cur = nxt; cA = nA; cB = nB; ++ui;
        if constexpr (ALIGN_EPI) { if (wr == 1) PG8_BAR; }
    }
    PG8_WAIT_V(0);
    if constexpr (!ALIGN_EPI) { if (wr == 0) PG8_BAR; }
    PG8_BAR;
    if constexpr (Epi::AFTER_DRAIN) { E.fused(acc, cur, wr, wc, fr, fq, lds, wid, lane); S.done(cur); }
#undef PG8_SA
#undef PG8_SB
#undef PG8_STAGE
#undef PG8_LDA
#undef PG8_LDB
#undef PG8_MMA
#undef PG8_WAIT_V
#undef PG8_WAIT_L
#undef PG8_BAR
#undef PG8_SCHED
}
}

#ifndef HOST_REP
#define HOST_REP 0
#endif
#ifndef N_LAUNCHES
#define N_LAUNCHES 1
#endif
#define DI __device__ __forceinline__
#define LAS __attribute__((address_space(3)))
using pg8::bf16_t; using pg8::bf16x8; using pg8::f32x4; using pg8::u32x4;
typedef unsigned u32x2 __attribute__((ext_vector_type(2)));
typedef short s16x4 __attribute__((ext_vector_type(4)));
#define MFMA16(a, b, c) __builtin_amdgcn_mfma_f32_16x16x32_bf16((a), (b), (c), 0, 0, 0)

constexpr int D = 1024, MP = 16384, MS = 512, M = MP + MS, SEQ = 2048, INW = 1280, FF = 2816, NG = 32;
constexpr float EPS = 1e-6f;
constexpr size_t O_PRE = 17301504, O_PIM = 17317888, O_PK = 17334272, O_PV = 17465344, O_PCONV = 17596416,
                 O_SRE = 17641472, O_SIM = 17674240, O_SK = 17707008, O_SV = 17772544, O_SCONV = 17838080;
constexpr size_t WS_WIN = 0, WS_WGLU = WS_WIN + (size_t)INW * D * 2, WS_WO = WS_WGLU + 512 * 512 * 2, WS_W1 = WS_WO + (size_t)D * D * 2,
                 WS_W2 = WS_W1 + (size_t)2 * FF * D * 2, WS_KT = WS_W2 + (size_t)D * FF * 2, WS_WT = WS_KT + (size_t)NG * 32 * 256 * 2,
                 WS_PRE = WS_WT + (size_t)NG * 128 * 512 * 2, WS_PIM = WS_PRE + (size_t)NG * 4096 * 4, WS_A32 = WS_PIM + (size_t)NG * 32 * 64 * 4,
                 WS_CT = WS_A32 + (size_t)NG * 64 * 2 * 4, WS_SSQ = WS_CT + (size_t)NG * 16 * 128 * 2, WS_MIX = WS_SSQ + (size_t)M * 16 * 4,
                 WS_X1B = WS_MIX + (size_t)M * D * 2, WS_H = WS_X1B + (size_t)M * D * 2, WS_X1F = WS_H + (size_t)M * FF * 2, WS_PART = WS_X1F + (size_t)M * D * 4, WS_PARTS = WS_PART + (size_t)64 * 4 * 256 * 4, WS_CTL = WS_PARTS + (size_t)256 * 32 * 4, WS_END = WS_CTL + 16384;
constexpr size_t WS_XN = WS_H, WS_U = WS_XN + (size_t)M * D * 2, WS_Q = WS_U + (size_t)M * 512 * 2, WS_KB = WS_Q + (size_t)M * 512 * 2,
                 WS_VT = WS_KB + (size_t)M * 128 * 2, WS_KS = WS_VT + (size_t)MP * 128 * 2, WS_VTS = WS_KS + (size_t)16 * 160 * 128 * 2,
                 WS_HIN = WS_VTS + (size_t)16 * 160 * 128 * 2, WS_UF = WS_HIN + (size_t)512 * NG * 128 * 4, WS_ALIAS_END = WS_UF + (size_t)M * 512 * 2;
static_assert(WS_ALIAS_END <= WS_END && WS_END <= 268435456, "d_ws map");
constexpr int LDS_BYTES = 163840, LDS_X = 131072;

DI unsigned f2bf(float f) { unsigned u = __builtin_bit_cast(unsigned, f); return (u + 0x7fffu + ((u >> 16) & 1u)) >> 16; }
typedef float f32x2_t __attribute__((ext_vector_type(2)));
typedef __bf16 bf16x2_t __attribute__((ext_vector_type(2)));
DI unsigned pk2(float lo, float hi) { f32x2_t v = {lo, hi}; bf16x2_t b = __builtin_convertvector(v, bf16x2_t); return __builtin_bit_cast(unsigned, b); }
DI float bflo(unsigned w) { return __builtin_bit_cast(float, w << 16); }
DI float bfhi(unsigned w) { return __builtin_bit_cast(float, w & 0xffff0000u); }
DI u32x4 pack8(const f32x4& a, const f32x4& b) { u32x4 w; w.x = pk2(a[0], a[1]); w.y = pk2(a[2], a[3]); w.z = pk2(b[0], b[1]); w.w = pk2(b[2], b[3]); return w; }
DI float dot2bf(unsigned a, unsigned b, float c) { return __builtin_amdgcn_fdot2_f32_bf16(__builtin_bit_cast(bf16x2_t, a), __builtin_bit_cast(bf16x2_t, b), c, false); }
DI float sigm(float x) { return __builtin_amdgcn_rcpf(1.0f + __expf(-x)); }
DI float gelu_tanh(float x) { const float z = 0.7978845608f * (x + 0.044715f * x * x * x); return x * sigm(2.0f * z); }
template <int CTRL> DI float dpp_shr(float v) { return __builtin_bit_cast(float, __builtin_amdgcn_update_dpp(0, __builtin_bit_cast(int, v), CTRL, 0xF, 0xF, false)); }
#define GAS __attribute__((address_space(1)))
DI void st_agent(float* p, float v) { __hip_atomic_store((GAS unsigned*)p, __builtin_bit_cast(unsigned, v), __ATOMIC_RELAXED, __HIP_MEMORY_SCOPE_AGENT); }
DI float ld_agent(const float* p) { return __builtin_bit_cast(float, __hip_atomic_load((GAS unsigned*)p, __ATOMIC_RELAXED, __HIP_MEMORY_SCOPE_AGENT)); }
DI void arrive_and_wait(unsigned* cnt, unsigned target) {
    (void)__hip_atomic_fetch_add((GAS unsigned*)cnt, 1u, __ATOMIC_RELAXED, __HIP_MEMORY_SCOPE_AGENT);
    while (__hip_atomic_load((GAS unsigned*)cnt, __ATOMIC_RELAXED, __HIP_MEMORY_SCOPE_AGENT) < target) __builtin_amdgcn_s_sleep(1);
}
DI void wait_ge16(const unsigned* c) { while (__hip_atomic_load((GAS unsigned*)c, __ATOMIC_RELAXED, __HIP_MEMORY_SCOPE_AGENT) < 16u) __builtin_amdgcn_s_sleep(1); }
DI float xsum4(float v) { v += __shfl_xor(v, 16); v += __shfl_xor(v, 32); return v; }

struct Args { const float* in[30]; float* out; unsigned char* ws; int ph_lo, ph_hi; };

struct Frame {
    LAS unsigned char* lds; int tid, lane, wave, G, bid;
    const float* const* in; float* out; unsigned char* ws;
};
#define WSP(T, off) ((T*)(F.ws + (off)))

DI void p0_transpose(const float* __restrict__ W, int N, const float* __restrict__ gk, bf16_t* __restrict__ WT, int ldt, int k0, int n0, int dst0, LAS float* scr, int tid) {
    const int c = tid & 63, r0 = tid >> 6;
    float v[16];
#pragma unroll
    for (int i = 0; i < 16; ++i) { const int r = r0 + 8 * i; v[i] = W[(size_t)(k0 + r) * N + n0 + c]; }
#pragma unroll
    for (int i = 0; i < 16; ++i) { const int r = r0 + 8 * i; float x = v[i]; if (gk) x *= gk[k0 + r]; scr[r * 65 + c] = x; }
    __syncthreads();
#pragma unroll
    for (int i = 0; i < 8; ++i) { const int n = r0 + 8 * i; bf16_t* o = WT + (size_t)(dst0 + n) * ldt + k0 + c;
        o[0] = (bf16_t)f2bf(scr[c * 65 + n]); o[64] = (bf16_t)f2bf(scr[(64 + c) * 65 + n]); }
    __syncthreads();
}

DI void p0_ssm_tables(const Frame& F, int task) {
    const int tid = F.tid, g = task >> 2, part = task & 3;
    LAS float* pwr = (LAS float*)F.lds; LAS float* pwi = pwr + 33 * 64; LAS float* bbr = pwi + 33 * 64; LAS float* bbi = bbr + 1024;
    const float* a_re = F.in[9] + g * 64; const float* a_im = F.in[10] + g * 64;
    const float dt = expf(F.in[11][g]);
    for (int i = tid; i < 33 * 64; i += 512) {
        const int d = i >> 6, n = i & 63; const float fd = (float)d;
        const float mag = expf(a_re[n] * dt * fd), ang = a_im[n] * dt * fd;
        pwr[i] = mag * cosf(ang); pwi[i] = mag * sinf(ang);
    }
    __syncthreads();
    for (int i = tid; i < 1024; i += 512) {
        const int n = i >> 4;
        const float are = a_re[n], aim = a_im[n], nr = pwr[64 + n] - 1.0f, ni = pwi[64 + n], den = are * are + aim * aim;
        const float cr = (nr * are + ni * aim) / den, ci = (ni * are - nr * aim) / den;
        const float br = F.in[12][(size_t)g * 1024 + i], bi = F.in[13][(size_t)g * 1024 + i];
        bbr[i] = cr * br - ci * bi; bbi[i] = cr * bi + ci * br;
    }
    __syncthreads();
    if (part == 0) {
        const int d = tid >> 4, p = tid & 15;
        float acc[16];
#pragma unroll
        for (int q = 0; q < 16; ++q) acc[q] = 0.f;
        const float* cre = F.in[14] + (size_t)(g * 16 + p) * 64; const float* cim = F.in[15] + (size_t)(g * 16 + p) * 64;
        for (int n = 0; n < 64; ++n) {
            const float cr = cre[n], ci = cim[n], pr = pwr[d * 64 + n], pi = pwi[d * 64 + n];
            const float xr = cr * pr - ci * pi, xi = cr * pi + ci * pr;
#pragma unroll
            for (int q = 0; q < 16; ++q) acc[q] += xr * bbr[n * 16 + q] - xi * bbi[n * 16 + q];
        }
        const float dv = (d == 0) ? F.in[16][g * 16 + p] : 0.f;
        u32x4 w0, w1;
#pragma unroll
        for (int q = 0; q < 16; ++q) acc[q] += (q == p) ? dv : 0.f;
        w0.x = pk2(acc[0], acc[1]); w0.y = pk2(acc[2], acc[3]); w0.z = pk2(acc[4], acc[5]); w0.w = pk2(acc[6], acc[7]);
        w1.x = pk2(acc[8], acc[9]); w1.y = pk2(acc[10], acc[11]); w1.z = pk2(acc[12], acc[13]); w1.w = pk2(acc[14], acc[15]);
        bf16_t* dst = WSP(bf16_t, WS_KT) + ((size_t)(g * 16 + (d >> 1)) * 64 + (d & 1) * 32 + p) * 8;
        *(u32x4*)dst = w0; *(u32x4*)(dst + 128) = w1;
    }
    if (part == 1 || part == 2) {
        bf16_t* wt = WSP(bf16_t, WS_WT) + (size_t)g * 65536;
        for (int idx = (part - 1) * 32768 + tid; idx < part * 32768; idx += 512) {
            const int j = idx & 7, lane = (idx >> 3) & 63, kk = (idx >> 9) & 15, nb = idx >> 13;
            const int n2 = nb * 16 + (lane & 15), n = n2 & 63, sidx = 2 * kk + (lane >> 5), pp = ((lane >> 4) & 1) * 8 + j;
            const float pr = pwr[(31 - sidx) * 64 + n], pi = pwi[(31 - sidx) * 64 + n], br = bbr[n * 16 + pp], bi = bbi[n * 16 + pp];
            wt[idx] = (bf16_t)f2bf(n2 < 64 ? pr * br - pi * bi : pr * bi + pi * br);
        }
    }
    if (part == 3) {
    for (int i = tid; i < 4096; i += 512) {
        const int e = i & 3, lane = (i >> 2) & 63, half = (i >> 8) & 1, reim = (i >> 9) & 1, nh = (i >> 10) & 1, mt = i >> 11;
        const int t = mt * 16 + (lane & 15), n = nh * 32 + (lane >> 4) * 8 + half * 4 + e;
        WSP(float, WS_PRE)[(size_t)g * 4096 + i] = reim ? pwi[(t + 1) * 64 + n] : pwr[(t + 1) * 64 + n];
    }
    if (tid < 64) { WSP(float, WS_A32)[(g * 64 + tid) * 2] = pwr[32 * 64 + tid]; WSP(float, WS_A32)[(g * 64 + tid) * 2 + 1] = pwi[32 * 64 + tid]; }
    for (int i = tid; i < 2048; i += 512) {
        const int j = i & 7, lane = (i >> 3) & 63, kk2 = i >> 9, p = lane & 15, n2 = kk2 * 32 + (lane >> 4) * 8 + j;
        const float v = n2 < 64 ? F.in[14][(size_t)(g * 16 + p) * 64 + n2] : -F.in[15][(size_t)(g * 16 + p) * 64 + n2 - 64];
        WSP(bf16_t, WS_CT)[(size_t)g * 2048 + i] = (bf16_t)f2bf(v);
    }
    }
    __syncthreads();
}

DI void p0_prologue(const Frame& F) {
    constexpr int T_SSM = 128, T_WIN = 8 * 20, T_WGLU = 64, T_WO = 128, T_WA = 8 * 44, T_WD = 22 * 16, T_XN = M / 16, T_CK = 64, T_CV = 64;
    LAS float* scr = (LAS float*)F.lds;
    const int G = F.G;
    int r = F.bid;
#define P0_LOOP(COUNT) for (int i = r; i < (COUNT); i += G)
#define P0_NEXT(COUNT) r = (r + G - (COUNT) % G) % G
    P0_LOOP(T_XN) {
        const int row = i * 16 + F.wave * 2;
        const float* xr = row < MP ? F.in[0] + (size_t)row * D : F.in[1] + (size_t)(row - MP) * D;
        f32x4 v[2][4]; float q0 = 0.f, q1 = 0.f;
#pragma unroll
        for (int k = 0; k < 4; ++k) { v[0][k] = *(const f32x4*)(xr + k * 256 + F.lane * 4); v[1][k] = *(const f32x4*)(xr + D + k * 256 + F.lane * 4); }
#pragma unroll
        for (int k = 0; k < 4; ++k) { q0 += v[0][k][0] * v[0][k][0] + v[0][k][1] * v[0][k][1] + v[0][k][2] * v[0][k][2] + v[0][k][3] * v[0][k][3];
                                      q1 += v[1][k][0] * v[1][k][0] + v[1][k][1] * v[1][k][1] + v[1][k][2] * v[1][k][2] + v[1][k][3] * v[1][k][3]; }
#pragma unroll
        for (int o = 1; o < 64; o <<= 1) { q0 += __shfl_xor(q0, o); q1 += __shfl_xor(q1, o); }
        const float rr0 = rsqrtf(q0 * (1.0f / D) + EPS), rr1 = rsqrtf(q1 * (1.0f / D) + EPS);
        bf16_t* dst = WSP(bf16_t, WS_XN) + (size_t)row * D;
#pragma unroll
        for (int k = 0; k < 4; ++k) { const f32x4 g = *(const f32x4*)(F.in[7] + k * 256 + F.lane * 4);
            u32x2 w; w.x = pk2(v[0][k][0] * rr0 * g[0], v[0][k][1] * rr0 * g[1]); w.y = pk2(v[0][k][2] * rr0 * g[2], v[0][k][3] * rr0 * g[3]); *(u32x2*)(dst + k * 256 + F.lane * 4) = w;
            w.x = pk2(v[1][k][0] * rr1 * g[0], v[1][k][1] * rr1 * g[1]); w.y = pk2(v[1][k][2] * rr1 * g[2], v[1][k][3] * rr1 * g[3]); *(u32x2*)(dst + D + k * 256 + F.lane * 4) = w; }
    }
    P0_NEXT(T_XN);
    P0_LOOP(T_WIN) p0_transpose(F.in[8], INW, nullptr, WSP(bf16_t, WS_WIN), D, (i % 8) * 128, (i / 8) * 64, (i / 8) * 64, scr, F.tid);
    P0_NEXT(T_WIN);
#undef P0_LOOP
#undef P0_NEXT
}

DI void p1_tail(const Frame& F) {
    constexpr int T_SSM = 128, T_WGLU = 64, T_CK = 64, T_CV = 64;
    const int nbusy = (M / 256) * (INW / 256) - F.G;
    if (nbusy < 0 || nbusy >= F.G || F.bid < nbusy) return;
    const int G = F.G - nbusy;
    int r = F.bid - nbusy;
#define P0_LOOP(COUNT) for (int i = r; i < (COUNT); i += G)
#define P0_NEXT(COUNT) r = (r + G - (COUNT) % G) % G
    P0_LOOP(T_SSM) p0_ssm_tables(F, i);
    P0_NEXT(T_SSM);
    P0_LOOP(T_WGLU) {
        const int ch = i * 512 + F.tid, lane = ch & 63, kk = (ch >> 6) & 15, ntg = ch >> 10;
        const float* src = F.in[17] + (size_t)(kk * 32 + (lane >> 4) * 8) * 512 + ntg * 16 + (lane & 15);
        f32x4 a, b;
#pragma unroll
        for (int j = 0; j < 4; ++j) { a[j] = src[(size_t)j * 512]; b[j] = src[(size_t)(j + 4) * 512]; }
        *(u32x4*)(WSP(bf16_t, WS_WGLU) + (size_t)ch * 8) = pack8(a, b);
    }
    P0_NEXT(T_WGLU);
    P0_LOOP(T_CK) {
        const int ch = i * 512 + F.tid, lane = ch & 63, kk = (ch >> 6) & 1, kb = (ch >> 7) & 7, kvh = (ch >> 10) & 1, sb = ch >> 11;
        const float* src = F.in[4] + (((size_t)sb * 128 + kb * 16 + (lane & 15)) * 2 + kvh) * 64 + kk * 32 + (lane >> 4) * 8;
        *(u32x4*)(WSP(bf16_t, WS_KS) + (((size_t)(sb * 2 + kvh) * 10 + kb) * 2 + kk) * 512 + lane * 8) = pack8(*(const f32x4*)src, *(const f32x4*)(src + 4));
    }
    P0_NEXT(T_CK);
    P0_LOOP(T_CV) {
        const int ch = i * 512 + F.tid, lane = ch & 63, db = (ch >> 6) & 3, kb = (ch >> 8) & 3, kvh = (ch >> 10) & 1, sb = ch >> 11;
        const float* src = F.in[5] + (((size_t)sb * 128 + kb * 32 + (lane >> 4) * 4) * 2 + kvh) * 64 + db * 16 + (lane & 15);
        f32x4 a, b;
#pragma unroll
        for (int j = 0; j < 4; ++j) { a[j] = src[(size_t)j * 128]; b[j] = src[(size_t)(16 + j) * 128]; }
        *(u32x4*)(WSP(bf16_t, WS_VTS) + (((size_t)(sb * 2 + kvh) * 5 + kb) * 4 + db) * 512 + lane * 8) = pack8(a, b);
    }
#undef P0_LOOP
#undef P0_NEXT
}

struct EpiIn {
    static constexpr bool PERM = true, AFTER_DRAIN = false;
    unsigned char* ws; float* out;
    DI void operator()(const f32x4 (&acc)[2][2][4][2], const pg8::Unit& u, int wr, int wc, int fr, int fq) const {
        bf16_t* const U = (bf16_t*)(ws + WS_U); bf16_t* const Q = (bf16_t*)(ws + WS_Q); bf16_t* const KB = (bf16_t*)(ws + WS_KB); bf16_t* const VT = (bf16_t*)(ws + WS_VT);
        bf16_t* const KS = (bf16_t*)(ws + WS_KS); bf16_t* const VTS = (bf16_t*)(ws + WS_VTS); bf16_t* const UF = (bf16_t*)(ws + WS_UF);
        const int row0 = u.pm * 256 + wr * 64 + fr;
        if (u.pn < 2) {
            const int colt = u.pn * 256 + wc * 32 + 8 * fq;
#pragma unroll
            for (int ai = 0; ai < 2; ++ai)
#pragma unroll
                for (int m = 0; m < 4; ++m) { const int row = row0 + ai * 128 + m * 16; bf16_t* rp = U + (size_t)row * 512 + colt;
                    const int tq = row < MP ? (row & 2047) : ((row - MP) & 31), sq = tq & 31, chunk = row < MP ? (tq >> 5) : ((row - MP) >> 5);
#pragma unroll
                    for (int bj = 0; bj < 2; ++bj) { const u32x4 w = pack8(acc[ai][bj][m][0], acc[ai][bj][m][1]); *(u32x4*)(rp + bj * 128) = w;
                        const int c0 = colt + bj * 128, g = c0 >> 4, lf = (((sq & 1) * 2 + ((c0 >> 3) & 1)) * 16 + (chunk & 15)) * 8;
                        bf16_t* uf = row < MP ? UF + ((((size_t)((row >> 11) * 32 + g) * 16 + (sq >> 1)) * 4 + (chunk >> 4)) * 64) * 8 + lf
                                              : UF + (size_t)MP * 512 + ((size_t)(g * 16 + (sq >> 1)) * 64) * 8 + lf;
                        *(u32x4*)uf = w; } }
        } else if (u.pn < 4) {
#pragma unroll
            for (int ai = 0; ai < 2; ++ai)
#pragma unroll
                for (int m = 0; m < 4; ++m) { const int rb = (u.pm * 256 + wr * 64 + ai * 128 + m * 16) >> 4;
#pragma unroll
                    for (int bj = 0; bj < 2; ++bj) { const int c0 = (u.pn - 2) * 256 + bj * 128 + wc * 32, h = c0 >> 6, kk = (c0 >> 5) & 1;
                        *(u32x4*)(Q + (((size_t)h * (M / 16) + rb) * 2 + kk) * 512 + (fq * 16 + fr) * 8) = pack8(acc[ai][bj][m][0] * 0.125f, acc[ai][bj][m][1] * 0.125f); } }
        } else {
            const int c = wc * 32 + 8 * fq, kvh = wc >> 1, kk = wc & 1, db = (c >> 4) & 3, fr0 = c & 15;
#pragma unroll
            for (int ai = 0; ai < 2; ++ai)
#pragma unroll
                for (int m = 0; m < 4; ++m) {
                    const int row = row0 + ai * 128 + m * 16;
                    const f32x4 k0 = acc[ai][0][m][0], k1 = acc[ai][0][m][1], v0 = acc[ai][1][m][0], v1 = acc[ai][1][m][1];
                    if (row < MP) {
                        const int b = row >> 11, t = row & 2047;
                        *(u32x4*)(KB + (((size_t)kvh * (M / 16) + (row >> 4)) * 2 + kk) * 512 + (fq * 16 + fr) * 8) = pack8(k0, k1);
                        const int w = t & 31; bf16_t* vt = VT + ((((size_t)(b * 2 + kvh) * 64 + (t >> 5)) * 4 + db) * 64 + ((w & 15) >> 2) * 16 + fr0) * 8 + (w & 3) + 4 * (w >> 4);
#pragma unroll
                        for (int j = 0; j < 4; ++j) { vt[j * 8] = (bf16_t)f2bf(v0[j]); vt[(j + 4) * 8] = (bf16_t)f2bf(v1[j]); }
                        if (t >= 1920) { float* pk = out + O_PK + ((size_t)b * 128 + (t - 1920)) * 128 + c; *(f32x4*)pk = k0; *(f32x4*)(pk + 4) = k1;
                                         float* pv = out + O_PV + ((size_t)b * 128 + (t - 1920)) * 128 + c; *(f32x4*)pv = v0; *(f32x4*)(pv + 4) = v1; }
                    } else {
                        const int sb = (row - MP) >> 5, st = (row - MP) & 31, key = 128 + st;
                        *(u32x4*)(KS + ((((size_t)(sb * 2 + kvh) * 10 + (key >> 4)) * 2 + kk) * 64 + fq * 16 + (key & 15)) * 8) = pack8(k0, k1);
                        const int w = key & 31; bf16_t* vt = VTS + ((((size_t)(sb * 2 + kvh) * 5 + (key >> 5)) * 4 + db) * 64 + ((w & 15) >> 2) * 16 + fr0) * 8 + (w & 3) + 4 * (w >> 4);
#pragma unroll
                        for (int j = 0; j < 4; ++j) { vt[j * 8] = (bf16_t)f2bf(v0[j]); vt[(j + 4) * 8] = (bf16_t)f2bf(v1[j]); }
                        float* pk = out + O_SK + ((size_t)sb * 32 + st) * 128 + c; *(f32x4*)pk = k0; *(f32x4*)(pk + 4) = k1;
                        float* pv = out + O_SV + ((size_t)sb * 32 + st) * 128 + c; *(f32x4*)pv = v0; *(f32x4*)(pv + 4) = v1;
                    }
                }
        }
    }
};

constexpr int LDO = 520;
DI void attn_task(const bf16_t* __restrict__ Qp, int nqb, const bf16_t* __restrict__ Kp, int nkb, const bf16_t* __restrict__ Vtp, int vstride,
                  float sink, const float* __restrict__ gat, bf16_t* __restrict__ outp, LAS float* ob, int h, int wave, int lane) {
    const int fr = lane & 15, fq = lane >> 4;
#pragma unroll 1
    for (int qb = 0; qb < nqb; ++qb) {
        const bf16_t* qrow = Qp + (size_t)qb * 1024 + lane * 8;
        const bf16x8 q0 = *(const bf16x8*)qrow, q1 = *(const bf16x8*)(qrow + 512);
        f32x4 s[12];
#pragma unroll
        for (int kb = 0; kb < 12; ++kb) {
            s[kb] = (f32x4){-INFINITY, -INFINITY, -INFINITY, -INFINITY};
            if (kb < nkb) {
                const bf16_t* krow = Kp + (size_t)kb * 1024 + lane * 8;
                const bf16x8 k0 = *(const bf16x8*)krow, k1 = *(const bf16x8*)(krow + 512);
                f32x4 z = (f32x4){0.f, 0.f, 0.f, 0.f};
                z = MFMA16(k0, q0, z); z = MFMA16(k1, q1, z); s[kb] = z;
            }
        }
        float m = sink;
#pragma unroll
        for (int kb = 0; kb < 12; ++kb) m = fmaxf(fmaxf(m, fmaxf(s[kb][0], s[kb][1])), fmaxf(s[kb][2], s[kb][3]));
        m = fmaxf(m, __shfl_xor(m, 16)); m = fmaxf(m, __shfl_xor(m, 32));
        float sum = 0.f;
#pragma unroll
        for (int kb = 0; kb < 12; ++kb)
#pragma unroll
            for (int e = 0; e < 4; ++e) { const float p = __expf(s[kb][e] - m); s[kb][e] = p; sum += p; }
        sum = xsum4(sum);
        const float inv = 1.0f / (sum + __expf(sink - m));
        f32x4 o[4];
#pragma unroll
        for (int db = 0; db < 4; ++db) o[db] = (f32x4){0.f, 0.f, 0.f, 0.f};
#pragma unroll
        for (int ks = 0; ks < 6; ++ks) {
            if (2 * ks < nkb) {
                const bf16x8 pb = __builtin_bit_cast(bf16x8, pack8(s[2 * ks], s[2 * ks + 1]));
#pragma unroll
                for (int db = 0; db < 4; ++db) {
                    const bf16x8 vf = *(const bf16x8*)(Vtp + (size_t)(ks * 4 + db) * 512 + lane * 8);
                    o[db] = MFMA16(vf, pb, o[db]);
                }
                if (ks & 1) __builtin_amdgcn_sched_barrier(0);
            }
        }
#pragma unroll
        for (int db = 0; db < 4; ++db) *(LAS f32x4*)(ob + (qb * 16 + fr) * LDO + h * 64 + db * 16 + fq * 4) = o[db] * inv;
    }
    __syncthreads();
    const int rpw = nqb * 2;
    const f32x4 g0 = *(const f32x4*)(gat + lane * 8), g1 = *(const f32x4*)(gat + lane * 8 + 4);
#pragma unroll 1
    for (int i = 0; i < rpw; ++i) {
        const int r = wave * rpw + i;
        f32x4 v0 = *(const LAS f32x4*)(ob + r * LDO + lane * 8), v1 = *(const LAS f32x4*)(ob + r * LDO + lane * 8 + 4);
        float q = v0[0] * v0[0] + v0[1] * v0[1] + v0[2] * v0[2] + v0[3] * v0[3] + v1[0] * v1[0] + v1[1] * v1[1] + v1[2] * v1[2] + v1[3] * v1[3];
#pragma unroll
        for (int o2 = 1; o2 < 64; o2 <<= 1) q += __shfl_xor(q, o2);
        const float rs = rsqrtf(q * (1.0f / 512.0f) + EPS);
        *(u32x4*)(outp + (size_t)r * D + lane * 8) = pack8(v0 * rs * g0, v1 * rs * g1);
    }
    __syncthreads();
}

template <int MT, bool SAMPLE>
DI void ssm_state(const Frame& F, int b, int g) {
    const int lane = F.lane, fr = lane & 15, fq = lane >> 4;
    const bf16_t* Ub = WSP(bf16_t, WS_UF) + (SAMPLE ? (size_t)MP * 512 + (size_t)g * 16 * 512 : (size_t)(b * 32 + g) * 16 * 2048) + lane * 8;
    const bf16_t* Wg = WSP(bf16_t, WS_WT) + (size_t)g * 65536 + lane * 8;
    const float* A32 = WSP(float, WS_A32) + g * 128;
    float* HIN = WSP(float, WS_HIN);
#pragma unroll 1
    for (int h2 = 0; h2 < 2; ++h2) {
        f32x4 acc[MT][4];
#pragma unroll
        for (int mt = 0; mt < MT; ++mt)
#pragma unroll
            for (int j = 0; j < 4; ++j) acc[mt][j] = (f32x4){0.f, 0.f, 0.f, 0.f};
#pragma unroll 2
        for (int kk = 0; kk < 16; ++kk) {
            bf16x8 a[MT], w[4];
#pragma unroll
            for (int mt = 0; mt < MT; ++mt) a[mt] = *(const bf16x8*)(Ub + (size_t)kk * (SAMPLE ? 512 : 2048) + mt * 512);
#pragma unroll
            for (int j = 0; j < 4; ++j) { const int nb = (j < 2) ? 2 * h2 + j : 4 + 2 * h2 + (j - 2); w[j] = *(const bf16x8*)(Wg + (size_t)(nb * 16 + kk) * 512); }
#pragma unroll
            for (int mt = 0; mt < MT; ++mt)
#pragma unroll
                for (int j = 0; j < 4; ++j) acc[mt][j] = MFMA16(a[mt], w[j], acc[mt][j]);
        }
#pragma unroll
        for (int i = 0; i < 2; ++i) {
            const int n = (2 * h2 + i) * 16 + fr;
            const float ar = A32[n * 2], ai = A32[n * 2 + 1];
            if constexpr (SAMPLE) {
#pragma unroll
                for (int e = 0; e < 4; ++e) {
                    const int sb = fq * 4 + e; const size_t idx = ((size_t)sb * 32 + g) * 64 + n;
                    const float hr = F.in[2][idx], hi = F.in[3][idx];
                    F.out[O_SRE + idx] = ar * hr - ai * hi + acc[0][i][e]; F.out[O_SIM + idx] = ar * hi + ai * hr + acc[0][2 + i][e];
                }
            } else {
            const float a2r = ar * ar - ai * ai, a2i = 2.f * ar * ai, a3r = a2r * ar - a2i * ai, a3i = a2r * ai + a2i * ar, a4r = a2r * a2r - a2i * a2i, a4i = 2.f * a2r * a2i;
            float h1r[MT], h1i[MT], h2r[MT], h2i[MT], h3r[MT], h3i[MT], er[MT], ei[MT], cr[MT], ci[MT];
#pragma unroll
            for (int mt = 0; mt < MT; ++mt) {
                const f32x4 sr = acc[mt][i], si = acc[mt][2 + i];
                h1r[mt] = sr[0]; h1i[mt] = si[0];
                h2r[mt] = ar * h1r[mt] - ai * h1i[mt] + sr[1]; h2i[mt] = ar * h1i[mt] + ai * h1r[mt] + si[1];
                h3r[mt] = ar * h2r[mt] - ai * h2i[mt] + sr[2]; h3i[mt] = ar * h2i[mt] + ai * h2r[mt] + si[2];
                er[mt] = ar * h3r[mt] - ai * h3i[mt] + sr[3]; ei[mt] = ar * h3i[mt] + ai * h3r[mt] + si[3];
                cr[mt] = 0.f; ci[mt] = 0.f;
            }
            float kr = 0.f, ki = 0.f;
#pragma unroll
            for (int gi = 0; gi < 4 * MT; ++gi) {
                const int mt = gi >> 2, src = (gi & 3) * 16 + fr;
                const float xr = __shfl(er[mt], src), xi = __shfl(ei[mt], src);
                if ((gi & 3) == fq) { cr[mt] = kr; ci[mt] = ki; }
                const float nr = a4r * kr - a4i * ki + xr, ni = a4r * ki + a4i * kr + xi; kr = nr; ki = ni;
            }
            if (fq == 0) { F.out[O_PRE + ((size_t)b * 32 + g) * 64 + n] = kr; F.out[O_PIM + ((size_t)b * 32 + g) * 64 + n] = ki; }
#pragma unroll
            for (int mt = 0; mt < MT; ++mt) {
                const int c0 = mt * 16 + fq * 4;
                float* hp = HIN + (((size_t)b * 64 + c0) * 32 + g) * 128 + n;
                const float kr0 = cr[mt], ki0 = ci[mt];
                hp[0] = kr0; hp[64] = ki0;
                hp[4096] = ar * kr0 - ai * ki0 + h1r[mt]; hp[4096 + 64] = ar * ki0 + ai * kr0 + h1i[mt];
                hp[8192] = a2r * kr0 - a2i * ki0 + h2r[mt]; hp[8192 + 64] = a2r * ki0 + a2i * kr0 + h2i[mt];
                hp[12288] = a3r * kr0 - a3i * ki0 + h3r[mt]; hp[12288 + 64] = a3r * ki0 + a3i * kr0 + h3i[mt];
            }
            }
        }
    }
}

DI void p23_phase(const Frame& F) {
    constexpr int T_SSM = 36, T_ATT = 272, T_P3 = 528;
    unsigned* hc = WSP(unsigned, WS_CTL) + 3584 + 224;
    LAS float* ob = (LAS float*)F.lds;
    for (int t = F.bid; t < T_SSM; t += F.G) {
        const int wt = t * 8 + F.wave;
        if (wt < 256) ssm_state<4, false>(F, wt >> 5, wt & 31); else ssm_state<1, true>(F, 0, wt - 256);
        asm volatile("s_waitcnt vmcnt(0)" ::: "memory");
        __syncthreads();
        if (F.tid == 0 && t < 32) {
            __builtin_amdgcn_fence(__ATOMIC_RELEASE, "agent");
            asm volatile("s_waitcnt vmcnt(0)" ::: "memory");
            (void)__hip_atomic_fetch_add((GAS unsigned*)(hc + (t >> 2)), 1u, __ATOMIC_RELAXED, __HIP_MEMORY_SCOPE_AGENT);
        }
    }
    const int t0 = (F.bid >= T_SSM % F.G) ? F.bid - T_SSM % F.G : F.bid + F.G - T_SSM % F.G;
    for (int a = t0; a < T_ATT; a += F.G) {
        const int h = F.wave, kvh = h >> 2;
        const float sink = F.in[19][h]; const float* gat = F.in[21];
        if (a < 256) {
            const int b = a >> 5, c = a & 31, c0 = c < 2 ? 0 : c - 2, row0 = b * SEQ + c * 64;
            attn_task(WSP(bf16_t, WS_Q) + ((size_t)h * (M / 16) + (row0 >> 4)) * 1024, 4, WSP(bf16_t, WS_KB) + ((size_t)kvh * (M / 16) + ((b * SEQ + c0 * 64) >> 4)) * 1024, (c - c0 + 1) * 4,
                      WSP(bf16_t, WS_VT) + ((size_t)(b * 2 + kvh) * 64 + c0 * 2) * 2048, 0, sink, gat, WSP(bf16_t, WS_MIX) + (size_t)row0 * D + 512, ob, h, F.wave, F.lane);
        } else {
            const int sb = a - 256, row0 = MP + sb * 32;
            attn_task(WSP(bf16_t, WS_Q) + ((size_t)h * (M / 16) + (row0 >> 4)) * 1024, 2, WSP(bf16_t, WS_KS) + (size_t)(sb * 2 + kvh) * 10 * 1024, 10,
                      WSP(bf16_t, WS_VTS) + (size_t)(sb * 2 + kvh) * 5 * 2048, 0, sink, gat, WSP(bf16_t, WS_MIX) + (size_t)row0 * D + 512, ob, h, F.wave, F.lane);
        }
    }
}
constexpr int P3_LDY = 520, P3_LDU = 72, P3_UST = 36864;
DI void p3_zero(const Frame& F) {
    LAS u32x4* z = (LAS u32x4*)(F.lds + P3_UST + F.wave * (64 * P3_LDU * 2));
    for (int i = F.lane; i < 32 * P3_LDU * 2 / 16; i += 64) z[i] = (u32x4){0u, 0u, 0u, 0u};
}
DI void p3_load_u(const Frame& F, int ci, u32x4 (&uv)[4]) {
    const int row0 = ci < 512 ? (ci >> 6) * SEQ + (ci & 63) * 32 : MP + (ci - 512) * 32;
    const bf16_t* up = WSP(bf16_t, WS_U) + (size_t)(row0 + (F.lane >> 3)) * 512 + F.wave * 64 + (F.lane & 7) * 8;
#pragma unroll
    for (int i = 0; i < 4; ++i) uv[i] = *(const u32x4*)(up + (size_t)i * 8 * 512);
}
DI void p3_task(const Frame& F, int ci, const u32x4 (&uv)[4]) {
    const int lane = F.lane, fr = lane & 15, fq = lane >> 4, wave = F.wave;
    const int row0 = ci < 512 ? (ci >> 6) * SEQ + (ci & 63) * 32 : MP + (ci - 512) * 32;
    constexpr int LDY = P3_LDY, LDU = P3_LDU;
    LAS bf16_t* y1 = (LAS bf16_t*)F.lds; LAS float* ssq = (LAS float*)(F.lds + 32 * LDY * 2);
    LAS bf16_t* ust = (LAS bf16_t*)(F.lds + P3_UST) + wave * (64 * LDU);
    LAS float* hst = (LAS float*)(F.lds + P3_UST + 8 * 64 * P3_LDU * 2) + wave * 512;
    f32x4 hv[2];
    {
        if (ci < 512) { const f32x4* hs = (const f32x4*)(WSP(float, WS_HIN) + ((size_t)ci * 32 + wave * 4) * 128); hv[0] = hs[lane]; hv[1] = hs[64 + lane]; }
        else {
#pragma unroll
            for (int j = 0; j < 2; ++j) { const int idx = lane + 64 * j, gg = wave * 4 + (idx >> 5), w = idx & 31;
                hv[j] = *(const f32x4*)((w < 16 ? F.in[2] : F.in[3]) + ((size_t)(ci - 512) * 32 + gg) * 64 + (w & 15) * 4); }
        }
#pragma unroll
        for (int i = 0; i < 4; ++i) *(LAS u32x4*)(ust + (32 + (lane >> 3) + 8 * i) * LDU + (lane & 7) * 8) = uv[i];
    }
#pragma unroll 1
    for (int gi = 0; gi < 4; ++gi) {
        const int g = wave * 4 + gi;
        f32x4 acc0 = (f32x4){0.f, 0.f, 0.f, 0.f}, acc1 = acc0;
        const bf16_t* Kg = WSP(bf16_t, WS_KT) + (size_t)g * 8192 + lane * 8;
        const LAS bf16_t* ub = ust + (32 + fr - (fq >> 1)) * LDU + gi * 16 + (fq & 1) * 8;
#pragma unroll
        for (int kk = 0; kk < 16; ++kk) {
            const bf16x8 kf = *(const bf16x8*)(Kg + kk * 512);
            acc1 = MFMA16(kf, *(const LAS bf16x8*)(ub + (16 - 2 * kk) * LDU), acc1);
            if (kk < 8) acc0 = MFMA16(kf, *(const LAS bf16x8*)(ub - 2 * kk * LDU), acc0);
        }
        if (gi == 0) { *(LAS f32x4*)(hst + lane * 4) = hv[0]; *(LAS f32x4*)(hst + 256 + lane * 4) = hv[1]; }
        const LAS float* hre = hst + gi * 128; const LAS float* him = hre + 64;
#pragma unroll
        for (int nh = 0; nh < 2; ++nh) {
            const int n0 = nh * 32 + fq * 8;
            const f32x4 hr0 = *(const LAS f32x4*)(hre + n0), hr1 = *(const LAS f32x4*)(hre + n0 + 4), hi0 = *(const LAS f32x4*)(him + n0), hi1 = *(const LAS f32x4*)(him + n0 + 4);
            const bf16_t* cp = WSP(bf16_t, WS_CT) + (size_t)g * 2048 + lane * 8;
            const bf16x8 cref = *(const bf16x8*)(cp + nh * 512), cimf = *(const bf16x8*)(cp + (2 + nh) * 512);
#pragma unroll
            for (int mt = 0; mt < 2; ++mt) {
                const float* pp = WSP(float, WS_PRE) + (size_t)g * 4096 + (mt * 2 + nh) * 1024 + lane * 4;
                const f32x4 pr0 = *(const f32x4*)pp, pr1 = *(const f32x4*)(pp + 256), pi0 = *(const f32x4*)(pp + 512), pi1 = *(const f32x4*)(pp + 768);
                const f32x4 gr0 = pr0 * hr0 - pi0 * hi0, gr1 = pr1 * hr1 - pi1 * hi1, gi0 = pr0 * hi0 + pi0 * hr0, gi1 = pr1 * hi1 + pi1 * hr1;
                const bf16x8 gre = __builtin_bit_cast(bf16x8, pack8(gr0, gr1)), gim = __builtin_bit_cast(bf16x8, pack8(gi0, gi1));
                if (mt == 0) { acc0 = MFMA16(cref, gre, acc0); acc0 = MFMA16(cimf, gim, acc0); }
                else         { acc1 = MFMA16(cref, gre, acc1); acc1 = MFMA16(cimf, gim, acc1); }
            }
        }
        {   u32x2 w; w.x = pk2(gelu_tanh(acc0[0]), gelu_tanh(acc0[1])); w.y = pk2(gelu_tanh(acc0[2]), gelu_tanh(acc0[3]));
            *(LAS u32x2*)(y1 + fr * LDY + g * 16 + fq * 4) = w;
            w.x = pk2(gelu_tanh(acc1[0]), gelu_tanh(acc1[1])); w.y = pk2(gelu_tanh(acc1[2]), gelu_tanh(acc1[3]));
            *(LAS u32x2*)(y1 + (16 + fr) * LDY + g * 16 + fq * 4) = w; }
    }
    __syncthreads();
    f32x4 a2[2][4];
#pragma unroll
    for (int mt = 0; mt < 2; ++mt)
#pragma unroll
        for (int nt = 0; nt < 4; ++nt) a2[mt][nt] = (f32x4){0.f, 0.f, 0.f, 0.f};
    const bf16_t* Wg = WSP(bf16_t, WS_WGLU) + (size_t)(wave * 4) * 8192 + lane * 8;
#pragma unroll 4
    for (int kk = 0; kk < 16; ++kk) {
        bf16x8 yf[2], wf[4];
#pragma unroll
        for (int mt = 0; mt < 2; ++mt) yf[mt] = *(const LAS bf16x8*)(y1 + (mt * 16 + fr) * LDY + kk * 32 + fq * 8);
#pragma unroll
        for (int nt = 0; nt < 4; ++nt) wf[nt] = *(const bf16x8*)(Wg + (size_t)nt * 8192 + kk * 512);
#pragma unroll
        for (int mt = 0; mt < 2; ++mt)
#pragma unroll
            for (int nt = 0; nt < 4; ++nt) a2[mt][nt] = MFMA16(wf[nt], yf[mt], a2[mt][nt]);
    }
    float q2[2] = {0.f, 0.f};
#pragma unroll
    for (int mt = 0; mt < 2; ++mt)
#pragma unroll
        for (int nt = 0; nt < 4; ++nt) {
            const int n = wave * 64 + nt * 16 + fq * 4;
            const f32x4 bias = *(const f32x4*)(F.in[18] + n);
            const u32x2 yw = *(const LAS u32x2*)(y1 + (mt * 16 + fr) * LDY + n);
            const float y0 = bflo(yw.x), y1v = bfhi(yw.x), y2v = bflo(yw.y), y3 = bfhi(yw.y);
            f32x4 r; r[0] = y0 * sigm(a2[mt][nt][0] + bias[0]); r[1] = y1v * sigm(a2[mt][nt][1] + bias[1]); r[2] = y2v * sigm(a2[mt][nt][2] + bias[2]); r[3] = y3 * sigm(a2[mt][nt][3] + bias[3]);
            a2[mt][nt] = r; q2[mt] += r[0] * r[0] + r[1] * r[1] + r[2] * r[2] + r[3] * r[3];
        }
    q2[0] = xsum4(q2[0]); q2[1] = xsum4(q2[1]);
    if (fq == 0) { ssq[wave * 32 + fr] = q2[0]; ssq[wave * 32 + 16 + fr] = q2[1]; }
    __syncthreads();
#pragma unroll
    for (int mt = 0; mt < 2; ++mt) {
        float tot = 0.f;
#pragma unroll
        for (int w = 0; w < 8; ++w) tot += ssq[w * 32 + mt * 16 + fr];
        const float rs = rsqrtf(tot * (1.0f / 512.0f) + EPS);
#pragma unroll
        for (int nt = 0; nt < 4; ++nt) {
            const int n = wave * 64 + nt * 16 + fq * 4;
            const f32x4 g = *(const f32x4*)(F.in[20] + n);
            u32x2 w; w.x = pk2(a2[mt][nt][0] * rs * g[0], a2[mt][nt][1] * rs * g[1]); w.y = pk2(a2[mt][nt][2] * rs * g[2], a2[mt][nt][3] * rs * g[3]);
            *(u32x2*)(WSP(bf16_t, WS_MIX) + (size_t)(row0 + mt * 16 + fr) * D + n) = w;
        }
    }
    __syncthreads();
}

DI void late_weights(const Frame& F) {
    constexpr int T_WO = 128, T_WA = 8 * 44, T_WD = 22 * 16;
    LAS float* scr = (LAS float*)F.lds;
    const int nskip = ((36 + 272 + 528) % F.G), G = F.G - nskip;
    if (F.bid < nskip || G <= 0) return;
    int r = F.bid - nskip;
#define P0_LOOP(COUNT) for (int i = r; i < (COUNT); i += G)
#define P0_NEXT(COUNT) r = (r + G - (COUNT) % G) % G
    P0_LOOP(T_WO) p0_transpose(F.in[22], D, nullptr, WSP(bf16_t, WS_WO), D, (i % 8) * 128, (i / 8) * 64, (i / 8) * 64, scr, F.tid);
    P0_NEXT(T_WO);
    P0_LOOP(T_WA) { const int n0 = (i / 8) * 64; p0_transpose(F.in[24], FF, F.in[23], WSP(bf16_t, WS_W1), D, (i % 8) * 128, n0, (n0 >> 7) * 256 + (n0 & 127), scr, F.tid); }
    P0_NEXT(T_WA);
    P0_LOOP(T_WA) { const int n0 = (i / 8) * 64; p0_transpose(F.in[25], FF, F.in[23], WSP(bf16_t, WS_W1), D, (i % 8) * 128, n0, (n0 >> 7) * 256 + 128 + (n0 & 127), scr, F.tid); }
    P0_NEXT(T_WA);
    P0_LOOP(T_WD) p0_transpose(F.in[28], D, nullptr, WSP(bf16_t, WS_W2), FF, (i % 22) * 128, (i / 22) * 64, (i / 22) * 64, scr, F.tid);
    P0_NEXT(T_WD);
#undef P0_LOOP
#undef P0_NEXT
}

DI void p3_loop(const Frame& F) {
    constexpr int T_PRE = 36 + 272, T_P3 = 528;
    unsigned* hc = WSP(unsigned, WS_CTL) + 3584 + 224;
    p3_zero(F);
    const int r0 = T_PRE % F.G, c0 = (F.bid >= r0) ? F.bid - r0 : F.bid + F.G - r0;
    u32x4 uv[4];
    if (c0 < T_P3) p3_load_u(F, c0, uv);
    for (int ci = c0; ci < T_P3; ci += F.G) {
        u32x4 un[4];
        if (ci + F.G < T_P3) p3_load_u(F, ci + F.G, un);
        if (ci < 512) {
            if (F.tid == 0) {
                while (__hip_atomic_load((GAS unsigned*)(hc + (ci >> 6)), __ATOMIC_RELAXED, __HIP_MEMORY_SCOPE_AGENT) < 4u) __builtin_amdgcn_s_sleep(1);
                __builtin_amdgcn_fence(__ATOMIC_ACQUIRE, "agent");
                asm volatile("s_waitcnt vmcnt(0)" ::: "memory");
            }
            __syncthreads();
        }
        p3_task(F, ci, uv);
#pragma unroll
        for (int i = 0; i < 4; ++i) uv[i] = un[i];
    }
}

DI void panel_rs(float* part, unsigned* cnt, LAS float* lx, int pm, int pn, float* rs_out = nullptr) {
    const int tid = threadIdx.x;
    __syncthreads();
    if (tid < 256) st_agent(part + (size_t)(pm * 4 + pn) * 256 + tid, lx[tid] + lx[256 + tid] + lx[512 + tid] + lx[768 + tid]);
    asm volatile("s_waitcnt vmcnt(0)" ::: "memory");
    __syncthreads();
    if (tid == 0) arrive_and_wait(cnt + pm, 4u);
    __syncthreads();
    if (tid < 256) { const float* pp = part + (size_t)pm * 1024 + tid; const float r = rsqrtf((ld_agent(pp) + ld_agent(pp + 256) + ld_agent(pp + 512) + ld_agent(pp + 768)) * (1.0f / D) + EPS); lx[1024 + tid] = r;
        if (rs_out && pn == 0) rs_out[pm * 256 + tid] = r; }
    __syncthreads();
}
struct EpiOut {
    static constexpr bool PERM = true, AFTER_DRAIN = false;
    const float* xp; float* RS; bf16_t* X1B; float* part; unsigned* cnt; LAS float* lx;
    DI void operator()(const f32x4 (&acc_)[2][2][4][2], const pg8::Unit& u, int wr, int wc, int fr, int fq) const {
        f32x4 (&acc)[2][2][4][2] = const_cast<f32x4 (&)[2][2][4][2]>(acc_);
        const int row0 = u.pm * 256 + wr * 64 + fr, col0 = u.pn * 256 + wc * 32 + 8 * fq;
#pragma unroll
        for (int ai = 0; ai < 2; ++ai)
#pragma unroll
            for (int m = 0; m < 4; ++m) {
                const size_t ro = (size_t)(row0 + ai * 128 + m * 16) * D + col0;
                float q = 0.f;
#pragma unroll
                for (int bj = 0; bj < 2; ++bj) {
                    const f32x4 v0 = acc[ai][bj][m][0] + *(const f32x4*)(xp + ro + bj * 128), v1 = acc[ai][bj][m][1] + *(const f32x4*)(xp + ro + bj * 128 + 4);
                    acc[ai][bj][m][0] = v0; acc[ai][bj][m][1] = v1;
                    q += v0[0] * v0[0] + v0[1] * v0[1] + v0[2] * v0[2] + v0[3] * v0[3] + v1[0] * v1[0] + v1[1] * v1[1] + v1[2] * v1[2] + v1[3] * v1[3];
                }
                q = xsum4(q);
                if (fq == 0) lx[wc * 256 + ai * 128 + wr * 64 + m * 16 + fr] = q;
            }
        panel_rs(part, cnt, lx, u.pm, u.pn, RS);
#pragma unroll
        for (int ai = 0; ai < 2; ++ai)
#pragma unroll
            for (int m = 0; m < 4; ++m) {
                const float rs = lx[1024 + ai * 128 + wr * 64 + m * 16 + fr];
                const size_t ro = (size_t)(row0 + ai * 128 + m * 16) * D + col0;
#pragma unroll
                for (int bj = 0; bj < 2; ++bj) *(u32x4*)(X1B + ro + bj * 128) = pack8(acc[ai][bj][m][0] * rs, acc[ai][bj][m][1] * rs);
            }
    }
};

struct EpiFfn {
    static constexpr bool PERM = true, AFTER_DRAIN = false;
    unsigned char* ws; const float* const* in; float* out; LAS float* bnd;
    DI void operator()(const f32x4 (&acc)[2][2][4][2], const pg8::Unit& u, int wr, int wc, int fr, int fq) const {
        const bf16_t* const X1B = (const bf16_t*)(ws + WS_X1B); const bf16_t* const W1T = (const bf16_t*)(ws + WS_W1);
        bf16_t* const H = (bf16_t*)(ws + WS_H); const float* const cstate = in[6];
        const int pm = u.pm, pn = u.pn, rowt = pm * 256, wave = wr * 4 + wc, tid = threadIdx.x;
        const bool sample = pm >= 64;
        const int cl = wc * 32 + 8 * fq, ff = pn * 128 + cl;
        LAS float* cwl = bnd + 17 * 2 * 128;
        if (tid < 128) { const float* cw = in[26] + pn * 128 + tid; cwl[tid] = cw[0]; cwl[128 + tid] = cw[FF]; cwl[256 + tid] = cw[2 * FF]; cwl[384 + tid] = in[27][pn * 128 + tid]; }
#pragma unroll
        for (int ai = 0; ai < 2; ++ai)
#pragma unroll
            for (int m = 0; m < 4; ++m) {
                const int blk = 8 * ai + 4 * wr + m;
                if (fr >= 14) {
                    const f32x4 a0 = acc[ai][0][m][0], a1 = acc[ai][0][m][1];
                    if (!sample || (blk & 1) == 0) { LAS float* bp = bnd + ((blk + 1) * 2 + (fr - 14)) * 128 + cl; *(LAS f32x4*)bp = a0; *(LAS f32x4*)(bp + 4) = a1; }
                    if (sample && (blk & 1)) { float* sp = out + O_SCONV + ((size_t)((pm - 64) * 8 + (blk >> 1)) * 2 + (fr - 14)) * FF + ff; *(f32x4*)sp = a0; *(f32x4*)(sp + 4) = a1; }
                    if (!sample && (pm & 7) == 7 && blk == 15) { float* sp = out + O_PCONV + ((size_t)(pm >> 3) * 2 + (fr - 14)) * FF + ff; *(f32x4*)sp = a0; *(f32x4*)(sp + 4) = a1; }
                    if (sample && (blk & 1) == 0) {
                        const float* sp = cstate + ((size_t)((pm - 64) * 8 + (blk >> 1)) * 2 + (fr - 14)) * FF + ff;
                        LAS float* bp = bnd + (blk * 2 + (fr - 14)) * 128 + cl; *(LAS f32x4*)bp = *(const f32x4*)sp; *(LAS f32x4*)(bp + 4) = *(const f32x4*)(sp + 4);
                    }
                    if (!sample && (pm & 7) == 0 && blk == 0) { LAS float* bp = bnd + (fr - 14) * 128 + cl; *(LAS f32x4*)bp = (f32x4){0.f, 0.f, 0.f, 0.f}; *(LAS f32x4*)(bp + 4) = (f32x4){0.f, 0.f, 0.f, 0.f}; }
                }
            }
        if (!sample && (pm & 7) != 0) {
            const int lane = fq * 16 + fr;
            const bf16_t* xp = X1B + (size_t)(rowt - 2) * D + lane * 8;
            const u32x4 xa0 = *(const u32x4*)xp, xa1 = *(const u32x4*)(xp + 512), xb0 = *(const u32x4*)(xp + D), xb1 = *(const u32x4*)(xp + D + 512);
#pragma unroll 1
            for (int ps = 0; ps < 4; ++ps) {
                float p0[4], p1[4];
                const bf16_t* wp = W1T + (size_t)(pn * 256 + wave * 16 + ps * 4) * D + lane * 8;
#pragma unroll
                for (int c = 0; c < 4; ++c) {
                    const u32x4 a = *(const u32x4*)(wp + (size_t)c * D), b = *(const u32x4*)(wp + (size_t)c * D + 512);
                    float s0 = 0.f, s1 = 0.f;
#pragma unroll
                    for (int j = 0; j < 4; ++j) {
                        s0 = dot2bf(a[j], xa0[j], s0); s0 = dot2bf(b[j], xa1[j], s0);
                        s1 = dot2bf(a[j], xb0[j], s1); s1 = dot2bf(b[j], xb1[j], s1);
                    }
                    p0[c] = s0; p1[c] = s1;
                }
#define HALO_STEP(N, BIT) _Pragma("unroll") for (int c = 0; c < N; ++c) { const bool hi_ = (lane & BIT) != 0; \
                    const float s0_ = hi_ ? p0[c] : p0[c + N], s1_ = hi_ ? p1[c] : p1[c + N]; \
                    const float r0_ = __shfl_xor(s0_, BIT), r1_ = __shfl_xor(s1_, BIT); \
                    p0[c] = (hi_ ? p0[c + N] : p0[c]) + r0_; p1[c] = (hi_ ? p1[c + N] : p1[c]) + r1_; }
                HALO_STEP(2, 32) HALO_STEP(1, 16)
#undef HALO_STEP
                float t0 = p0[0], t1 = p1[0];
                t0 += __shfl_xor(t0, 8); t1 += __shfl_xor(t1, 8); t0 += __shfl_xor(t0, 4); t1 += __shfl_xor(t1, 4); t0 += __shfl_xor(t0, 2); t1 += __shfl_xor(t1, 2); t0 += __shfl_xor(t0, 1); t1 += __shfl_xor(t1, 1);
                if ((lane & 15) == 0) { const int col = wave * 16 + ps * 4 + ((lane >> 5) & 1) * 2 + ((lane >> 4) & 1);
                    bnd[col] = t0; bnd[128 + col] = t1; }
            }
        }
        __syncthreads();
#pragma unroll
        for (int ai = 0; ai < 2; ++ai)
#pragma unroll
            for (int m = 0; m < 4; ++m) {
                const int blk = 8 * ai + 4 * wr + m, row = rowt + ai * 128 + wr * 64 + m * 16 + fr;
                f32x4 hv[2];
#pragma unroll
                for (int n = 0; n < 2; ++n) {
                    const f32x4 cur = acc[ai][0][m][n], upv = acc[ai][1][m][n];
                    f32x4 p1, p2;
#pragma unroll
                    for (int e = 0; e < 4; ++e) { p1[e] = dpp_shr<0x111>(cur[e]); p2[e] = dpp_shr<0x112>(cur[e]); }
                    const f32x4 b0 = *(const LAS f32x4*)(bnd + (blk * 2 + 0) * 128 + cl + 4 * n), b1 = *(const LAS f32x4*)(bnd + (blk * 2 + 1) * 128 + cl + 4 * n);
                    if (fr == 0) { p1 = b1; p2 = b0; } else if (fr == 1) { p2 = b1; }
                    const LAS float* wl = cwl + cl + 4 * n;
                    const f32x4 c = *(const LAS f32x4*)(wl + 384) + *(const LAS f32x4*)wl * p2 + *(const LAS f32x4*)(wl + 128) * p1 + *(const LAS f32x4*)(wl + 256) * cur;
#pragma unroll
                    for (int e = 0; e < 4; ++e) hv[n][e] = c[e] * sigm(c[e]) * upv[e];
                }
                *(u32x4*)(H + (size_t)row * FF + ff) = pack8(hv[0], hv[1]);
            }
        __syncthreads();
    }
};

struct EpiDown {
    static constexpr bool PERM = true, AFTER_DRAIN = false;
    float* out; const bf16_t* X1B; const float* RS; const float* gfin; float* part; unsigned* cnt; LAS float* lx;
    DI void operator()(const f32x4 (&acc_)[2][2][4][2], const pg8::Unit& u, int wr, int wc, int fr, int fq) const {
        f32x4 (&acc)[2][2][4][2] = const_cast<f32x4 (&)[2][2][4][2]>(acc_);
        const int row0 = u.pm * 256 + wr * 64 + fr, col0 = u.pn * 256 + wc * 32 + 8 * fq;
#pragma unroll
        for (int ai = 0; ai < 2; ++ai)
#pragma unroll
            for (int m = 0; m < 4; ++m) {
                const int row = row0 + ai * 128 + m * 16;
                const bf16_t* xrow = X1B + (size_t)row * D + col0;
                const float ir = 1.0f / RS[row];
                float q = 0.f;
#pragma unroll
                for (int bj = 0; bj < 2; ++bj) {
                    const u32x4 xw = *(const u32x4*)(xrow + bj * 128);
                    const f32x4 x0 = (f32x4){bflo(xw.x), bfhi(xw.x), bflo(xw.y), bfhi(xw.y)}, x1v = (f32x4){bflo(xw.z), bfhi(xw.z), bflo(xw.w), bfhi(xw.w)};
                    const f32x4 v0 = acc[ai][bj][m][0] + x0 * ir, v1 = acc[ai][bj][m][1] + x1v * ir;
                    acc[ai][bj][m][0] = v0; acc[ai][bj][m][1] = v1;
                    q += v0[0] * v0[0] + v0[1] * v0[1] + v0[2] * v0[2] + v0[3] * v0[3] + v1[0] * v1[0] + v1[1] * v1[1] + v1[2] * v1[2] + v1[3] * v1[3];
                }
                q = xsum4(q);
                if (fq == 0) lx[wc * 256 + ai * 128 + wr * 64 + m * 16 + fr] = q;
            }
        panel_rs(part, cnt, lx, u.pm, u.pn);
        f32x4 gv[2][2];
#pragma unroll
        for (int bj = 0; bj < 2; ++bj) { gv[bj][0] = *(const f32x4*)(gfin + col0 + bj * 128); gv[bj][1] = *(const f32x4*)(gfin + col0 + bj * 128 + 4); }
#pragma unroll
        for (int ai = 0; ai < 2; ++ai)
#pragma unroll
            for (int m = 0; m < 4; ++m) {
                float* orow = out + (size_t)(row0 + ai * 128 + m * 16) * D + col0;
                const float rs = lx[1024 + ai * 128 + wr * 64 + m * 16 + fr];
#pragma unroll
                for (int bj = 0; bj < 2; ++bj) { *(f32x4*)(orow + bj * 128) = acc[ai][bj][m][0] * rs * gv[bj][0]; *(f32x4*)(orow + bj * 128 + 4) = acc[ai][bj][m][1] * rs * gv[bj][1]; }
            }
    }
};


template <int K> DI f32x4 mini_tile_ks(const Frame& F, const bf16_t* __restrict__ A, const bf16_t* __restrict__ Bt, int row0, int col0) {
    constexpr int KC = 256, LDT = 264, NCH = K / KC, LDR = 68;
    const int tid = F.tid, lane = F.lane, fr = lane & 15, fq = lane >> 4, mt = F.wave & 1, nt = F.wave >> 1;
    LAS bf16_t* tile = (LAS bf16_t*)F.lds;
    const bf16_t* src[6]; int dst[6];
#pragma unroll
    for (int j = 0; j < 6; ++j) { const int p = tid + 512 * j, r = p >> 5, c = (p & 31) * 8;
        src[j] = (r < 32 ? A + (size_t)(row0 + r) * K : Bt + (size_t)(col0 + r - 32) * K) + c; dst[j] = r * LDT + c; }
    u32x4 pre[6];
#pragma unroll
    for (int j = 0; j < 6; ++j) pre[j] = *(const u32x4*)src[j];
    f32x4 acc = (f32x4){0.f, 0.f, 0.f, 0.f};
#pragma unroll 1
    for (int ch = 0; ch < NCH; ++ch) {
#pragma unroll
        for (int j = 0; j < 6; ++j) *(LAS u32x4*)(tile + dst[j]) = pre[j];
        __syncthreads();
        if (ch + 1 < NCH) {
#pragma unroll
            for (int j = 0; j < 6; ++j) pre[j] = *(const u32x4*)(src[j] + (size_t)(ch + 1) * KC);
        }
        const LAS bf16_t* xa = tile + (mt * 16 + fr) * LDT + fq * 8;
        const LAS bf16_t* wb = tile + (32 + nt * 16 + fr) * LDT + fq * 8;
#pragma unroll
        for (int ks = 0; ks < KC / 32; ++ks) acc = MFMA16(*(const LAS bf16x8*)(wb + ks * 32), *(const LAS bf16x8*)(xa + ks * 32), acc);
        __syncthreads();
    }
    LAS float* red = (LAS float*)F.lds;
    *(LAS f32x4*)(red + (mt * 16 + fr) * LDR + nt * 16 + fq * 4) = acc;
    __syncthreads();
    const f32x4 out = *(const LAS f32x4*)(red + (tid >> 4) * LDR + (tid & 15) * 4);
    __syncthreads();
    return out;
}
constexpr int MINI_PARK = LDS_X + 8192;
DI void p4_sample_a(const Frame& F) {
    if (F.bid >= 256) return;
    float* PS = WSP(float, WS_PARTS); unsigned* cnt = WSP(unsigned, WS_CTL) + 3584 + 192;
    const int t = F.bid, rg = t & 15, cg = t >> 4, rl = F.tid >> 4, row = MP + rg * 32 + rl, n0 = cg * 64 + (F.tid & 15) * 4;
    const f32x4 acc = mini_tile_ks<D>(F, WSP(bf16_t, WS_MIX), WSP(bf16_t, WS_WO), MP + rg * 32, cg * 64);
    const f32x4 v = acc + *(const f32x4*)(F.in[1] + (size_t)(row - MP) * D + n0);
    float q = v[0] * v[0] + v[1] * v[1] + v[2] * v[2] + v[3] * v[3];
    q += __shfl_xor(q, 1); q += __shfl_xor(q, 2); q += __shfl_xor(q, 4); q += __shfl_xor(q, 8);
    if ((F.tid & 15) == 0) st_agent(PS + (size_t)(rg * 16 + cg) * 32 + rl, q);
    *(LAS f32x4*)(F.lds + MINI_PARK + F.tid * 16) = v;
    asm volatile("s_waitcnt vmcnt(0)" ::: "memory");
    __syncthreads();
    if (F.tid == 0) (void)__hip_atomic_fetch_add((GAS unsigned*)(cnt + rg), 1u, __ATOMIC_RELAXED, __HIP_MEMORY_SCOPE_AGENT);
}
DI void p4_sample_b(const Frame& F) {
    if (F.bid >= 256) return;
    float* PS = WSP(float, WS_PARTS); unsigned* cnt = WSP(unsigned, WS_CTL) + 3584 + 192;
    const int t = F.bid, rg = t & 15, cg = t >> 4, rl = F.tid >> 4, row = MP + rg * 32 + rl, n0 = cg * 64 + (F.tid & 15) * 4;
    if (F.tid == 0) wait_ge16(cnt + rg);
    __syncthreads();
    float tot = 0.f;
#pragma unroll
    for (int c = 0; c < 16; ++c) tot += ld_agent(PS + (size_t)(rg * 16 + c) * 32 + rl);
    const float rs = rsqrtf(tot * (1.0f / D) + EPS);
    const f32x4 v = *(const LAS f32x4*)(F.lds + MINI_PARK + F.tid * 16);
    *(f32x4*)(WSP(float, WS_X1F) + (size_t)row * D + n0) = v;
    u32x2 w; w.x = pk2(v[0] * rs, v[1] * rs); w.y = pk2(v[2] * rs, v[3] * rs); *(u32x2*)(WSP(bf16_t, WS_X1B) + (size_t)row * D + n0) = w;
}
DI void p6_sample_a(const Frame& F) {
    if (F.bid >= 256) return;
    float* PS = WSP(float, WS_PARTS); unsigned* cnt = WSP(unsigned, WS_CTL) + 3584 + 208;
    const int t = F.bid, rg = t & 15, cg = t >> 4, rl = F.tid >> 4, row = MP + rg * 32 + rl, n0 = cg * 64 + (F.tid & 15) * 4;
    const f32x4 acc = mini_tile_ks<FF>(F, WSP(bf16_t, WS_H), WSP(bf16_t, WS_W2), MP + rg * 32, cg * 64);
    const f32x4 v = acc + *(const f32x4*)(WSP(float, WS_X1F) + (size_t)row * D + n0);
    float q = v[0] * v[0] + v[1] * v[1] + v[2] * v[2] + v[3] * v[3];
    q += __shfl_xor(q, 1); q += __shfl_xor(q, 2); q += __shfl_xor(q, 4); q += __shfl_xor(q, 8);
    if ((F.tid & 15) == 0) st_agent(PS + (size_t)(rg * 16 + cg) * 32 + rl, q);
    *(LAS f32x4*)(F.lds + MINI_PARK + F.tid * 16) = v;
    asm volatile("s_waitcnt vmcnt(0)" ::: "memory");
    __syncthreads();
    if (F.tid == 0) (void)__hip_atomic_fetch_add((GAS unsigned*)(cnt + rg), 1u, __ATOMIC_RELAXED, __HIP_MEMORY_SCOPE_AGENT);
}
DI void p6_sample_b(const Frame& F) {
    if (F.bid >= 256) return;
    float* PS = WSP(float, WS_PARTS); unsigned* cnt = WSP(unsigned, WS_CTL) + 3584 + 208;
    const int t = F.bid, rg = t & 15, cg = t >> 4, rl = F.tid >> 4, row = MP + rg * 32 + rl, n0 = cg * 64 + (F.tid & 15) * 4;
    if (F.tid == 0) wait_ge16(cnt + rg);
    __syncthreads();
    float tot = 0.f;
#pragma unroll
    for (int c = 0; c < 16; ++c) tot += ld_agent(PS + (size_t)(rg * 16 + c) * 32 + rl);
    const float rs = rsqrtf(tot * (1.0f / D) + EPS);
    const f32x4 v = *(const LAS f32x4*)(F.lds + MINI_PARK + F.tid * 16);
    *(f32x4*)(F.out + (size_t)row * D + n0) = v * rs * *(const f32x4*)(F.in[29] + n0);
}

#define RLX_AGENT __ATOMIC_RELAXED, __HIP_MEMORY_SCOPE_AGENT
#define XB_TMO      128
#define XB_XCNT(j)  (256  + 64 * (j))
#define XB_XSUB(j)  (1280 + 64 * (j))
#define XB_XGEN(j)  (2304 + 64 * (j))
#define XB_TOP      3328
#define XB_TOPGEN   3392
#define XCD_BAR_WORDS 3456
#define XB_SPIN_CAP (1u << 18)

__device__ __forceinline__ unsigned xb_ld(unsigned* p)              { return __hip_atomic_load(p, __ATOMIC_RELAXED, __HIP_MEMORY_SCOPE_AGENT); }
__device__ __forceinline__ unsigned xb_add(unsigned* p, unsigned v) { return __hip_atomic_fetch_add(p, v, __ATOMIC_RELAXED, __HIP_MEMORY_SCOPE_AGENT); }
__device__ __forceinline__ unsigned xb_xcc_id() { return (unsigned)__builtin_amdgcn_s_getreg((3 << 11) | 20) & 0xFu; }
#define XB_SPIN(cond, bar) do { unsigned _sp = 0; while (cond) { __builtin_amdgcn_s_sleep(1); \
    if ((++_sp & 255u) == 0u) { if (xb_ld(&(bar)[XB_TMO])) break; if (_sp > XB_SPIN_CAP) { atomicAdd(&(bar)[XB_TMO], 1u); break; } } } } while (0)

struct XcdBarrier {
    unsigned* bar; unsigned x;
    volatile LAS unsigned* st;
};

__device__ __forceinline__ XcdBarrier xcd_barrier_post(unsigned* bar, volatile LAS unsigned* st) {
    XcdBarrier b; b.bar = bar; b.x = xb_xcc_id(); b.st = st;
    if (threadIdx.x == 0) (void)xb_add(&bar[XB_XCNT(b.x)], 1u);
    return b;
}
__device__ __forceinline__ void xcd_barrier_complete(unsigned* bar, unsigned x, unsigned& nloc, unsigned& nx) {
    const unsigned G = gridDim.x * gridDim.y * gridDim.z;
    unsigned sum, cnt, mine, sp = 0u;
    for (;;) {
        sum = 0u; cnt = 0u; mine = 0u;
#pragma unroll
        for (unsigned j = 0; j < 16; ++j) { const unsigned c = xb_ld(&bar[XB_XCNT(j)]); sum += c; cnt += (c > 0u) ? 1u : 0u; mine = (j == x) ? c : mine; }
        if (sum == G) break;
        __builtin_amdgcn_s_sleep(1);
        if ((++sp & 255u) == 0u) { if (xb_ld(&bar[XB_TMO])) break; if (sp > XB_SPIN_CAP) { atomicAdd(&bar[XB_TMO], 1u); break; } }
    }
    nloc = mine > 0u ? mine : 1u; nx = cnt > 0u ? cnt : 1u;
}

__device__ __forceinline__ void xcd_barrier(const XcdBarrier& b) {
    asm volatile("s_waitcnt vmcnt(0)" ::: "memory");
    __syncthreads();
    if (threadIdx.x == 0) {
        unsigned* bar = b.bar;
        __builtin_amdgcn_s_waitcnt(0);
        unsigned nloc = b.st[0], nx = b.st[1];
        if (nloc == 0u) { xcd_barrier_complete(bar, b.x, nloc, nx); b.st[0] = nloc; b.st[1] = nx; }
        const unsigned old = xb_add(&bar[XB_XSUB(b.x)], 1u);
        const unsigned gen = old / nloc;
        if (old + 1u == (gen + 1u) * nloc) {
            __builtin_amdgcn_fence(__ATOMIC_RELEASE, "agent");
            asm volatile("s_waitcnt vmcnt(0)" ::: "memory");
            const unsigned og = xb_add(&bar[XB_TOP], 1u);
            const unsigned tg = og / nx;
            if (og + 1u == (tg + 1u) * nx) xb_add(&bar[XB_TOPGEN], 1u);
            else XB_SPIN(xb_ld(&bar[XB_TOPGEN]) == tg, bar);
            __builtin_amdgcn_fence(__ATOMIC_ACQUIRE, "agent");
            xb_add(&bar[XB_XGEN(b.x)], 1u);
            asm volatile("s_waitcnt vmcnt(0)" ::: "memory");
        } else {
            XB_SPIN(xb_ld(&bar[XB_XGEN(b.x)]) == gen, bar);
            __builtin_amdgcn_fence(__ATOMIC_ACQUIRE, "agent");
            asm volatile("s_waitcnt vmcnt(0)" ::: "memory");
        }
    }
    __syncthreads();
}

DI void grid_bar(unsigned* ctr, unsigned target) {
    asm volatile("s_waitcnt vmcnt(0)" ::: "memory");
    __syncthreads();
    if (threadIdx.x == 0) {
        __builtin_amdgcn_fence(__ATOMIC_RELEASE, "agent");
        asm volatile("s_waitcnt vmcnt(0)" ::: "memory");
        (void)__hip_atomic_fetch_add(ctr, 1u, __ATOMIC_RELAXED, __HIP_MEMORY_SCOPE_AGENT);
        while (__hip_atomic_load(ctr, __ATOMIC_RELAXED, __HIP_MEMORY_SCOPE_AGENT) < target) __builtin_amdgcn_s_sleep(1);
        __builtin_amdgcn_fence(__ATOMIC_ACQUIRE, "agent");
        asm volatile("s_waitcnt vmcnt(0)" ::: "memory");
    }
    __syncthreads();
}

#ifndef PH_MASK
#define PH_MASK 255
#endif
__global__ void __launch_bounds__(512, 2) mega_fwd(Args args) {
    extern __shared__ __attribute__((aligned(16))) unsigned char lds_raw[];
    cg::grid_group grid = cg::this_grid();
    Frame F;
    F.lds = (LAS unsigned char*)lds_raw; F.tid = threadIdx.x; F.lane = F.tid & 63; F.wave = __builtin_amdgcn_readfirstlane(F.tid >> 6);
    F.G = gridDim.x; F.bid = blockIdx.x; F.in = args.in; F.out = args.out; F.ws = args.ws;
    const int lo = args.ph_lo, hi = args.ph_hi;
#define IN(k) (((PH_MASK >> (k)) & 1) && lo <= (k) && (k) < hi)
    volatile LAS unsigned* xb_st = (volatile LAS unsigned*)(F.lds + LDS_BYTES - 64);
    if (F.tid < 2) xb_st[F.tid] = 0u;
    __syncthreads();
    XcdBarrier xbar; xbar.bar = WSP(unsigned, WS_CTL); xbar.x = 0; xbar.st = xb_st;
    if (lo + 1 < hi) xbar = xcd_barrier_post(WSP(unsigned, WS_CTL), xb_st);
    unsigned bar_n = 0;
#ifdef USE_CG_SYNC
#define SEAM(k) do { if (lo <= (k) && (k) + 1 < hi) grid.sync(); } while (0)
#else
#ifdef USE_CENTRAL_BAR
#define SEAM(k) do { if (lo <= (k) && (k) + 1 < hi) { bar_n += (unsigned)F.G; grid_bar(WSP(unsigned, WS_CTL) + 3520, bar_n); } } while (0)
#else
#define SEAM(k) do { if (lo <= (k) && (k) + 1 < hi) xcd_barrier(xbar); } while (0)
#endif
#endif
    if (hi > 8) grid.sync();
#ifndef REP_MASK
#define REP_MASK 0
#endif
#define REPS(k) for (int rep_ = 0; rep_ < 1 + ((REP_MASK >> (k)) & 1); ++rep_)
    if (IN(0)) { p0_prologue(F); } SEAM(0);
#ifdef EXTRA_SYNC
    for (int i_ = 0; i_ < EXTRA_SYNC; ++i_) SEAM(0);
#endif
#if (REP_MASK >> 0) & 1
    p0_prologue(F); grid.sync();
#endif
    if (IN(1)) {
        pg8::Gemm g{WSP(bf16_t, WS_XN), WSP(bf16_t, WS_WIN), M, INW, D}; pg8::StaticOrder S; S.init(M, INW, F.G, F.bid);
        EpiIn E{F.ws, F.out};
        pg8::gemm_phase<EpiIn, pg8::StaticOrder, true, true>(F.lds, g, S, E);
        p1_tail(F);
    } SEAM(1);
    if (IN(2)) { p23_phase(F); p3_loop(F); late_weights(F); }
#if (REP_MASK >> 2) & 1
    p2_phase(F); grid.sync();
#endif
    SEAM(2);
#if (REP_MASK >> 3) & 1
    for (int t = F.bid; t < 528; t += F.G) p3_task(F, t); grid.sync();
#endif
    if (IN(4)) {
        p4_sample_a(F);
        pg8::Gemm g{WSP(bf16_t, WS_MIX), WSP(bf16_t, WS_WO), MP, D, D}; pg8::StaticOrder S; S.init(MP, D, F.G, F.bid);
        EpiOut E{F.in[0], WSP(float, WS_SSQ), WSP(bf16_t, WS_X1B), WSP(float, WS_PART), WSP(unsigned, WS_CTL) + 3584 + 128, (LAS float*)(F.lds + LDS_X)};
        pg8::gemm_phase<EpiOut, pg8::StaticOrder, true, true>(F.lds, g, S, E);
        p4_sample_b(F);
    } SEAM(4);
    if (IN(5)) {
        pg8::Gemm g{WSP(bf16_t, WS_X1B), WSP(bf16_t, WS_W1), M, 2 * FF, D}; pg8::StaticOrder S; S.init(M, 2 * FF, F.G, F.bid);
        EpiFfn E{F.ws, F.in, F.out, (LAS float*)(F.lds + LDS_X)};
        pg8::gemm_phase<EpiFfn, pg8::StaticOrder, true, true>(F.lds, g, S, E);
    } SEAM(5);
    if (IN(6)) {
        p6_sample_a(F);
        pg8::Gemm g{WSP(bf16_t, WS_H), WSP(bf16_t, WS_W2), MP, D, FF}; pg8::StaticOrder S; S.init(MP, D, F.G, F.bid);
        EpiDown E{F.out, WSP(bf16_t, WS_X1B), WSP(float, WS_SSQ), F.in[29], WSP(float, WS_PART), WSP(unsigned, WS_CTL) + 3584 + 64, (LAS float*)(F.lds + LDS_X)};
        pg8::gemm_phase<EpiDown, pg8::StaticOrder, true, true>(F.lds, g, S, E);
        p6_sample_b(F);
    }
#undef IN
#undef SEAM
}

extern "C" void kernel_launch(void* const* d_in, const int* in_sizes, int n_in, void* d_out, int out_size, void* d_ws, size_t ws_size, hipStream_t stream) {
    static int grid = 0;
    if (grid == 0) {
        if (n_in != 30 || ws_size < WS_END) { fprintf(stderr, "kernel_launch: unexpected n_in %d / ws_size %zu (need %zu)\n", n_in, ws_size, (size_t)WS_END); grid = -1; return; }
        int dev = 0, cus = 0, per_cu = 0;
        (void)hipGetDevice(&dev); (void)hipDeviceGetAttribute(&cus, hipDeviceAttributeMultiprocessorCount, dev);
        if (hipFuncSetAttribute((const void*)mega_fwd, hipFuncAttributeMaxDynamicSharedMemorySize, LDS_BYTES) != hipSuccess) { fprintf(stderr, "hipFuncSetAttribute failed\n"); grid = -1; return; }
        if (hipOccupancyMaxActiveBlocksPerMultiprocessor(&per_cu, (const void*)mega_fwd, 512, LDS_BYTES) != hipSuccess || per_cu < 1) { fprintf(stderr, "occupancy query: %d\n", per_cu); per_cu = 1; }
        (void)hipGetLastError();
        grid = cus * (per_cu > 1 ? 1 : per_cu);
        if (grid <= 0) grid = 256;
    }
    if (grid < 0) return;
    Args a{};
    for (int i = 0; i < 30; ++i) a.in[i] = (const float*)d_in[i];
    a.out = (float*)d_out; a.ws = (unsigned char*)d_ws;
    (void)hipMemsetAsync((unsigned char*)d_ws + WS_CTL, 0, 16384, stream);
#if N_LAUNCHES == 1
    a.ph_lo = 0; a.ph_hi = 8;
    void* kargs[] = {&a};
    hipError_t e = hipLaunchCooperativeKernel((const void*)mega_fwd, dim3(grid), dim3(512), kargs, LDS_BYTES, stream);
    if (e != hipSuccess) fprintf(stderr, "cooperative launch failed: %s (grid %d)\n", hipGetErrorString(e), grid);
#else
    for (int p = 0; p < 8; ++p) { a.ph_lo = p; a.ph_hi = p + 1; for (int r = 0; r < 1 + ((HOST_REP >> p) & 1); ++r) hipLaunchKernelGGL(mega_fwd, dim3(grid), dim3(512), LDS_BYTES, stream, a); }
#endif
}
```

```cpp
#include <hip/hip_runtime.h>
#include <hip/hip_cooperative_groups.h>
#include <cstdio>
#include <cstdint>
namespace cg = cooperative_groups;

namespace pg8 {
#define PG8_LAS __attribute__((address_space(3)))
typedef unsigned short bf16_t;
typedef short bf16x8 __attribute__((ext_vector_type(8)));
typedef float f32x4 __attribute__((ext_vector_type(4)));
typedef unsigned u32x4 __attribute__((ext_vector_type(4)));
constexpr int BM = 256, BK = 64, HALF = 128, HTB = HALF * BK * 2  , STAGE_BYTES = 8 * HTB, NXCD = 8, WGM = 8;

__host__ __device__ __forceinline__ int lds_byte(int r, int c) { const int st = (r >> 4) * 2 + (c >> 5), rr = r & 15, cc = c & 31, ob = rr * 64 + cc * 2; return st * 1024 + (ob ^ (((ob >> 9) & 1) << 5)); }
__host__ __device__ __forceinline__ void stage_rc(int b, int& R, int& C) { const int st = b / 1024, sb = b % 1024, swz = sb ^ (((sb >> 9) & 1) << 5); R = (st >> 1) * 16 + swz / 64; C = (st & 1) * 32 + (swz % 64) / 2; }
__host__ __device__ __forceinline__ int perm32(int rho) { const int n = rho >> 4, i = rho & 15; return 8 * (i >> 2) + 4 * n + (i & 3); }

struct Unit { int pm, pn; };
struct Gemm { const bf16_t* A; const bf16_t* Bt; int M, N, K; };

struct StaticOrder {
    int nM, nN, nwg, G, c;
    __host__ __device__ void init(int M, int N, int G_, int c_) { nM = M / BM; nN = N / BM; nwg = nM * nN; G = G_; c = c_; }
    __host__ __device__ bool next(int i, Unit& u) const {
        const long L = (long)i * G + c; if (L >= nwg) return false;
        int wgid = (int)L; { const int q = nwg / NXCD, r = nwg % NXCD, xcd = wgid % NXCD, off = wgid / NXCD; wgid = (xcd < r ? xcd * (q + 1) : r * (q + 1) + (xcd - r) * q) + off; }
        const int nig = WGM * nN, gid = wgid / nig, fm = gid * WGM, gsz = (nM - fm) < WGM ? (nM - fm) : WGM;
        u.pm = fm + ((wgid % nig) % gsz); u.pn = (wgid % nig) / gsz; return true;
    }
    __device__ __forceinline__ void a_ready(const Unit&) const {}
    __device__ __forceinline__ void done(const Unit&) const {}
};

__device__ __forceinline__ unsigned cvt_pk_bf16(float lo, float hi) { unsigned r; asm volatile("v_cvt_pk_bf16_f32 %0, %1, %2" : "=v"(r) : "v"(lo), "v"(hi)); return r; }
template <class Epi, class Sched, bool ALIGN_EPI = false, bool SP2 = false>
__device__ __forceinline__ void gemm_phase(PG8_LAS unsigned char* lds, const Gemm g, const Sched& S, const Epi& E) {
    const int tid = threadIdx.x, wid = __builtin_amdgcn_readfirstlane(tid >> 6), lane = tid & 63, wr = wid >> 2, wc = wid & 3, fr = lane & 15, fq = lane >> 4;
    const int K = g.K, nt = K / BK;
    unsigned voffA[2], voffB[2];
#pragma unroll
    for (int i = 0; i < 2; ++i) { int R, C; stage_rc(tid * 16 + i * 8192, R, C); const int Rb = Epi::PERM ? ((R & ~31) + perm32(R & 31)) : R;
        voffA[i] = (unsigned)(R * K + C) * 2u; voffB[i] = (unsigned)(Rb * K + C) * 2u; }
    const size_t kstep = (size_t)(BK * 2);
    const size_t hstep = (size_t)HALF * K * 2;
    const size_t tstep = 2 * hstep;
    const unsigned ldsw = (unsigned)wid * 1024u;
    const int aoff = lds_byte(wr * 64 + fr, fq * 8), boff = lds_byte(wc * 32 + fr, fq * 8);
#define PG8_SA(b, h) (((b) * 2 + (h)) * HTB)
#define PG8_SB(b, h) ((4 + (b) * 2 + (h)) * HTB)
#define PG8_STAGE(bufoff, gbase, voff) do { _Pragma("unroll") for (int _i = 0; _i < 2; ++_i) \
        __builtin_amdgcn_global_load_lds((const unsigned*)((const char*)(gbase) + (voff)[_i]), (PG8_LAS unsigned*)(lds + (bufoff) + ldsw + _i * 8192), 16, 0, 0); } while (0)
#define PG8_LDA(dst, b, h) do { _Pragma("unroll") for (int m = 0; m < 4; ++m) _Pragma("unroll") for (int k = 0; k < 2; ++k) dst[m][k] = *(const PG8_LAS bf16x8*)(lds + PG8_SA(b, h) + aoff + m * 2048 + k * 1024); } while (0)
#define PG8_LDB(dst, b, h) do { _Pragma("unroll") for (int n = 0; n < 2; ++n) _Pragma("unroll") for (int k = 0; k < 2; ++k) dst[n][k] = *(const PG8_LAS bf16x8*)(lds + PG8_SB(b, h) + boff + n * 2048 + k * 1024); } while (0)
#define PG8_MMA(ai, bj, At, Bt) do { __builtin_amdgcn_s_setprio(1); _Pragma("unroll") for (int m = 0; m < 4; ++m) _Pragma("unroll") for (int n = 0; n < 2; ++n) _Pragma("unroll") for (int k = 0; k < 2; ++k) \
        acc[ai][bj][m][n] = __builtin_amdgcn_mfma_f32_16x16x32_bf16(Bt[n][k], At[m][k], acc[ai][bj][m][n], 0, 0, 0); __builtin_amdgcn_s_setprio(0); } while (0)
#define PG8_WAIT_V(n) asm volatile("s_waitcnt vmcnt(" #n ")" ::: "memory")
#define PG8_WAIT_L(n) asm volatile("s_waitcnt lgkmcnt(" #n ")" ::: "memory")
#define PG8_BAR __builtin_amdgcn_s_barrier()
#define PG8_SCHED __builtin_amdgcn_sched_barrier(0)
    Unit cur, nxt; int ui = 0;
    if (!S.next(0, cur)) return;
    f32x4 acc[2][2][4][2];
#pragma unroll
    for (int a = 0; a < 2; ++a)
#pragma unroll
        for (int b = 0; b < 2; ++b)
#pragma unroll
            for (int m = 0; m < 4; ++m)
#pragma unroll
                for (int n = 0; n < 2; ++n) acc[a][b][m][n] = (f32x4){0.f, 0.f, 0.f, 0.f};
    bf16x8 At[4][2], B0[2][2], B1[2][2];
    const char* cA = (const char*)g.A + (size_t)cur.pm * tstep; const char* cB = (const char*)g.Bt + (size_t)cur.pn * tstep;
    S.a_ready(cur);
    if constexpr (SP2) {
        PG8_STAGE(PG8_SB(0, 0), cB, voffB); PG8_STAGE(PG8_SB(0, 1), cB + hstep, voffB); PG8_STAGE(PG8_SA(0, 0), cA, voffA); PG8_STAGE(PG8_SA(0, 1), cA + hstep, voffA);
        if (wr == 1) PG8_BAR;
        PG8_WAIT_V(2); PG8_BAR;
        PG8_STAGE(PG8_SB(1, 0), cB + kstep, voffB); PG8_STAGE(PG8_SA(1, 0), cA + kstep, voffA); PG8_STAGE(PG8_SB(1, 1), cB + hstep + kstep, voffB);
        PG8_WAIT_V(6); PG8_BAR;
    } else {
        PG8_STAGE(PG8_SB(0, 0), cB, voffB); PG8_STAGE(PG8_SA(0, 0), cA, voffA); PG8_STAGE(PG8_SB(0, 1), cB + hstep, voffB); PG8_STAGE(PG8_SA(0, 1), cA + hstep, voffA);
        if (wr == 1) PG8_BAR;
        PG8_WAIT_V(4); PG8_BAR;
        PG8_STAGE(PG8_SB(1, 0), cB + kstep, voffB); PG8_STAGE(PG8_SA(1, 0), cA + kstep, voffA); PG8_STAGE(PG8_SB(1, 1), cB + hstep + kstep, voffB);
        PG8_WAIT_V(6); PG8_BAR;
    }
    for (;;) {
        const bool has_next = S.next(ui + 1, nxt);
        const char* nA = has_next ? (const char*)g.A + (size_t)nxt.pm * tstep : cA; const char* nB = has_next ? (const char*)g.Bt + (size_t)nxt.pn * tstep : cB;
        for (int t = 0; t < nt; t += 2) {
            const bool last = (t == nt - 2);
            const char* a1 = cA + (size_t)(t + 1) * kstep;
            const char* a2 = last ? nA : cA + (size_t)(t + 2) * kstep; const char* b2 = last ? nB : cB + (size_t)(t + 2) * kstep;
            const char* a3 = a2 + kstep; const char* b3 = b2 + kstep;
            if (last && has_next) S.a_ready(nxt);
            if constexpr (SP2) {
            PG8_LDB(B0, 0, 0); PG8_LDB(B1, 0, 1); PG8_SCHED; PG8_LDA(At, 0, 0); PG8_STAGE(PG8_SA(1, 1), a1 + hstep, voffA);
            PG8_WAIT_V(8); PG8_WAIT_L(0); PG8_BAR; PG8_MMA(0, 0, At, B0); PG8_MMA(0, 1, At, B1); PG8_BAR; PG8_SCHED;
            PG8_LDA(At, 0, 1); PG8_STAGE(PG8_SB(0, 0), b2, voffB); PG8_STAGE(PG8_SB(0, 1), b2 + hstep, voffB); PG8_STAGE(PG8_SA(0, 0), a2, voffA);
            PG8_WAIT_V(8); PG8_WAIT_L(0); PG8_BAR; PG8_MMA(1, 0, At, B0); PG8_MMA(1, 1, At, B1); PG8_BAR; PG8_SCHED;
            PG8_LDB(B0, 1, 0); PG8_LDB(B1, 1, 1); PG8_SCHED; PG8_LDA(At, 1, 0); PG8_STAGE(PG8_SA(0, 1), a2 + hstep, voffA);
            PG8_WAIT_V(8); PG8_WAIT_L(0); PG8_BAR; PG8_MMA(0, 0, At, B0); PG8_MMA(0, 1, At, B1); PG8_BAR; PG8_SCHED;
            PG8_LDA(At, 1, 1); PG8_STAGE(PG8_SB(1, 0), b3, voffB); PG8_STAGE(PG8_SB(1, 1), b3 + hstep, voffB); PG8_STAGE(PG8_SA(1, 0), a3, voffA);
            PG8_WAIT_V(8); PG8_WAIT_L(0); PG8_BAR; PG8_MMA(1, 0, At, B0); PG8_MMA(1, 1, At, B1); PG8_BAR; PG8_SCHED;
            } else {
            PG8_LDB(B0, 0, 0); PG8_SCHED; PG8_LDA(At, 0, 0); PG8_STAGE(PG8_SA(1, 1), a1 + hstep, voffA);
            PG8_WAIT_L(8); PG8_BAR; PG8_WAIT_L(0); PG8_MMA(0, 0, At, B0); PG8_BAR; PG8_SCHED;
            PG8_LDB(B1, 0, 1); PG8_STAGE(PG8_SB(0, 0), b2, voffB);
            PG8_BAR; PG8_WAIT_L(0); PG8_MMA(0, 1, At, B1); PG8_BAR;
            PG8_LDA(At, 0, 1); PG8_STAGE(PG8_SA(0, 0), a2, voffA);
            PG8_BAR; PG8_WAIT_L(0); PG8_MMA(1, 0, At, B0); PG8_BAR; PG8_SCHED;
            PG8_STAGE(PG8_SB(0, 1), b2 + hstep, voffB);
            PG8_WAIT_V(6); PG8_BAR; PG8_MMA(1, 1, At, B1); PG8_BAR;
            PG8_LDB(B0, 1, 0); PG8_SCHED; PG8_LDA(At, 1, 0); PG8_STAGE(PG8_SA(0, 1), a2 + hstep, voffA);
            PG8_WAIT_L(8); PG8_BAR; PG8_WAIT_L(0); PG8_MMA(0, 0, At, B0); PG8_BAR; PG8_SCHED;
            PG8_LDB(B1, 1, 1); PG8_STAGE(PG8_SB(1, 0), b3, voffB);
            PG8_BAR; PG8_WAIT_L(0); PG8_MMA(0, 1, At, B1); PG8_BAR;
            PG8_LDA(At, 1, 1); PG8_STAGE(PG8_SA(1, 0), a3, voffA);
            PG8_BAR; PG8_WAIT_L(0); PG8_MMA(1, 0, At, B0); PG8_BAR; PG8_SCHED;
            PG8_STAGE(PG8_SB(1, 1), b3 + hstep, voffB);
            PG8_WAIT_V(6); PG8_BAR; PG8_MMA(1, 1, At, B1); PG8_BAR;
            }
        }
        if constexpr (ALIGN_EPI) { if (wr == 0) PG8_BAR; }
        if constexpr (!Epi::AFTER_DRAIN) { E(acc, cur, wr, wc, fr, fq); S.done(cur); }
        if (!has_next) break;
#pragma unroll
        for (int a = 0; a < 2; ++a)
#pragma unroll
            for (int b = 0; b < 2; ++b)
#pragma unroll
                for (int m = 0; m < 4; ++m)
#pragma unroll
                    for (int n = 0; n < 2; ++n) acc[a][b][m][n] = (f32x4){0.f, 0.f, 0.f, 0.f};
        cur = nxt; cA = nA; cB = nB; ++ui;
        if constexpr (ALIGN_EPI) { if (wr == 1) PG8_BAR; }
    }
    PG8_WAIT_V(0);
    if constexpr (!ALIGN_EPI) { if (wr == 0) PG8_BAR; }
    PG8_BAR;
    if constexpr (Epi::AFTER_DRAIN) { E.fused(acc, cur, wr, wc, fr, fq, lds, wid, lane); S.done(cur); }
#undef PG8_SA
#undef PG8_SB
#undef PG8_STAGE
#undef PG8_LDA
#undef PG8_LDB
#undef PG8_MMA
#undef PG8_WAIT_V
#undef PG8_WAIT_L
#undef PG8_BAR
#undef PG8_SCHED
}
}

#ifndef HOST_REP
#define HOST_REP 0
#endif
#ifndef N_LAUNCHES
#define N_LAUNCHES 1
#endif
#define DI __device__ __forceinline__
#define LAS __attribute__((address_space(3)))
using pg8::bf16_t; using pg8::bf16x8; using pg8::f32x4; using pg8::u32x4;
typedef unsigned u32x2 __attribute__((ext_vector_type(2)));
typedef short s16x4 __attribute__((ext_vector_type(4)));
#define MFMA16(a, b, c) __builtin_amdgcn_mfma_f32_16x16x32_bf16((a), (b), (c), 0, 0, 0)

constexpr int D = 1024, MP = 16384, MS = 512, M = MP + MS, SEQ = 2048, INW = 1280, FF = 2816, NG = 32;
constexpr float EPS = 1e-6f;
constexpr size_t O_PRE = 17301504, O_PIM = 17317888, O_PK = 17334272, O_PV = 17465344, O_PCONV = 17596416,
                 O_SRE = 17641472, O_SIM = 17674240, O_SK = 17707008, O_SV = 17772544, O_SCONV = 17838080;
constexpr size_t WS_WIN = 0, WS_WGLU = WS_WIN + (size_t)INW * D * 2, WS_WO = WS_WGLU + 512 * 512 * 2, WS_W1 = WS_WO + (size_t)D * D * 2,
                 WS_W2 = WS_W1 + (size_t)2 * FF * D * 2, WS_KT = WS_W2 + (size_t)D * FF * 2, WS_WT = WS_KT + (size_t)NG * 32 * 256 * 2,
                 WS_PRE = WS_WT + (size_t)NG * 128 * 512 * 2, WS_PIM = WS_PRE + (size_t)NG * 4096 * 4, WS_A32 = WS_PIM + (size_t)NG * 32 * 64 * 4,
                 WS_CT = WS_A32 + (size_t)NG * 64 * 2 * 4, WS_SSQ = WS_CT + (size_t)NG * 16 * 128 * 2, WS_MIX = WS_SSQ + (size_t)M * 16 * 4,
                 WS_X1B = WS_MIX + (size_t)M * D * 2, WS_H = WS_X1B + (size_t)M * D * 2, WS_X1F = WS_H + (size_t)M * FF * 2, WS_PART = WS_X1F + (size_t)M * D * 4, WS_PARTS = WS_PART + (size_t)64 * 4 * 256 * 4, WS_CTL = WS_PARTS + (size_t)256 * 32 * 4, WS_END = WS_CTL + 16384;
constexpr size_t WS_XN = WS_H, WS_U = WS_XN + (size_t)M * D * 2, WS_Q = WS_U + (size_t)M * 512 * 2, WS_KB = WS_Q + (size_t)M * 512 * 2,
                 WS_VT = WS_KB + (size_t)M * 128 * 2, WS_KS = WS_VT + (size_t)MP * 128 * 2, WS_VTS = WS_KS + (size_t)16 * 160 * 128 * 2,
                 WS_HIN = WS_VTS + (size_t)16 * 160 * 128 * 2, WS_UF = WS_HIN + (size_t)512 * NG * 128 * 4, WS_ALIAS_END = WS_UF + (size_t)M * 512 * 2;
static_assert(WS_ALIAS_END <= WS_END && WS_END <= 268435456, "d_ws map");
constexpr int LDS_BYTES = 163840, LDS_X = 131072;

DI unsigned f2bf(float f) { unsigned u = __builtin_bit_cast(unsigned, f); return (u + 0x7fffu + ((u >> 16) & 1u)) >> 16; }
typedef float f32x2_t __attribute__((ext_vector_type(2)));
typedef __bf16 bf16x2_t __attribute__((ext_vector_type(2)));
DI unsigned pk2(float lo, float hi) { f32x2_t v = {lo, hi}; bf16x2_t b = __builtin_convertvector(v, bf16x2_t); return __builtin_bit_cast(unsigned, b); }
DI float bflo(unsigned w) { return __builtin_bit_cast(float, w << 16); }
DI float bfhi(unsigned w) { return __builtin_bit_cast(float, w & 0xffff0000u); }
DI u32x4 pack8(const f32x4& a, const f32x4& b) { u32x4 w; w.x = pk2(a[0], a[1]); w.y = pk2(a[2], a[3]); w.z = pk2(b[0], b[1]); w.w = pk2(b[2], b[3]); return w; }
DI float dot2bf(unsigned a, unsigned b, float c) { return __builtin_amdgcn_fdot2_f32_bf16(__builtin_bit_cast(bf16x2_t, a), __builtin_bit_cast(bf16x2_t, b), c, false); }
DI float sigm(float x) { return __builtin_amdgcn_rcpf(1.0f + __expf(-x)); }
DI float gelu_tanh(float x) { const float z = 0.7978845608f * (x + 0.044715f * x * x * x); return x * sigm(2.0f * z); }
template <int CTRL> DI float dpp_shr(float v) { return __builtin_bit_cast(float, __builtin_amdgcn_update_dpp(0, __builtin_bit_cast(int, v), CTRL, 0xF, 0xF, false)); }
#define GAS __attribute__((address_space(1)))
DI void st_agent(float* p, float v) { __hip_atomic_store((GAS unsigned*)p, __builtin_bit_cast(unsigned, v), __ATOMIC_RELAXED, __HIP_MEMORY_SCOPE_AGENT); }
DI float ld_agent(const float* p) { return __builtin_bit_cast(float, __hip_atomic_load((GAS unsigned*)p, __ATOMIC_RELAXED, __HIP_MEMORY_SCOPE_AGENT)); }
DI void arrive_and_wait(unsigned* cnt, unsigned target) {
    (void)__hip_atomic_fetch_add((GAS unsigned*)cnt, 1u, __ATOMIC_RELAXED, __HIP_MEMORY_SCOPE_AGENT);
    while (__hip_atomic_load((GAS unsigned*)cnt, __ATOMIC_RELAXED, __HIP_MEMORY_SCOPE_AGENT) < target) __builtin_amdgcn_s_sleep(1);
}
DI void wait_ge16(const unsigned* c) { while (__hip_atomic_load((GAS unsigned*)c, __ATOMIC_RELAXED, __HIP_MEMORY_SCOPE_AGENT) < 16u) __builtin_amdgcn_s_sleep(1); }
DI float xsum4(float v) { v += __shfl_xor(v, 16); v += __shfl_xor(v, 32); return v; }

struct Args { const float* in[30]; float* out; unsigned char* ws; int ph_lo, ph_hi; };

struct Frame {
    LAS unsigned char* lds; int tid, lane, wave, G, bid;
    const float* const* in; float* out; unsigned char* ws;
};
#define WSP(T, off) ((T*)(F.ws + (off)))

DI void p0_transpose(const float* __restrict__ W, int N, const float* __restrict__ gk, bf16_t* __restrict__ WT, int ldt, int k0, int n0, int dst0, LAS float* scr, int tid) {
    const int c = tid & 63, r0 = tid >> 6;
    float v[16];
#pragma unroll
    for (int i = 0; i < 16; ++i) { const int r = r0 + 8 * i; v[i] = W[(size_t)(k0 + r) * N + n0 + c]; }
#pragma unroll
    for (int i = 0; i < 16; ++i) { const int r = r0 + 8 * i; float x = v[i]; if (gk) x *= gk[k0 + r]; scr[r * 65 + c] = x; }
    __syncthreads();
#pragma unroll
    for (int i = 0; i < 8; ++i) { const int n = r0 + 8 * i;
        *(unsigned*)(WT + (size_t)(dst0 + n) * ldt + k0 + 2 * c) = f2bf(scr[(2 * c) * 65 + n]) | (f2bf(scr[(2 * c + 1) * 65 + n]) << 16); }
    __syncthreads();
}

DI void p0_ssm_tables(const Frame& F, int task) {
    const int tid = F.tid, g = task >> 2, part = task & 3;
    LAS float* pwr = (LAS float*)F.lds; LAS float* pwi = pwr + 33 * 64; LAS float* bbr = pwi + 33 * 64; LAS float* bbi = bbr + 1024;
    const float* a_re = F.in[9] + g * 64; const float* a_im = F.in[10] + g * 64;
    const float dt = expf(F.in[11][g]);
    for (int i = tid; i < 33 * 64; i += 512) {
        const int d = i >> 6, n = i & 63; const float fd = (float)d;
        const float mag = expf(a_re[n] * dt * fd), ang = a_im[n] * dt * fd;
        pwr[i] = mag * cosf(ang); pwi[i] = mag * sinf(ang);
    }
    __syncthreads();
    for (int i = tid; i < 1024; i += 512) {
        const int n = i >> 4;
        const float are = a_re[n], aim = a_im[n], nr = pwr[64 + n] - 1.0f, ni = pwi[64 + n], den = are * are + aim * aim;
        const float cr = (nr * are + ni * aim) / den, ci = (ni * are - nr * aim) / den;
        const float br = F.in[12][(size_t)g * 1024 + i], bi = F.in[13][(size_t)g * 1024 + i];
        bbr[i] = cr * br - ci * bi; bbi[i] = cr * bi + ci * br;
    }
    __syncthreads();
    if (part == 0) {
        const int d = tid >> 4, p = tid & 15;
        float acc[16];
#pragma unroll
        for (int q = 0; q < 16; ++q) acc[q] = 0.f;
        const float* cre = F.in[14] + (size_t)(g * 16 + p) * 64; const float* cim = F.in[15] + (size_t)(g * 16 + p) * 64;
        for (int n = 0; n < 64; ++n) {
            const float cr = cre[n], ci = cim[n], pr = pwr[d * 64 + n], pi = pwi[d * 64 + n];
            const float xr = cr * pr - ci * pi, xi = cr * pi + ci * pr;
#pragma unroll
            for (int q = 0; q < 16; ++q) acc[q] += xr * bbr[n * 16 + q] - xi * bbi[n * 16 + q];
        }
        const float dv = (d == 0) ? F.in[16][g * 16 + p] : 0.f;
        u32x4 w0, w1;
#pragma unroll
        for (int q = 0; q < 16; ++q) acc[q] += (q == p) ? dv : 0.f;
        w0.x = pk2(acc[0], acc[1]); w0.y = pk2(acc[2], acc[3]); w0.z = pk2(acc[4], acc[5]); w0.w = pk2(acc[6], acc[7]);
        w1.x = pk2(acc[8], acc[9]); w1.y = pk2(acc[10], acc[11]); w1.z = pk2(acc[12], acc[13]); w1.w = pk2(acc[14], acc[15]);
        bf16_t* dst = WSP(bf16_t, WS_KT) + ((size_t)(g * 16 + (d >> 1)) * 64 + (d & 1) * 32 + p) * 8;
        *(u32x4*)dst = w0; *(u32x4*)(dst + 128) = w1;
    }
    if (part == 1 || part == 2) {
        bf16_t* wt = WSP(bf16_t, WS_WT) + (size_t)g * 65536;
        for (int idx = (part - 1) * 32768 + tid; idx < part * 32768; idx += 512) {
            const int j = idx & 7, lane = (idx >> 3) & 63, kk = (idx >> 9) & 15, nb = idx >> 13;
            const int n2 = nb * 16 + (lane & 15), n = n2 & 63, sidx = 2 * kk + (lane >> 5), pp = ((lane >> 4) & 1) * 8 + j;
            const float pr = pwr[(31 - sidx) * 64 + n], pi = pwi[(31 - sidx) * 64 + n], br = bbr[n * 16 + pp], bi = bbi[n * 16 + pp];
            wt[idx] = (bf16_t)f2bf(n2 < 64 ? pr * br - pi * bi : pr * bi + pi * br);
        }
    }
    if (part == 3) {
    for (int i = tid; i < 4096; i += 512) {
        const int e = i & 3, lane = (i >> 2) & 63, half = (i >> 8) & 1, reim = (i >> 9) & 1, nh = (i >> 10) & 1, mt = i >> 11;
        const int t = mt * 16 + (lane & 15), n = nh * 32 + (lane >> 4) * 8 + half * 4 + e;
        WSP(float, WS_PRE)[(size_t)g * 4096 + i] = reim ? pwi[(t + 1) * 64 + n] : pwr[(t + 1) * 64 + n];
    }
    if (tid < 64) { WSP(float, WS_A32)[(g * 64 + tid) * 2] = pwr[32 * 64 + tid]; WSP(float, WS_A32)[(g * 64 + tid) * 2 + 1] = pwi[32 * 64 + tid]; }
    for (int i = tid; i < 2048; i += 512) {
        const int j = i & 7, lane = (i >> 3) & 63, kk2 = i >> 9, p = lane & 15, n2 = kk2 * 32 + (lane >> 4) * 8 + j;
        const float v = n2 < 64 ? F.in[14][(size_t)(g * 16 + p) * 64 + n2] : -F.in[15][(size_t)(g * 16 + p) * 64 + n2 - 64];
        WSP(bf16_t, WS_CT)[(size_t)g * 2048 + i] = (bf16_t)f2bf(v);
    }
    }
    __syncthreads();
}

DI void p0_prologue(const Frame& F) {
    constexpr int T_SSM = 128, T_WIN = 8 * 20, T_WGLU = 64, T_WO = 128, T_WA = 8 * 44, T_WD = 22 * 16, T_XN = M / 16, T_CK = 64, T_CV = 64;
    LAS float* scr = (LAS float*)F.lds;
    const int G = F.G;
    int r = F.bid;
#define P0_LOOP(COUNT) for (int i = r; i < (COUNT); i += G)
#define P0_NEXT(COUNT) r = (r + G - (COUNT) % G) % G
    P0_LOOP(T_XN) {
        const int row = i * 16 + F.wave * 2;
        const float* xr = row < MP ? F.in[0] + (size_t)row * D : F.in[1] + (size_t)(row - MP) * D;
        f32x4 v[2][4]; float q0 = 0.f, q1 = 0.f;
#pragma unroll
        for (int k = 0; k < 4; ++k) { v[0][k] = *(const f32x4*)(xr + k * 256 + F.lane * 4); v[1][k] = *(const f32x4*)(xr + D + k * 256 + F.lane * 4); }
#pragma unroll
        for (int k = 0; k < 4; ++k) { q0 += v[0][k][0] * v[0][k][0] + v[0][k][1] * v[0][k][1] + v[0][k][2] * v[0][k][2] + v[0][k][3] * v[0][k][3];
                                      q1 += v[1][k][0] * v[1][k][0] + v[1][k][1] * v[1][k][1] + v[1][k][2] * v[1][k][2] + v[1][k][3] * v[1][k][3]; }
#pragma unroll
        for (int o = 1; o < 64; o <<= 1) { q0 += __shfl_xor(q0, o); q1 += __shfl_xor(q1, o); }
        const float rr0 = rsqrtf(q0 * (1.0f / D) + EPS), rr1 = rsqrtf(q1 * (1.0f / D) + EPS);
        bf16_t* dst = WSP(bf16_t, WS_XN) + (size_t)row * D;
#pragma unroll
        for (int k = 0; k < 4; ++k) { const f32x4 g = *(const f32x4*)(F.in[7] + k * 256 + F.lane * 4);
            u32x2 w; w.x = pk2(v[0][k][0] * rr0 * g[0], v[0][k][1] * rr0 * g[1]); w.y = pk2(v[0][k][2] * rr0 * g[2], v[0][k][3] * rr0 * g[3]); *(u32x2*)(dst + k * 256 + F.lane * 4) = w;
            w.x = pk2(v[1][k][0] * rr1 * g[0], v[1][k][1] * rr1 * g[1]); w.y = pk2(v[1][k][2] * rr1 * g[2], v[1][k][3] * rr1 * g[3]); *(u32x2*)(dst + D + k * 256 + F.lane * 4) = w; }
    }
    P0_NEXT(T_XN);
    P0_LOOP(T_WIN) p0_transpose(F.in[8], INW, nullptr, WSP(bf16_t, WS_WIN), D, (i % 8) * 128, (i / 8) * 64, (i / 8) * 64, scr, F.tid);
    P0_NEXT(T_WIN);
#undef P0_LOOP
#undef P0_NEXT
}

DI void p1_tail(const Frame& F) {
    constexpr int T_SSM = 128, T_WGLU = 64, T_CK = 64, T_CV = 64;
    const int nbusy = (M / 256) * (INW / 256) - F.G;
    if (nbusy < 0 || nbusy >= F.G || F.bid < nbusy) return;
    const int G = F.G - nbusy;
    int r = F.bid - nbusy;
#define P0_LOOP(COUNT) for (int i = r; i < (COUNT); i += G)
#define P0_NEXT(COUNT) r = (r + G - (COUNT) % G) % G
    P0_LOOP(T_SSM) p0_ssm_tables(F, i);
    P0_NEXT(T_SSM);
    P0_LOOP(T_WGLU) {
        const int ch = i * 512 + F.tid, lane = ch & 63, kk = (ch >> 6) & 15, ntg = ch >> 10;
        const float* src = F.in[17] + (size_t)(kk * 32 + (lane >> 4) * 8) * 512 + ntg * 16 + (lane & 15);
        f32x4 a, b;
#pragma unroll
        for (int j = 0; j < 4; ++j) { a[j] = src[(size_t)j * 512]; b[j] = src[(size_t)(j + 4) * 512]; }
        *(u32x4*)(WSP(bf16_t, WS_WGLU) + (size_t)ch * 8) = pack8(a, b);
    }
    P0_NEXT(T_WGLU);
    P0_LOOP(T_CK) {
        const int ch = i * 512 + F.tid, lane = ch & 63, kk = (ch >> 6) & 1, kb = (ch >> 7) & 7, kvh = (ch >> 10) & 1, sb = ch >> 11;
        const float* src = F.in[4] + (((size_t)sb * 128 + kb * 16 + (lane & 15)) * 2 + kvh) * 64 + kk * 32 + (lane >> 4) * 8;
        *(u32x4*)(WSP(bf16_t, WS_KS) + (((size_t)(sb * 2 + kvh) * 10 + kb) * 2 + kk) * 512 + lane * 8) = pack8(*(const f32x4*)src, *(const f32x4*)(src + 4));
    }
    P0_NEXT(T_CK);
    P0_LOOP(T_CV) {
        const int ch = i * 512 + F.tid, lane = ch & 63, db = (ch >> 6) & 3, kb = (ch >> 8) & 3, kvh = (ch >> 10) & 1, sb = ch >> 11;
        const float* src = F.in[5] + (((size_t)sb * 128 + kb * 32 + (lane >> 4) * 4) * 2 + kvh) * 64 + db * 16 + (lane & 15);
        f32x4 a, b;
#pragma unroll
        for (int j = 0; j < 4; ++j) { a[j] = src[(size_t)j * 128]; b[j] = src[(size_t)(16 + j) * 128]; }
        *(u32x4*)(WSP(bf16_t, WS_VTS) + (((size_t)(sb * 2 + kvh) * 5 + kb) * 4 + db) * 512 + lane * 8) = pack8(a, b);
    }
#undef P0_LOOP
#undef P0_NEXT
}

struct EpiIn {
    static constexpr bool PERM = true, AFTER_DRAIN = false;
    unsigned char* ws; float* out;
    DI void operator()(const f32x4 (&acc)[2][2][4][2], const pg8::Unit& u, int wr, int wc, int fr, int fq) const {
        bf16_t* const U = (bf16_t*)(ws + WS_U); bf16_t* const Q = (bf16_t*)(ws + WS_Q); bf16_t* const KB = (bf16_t*)(ws + WS_KB); bf16_t* const VT = (bf16_t*)(ws + WS_VT);
        bf16_t* const KS = (bf16_t*)(ws + WS_KS); bf16_t* const VTS = (bf16_t*)(ws + WS_VTS); bf16_t* const UF = (bf16_t*)(ws + WS_UF);
        const int row0 = u.pm * 256 + wr * 64 + fr;
        if (u.pn < 2) {
            const int colt = u.pn * 256 + wc * 32 + 8 * fq;
#pragma unroll
            for (int ai = 0; ai < 2; ++ai)
#pragma unroll
                for (int m = 0; m < 4; ++m) { const int row = row0 + ai * 128 + m * 16; bf16_t* rp = U + (size_t)row * 512 + colt;
                    const int tq = row < MP ? (row & 2047) : ((row - MP) & 31), sq = tq & 31, chunk = row < MP ? (tq >> 5) : ((row - MP) >> 5);
#pragma unroll
                    for (int bj = 0; bj < 2; ++bj) { const u32x4 w = pack8(acc[ai][bj][m][0], acc[ai][bj][m][1]); *(u32x4*)(rp + bj * 128) = w;
                        const int c0 = colt + bj * 128, g = c0 >> 4, lf = (((sq & 1) * 2 + ((c0 >> 3) & 1)) * 16 + (chunk & 15)) * 8;
                        bf16_t* uf = row < MP ? UF + ((((size_t)((row >> 11) * 32 + g) * 16 + (sq >> 1)) * 4 + (chunk >> 4)) * 64) * 8 + lf
                                              : UF + (size_t)MP * 512 + ((size_t)(g * 16 + (sq >> 1)) * 64) * 8 + lf;
                        *(u32x4*)uf = w; } }
        } else if (u.pn < 4) {
#pragma unroll
            for (int ai = 0; ai < 2; ++ai)
#pragma unroll
                for (int m = 0; m < 4; ++m) { const int rb = (u.pm * 256 + wr * 64 + ai * 128 + m * 16) >> 4;
#pragma unroll
                    for (int bj = 0; bj < 2; ++bj) { const int c0 = (u.pn - 2) * 256 + bj * 128 + wc * 32, h = c0 >> 6, kk = (c0 >> 5) & 1;
                        *(u32x4*)(Q + (((size_t)h * (M / 16) + rb) * 2 + kk) * 512 + (fq * 16 + fr) * 8) = pack8(acc[ai][bj][m][0] * 0.125f, acc[ai][bj][m][1] * 0.125f); } }
        } else {
            const int c = wc * 32 + 8 * fq, kvh = wc >> 1, kk = wc & 1, db = (c >> 4) & 3, fr0 = c & 15;
#pragma unroll
            for (int ai = 0; ai < 2; ++ai)
#pragma unroll
                for (int m = 0; m < 4; ++m) {
                    const int row = row0 + ai * 128 + m * 16;
                    const f32x4 k0 = acc[ai][0][m][0], k1 = acc[ai][0][m][1], v0 = acc[ai][1][m][0], v1 = acc[ai][1][m][1];
                    if (row < MP) {
                        const int b = row >> 11, t = row & 2047;
                        *(u32x4*)(KB + (((size_t)kvh * (M / 16) + (row >> 4)) * 2 + kk) * 512 + (fq * 16 + fr) * 8) = pack8(k0, k1);
                        const int w = t & 31; bf16_t* vt = VT + ((((size_t)(b * 2 + kvh) * 64 + (t >> 5)) * 4 + db) * 64 + ((w & 15) >> 2) * 16 + fr0) * 8 + (w & 3) + 4 * (w >> 4);
#pragma unroll
                        for (int j = 0; j < 4; ++j) { vt[j * 8] = (bf16_t)f2bf(v0[j]); vt[(j + 4) * 8] = (bf16_t)f2bf(v1[j]); }
                        if (t >= 1920) { float* pk = out + O_PK + ((size_t)b * 128 + (t - 1920)) * 128 + c; *(f32x4*)pk = k0; *(f32x4*)(pk + 4) = k1;
                                         float* pv = out + O_PV + ((size_t)b * 128 + (t - 1920)) * 128 + c; *(f32x4*)pv = v0; *(f32x4*)(pv + 4) = v1; }
                    } else {
                        const int sb = (row - MP) >> 5, st = (row - MP) & 31, key = 128 + st;
                        *(u32x4*)(KS + ((((size_t)(sb * 2 + kvh) * 10 + (key >> 4)) * 2 + kk) * 64 + fq * 16 + (key & 15)) * 8) = pack8(k0, k1);
                        const int w = key & 31; bf16_t* vt = VTS + ((((size_t)(sb * 2 + kvh) * 5 + (key >> 5)) * 4 + db) * 64 + ((w & 15) >> 2) * 16 + fr0) * 8 + (w & 3) + 4 * (w >> 4);
#pragma unroll
                        for (int j = 0; j < 4; ++j) { vt[j * 8] = (bf16_t)f2bf(v0[j]); vt[(j + 4) * 8] = (bf16_t)f2bf(v1[j]); }
                        float* pk = out + O_SK + ((size_t)sb * 32 + st) * 128 + c; *(f32x4*)pk = k0; *(f32x4*)(pk + 4) = k1;
                        float* pv = out + O_SV + ((size_t)sb * 32 + st) * 128 + c; *(f32x4*)pv = v0; *(f32x4*)(pv + 4) = v1;
                    }
                }
        }
    }
};

constexpr int LDO = 520;
DI void attn_task(const bf16_t* __restrict__ Qp, int nqb, const bf16_t* __restrict__ Kp, int nkb, const bf16_t* __restrict__ Vtp, int vstride,
                  float sink, const float* __restrict__ gat, bf16_t* __restrict__ outp, LAS float* ob, int h, int wave, int lane) {
    const int fr = lane & 15, fq = lane >> 4;
#pragma unroll 1
    for (int qb = 0; qb < nqb; ++qb) {
        const bf16_t* qrow = Qp + (size_t)qb * 1024 + lane * 8;
        const bf16x8 q0 = *(const bf16x8*)qrow, q1 = *(const bf16x8*)(qrow + 512);
        f32x4 s[12];
#pragma unroll
        for (int kb = 0; kb < 12; ++kb) {
            s[kb] = (f32x4){-INFINITY, -INFINITY, -INFINITY, -INFINITY};
            if (kb < nkb) {
                const bf16_t* krow = Kp + (size_t)kb * 1024 + lane * 8;
                const bf16x8 k0 = *(const bf16x8*)krow, k1 = *(const bf16x8*)(krow + 512);
                f32x4 z = (f32x4){0.f, 0.f, 0.f, 0.f};
                z = MFMA16(k0, q0, z); z = MFMA16(k1, q1, z); s[kb] = z;
            }
        }
        float m = sink;
#pragma unroll
        for (int kb = 0; kb < 12; ++kb) m = fmaxf(fmaxf(m, fmaxf(s[kb][0], s[kb][1])), fmaxf(s[kb][2], s[kb][3]));
        m = fmaxf(m, __shfl_xor(m, 16)); m = fmaxf(m, __shfl_xor(m, 32));
        float sum = 0.f;
#pragma unroll
        for (int kb = 0; kb < 12; ++kb)
#pragma unroll
            for (int e = 0; e < 4; ++e) { const float p = __expf(s[kb][e] - m); s[kb][e] = p; sum += p; }
        sum = xsum4(sum);
        const float inv = 1.0f / (sum + __expf(sink - m));
        f32x4 o[4];
#pragma unroll
        for (int db = 0; db < 4; ++db) o[db] = (f32x4){0.f, 0.f, 0.f, 0.f};
#pragma unroll
        for (int ks = 0; ks < 6; ++ks) {
            if (2 * ks < nkb) {
                const bf16x8 pb = __builtin_bit_cast(bf16x8, pack8(s[2 * ks], s[2 * ks + 1]));
#pragma unroll
                for (int db = 0; db < 4; ++db) {
                    const bf16x8 vf = *(const bf16x8*)(Vtp + (size_t)(ks * 4 + db) * 512 + lane * 8);
                    o[db] = MFMA16(vf, pb, o[db]);
                }
                if (ks & 1) __builtin_amdgcn_sched_barrier(0);
            }
        }
#pragma unroll
        for (int db = 0; db < 4; ++db) *(LAS f32x4*)(ob + (qb * 16 + fr) * LDO + h * 64 + db * 16 + fq * 4) = o[db] * inv;
    }
    __syncthreads();
    const int rpw = nqb * 2;
    const f32x4 g0 = *(const f32x4*)(gat + lane * 8), g1 = *(const f32x4*)(gat + lane * 8 + 4);
#pragma unroll 1
    for (int i = 0; i < rpw; ++i) {
        const int r = wave * rpw + i;
        f32x4 v0 = *(const LAS f32x4*)(ob + r * LDO + lane * 8), v1 = *(const LAS f32x4*)(ob + r * LDO + lane * 8 + 4);
        float q = v0[0] * v0[0] + v0[1] * v0[1] + v0[2] * v0[2] + v0[3] * v0[3] + v1[0] * v1[0] + v1[1] * v1[1] + v1[2] * v1[2] + v1[3] * v1[3];
#pragma unroll
        for (int o2 = 1; o2 < 64; o2 <<= 1) q += __shfl_xor(q, o2);
        const float rs = rsqrtf(q * (1.0f / 512.0f) + EPS);
        *(u32x4*)(outp + (size_t)r * D + lane * 8) = pack8(v0 * rs * g0, v1 * rs * g1);
    }
    __syncthreads();
}

template <int MT, bool SAMPLE>
DI void ssm_state(const Frame& F, int b, int g) {
    const int lane = F.lane, fr = lane & 15, fq = lane >> 4;
    const bf16_t* Ub = WSP(bf16_t, WS_UF) + (SAMPLE ? (size_t)MP * 512 + (size_t)g * 16 * 512 : (size_t)(b * 32 + g) * 16 * 2048) + lane * 8;
    const bf16_t* Wg = WSP(bf16_t, WS_WT) + (size_t)g * 65536 + lane * 8;
    const float* A32 = WSP(float, WS_A32) + g * 128;
    float* HIN = WSP(float, WS_HIN);
#pragma unroll 1
    for (int h2 = 0; h2 < 2; ++h2) {
        f32x4 acc[MT][4];
#pragma unroll
        for (int mt = 0; mt < MT; ++mt)
#pragma unroll
            for (int j = 0; j < 4; ++j) acc[mt][j] = (f32x4){0.f, 0.f, 0.f, 0.f};
#pragma unroll 2
        for (int kk = 0; kk < 16; ++kk) {
            bf16x8 a[MT], w[4];
#pragma unroll
            for (int mt = 0; mt < MT; ++mt) a[mt] = *(const bf16x8*)(Ub + (size_t)kk * (SAMPLE ? 512 : 2048) + mt * 512);
#pragma unroll
            for (int j = 0; j < 4; ++j) { const int nb = (j < 2) ? 2 * h2 + j : 4 + 2 * h2 + (j - 2); w[j] = *(const bf16x8*)(Wg + (size_t)(nb * 16 + kk) * 512); }
#pragma unroll
            for (int mt = 0; mt < MT; ++mt)
#pragma unroll
                for (int j = 0; j < 4; ++j) acc[mt][j] = MFMA16(a[mt], w[j], acc[mt][j]);
        }
#pragma unroll
        for (int i = 0; i < 2; ++i) {
            const int n = (2 * h2 + i) * 16 + fr;
            const float ar = A32[n * 2], ai = A32[n * 2 + 1];
            if constexpr (SAMPLE) {
#pragma unroll
                for (int e = 0; e < 4; ++e) {
                    const int sb = fq * 4 + e; const size_t idx = ((size_t)sb * 32 + g) * 64 + n;
                    const float hr = F.in[2][idx], hi = F.in[3][idx];
                    F.out[O_SRE + idx] = ar * hr - ai * hi + acc[0][i][e]; F.out[O_SIM + idx] = ar * hi + ai * hr + acc[0][2 + i][e];
                }
            } else {
            const float a2r = ar * ar - ai * ai, a2i = 2.f * ar * ai, a3r = a2r * ar - a2i * ai, a3i = a2r * ai + a2i * ar, a4r = a2r * a2r - a2i * a2i, a4i = 2.f * a2r * a2i;
            float h1r[MT], h1i[MT], h2r[MT], h2i[MT], h3r[MT], h3i[MT], er[MT], ei[MT], cr[MT], ci[MT];
#pragma unroll
            for (int mt = 0; mt < MT; ++mt) {
                const f32x4 sr = acc[mt][i], si = acc[mt][2 + i];
                h1r[mt] = sr[0]; h1i[mt] = si[0];
                h2r[mt] = ar * h1r[mt] - ai * h1i[mt] + sr[1]; h2i[mt] = ar * h1i[mt] + ai * h1r[mt] + si[1];
                h3r[mt] = ar * h2r[mt] - ai * h2i[mt] + sr[2]; h3i[mt] = ar * h2i[mt] + ai * h2r[mt] + si[2];
                er[mt] = ar * h3r[mt] - ai * h3i[mt] + sr[3]; ei[mt] = ar * h3i[mt] + ai * h3r[mt] + si[3];
                cr[mt] = 0.f; ci[mt] = 0.f;
            }
            float kr = 0.f, ki = 0.f;
#pragma unroll
            for (int gi = 0; gi < 4 * MT; ++gi) {
                const int mt = gi >> 2, src = (gi & 3) * 16 + fr;
                const float xr = __shfl(er[mt], src), xi = __shfl(ei[mt], src);
                if ((gi & 3) == fq) { cr[mt] = kr; ci[mt] = ki; }
                const float nr = a4r * kr - a4i * ki + xr, ni = a4r * ki + a4i * kr + xi; kr = nr; ki = ni;
            }
            if (fq == 0) { F.out[O_PRE + ((size_t)b * 32 + g) * 64 + n] = kr; F.out[O_PIM + ((size_t)b * 32 + g) * 64 + n] = ki; }
#pragma unroll
            for (int mt = 0; mt < MT; ++mt) {
                const int c0 = mt * 16 + fq * 4;
                float* hp = HIN + (((size_t)b * 64 + c0) * 32 + g) * 128 + n;
                const float kr0 = cr[mt], ki0 = ci[mt];
                hp[0] = kr0; hp[64] = ki0;
                hp[4096] = ar * kr0 - ai * ki0 + h1r[mt]; hp[4096 + 64] = ar * ki0 + ai * kr0 + h1i[mt];
                hp[8192] = a2r * kr0 - a2i * ki0 + h2r[mt]; hp[8192 + 64] = a2r * ki0 + a2i * kr0 + h2i[mt];
                hp[12288] = a3r * kr0 - a3i * ki0 + h3r[mt]; hp[12288 + 64] = a3r * ki0 + a3i * kr0 + h3i[mt];
            }
            }
        }
    }
}

DI void p23_phase(const Frame& F) {
    constexpr int T_SSM = 36, T_ATT = 272, T_P3 = 528;
    unsigned* hc = WSP(unsigned, WS_CTL) + 3584 + 224;
    LAS float* ob = (LAS float*)F.lds;
    for (int t = F.bid; t < T_SSM; t += F.G) {
        const int wt = t * 8 + F.wave;
        if (wt < 256) ssm_state<4, false>(F, wt >> 5, wt & 31); else ssm_state<1, true>(F, 0, wt - 256);
        asm volatile("s_waitcnt vmcnt(0)" ::: "memory");
        __syncthreads();
        if (F.tid == 0 && t < 32) {
            __builtin_amdgcn_fence(__ATOMIC_RELEASE, "agent");
            asm volatile("s_waitcnt vmcnt(0)" ::: "memory");
            (void)__hip_atomic_fetch_add((GAS unsigned*)(hc + (t >> 2)), 1u, __ATOMIC_RELAXED, __HIP_MEMORY_SCOPE_AGENT);
        }
    }
    const int t0 = (F.bid >= T_SSM % F.G) ? F.bid - T_SSM % F.G : F.bid + F.G - T_SSM % F.G;
    for (int a = t0; a < T_ATT; a += F.G) {
        const int h = F.wave, kvh = h >> 2;
        const float sink = F.in[19][h]; const float* gat = F.in[21];
        if (a < 256) {
            const int b = a >> 5, c = a & 31, c0 = c < 2 ? 0 : c - 2, row0 = b * SEQ + c * 64;
            attn_task(WSP(bf16_t, WS_Q) + ((size_t)h * (M / 16) + (row0 >> 4)) * 1024, 4, WSP(bf16_t, WS_KB) + ((size_t)kvh * (M / 16) + ((b * SEQ + c0 * 64) >> 4)) * 1024, (c - c0 + 1) * 4,
                      WSP(bf16_t, WS_VT) + ((size_t)(b * 2 + kvh) * 64 + c0 * 2) * 2048, 0, sink, gat, WSP(bf16_t, WS_MIX) + (size_t)row0 * D + 512, ob, h, F.wave, F.lane);
        } else {
            const int sb = a - 256, row0 = MP + sb * 32;
            attn_task(WSP(bf16_t, WS_Q) + ((size_t)h * (M / 16) + (row0 >> 4)) * 1024, 2, WSP(bf16_t, WS_KS) + (size_t)(sb * 2 + kvh) * 10 * 1024, 10,
                      WSP(bf16_t, WS_VTS) + (size_t)(sb * 2 + kvh) * 5 * 2048, 0, sink, gat, WSP(bf16_t, WS_MIX) + (size_t)row0 * D + 512, ob, h, F.wave, F.lane);
        }
    }
}
constexpr int P3_LDY = 520, P3_LDU = 72, P3_UST = 36864;
DI void p3_zero(const Frame& F) {
    LAS u32x4* z = (LAS u32x4*)(F.lds + P3_UST + F.wave * (64 * P3_LDU * 2));
    for (int i = F.lane; i < 32 * P3_LDU * 2 / 16; i += 64) z[i] = (u32x4){0u, 0u, 0u, 0u};
}
DI void p3_load_u(const Frame& F, int ci, u32x4 (&uv)[4]) {
    const int row0 = ci < 512 ? (ci >> 6) * SEQ + (ci & 63) * 32 : MP + (ci - 512) * 32;
    const bf16_t* up = WSP(bf16_t, WS_U) + (size_t)(row0 + (F.lane >> 3)) * 512 + F.wave * 64 + (F.lane & 7) * 8;
#pragma unroll
    for (int i = 0; i < 4; ++i) uv[i] = *(const u32x4*)(up + (size_t)i * 8 * 512);
}
DI void p3_task(const Frame& F, int ci, const u32x4 (&uv)[4]) {
    const int lane = F.lane, fr = lane & 15, fq = lane >> 4, wave = F.wave;
    const int row0 = ci < 512 ? (ci >> 6) * SEQ + (ci & 63) * 32 : MP + (ci - 512) * 32;
    constexpr int LDY = P3_LDY, LDU = P3_LDU;
    LAS bf16_t* y1 = (LAS bf16_t*)F.lds; LAS float* ssq = (LAS float*)(F.lds + 32 * LDY * 2);
    LAS bf16_t* ust = (LAS bf16_t*)(F.lds + P3_UST) + wave * (64 * LDU);
    LAS float* hst = (LAS float*)(F.lds + P3_UST + 8 * 64 * P3_LDU * 2) + wave * 512;
    f32x4 hv[2];
    {
        if (ci < 512) { const f32x4* hs = (const f32x4*)(WSP(float, WS_HIN) + ((size_t)ci * 32 + wave * 4) * 128); hv[0] = hs[lane]; hv[1] = hs[64 + lane]; }
        else {
#pragma unroll
            for (int j = 0; j < 2; ++j) { const int idx = lane + 64 * j, gg = wave * 4 + (idx >> 5), w = idx & 31;
                hv[j] = *(const f32x4*)((w < 16 ? F.in[2] : F.in[3]) + ((size_t)(ci - 512) * 32 + gg) * 64 + (w & 15) * 4); }
        }
#pragma unroll
        for (int i = 0; i < 4; ++i) *(LAS u32x4*)(ust + (32 + (lane >> 3) + 8 * i) * LDU + (lane & 7) * 8) = uv[i];
    }
#pragma unroll 1
    for (int gi = 0; gi < 4; ++gi) {
        const int g = wave * 4 + gi;
        f32x4 acc0 = (f32x4){0.f, 0.f, 0.f, 0.f}, acc1 = acc0;
        const bf16_t* Kg = WSP(bf16_t, WS_KT) + (size_t)g * 8192 + lane * 8;
        const LAS bf16_t* ub = ust + (32 + fr - (fq >> 1)) * LDU + gi * 16 + (fq & 1) * 8;
#pragma unroll
        for (int kk = 0; kk < 16; ++kk) {
            const bf16x8 kf = *(const bf16x8*)(Kg + kk * 512);
            acc1 = MFMA16(kf, *(const LAS bf16x8*)(ub + (16 - 2 * kk) * LDU), acc1);
            if (kk < 8) acc0 = MFMA16(kf, *(const LAS bf16x8*)(ub - 2 * kk * LDU), acc0);
        }
        if (gi == 0) { *(LAS f32x4*)(hst + lane * 4) = hv[0]; *(LAS f32x4*)(hst + 256 + lane * 4) = hv[1]; }
        const LAS float* hre = hst + gi * 128; const LAS float* him = hre + 64;
#pragma unroll
        for (int nh = 0; nh < 2; ++nh) {
            const int n0 = nh * 32 + fq * 8;
            const f32x4 hr0 = *(const LAS f32x4*)(hre + n0), hr1 = *(const LAS f32x4*)(hre + n0 + 4), hi0 = *(const LAS f32x4*)(him + n0), hi1 = *(const LAS f32x4*)(him + n0 + 4);
            const bf16_t* cp = WSP(bf16_t, WS_CT) + (size_t)g * 2048 + lane * 8;
            const bf16x8 cref = *(const bf16x8*)(cp + nh * 512), cimf = *(const bf16x8*)(cp + (2 + nh) * 512);
#pragma unroll
            for (int mt = 0; mt < 2; ++mt) {
                const float* pp = WSP(float, WS_PRE) + (size_t)g * 4096 + (mt * 2 + nh) * 1024 + lane * 4;
                const f32x4 pr0 = *(const f32x4*)pp, pr1 = *(const f32x4*)(pp + 256), pi0 = *(const f32x4*)(pp + 512), pi1 = *(const f32x4*)(pp + 768);
                const f32x4 gr0 = pr0 * hr0 - pi0 * hi0, gr1 = pr1 * hr1 - pi1 * hi1, gi0 = pr0 * hi0 + pi0 * hr0, gi1 = pr1 * hi1 + pi1 * hr1;
                const bf16x8 gre = __builtin_bit_cast(bf16x8, pack8(gr0, gr1)), gim = __builtin_bit_cast(bf16x8, pack8(gi0, gi1));
                if (mt == 0) { acc0 = MFMA16(cref, gre, acc0); acc0 = MFMA16(cimf, gim, acc0); }
                else         { acc1 = MFMA16(cref, gre, acc1); acc1 = MFMA16(cimf, gim, acc1); }
            }
        }
        {   u32x2 w; w.x = pk2(gelu_tanh(acc0[0]), gelu_tanh(acc0[1])); w.y = pk2(gelu_tanh(acc0[2]), gelu_tanh(acc0[3]));
            *(LAS u32x2*)(y1 + fr * LDY + g * 16 + fq * 4) = w;
            w.x = pk2(gelu_tanh(acc1[0]), gelu_tanh(acc1[1])); w.y = pk2(gelu_tanh(acc1[2]), gelu_tanh(acc1[3]));
            *(LAS u32x2*)(y1 + (16 + fr) * LDY + g * 16 + fq * 4) = w; }
    }
    __syncthreads();
    f32x4 a2[2][4];
#pragma unroll
    for (int mt = 0; mt < 2; ++mt)
#pragma unroll
        for (int nt = 0; nt < 4; ++nt) a2[mt][nt] = (f32x4){0.f, 0.f, 0.f, 0.f};
    const bf16_t* Wg = WSP(bf16_t, WS_WGLU) + (size_t)(wave * 4) * 8192 + lane * 8;
#pragma unroll 4
    for (int kk = 0; kk < 16; ++kk) {
        bf16x8 yf[2], wf[4];
#pragma unroll
        for (int mt = 0; mt < 2; ++mt) yf[mt] = *(const LAS bf16x8*)(y1 + (mt * 16 + fr) * LDY + kk * 32 + fq * 8);
#pragma unroll
        for (int nt = 0; nt < 4; ++nt) wf[nt] = *(const bf16x8*)(Wg + (size_t)nt * 8192 + kk * 512);
#pragma unroll
        for (int mt = 0; mt < 2; ++mt)
#pragma unroll
            for (int nt = 0; nt < 4; ++nt) a2[mt][nt] = MFMA16(wf[nt], yf[mt], a2[mt][nt]);
    }
    float q2[2] = {0.f, 0.f};
#pragma unroll
    for (int mt = 0; mt < 2; ++mt)
#pragma unroll
        for (int nt = 0; nt < 4; ++nt) {
            const int n = wave * 64 + nt * 16 + fq * 4;
            const f32x4 bias = *(const f32x4*)(F.in[18] + n);
            const u32x2 yw = *(const LAS u32x2*)(y1 + (mt * 16 + fr) * LDY + n);
            const float y0 = bflo(yw.x), y1v = bfhi(yw.x), y2v = bflo(yw.y), y3 = bfhi(yw.y);
            f32x4 r; r[0] = y0 * sigm(a2[mt][nt][0] + bias[0]); r[1] = y1v * sigm(a2[mt][nt][1] + bias[1]); r[2] = y2v * sigm(a2[mt][nt][2] + bias[2]); r[3] = y3 * sigm(a2[mt][nt][3] + bias[3]);
            a2[mt][nt] = r; q2[mt] += r[0] * r[0] + r[1] * r[1] + r[2] * r[2] + r[3] * r[3];
        }
    q2[0] = xsum4(q2[0]); q2[1] = xsum4(q2[1]);
    if (fq == 0) { ssq[wave * 32 + fr] = q2[0]; ssq[wave * 32 + 16 + fr] = q2[1]; }
    __syncthreads();
#pragma unroll
    for (int mt = 0; mt < 2; ++mt) {
        float tot = 0.f;
#pragma unroll
        for (int w = 0; w < 8; ++w) tot += ssq[w * 32 + mt * 16 + fr];
        const float rs = rsqrtf(tot * (1.0f / 512.0f) + EPS);
#pragma unroll
        for (int nt = 0; nt < 4; ++nt) {
            const int n = wave * 64 + nt * 16 + fq * 4;
            const f32x4 g = *(const f32x4*)(F.in[20] + n);
            u32x2 w; w.x = pk2(a2[mt][nt][0] * rs * g[0], a2[mt][nt][1] * rs * g[1]); w.y = pk2(a2[mt][nt][2] * rs * g[2], a2[mt][nt][3] * rs * g[3]);
            *(u32x2*)(WSP(bf16_t, WS_MIX) + (size_t)(row0 + mt * 16 + fr) * D + n) = w;
        }
    }
    __syncthreads();
}

DI void late_weights(const Frame& F) {
    constexpr int T_WO = 128, T_WA = 8 * 44, T_WD = 22 * 16;
    LAS float* scr = (LAS float*)F.lds;
    const int nskip = ((36 + 272 + 528) % F.G), G = F.G - nskip;
    if (F.bid < nskip || G <= 0) return;
    int r = F.bid - nskip;
#define P0_LOOP(COUNT) for (int i = r; i < (COUNT); i += G)
#define P0_NEXT(COUNT) r = (r + G - (COUNT) % G) % G
    P0_LOOP(T_WO) p0_transpose(F.in[22], D, nullptr, WSP(bf16_t, WS_WO), D, (i % 8) * 128, (i / 8) * 64, (i / 8) * 64, scr, F.tid);
    P0_NEXT(T_WO);
    P0_LOOP(T_WA) { const int n0 = (i / 8) * 64; p0_transpose(F.in[24], FF, F.in[23], WSP(bf16_t, WS_W1), D, (i % 8) * 128, n0, (n0 >> 7) * 256 + (n0 & 127), scr, F.tid); }
    P0_NEXT(T_WA);
    P0_LOOP(T_WA) { const int n0 = (i / 8) * 64; p0_transpose(F.in[25], FF, F.in[23], WSP(bf16_t, WS_W1), D, (i % 8) * 128, n0, (n0 >> 7) * 256 + 128 + (n0 & 127), scr, F.tid); }
    P0_NEXT(T_WA);
    P0_LOOP(T_WD) p0_transpose(F.in[28], D, nullptr, WSP(bf16_t, WS_W2), FF, (i % 22) * 128, (i / 22) * 64, (i / 22) * 64, scr, F.tid);
    P0_NEXT(T_WD);
#undef P0_LOOP
#undef P0_NEXT
}

DI void p3_loop(const Frame& F) {
    constexpr int T_PRE = 36 + 272, T_P3 = 528;
    unsigned* hc = WSP(unsigned, WS_CTL) + 3584 + 224;
    p3_zero(F);
    const int r0 = T_PRE % F.G, c0 = (F.bid >= r0) ? F.bid - r0 : F.bid + F.G - r0;
    u32x4 uv[4];
    if (c0 < T_P3) p3_load_u(F, c0, uv);
    for (int ci = c0; ci < T_P3; ci += F.G) {
        u32x4 un[4];
        if (ci + F.G < T_P3) p3_load_u(F, ci + F.G, un);
        if (ci < 512) {
            if (F.tid == 0) {
                while (__hip_atomic_load((GAS unsigned*)(hc + (ci >> 6)), __ATOMIC_RELAXED, __HIP_MEMORY_SCOPE_AGENT) < 4u) __builtin_amdgcn_s_sleep(1);
                __builtin_amdgcn_fence(__ATOMIC_ACQUIRE, "agent");
                asm volatile("s_waitcnt vmcnt(0)" ::: "memory");
            }
            __syncthreads();
        }
        p3_task(F, ci, uv);
#pragma unroll
        for (int i = 0; i < 4; ++i) uv[i] = un[i];
    }
}

DI void panel_rs(float* part, unsigned* cnt, LAS float* lx, int pm, int pn, float* rs_out = nullptr) {
    const int tid = threadIdx.x;
    __syncthreads();
    if (tid < 256) st_agent(part + (size_t)(pm * 4 + pn) * 256 + tid, lx[tid] + lx[256 + tid] + lx[512 + tid] + lx[768 + tid]);
    asm volatile("s_waitcnt vmcnt(0)" ::: "memory");
    __syncthreads();
    if (tid == 0) arrive_and_wait(cnt + pm, 4u);
    __syncthreads();
    if (tid < 256) { const float* pp = part + (size_t)pm * 1024 + tid; const float r = rsqrtf((ld_agent(pp) + ld_agent(pp + 256) + ld_agent(pp + 512) + ld_agent(pp + 768)) * (1.0f / D) + EPS); lx[1024 + tid] = r;
        if (rs_out && pn == 0) rs_out[pm * 256 + tid] = r; }
    __syncthreads();
}
struct EpiOut {
    static constexpr bool PERM = true, AFTER_DRAIN = false;
    const float* xp; float* RS; bf16_t* X1B; float* part; unsigned* cnt; LAS float* lx;
    DI void operator()(const f32x4 (&acc_)[2][2][4][2], const pg8::Unit& u, int wr, int wc, int fr, int fq) const {
        f32x4 (&acc)[2][2][4][2] = const_cast<f32x4 (&)[2][2][4][2]>(acc_);
        const int row0 = u.pm * 256 + wr * 64 + fr, col0 = u.pn * 256 + wc * 32 + 8 * fq;
#pragma unroll
        for (int ai = 0; ai < 2; ++ai)
#pragma unroll
            for (int m = 0; m < 4; ++m) {
                const size_t ro = (size_t)(row0 + ai * 128 + m * 16) * D + col0;
                float q = 0.f;
#pragma unroll
                for (int bj = 0; bj < 2; ++bj) {
                    const f32x4 v0 = acc[ai][bj][m][0] + *(const f32x4*)(xp + ro + bj * 128), v1 = acc[ai][bj][m][1] + *(const f32x4*)(xp + ro + bj * 128 + 4);
                    acc[ai][bj][m][0] = v0; acc[ai][bj][m][1] = v1;
                    q += v0[0] * v0[0] + v0[1] * v0[1] + v0[2] * v0[2] + v0[3] * v0[3] + v1[0] * v1[0] + v1[1] * v1[1] + v1[2] * v1[2] + v1[3] * v1[3];
                }
                q = xsum4(q);
                if (fq == 0) lx[wc * 256 + ai * 128 + wr * 64 + m * 16 + fr] = q;
            }
        panel_rs(part, cnt, lx, u.pm, u.pn, RS);
#pragma unroll
        for (int ai = 0; ai < 2; ++ai)
#pragma unroll
            for (int m = 0; m < 4; ++m) {
                const float rs = lx[1024 + ai * 128 + wr * 64 + m * 16 + fr];
                const size_t ro = (size_t)(row0 + ai * 128 + m * 16) * D + col0;
#pragma unroll
                for (int bj = 0; bj < 2; ++bj) *(u32x4*)(X1B + ro + bj * 128) = pack8(acc[ai][bj][m][0] * rs, acc[ai][bj][m][1] * rs);
            }
    }
};

struct EpiFfn {
    static constexpr bool PERM = true, AFTER_DRAIN = false;
    unsigned char* ws; const float* const* in; float* out; LAS float* bnd;
    DI void operator()(const f32x4 (&acc)[2][2][4][2], const pg8::Unit& u, int wr, int wc, int fr, int fq) const {
        const bf16_t* const X1B = (const bf16_t*)(ws + WS_X1B); const bf16_t* const W1T = (const bf16_t*)(ws + WS_W1);
        bf16_t* const H = (bf16_t*)(ws + WS_H); const float* const cstate = in[6];
        const int pm = u.pm, pn = u.pn, rowt = pm * 256, wave = wr * 4 + wc, tid = threadIdx.x;
        const bool sample = pm >= 64;
        const int cl = wc * 32 + 8 * fq, ff = pn * 128 + cl;
        LAS float* cwl = bnd + 17 * 2 * 128;
        if (tid < 128) { const float* cw = in[26] + pn * 128 + tid; cwl[tid] = cw[0]; cwl[128 + tid] = cw[FF]; cwl[256 + tid] = cw[2 * FF]; cwl[384 + tid] = in[27][pn * 128 + tid]; }
#pragma unroll
        for (int ai = 0; ai < 2; ++ai)
#pragma unroll
            for (int m = 0; m < 4; ++m) {
                const int blk = 8 * ai + 4 * wr + m;
                if (fr >= 14) {
                    const f32x4 a0 = acc[ai][0][m][0], a1 = acc[ai][0][m][1];
                    if (!sample || (blk & 1) == 0) { LAS float* bp = bnd + ((blk + 1) * 2 + (fr - 14)) * 128 + cl; *(LAS f32x4*)bp = a0; *(LAS f32x4*)(bp + 4) = a1; }
                    if (sample && (blk & 1)) { float* sp = out + O_SCONV + ((size_t)((pm - 64) * 8 + (blk >> 1)) * 2 + (fr - 14)) * FF + ff; *(f32x4*)sp = a0; *(f32x4*)(sp + 4) = a1; }
                    if (!sample && (pm & 7) == 7 && blk == 15) { float* sp = out + O_PCONV + ((size_t)(pm >> 3) * 2 + (fr - 14)) * FF + ff; *(f32x4*)sp = a0; *(f32x4*)(sp + 4) = a1; }
                    if (sample && (blk & 1) == 0) {
                        const float* sp = cstate + ((size_t)((pm - 64) * 8 + (blk >> 1)) * 2 + (fr - 14)) * FF + ff;
                        LAS float* bp = bnd + (blk * 2 + (fr - 14)) * 128 + cl; *(LAS f32x4*)bp = *(const f32x4*)sp; *(LAS f32x4*)(bp + 4) = *(const f32x4*)(sp + 4);
                    }
                    if (!sample && (pm & 7) == 0 && blk == 0) { LAS float* bp = bnd + (fr - 14) * 128 + cl; *(LAS f32x4*)bp = (f32x4){0.f, 0.f, 0.f, 0.f}; *(LAS f32x4*)(bp + 4) = (f32x4){0.f, 0.f, 0.f, 0.f}; }
                }
            }
        if (!sample && (pm & 7) != 0) {
            const int lane = fq * 16 + fr;
            const bf16_t* xp = X1B + (size_t)(rowt - 2) * D + lane * 8;
            const u32x4 xa0 = *(const u32x4*)xp, xa1 = *(const u32x4*)(xp + 512), xb0 = *(const u32x4*)(xp + D), xb1 = *(const u32x4*)(xp + D + 512);
#pragma unroll 1
            for (int ps = 0; ps < 4; ++ps) {
                float p0[4], p1[4];
                const bf16_t* wp = W1T + (size_t)(pn * 256 + wave * 16 + ps * 4) * D + lane * 8;
#pragma unroll
                for (int c = 0; c < 4; ++c) {
                    const u32x4 a = *(const u32x4*)(wp + (size_t)c * D), b = *(const u32x4*)(wp + (size_t)c * D + 512);
                    float s0 = 0.f, s1 = 0.f;
#pragma unroll
                    for (int j = 0; j < 4; ++j) {
                        s0 = dot2bf(a[j], xa0[j], s0); s0 = dot2bf(b[j], xa1[j], s0);
                        s1 = dot2bf(a[j], xb0[j], s1); s1 = dot2bf(b[j], xb1[j], s1);
                    }
                    p0[c] = s0; p1[c] = s1;
                }
#define HALO_STEP(N, BIT) _Pragma("unroll") for (int c = 0; c < N; ++c) { const bool hi_ = (lane & BIT) != 0; \
                    const float s0_ = hi_ ? p0[c] : p0[c + N], s1_ = hi_ ? p1[c] : p1[c + N]; \
                    const float r0_ = __shfl_xor(s0_, BIT), r1_ = __shfl_xor(s1_, BIT); \
                    p0[c] = (hi_ ? p0[c + N] : p0[c]) + r0_; p1[c] = (hi_ ? p1[c + N] : p1[c]) + r1_; }
                HALO_STEP(2, 32) HALO_STEP(1, 16)
#undef HALO_STEP
                float t0 = p0[0], t1 = p1[0];
                t0 += __shfl_xor(t0, 8); t1 += __shfl_xor(t1, 8); t0 += __shfl_xor(t0, 4); t1 += __shfl_xor(t1, 4); t0 += __shfl_xor(t0, 2); t1 += __shfl_xor(t1, 2); t0 += __shfl_xor(t0, 1); t1 += __shfl_xor(t1, 1);
                if ((lane & 15) == 0) { const int col = wave * 16 + ps * 4 + ((lane >> 5) & 1) * 2 + ((lane >> 4) & 1);
                    bnd[col] = t0; bnd[128 + col] = t1; }
            }
        }
        __syncthreads();
#pragma unroll
        for (int ai = 0; ai < 2; ++ai)
#pragma unroll
            for (int m = 0; m < 4; ++m) {
                const int blk = 8 * ai + 4 * wr + m, row = rowt + ai * 128 + wr * 64 + m * 16 + fr;
                f32x4 hv[2];
#pragma unroll
                for (int n = 0; n < 2; ++n) {
                    const f32x4 cur = acc[ai][0][m][n], upv = acc[ai][1][m][n];
                    f32x4 p1, p2;
#pragma unroll
                    for (int e = 0; e < 4; ++e) { p1[e] = dpp_shr<0x111>(cur[e]); p2[e] = dpp_shr<0x112>(cur[e]); }
                    const f32x4 b0 = *(const LAS f32x4*)(bnd + (blk * 2 + 0) * 128 + cl + 4 * n), b1 = *(const LAS f32x4*)(bnd + (blk * 2 + 1) * 128 + cl + 4 * n);
                    if (fr == 0) { p1 = b1; p2 = b0; } else if (fr == 1) { p2 = b1; }
                    const LAS float* wl = cwl + cl + 4 * n;
                    const f32x4 c = *(const LAS f32x4*)(wl + 384) + *(const LAS f32x4*)wl * p2 + *(const LAS f32x4*)(wl + 128) * p1 + *(const LAS f32x4*)(wl + 256) * cur;
#pragma unroll
                    for (int e = 0; e < 4; ++e) hv[n][e] = c[e] * sigm(c[e]) * upv[e];
                }
                *(u32x4*)(H + (size_t)row * FF + ff) = pack8(hv[0], hv[1]);
            }
        __syncthreads();
    }
};

struct EpiDown {
    static constexpr bool PERM = true, AFTER_DRAIN = false;
    float* out; const bf16_t* X1B; const float* RS; const float* gfin; float* part; unsigned* cnt; LAS float* lx;
    DI void operator()(const f32x4 (&acc_)[2][2][4][2], const pg8::Unit& u, int wr, int wc, int fr, int fq) const {
        f32x4 (&acc)[2][2][4][2] = const_cast<f32x4 (&)[2][2][4][2]>(acc_);
        const int row0 = u.pm * 256 + wr * 64 + fr, col0 = u.pn * 256 + wc * 32 + 8 * fq;
#pragma unroll
        for (int ai = 0; ai < 2; ++ai)
#pragma unroll
            for (int m = 0; m < 4; ++m) {
                const int row = row0 + ai * 128 + m * 16;
                const bf16_t* xrow = X1B + (size_t)row * D + col0;
                const float ir = 1.0f / RS[row];
                float q = 0.f;
#pragma unroll
                for (int bj = 0; bj < 2; ++bj) {
                    const u32x4 xw = *(const u32x4*)(xrow + bj * 128);
                    const f32x4 x0 = (f32x4){bflo(xw.x), bfhi(xw.x), bflo(xw.y), bfhi(xw.y)}, x1v = (f32x4){bflo(xw.z), bfhi(xw.z), bflo(xw.w), bfhi(xw.w)};
                    const f32x4 v0 = acc[ai][bj][m][0] + x0 * ir, v1 = acc[ai][bj][m][1] + x1v * ir;
                    acc[ai][bj][m][0] = v0; acc[ai][bj][m][1] = v1;
                    q += v0[0] * v0[0] + v0[1] * v0[1] + v0[2] * v0[2] + v0[3] * v0[3] + v1[0] * v1[0] + v1[1] * v1[1] + v1[2] * v1[2] + v1[3] * v1[3];
                }
                q = xsum4(q);
                if (fq == 0) lx[wc * 256 + ai * 128 + wr * 64 + m * 16 + fr] = q;
            }
        panel_rs(part, cnt, lx, u.pm, u.pn);
        f32x4 gv[2][2];
#pragma unroll
        for (int bj = 0; bj < 2; ++bj) { gv[bj][0] = *(const f32x4*)(gfin + col0 + bj * 128); gv[bj][1] = *(const f32x4*)(gfin + col0 + bj * 128 + 4); }
#pragma unroll
        for (int ai = 0; ai < 2; ++ai)
#pragma unroll
            for (int m = 0; m < 4; ++m) {
                float* orow = out + (size_t)(row0 + ai * 128 + m * 16) * D + col0;
                const float rs = lx[1024 + ai * 128 + wr * 64 + m * 16 + fr];
#pragma unroll
                for (int bj = 0; bj < 2; ++bj) { *(f32x4*)(orow + bj * 128) = acc[ai][bj][m][0] * rs * gv[bj][0]; *(f32x4*)(orow + bj * 128 + 4) = acc[ai][bj][m][1] * rs * gv[bj][1]; }
            }
    }
};


template <int K> DI f32x4 mini_tile_ks(const Frame& F, const bf16_t* __restrict__ A, const bf16_t* __restrict__ Bt, int row0, int col0) {
    constexpr int KC = 256, LDT = 264, NCH = K / KC, LDR = 68;
    const int tid = F.tid, lane = F.lane, fr = lane & 15, fq = lane >> 4, mt = F.wave & 1, nt = F.wave >> 1;
    LAS bf16_t* tile = (LAS bf16_t*)F.lds;
    const bf16_t* src[6]; int dst[6];
#pragma unroll
    for (int j = 0; j < 6; ++j) { const int p = tid + 512 * j, r = p >> 5, c = (p & 31) * 8;
        src[j] = (r < 32 ? A + (size_t)(row0 + r) * K : Bt + (size_t)(col0 + r - 32) * K) + c; dst[j] = r * LDT + c; }
    u32x4 pre[6];
#pragma unroll
    for (int j = 0; j < 6; ++j) pre[j] = *(const u32x4*)src[j];
    f32x4 acc = (f32x4){0.f, 0.f, 0.f, 0.f};
#pragma unroll 1
    for (int ch = 0; ch < NCH; ++ch) {
#pragma unroll
        for (int j = 0; j < 6; ++j) *(LAS u32x4*)(tile + dst[j]) = pre[j];
        __syncthreads();
        if (ch + 1 < NCH) {
#pragma unroll
            for (int j = 0; j < 6; ++j) pre[j] = *(const u32x4*)(src[j] + (size_t)(ch + 1) * KC);
        }
        const LAS bf16_t* xa = tile + (mt * 16 + fr) * LDT + fq * 8;
        const LAS bf16_t* wb = tile + (32 + nt * 16 + fr) * LDT + fq * 8;
#pragma unroll
        for (int ks = 0; ks < KC / 32; ++ks) acc = MFMA16(*(const LAS bf16x8*)(wb + ks * 32), *(const LAS bf16x8*)(xa + ks * 32), acc);
        __syncthreads();
    }
    LAS float* red = (LAS float*)F.lds;
    *(LAS f32x4*)(red + (mt * 16 + fr) * LDR + nt * 16 + fq * 4) = acc;
    __syncthreads();
    const f32x4 out = *(const LAS f32x4*)(red + (tid >> 4) * LDR + (tid & 15) * 4);
    __syncthreads();
    return out;
}
constexpr int MINI_PARK = LDS_X + 8192;
DI void p4_sample_a(const Frame& F) {
    if (F.bid >= 256) return;
    float* PS = WSP(float, WS_PARTS); unsigned* cnt = WSP(unsigned, WS_CTL) + 3584 + 192;
    const int t = F.bid, rg = t & 15, cg = t >> 4, rl = F.tid >> 4, row = MP + rg * 32 + rl, n0 = cg * 64 + (F.tid & 15) * 4;
    const f32x4 acc = mini_tile_ks<D>(F, WSP(bf16_t, WS_MIX), WSP(bf16_t, WS_WO), MP + rg * 32, cg * 64);
    const f32x4 v = acc + *(const f32x4*)(F.in[1] + (size_t)(row - MP) * D + n0);
    float q = v[0] * v[0] + v[1] * v[1] + v[2] * v[2] + v[3] * v[3];
    q += __shfl_xor(q, 1); q += __shfl_xor(q, 2); q += __shfl_xor(q, 4); q += __shfl_xor(q, 8);
    if ((F.tid & 15) == 0) st_agent(PS + (size_t)(rg * 16 + cg) * 32 + rl, q);
    *(LAS f32x4*)(F.lds + MINI_PARK + F.tid * 16) = v;
    asm volatile("s_waitcnt vmcnt(0)" ::: "memory");
    __syncthreads();
    if (F.tid == 0) (void)__hip_atomic_fetch_add((GAS unsigned*)(cnt + rg), 1u, __ATOMIC_RELAXED, __HIP_MEMORY_SCOPE_AGENT);
}
DI void p4_sample_b(const Frame& F) {
    if (F.bid >= 256) return;
    float* PS = WSP(float, WS_PARTS); unsigned* cnt = WSP(unsigned, WS_CTL) + 3584 + 192;
    const int t = F.bid, rg = t & 15, cg = t >> 4, rl = F.tid >> 4, row = MP + rg * 32 + rl, n0 = cg * 64 + (F.tid & 15) * 4;
    if (F.tid == 0) wait_ge16(cnt + rg);
    __syncthreads();
    float tot = 0.f;
#pragma unroll
    for (int c = 0; c < 16; ++c) tot += ld_agent(PS + (size_t)(rg * 16 + c) * 32 + rl);
    const float rs = rsqrtf(tot * (1.0f / D) + EPS);
    const f32x4 v = *(const LAS f32x4*)(F.lds + MINI_PARK + F.tid * 16);
    *(f32x4*)(WSP(float, WS_X1F) + (size_t)row * D + n0) = v;
    u32x2 w; w.x = pk2(v[0] * rs, v[1] * rs); w.y = pk2(v[2] * rs, v[3] * rs); *(u32x2*)(WSP(bf16_t, WS_X1B) + (size_t)row * D + n0) = w;
}
DI void p6_sample_a(const Frame& F) {
    if (F.bid >= 256) return;
    float* PS = WSP(float, WS_PARTS); unsigned* cnt = WSP(unsigned, WS_CTL) + 3584 + 208;
    const int t = F.bid, rg = t & 15, cg = t >> 4, rl = F.tid >> 4, row = MP + rg * 32 + rl, n0 = cg * 64 + (F.tid & 15) * 4;
    const f32x4 acc = mini_tile_ks<FF>(F, WSP(bf16_t, WS_H), WSP(bf16_t, WS_W2), MP + rg * 32, cg * 64);
    const f32x4 v = acc + *(const f32x4*)(WSP(float, WS_X1F) + (size_t)row * D + n0);
    float q = v[0] * v[0] + v[1] * v[1] + v[2] * v[2] + v[3] * v[3];
    q += __shfl_xor(q, 1); q += __shfl_xor(q, 2); q += __shfl_xor(q, 4); q += __shfl_xor(q, 8);
    if ((F.tid & 15) == 0) st_agent(PS + (size_t)(rg * 16 + cg) * 32 + rl, q);
    *(LAS f32x4*)(F.lds + MINI_PARK + F.tid * 16) = v;
    asm volatile("s_waitcnt vmcnt(0)" ::: "memory");
    __syncthreads();
    if (F.tid == 0) (void)__hip_atomic_fetch_add((GAS unsigned*)(cnt + rg), 1u, __ATOMIC_RELAXED, __HIP_MEMORY_SCOPE_AGENT);
}
DI void p6_sample_b(const Frame& F) {
    if (F.bid >= 256) return;
    float* PS = WSP(float, WS_PARTS); unsigned* cnt = WSP(unsigned, WS_CTL) + 3584 + 208;
    const int t = F.bid, rg = t & 15, cg = t >> 4, rl = F.tid >> 4, row = MP + rg * 32 + rl, n0 = cg * 64 + (F.tid & 15) * 4;
    if (F.tid == 0) wait_ge16(cnt + rg);
    __syncthreads();
    float tot = 0.f;
#pragma unroll
    for (int c = 0; c < 16; ++c) tot += ld_agent(PS + (size_t)(rg * 16 + c) * 32 + rl);
    const float rs = rsqrtf(tot * (1.0f / D) + EPS);
    const f32x4 v = *(const LAS f32x4*)(F.lds + MINI_PARK + F.tid * 16);
    *(f32x4*)(F.out + (size_t)row * D + n0) = v * rs * *(const f32x4*)(F.in[29] + n0);
}

#define RLX_AGENT __ATOMIC_RELAXED, __HIP_MEMORY_SCOPE_AGENT
#define XB_TMO      128
#define XB_XCNT(j)  (256  + 64 * (j))
#define XB_XSUB(j)  (1280 + 64 * (j))
#define XB_XGEN(j)  (2304 + 64 * (j))
#define XB_TOP      3328
#define XB_TOPGEN   3392
#define XCD_BAR_WORDS 3456
#define XB_SPIN_CAP (1u << 18)

__device__ __forceinline__ unsigned xb_ld(unsigned* p)              { return __hip_atomic_load(p, __ATOMIC_RELAXED, __HIP_MEMORY_SCOPE_AGENT); }
__device__ __forceinline__ unsigned xb_add(unsigned* p, unsigned v) { return __hip_atomic_fetch_add(p, v, __ATOMIC_RELAXED, __HIP_MEMORY_SCOPE_AGENT); }
__device__ __forceinline__ unsigned xb_xcc_id() { return (unsigned)__builtin_amdgcn_s_getreg((3 << 11) | 20) & 0xFu; }
#define XB_SPIN(cond, bar) do { unsigned _sp = 0; while (cond) { __builtin_amdgcn_s_sleep(1); \
    if ((++_sp & 255u) == 0u) { if (xb_ld(&(bar)[XB_TMO])) break; if (_sp > XB_SPIN_CAP) { atomicAdd(&(bar)[XB_TMO], 1u); break; } } } } while (0)

struct XcdBarrier {
    unsigned* bar; unsigned x;
    volatile LAS unsigned* st;
};

__device__ __forceinline__ XcdBarrier xcd_barrier_post(unsigned* bar, volatile LAS unsigned* st) {
    XcdBarrier b; b.bar = bar; b.x = xb_xcc_id(); b.st = st;
    if (threadIdx.x == 0) (void)xb_add(&bar[XB_XCNT(b.x)], 1u);
    return b;
}
__device__ __forceinline__ void xcd_barrier_complete(unsigned* bar, unsigned x, unsigned& nloc, unsigned& nx) {
    const unsigned G = gridDim.x * gridDim.y * gridDim.z;
    unsigned sum, cnt, mine, sp = 0u;
    for (;;) {
        sum = 0u; cnt = 0u; mine = 0u;
#pragma unroll
        for (unsigned j = 0; j < 16; ++j) { const unsigned c = xb_ld(&bar[XB_XCNT(j)]); sum += c; cnt += (c > 0u) ? 1u : 0u; mine = (j == x) ? c : mine; }
        if (sum == G) break;
        __builtin_amdgcn_s_sleep(1);
        if ((++sp & 255u) == 0u) { if (xb_ld(&bar[XB_TMO])) break; if (sp > XB_SPIN_CAP) { atomicAdd(&bar[XB_TMO], 1u); break; } }
    }
    nloc = mine > 0u ? mine : 1u; nx = cnt > 0u ? cnt : 1u;
}

__device__ __forceinline__ void xcd_barrier(const XcdBarrier& b) {
    asm volatile("s_waitcnt vmcnt(0)" ::: "memory");
    __syncthreads();
    if (threadIdx.x == 0) {
        unsigned* bar = b.bar;
        __builtin_amdgcn_s_waitcnt(0);
        unsigned nloc = b.st[0], nx = b.st[1];
        if (nloc == 0u) { xcd_barrier_complete(bar, b.x, nloc, nx); b.st[0] = nloc; b.st[1] = nx; }
        const unsigned old = xb_add(&bar[XB_XSUB(b.x)], 1u);
        const unsigned gen = old / nloc;
        if (old + 1u == (gen + 1u) * nloc) {
            __builtin_amdgcn_fence(__ATOMIC_RELEASE, "agent");
            asm volatile("s_waitcnt vmcnt(0)" ::: "memory");
            const unsigned og = xb_add(&bar[XB_TOP], 1u);
            const unsigned tg = og / nx;
            if (og + 1u == (tg + 1u) * nx) xb_add(&bar[XB_TOPGEN], 1u);
            else XB_SPIN(xb_ld(&bar[XB_TOPGEN]) == tg, bar);
            __builtin_amdgcn_fence(__ATOMIC_ACQUIRE, "agent");
            xb_add(&bar[XB_XGEN(b.x)], 1u);
            asm volatile("s_waitcnt vmcnt(0)" ::: "memory");
        } else {
            XB_SPIN(xb_ld(&bar[XB_XGEN(b.x)]) == gen, bar);
            __builtin_amdgcn_fence(__ATOMIC_ACQUIRE, "agent");
            asm volatile("s_waitcnt vmcnt(0)" ::: "memory");
        }
    }
    __syncthreads();
}

DI void grid_bar(unsigned* ctr, unsigned target) {
    asm volatile("s_waitcnt vmcnt(0)" ::: "memory");
    __syncthreads();
    if (threadIdx.x == 0) {
        __builtin_amdgcn_fence(__ATOMIC_RELEASE, "agent");
        asm volatile("s_waitcnt vmcnt(0)" ::: "memory");
        (void)__hip_atomic_fetch_add(ctr, 1u, __ATOMIC_RELAXED, __HIP_MEMORY_SCOPE_AGENT);
        while (__hip_atomic_load(ctr, __ATOMIC_RELAXED, __HIP_MEMORY_SCOPE_AGENT) < target) __builtin_amdgcn_s_sleep(1);
        __builtin_amdgcn_fence(__ATOMIC_ACQUIRE, "agent");
        asm volatile("s_waitcnt vmcnt(0)" ::: "memory");
    }
    __syncthreads();
}

#ifndef PH_MASK
#define PH_MASK 255
#endif
__global__ void __launch_bounds__(512, 2) mega_fwd(Args args) {
    extern __shared__ __attribute__((aligned(16))) unsigned char lds_raw[];
    cg::grid_group grid = cg::this_grid();
    Frame F;
    F.lds = (LAS unsigned char*)lds_raw; F.tid = threadIdx.x; F.lane = F.tid & 63; F.wave = __builtin_amdgcn_readfirstlane(F.tid >> 6);
    F.G = gridDim.x; F.bid = blockIdx.x; F.in = args.in; F.out = args.out; F.ws = args.ws;
    const int lo = args.ph_lo, hi = args.ph_hi;
#define IN(k) (((PH_MASK >> (k)) & 1) && lo <= (k) && (k) < hi)
    volatile LAS unsigned* xb_st = (volatile LAS unsigned*)(F.lds + LDS_BYTES - 64);
    if (F.tid < 2) xb_st[F.tid] = 0u;
    __syncthreads();
    XcdBarrier xbar; xbar.bar = WSP(unsigned, WS_CTL); xbar.x = 0; xbar.st = xb_st;
    if (lo + 1 < hi) xbar = xcd_barrier_post(WSP(unsigned, WS_CTL), xb_st);
    unsigned bar_n = 0;
#ifdef USE_CG_SYNC
#define SEAM(k) do { if (lo <= (k) && (k) + 1 < hi) grid.sync(); } while (0)
#else
#ifdef USE_CENTRAL_BAR
#define SEAM(k) do { if (lo <= (k) && (k) + 1 < hi) { bar_n += (unsigned)F.G; grid_bar(WSP(unsigned, WS_CTL) + 3520, bar_n); } } while (0)
#else
#define SEAM(k) do { if (lo <= (k) && (k) + 1 < hi) xcd_barrier(xbar); } while (0)
#endif
#endif
    if (hi > 8) grid.sync();
#ifndef REP_MASK
#define REP_MASK 0
#endif
#define REPS(k) for (int rep_ = 0; rep_ < 1 + ((REP_MASK >> (k)) & 1); ++rep_)
    if (IN(0)) { p0_prologue(F); } SEAM(0);
#ifdef EXTRA_SYNC
    for (int i_ = 0; i_ < EXTRA_SYNC; ++i_) SEAM(0);
#endif
#if (REP_MASK >> 0) & 1
    p0_prologue(F); grid.sync();
#endif
    if (IN(1)) {
        pg8::Gemm g{WSP(bf16_t, WS_XN), WSP(bf16_t, WS_WIN), M, INW, D}; pg8::StaticOrder S; S.init(M, INW, F.G, F.bid);
        EpiIn E{F.ws, F.out};
        pg8::gemm_phase<EpiIn, pg8::StaticOrder, true, true>(F.lds, g, S, E);
        p1_tail(F);
    } SEAM(1);
    if (IN(2)) { p23_phase(F); p3_loop(F); late_weights(F); }
#if (REP_MASK >> 2) & 1
    p2_phase(F); grid.sync();
#endif
    SEAM(2);
#if (REP_MASK >> 3) & 1
    for (int t = F.bid; t < 528; t += F.G) p3_task(F, t); grid.sync();
#endif
    if (IN(4)) {
        p4_sample_a(F);
        pg8::Gemm g{WSP(bf16_t, WS_MIX), WSP(bf16_t, WS_WO), MP, D, D}; pg8::StaticOrder S; S.init(MP, D, F.G, F.bid);
        EpiOut E{F.in[0], WSP(float, WS_SSQ), WSP(bf16_t, WS_X1B), WSP(float, WS_PART), WSP(unsigned, WS_CTL) + 3584 + 128, (LAS float*)(F.lds + LDS_X)};
        pg8::gemm_phase<EpiOut, pg8::StaticOrder, true, true>(F.lds, g, S, E);
        p4_sample_b(F);
    } SEAM(4);
    if (IN(5)) {
        pg8::Gemm g{WSP(bf16_t, WS_X1B), WSP(bf16_t, WS_W1), M, 2 * FF, D}; pg8::StaticOrder S; S.init(M, 2 * FF, F.G, F.bid);
        EpiFfn E{F.ws, F.in, F.out, (LAS float*)(F.lds + LDS_X)};
        pg8::gemm_phase<EpiFfn, pg8::StaticOrder, true, true>(F.lds, g, S, E);
    } SEAM(5);
    if (IN(6)) {
        p6_sample_a(F);
        pg8::Gemm g{WSP(bf16_t, WS_H), WSP(bf16_t, WS_W2), MP, D, FF}; pg8::StaticOrder S; S.init(MP, D, F.G, F.bid);
        EpiDown E{F.out, WSP(bf16_t, WS_X1B), WSP(float, WS_SSQ), F.in[29], WSP(float, WS_PART), WSP(unsigned, WS_CTL) + 3584 + 64, (LAS float*)(F.lds + LDS_X)};
        pg8::gemm_phase<EpiDown, pg8::StaticOrder, true, true>(F.lds, g, S, E);
        p6_sample_b(F);
    }
#undef IN
#undef SEAM
}

extern "C" void kernel_launch(void* const* d_in, const int* in_sizes, int n_in, void* d_out, int out_size, void* d_ws, size_t ws_size, hipStream_t stream) {
    static int grid = 0;
    if (grid == 0) {
        if (n_in != 30 || ws_size < WS_END) { fprintf(stderr, "kernel_launch: unexpected n_in %d / ws_size %zu (need %zu)\n", n_in, ws_size, (size_t)WS_END); grid = -1; return; }
        int dev = 0, cus = 0, per_cu = 0;
        (void)hipGetDevice(&dev); (void)hipDeviceGetAttribute(&cus, hipDeviceAttributeMultiprocessorCount, dev);
        if (hipFuncSetAttribute((const void*)mega_fwd, hipFuncAttributeMaxDynamicSharedMemorySize, LDS_BYTES) != hipSuccess) { fprintf(stderr, "hipFuncSetAttribute failed\n"); grid = -1; return; }
        if (hipOccupancyMaxActiveBlocksPerMultiprocessor(&per_cu, (const void*)mega_fwd, 512, LDS_BYTES) != hipSuccess || per_cu < 1) { fprintf(stderr, "occupancy query: %d\n", per_cu); per_cu = 1; }
        (void)hipGetLastError();
        grid = cus * (per_cu > 1 ? 1 : per_cu);
        if (grid <= 0) grid = 256;
    }
    if (grid < 0) return;
    Args a{};
    for (int i = 0; i < 30; ++i) a.in[i] = (const float*)d_in[i];
    a.out = (float*)d_out; a.ws = (unsigned char*)d_ws;
    (void)hipMemsetAsync((unsigned char*)d_ws + WS_CTL, 0, 16384, stream);
#if N_LAUNCHES == 1
    a.ph_lo = 0; a.ph_hi = 8;
    void* kargs[] = {&a};
    hipError_t e = hipLaunchCooperativeKernel((const void*)mega_fwd, dim3(grid), dim3(512), kargs, LDS_BYTES, stream);
    if (e != hipSuccess) fprintf(stderr, "cooperative launch failed: %s (grid %d)\n", hipGetErrorString(e), grid);
#else
    for (int p = 0; p < 8; ++p) { a.ph_lo = p; a.ph_hi = p + 1; for (int r = 0; r < 1 + ((HOST_REP >> p) & 1); ++r) hipLaunchKernelGGL(mega_fwd, dim3(grid), dim3(512), LDS_BYTES, stream, a); }
#endif
}
```

```cpp
#include <hip/hip_runtime.h>
#include <hip/hip_cooperative_groups.h>
#include <cstdio>
#include <cstdint>
namespace cg = cooperative_groups;

namespace pg8 {
#define PG8_LAS __attribute__((address_space(3)))
typedef unsigned short bf16_t;
typedef short bf16x8 __attribute__((ext_vector_type(8)));
typedef float f32x4 __attribute__((ext_vector_type(4)));
typedef unsigned u32x4 __attribute__((ext_vector_type(4)));
constexpr int BM = 256, BK = 64, HALF = 128, HTB = HALF * BK * 2  , STAGE_BYTES = 8 * HTB, NXCD = 8, WGM = 8;

__host__ __device__ __forceinline__ int lds_byte(int r, int c) { const int st = (r >> 4) * 2 + (c >> 5), rr = r & 15, cc = c & 31, ob = rr * 64 + cc * 2; return st * 1024 + (ob ^ (((ob >> 9) & 1) << 5)); }
__host__ __device__ __forceinline__ void stage_rc(int b, int& R, int& C) { const int st = b / 1024, sb = b % 1024, swz = sb ^ (((sb >> 9) & 1) << 5); R = (st >> 1) * 16 + swz / 64; C = (st & 1) * 32 + (swz % 64) / 2; }
__host__ __device__ __forceinline__ int perm32(int rho) { const int n = rho >> 4, i = rho & 15; return 8 * (i >> 2) + 4 * n + (i & 3); }

struct Unit { int pm, pn; };
struct Gemm { const bf16_t* A; const bf16_t* Bt; int M, N, K; };

struct StaticOrder {
    int nM, nN, nwg, G, c;
    __host__ __device__ void init(int M, int N, int G_, int c_) { nM = M / BM; nN = N / BM; nwg = nM * nN; G = G_; c = c_; }
    __host__ __device__ bool next(int i, Unit& u) const {
        const long L = (long)i * G + c; if (L >= nwg) return false;
        int wgid = (int)L; { const int q = nwg / NXCD, r = nwg % NXCD, xcd = wgid % NXCD, off = wgid / NXCD; wgid = (xcd < r ? xcd * (q + 1) : r * (q + 1) + (xcd - r) * q) + off; }
        const int nig = WGM * nN, gid = wgid / nig, fm = gid * WGM, gsz = (nM - fm) < WGM ? (nM - fm) : WGM;
        u.pm = fm + ((wgid % nig) % gsz); u.pn = (wgid % nig) / gsz; return true;
    }
    __device__ __forceinline__ void a_ready(const Unit&) const {}
    __device__ __forceinline__ void done(const Unit&) const {}
};

__device__ __forceinline__ unsigned cvt_pk_bf16(float lo, float hi) { unsigned r; asm volatile("v_cvt_pk_bf16_f32 %0, %1, %2" : "=v"(r) : "v"(lo), "v"(hi)); return r; }
template <class Epi, class Sched, bool ALIGN_EPI = false, bool SP2 = false>
__device__ __forceinline__ void gemm_phase(PG8_LAS unsigned char* lds, const Gemm g, const Sched& S, const Epi& E) {
    const int tid = threadIdx.x, wid = __builtin_amdgcn_readfirstlane(tid >> 6), lane = tid & 63, wr = wid >> 2, wc = wid & 3, fr = lane & 15, fq = lane >> 4;
    const int K = g.K, nt = K / BK;
    unsigned voffA[2], voffB[2];
#pragma unroll
    for (int i = 0; i < 2; ++i) { int R, C; stage_rc(tid * 16 + i * 8192, R, C); const int Rb = Epi::PERM ? ((R & ~31) + perm32(R & 31)) : R;
        voffA[i] = (unsigned)(R * K + C) * 2u; voffB[i] = (unsigned)(Rb * K + C) * 2u; }
    const size_t kstep = (size_t)(BK * 2);
    const size_t hstep = (size_t)HALF * K * 2;
    const size_t tstep = 2 * hstep;
    const unsigned ldsw = (unsigned)wid * 1024u;
    const int aoff = lds_byte(wr * 64 + fr, fq * 8), boff = lds_byte(wc * 32 + fr, fq * 8);
#define PG8_SA(b, h) (((b) * 2 + (h)) * HTB)
#define PG8_SB(b, h) ((4 + (b) * 2 + (h)) * HTB)
#define PG8_STAGE(bufoff, gbase, voff) do { _Pragma("unroll") for (int _i = 0; _i < 2; ++_i) \
        __builtin_amdgcn_global_load_lds((const unsigned*)((const char*)(gbase) + (voff)[_i]), (PG8_LAS unsigned*)(lds + (bufoff) + ldsw + _i * 8192), 16, 0, 0); } while (0)
#define PG8_LDA(dst, b, h) do { _Pragma("unroll") for (int m = 0; m < 4; ++m) _Pragma("unroll") for (int k = 0; k < 2; ++k) dst[m][k] = *(const PG8_LAS bf16x8*)(lds + PG8_SA(b, h) + aoff + m * 2048 + k * 1024); } while (0)
#define PG8_LDB(dst, b, h) do { _Pragma("unroll") for (int n = 0; n < 2; ++n) _Pragma("unroll") for (int k = 0; k < 2; ++k) dst[n][k] = *(const PG8_LAS bf16x8*)(lds + PG8_SB(b, h) + boff + n * 2048 + k * 1024); } while (0)
#define PG8_MMA(ai, bj, At, Bt) do { __builtin_amdgcn_s_setprio(1); _Pragma("unroll") for (int m = 0; m < 4; ++m) _Pragma("unroll") for (int n = 0; n < 2; ++n) _Pragma("unroll") for (int k = 0; k < 2; ++k) \
        acc[ai][bj][m][n] = __builtin_amdgcn_mfma_f32_16x16x32_bf16(Bt[n][k], At[m][k], acc[ai][bj][m][n], 0, 0, 0); __builtin_amdgcn_s_setprio(0); } while (0)
#define PG8_WAIT_V(n) asm volatile("s_waitcnt vmcnt(" #n ")" ::: "memory")
#define PG8_WAIT_L(n) asm volatile("s_waitcnt lgkmcnt(" #n ")" ::: "memory")
#define PG8_BAR __builtin_amdgcn_s_barrier()
#define PG8_SCHED __builtin_amdgcn_sched_barrier(0)
    Unit cur, nxt; int ui = 0;
    if (!S.next(0, cur)) return;
    f32x4 acc[2][2][4][2];
#pragma unroll
    for (int a = 0; a < 2; ++a)
#pragma unroll
        for (int b = 0; b < 2; ++b)
#pragma unroll
            for (int m = 0; m < 4; ++m)
#pragma unroll
                for (int n = 0; n < 2; ++n) acc[a][b][m][n] = (f32x4){0.f, 0.f, 0.f, 0.f};
    bf16x8 At[4][2], B0[2][2], B1[2][2];
    const char* cA = (const char*)g.A + (size_t)cur.pm * tstep; const char* cB = (const char*)g.Bt + (size_t)cur.pn * tstep;
    S.a_ready(cur);
    if constexpr (SP2) {
        PG8_STAGE(PG8_SB(0, 0), cB, voffB); PG8_STAGE(PG8_SB(0, 1), cB + hstep, voffB); PG8_STAGE(PG8_SA(0, 0), cA, voffA); PG8_STAGE(PG8_SA(0, 1), cA + hstep, voffA);
        if (wr == 1) PG8_BAR;
        PG8_WAIT_V(2); PG8_BAR;
        PG8_STAGE(PG8_SB(1, 0), cB + kstep, voffB); PG8_STAGE(PG8_SA(1, 0), cA + kstep, voffA); PG8_STAGE(PG8_SB(1, 1), cB + hstep + kstep, voffB);
        PG8_WAIT_V(6); PG8_BAR;
    } else {
        PG8_STAGE(PG8_SB(0, 0), cB, voffB); PG8_STAGE(PG8_SA(0, 0), cA, voffA); PG8_STAGE(PG8_SB(0, 1), cB + hstep, voffB); PG8_STAGE(PG8_SA(0, 1), cA + hstep, voffA);
        if (wr == 1) PG8_BAR;
        PG8_WAIT_V(4); PG8_BAR;
        PG8_STAGE(PG8_SB(1, 0), cB + kstep, voffB); PG8_STAGE(PG8_SA(1, 0), cA + kstep, voffA); PG8_STAGE(PG8_SB(1, 1), cB + hstep + kstep, voffB);
        PG8_WAIT_V(6); PG8_BAR;
    }
    for (;;) {
        const bool has_next = S.next(ui + 1, nxt);
        const char* nA = has_next ? (const char*)g.A + (size_t)nxt.pm * tstep : cA; const char* nB = has_next ? (const char*)g.Bt + (size_t)nxt.pn * tstep : cB;
        for (int t = 0; t < nt; t += 2) {
            const bool last = (t == nt - 2);
            const char* a1 = cA + (size_t)(t + 1) * kstep;
            const char* a2 = last ? nA : cA + (size_t)(t + 2) * kstep; const char* b2 = last ? nB : cB + (size_t)(t + 2) * kstep;
            const char* a3 = a2 + kstep; const char* b3 = b2 + kstep;
            if (last && has_next) S.a_ready(nxt);
            if constexpr (SP2) {
            PG8_LDB(B0, 0, 0); PG8_LDB(B1, 0, 1); PG8_SCHED; PG8_LDA(At, 0, 0); PG8_STAGE(PG8_SA(1, 1), a1 + hstep, voffA);
            PG8_WAIT_V(8); PG8_WAIT_L(0); PG8_BAR; PG8_MMA(0, 0, At, B0); PG8_MMA(0, 1, At, B1); PG8_BAR; PG8_SCHED;
            PG8_LDA(At, 0, 1); PG8_STAGE(PG8_SB(0, 0), b2, voffB); PG8_STAGE(PG8_SB(0, 1), b2 + hstep, voffB); PG8_STAGE(PG8_SA(0, 0), a2, voffA);
            PG8_WAIT_V(8); PG8_WAIT_L(0); PG8_BAR; PG8_MMA(1, 0, At, B0); PG8_MMA(1, 1, At, B1); PG8_BAR; PG8_SCHED;
            PG8_LDB(B0, 1, 0); PG8_LDB(B1, 1, 1); PG8_SCHED; PG8_LDA(At, 1, 0); PG8_STAGE(PG8_SA(0, 1), a2 + hstep, voffA);
            PG8_WAIT_V(8); PG8_WAIT_L(0); PG8_BAR; PG8_MMA(0, 0, At, B0); PG8_MMA(0, 1, At, B1); PG8_BAR; PG8_SCHED;
            PG8_LDA(At, 1, 1); PG8_STAGE(PG8_SB(1, 0), b3, voffB); PG8_STAGE(PG8_SB(1, 1), b3 + hstep, voffB); PG8_STAGE(PG8_SA(1, 0), a3, voffA);
            PG8_WAIT_V(8); PG8_WAIT_L(0); PG8_BAR; PG8_MMA(1, 0, At, B0); PG8_MMA(1, 1, At, B1); PG8_BAR; PG8_SCHED;
            } else {
            PG8_LDB(B0, 0, 0); PG8_SCHED; PG8_LDA(At, 0, 0); PG8_STAGE(PG8_SA(1, 1), a1 + hstep, voffA);
            PG8_WAIT_L(8); PG8_BAR; PG8_WAIT_L(0); PG8_MMA(0, 0, At, B0); PG8_BAR; PG8_SCHED;
            PG8_LDB(B1, 0, 1); PG8_STAGE(PG8_SB(0, 0), b2, voffB);
            PG8_BAR; PG8_WAIT_L(0); PG8_MMA(0, 1, At, B1); PG8_BAR;
            PG8_LDA(At, 0, 1); PG8_STAGE(PG8_SA(0, 0), a2, voffA);
            PG8_BAR; PG8_WAIT_L(0); PG8_MMA(1, 0, At, B0); PG8_BAR; PG8_SCHED;
            PG8_STAGE(PG8_SB(0, 1), b2 + hstep, voffB);
            PG8_WAIT_V(6); PG8_BAR; PG8_MMA(1, 1, At, B1); PG8_BAR;
            PG8_LDB(B0, 1, 0); PG8_SCHED; PG8_LDA(At, 1, 0); PG8_STAGE(PG8_SA(0, 1), a2 + hstep, voffA);
            PG8_WAIT_L(8); PG8_BAR; PG8_WAIT_L(0); PG8_MMA(0, 0, At, B0); PG8_BAR; PG8_SCHED;
            PG8_LDB(B1, 1, 1); PG8_STAGE(PG8_SB(1, 0), b3, voffB);
            PG8_BAR; PG8_WAIT_L(0); PG8_MMA(0, 1, At, B1); PG8_BAR;
            PG8_LDA(At, 1, 1); PG8_STAGE(PG8_SA(1, 0), a3, voffA);
            PG8_BAR; PG8_WAIT_L(0); PG8_MMA(1, 0, At, B0); PG8_BAR; PG8_SCHED;
            PG8_STAGE(PG8_SB(1, 1), b3 + hstep, voffB);
            PG8_WAIT_V(6); PG8_BAR; PG8_MMA(1, 1, At, B1); PG8_BAR;
            }
        }
        if constexpr (ALIGN_EPI) { if (wr == 0) PG8_BAR; }
        if constexpr (!Epi::AFTER_DRAIN) { E(acc, cur, wr, wc, fr, fq); S.done(cur); }
        if (!has_next) break;
#pragma unroll
        for (int a = 0; a < 2; ++a)
#pragma unroll
            for (int b = 0; b < 2; ++b)
#pragma unroll
                for (int m = 0; m < 4; ++m)
#pragma unroll
                    for (int n = 0; n < 2; ++n) acc[a][b][m][n] = (f32x4){0.f, 0.f, 0.f, 0.f};
        cur = nxt; cA = nA; cB = nB; ++ui;
        if constexpr (ALIGN_EPI) { if (wr == 1) PG8_BAR; }
    }
    PG8_WAIT_V(0);
    if constexpr (!ALIGN_EPI) { if (wr == 0) PG8_BAR; }
    PG8_BAR;
    if constexpr (Epi::AFTER_DRAIN) { E.fused(acc, cur, wr, wc, fr, fq, lds, wid, lane); S.done(cur); }
#undef PG8_SA
#undef PG8_SB
#undef PG8_STAGE
#undef PG8_LDA
#undef PG8_LDB
#undef PG8_MMA
#undef PG8_WAIT_V
#undef PG8_WAIT_L
#undef PG8_BAR
#undef PG8_SCHED
}
}

#ifndef HOST_REP
#define HOST_REP 0
#endif
#ifndef N_LAUNCHES
#define N_LAUNCHES 1
#endif
#define DI __device__ __forceinline__
#define LAS __attribute__((address_space(3)))
using pg8::bf16_t; using pg8::bf16x8; using pg8::f32x4; using pg8::u32x4;
typedef unsigned u32x2 __attribute__((ext_vector_type(2)));
typedef short s16x4 __attribute__((ext_vector_type(4)));
#define MFMA16(a, b, c) __builtin_amdgcn_mfma_f32_16x16x32_bf16((a), (b), (c), 0, 0, 0)

constexpr int D = 1024, MP = 16384, MS = 512, M = MP + MS, SEQ = 2048, INW = 1280, FF = 2816, NG = 32;
constexpr float EPS = 1e-6f;
constexpr size_t O_PRE = 17301504, O_PIM = 17317888, O_PK = 17334272, O_PV = 17465344, O_PCONV = 17596416,
                 O_SRE = 17641472, O_SIM = 17674240, O_SK = 17707008, O_SV = 17772544, O_SCONV = 17838080;
constexpr size_t WS_WIN = 0, WS_WGLU = WS_WIN + (size_t)INW * D * 2, WS_WO = WS_WGLU + 512 * 512 * 2, WS_W1 = WS_WO + (size_t)D * D * 2,
                 WS_W2 = WS_W1 + (size_t)2 * FF * D * 2, WS_KT = WS_W2 + (size_t)D * FF * 2, WS_WT = WS_KT + (size_t)NG * 32 * 256 * 2,
                 WS_PRE = WS_WT + (size_t)NG * 128 * 512 * 2, WS_PIM = WS_PRE + (size_t)NG * 4096 * 4, WS_A32 = WS_PIM + (size_t)NG * 32 * 64 * 4,
                 WS_CT = WS_A32 + (size_t)NG * 64 * 2 * 4, WS_SSQ = WS_CT + (size_t)NG * 16 * 128 * 2, WS_MIX = WS_SSQ + (size_t)M * 16 * 4,
                 WS_X1B = WS_MIX + (size_t)M * D * 2, WS_H = WS_X1B + (size_t)M * D * 2, WS_X1F = WS_H + (size_t)M * FF * 2, WS_PART = WS_X1F + (size_t)M * D * 4, WS_PARTS = WS_PART + (size_t)64 * 4 * 256 * 4, WS_CTL = WS_PARTS + (size_t)256 * 32 * 4, WS_END = WS_CTL + 16384;
constexpr size_t WS_XN = WS_H, WS_U = WS_XN + (size_t)M * D * 2, WS_Q = WS_U + (size_t)M * 512 * 2, WS_KB = WS_Q + (size_t)M * 512 * 2,
                 WS_VT = WS_KB + (size_t)M * 128 * 2, WS_KS = WS_VT + (size_t)MP * 128 * 2, WS_VTS = WS_KS + (size_t)16 * 160 * 128 * 2,
                 WS_HIN = WS_VTS + (size_t)16 * 160 * 128 * 2, WS_UF = WS_HIN + (size_t)512 * NG * 128 * 4, WS_ALIAS_END = WS_UF + (size_t)M * 512 * 2;
static_assert(WS_ALIAS_END <= WS_END && WS_END <= 268435456, "d_ws map");
constexpr int LDS_BYTES = 163840, LDS_X = 131072;

DI unsigned f2bf(float f) { unsigned u = __builtin_bit_cast(unsigned, f); return (u + 0x7fffu + ((u >> 16) & 1u)) >> 16; }
typedef float f32x2_t __attribute__((ext_vector_type(2)));
typedef __bf16 bf16x2_t __attribute__((ext_vector_type(2)));
DI unsigned pk2(float lo, float hi) { f32x2_t v = {lo, hi}; bf16x2_t b = __builtin_convertvector(v, bf16x2_t); return __builtin_bit_cast(unsigned, b); }
DI float bflo(unsigned w) { return __builtin_bit_cast(float, w << 16); }
DI float bfhi(unsigned w) { return __builtin_bit_cast(float, w & 0xffff0000u); }
DI u32x4 pack8(const f32x4& a, const f32x4& b) { u32x4 w; w.x = pk2(a[0], a[1]); w.y = pk2(a[2], a[3]); w.z = pk2(b[0], b[1]); w.w = pk2(b[2], b[3]); return w; }
DI float dot2bf(unsigned a, unsigned b, float c) { return __builtin_amdgcn_fdot2_f32_bf16(__builtin_bit_cast(bf16x2_t, a), __builtin_bit_cast(bf16x2_t, b), c, false); }
DI float sigm(float x) { return __builtin_amdgcn_rcpf(1.0f + __expf(-x)); }
DI float gelu_tanh(float x) { const float z = 0.7978845608f * (x + 0.044715f * x * x * x); return x * sigm(2.0f * z); }
template <int CTRL> DI float dpp_shr(float v) { return __builtin_bit_cast(float, __builtin_amdgcn_update_dpp(0, __builtin_bit_cast(int, v), CTRL, 0xF, 0xF, false)); }
#define GAS __attribute__((address_space(1)))
DI void st_agent(float* p, float v) { __hip_atomic_store((GAS unsigned*)p, __builtin_bit_cast(unsigned, v), __ATOMIC_RELAXED, __HIP_MEMORY_SCOPE_AGENT); }
DI float ld_agent(const float* p) { return __builtin_bit_cast(float, __hip_atomic_load((GAS unsigned*)p, __ATOMIC_RELAXED, __HIP_MEMORY_SCOPE_AGENT)); }
DI void arrive_and_wait(unsigned* cnt, unsigned target) {
    (void)__hip_atomic_fetch_add((GAS unsigned*)cnt, 1u, __ATOMIC_RELAXED, __HIP_MEMORY_SCOPE_AGENT);
    while (__hip_atomic_load((GAS unsigned*)cnt, __ATOMIC_RELAXED, __HIP_MEMORY_SCOPE_AGENT) < target) __builtin_amdgcn_s_sleep(1);
}
DI void wait_ge16(const unsigned* c) { while (__hip_atomic_load((GAS unsigned*)c, __ATOMIC_RELAXED, __HIP_MEMORY_SCOPE_AGENT) < 16u) __builtin_amdgcn_s_sleep(1); }
DI float xsum4(float v) { v += __shfl_xor(v, 16); v += __shfl_xor(v, 32); return v; }

struct Args { const float* in[30]; float* out; unsigned char* ws; int ph_lo, ph_hi; };

struct Frame {
    LAS unsigned char* lds; int tid, lane, wave, G, bid;
    const float* const* in; float* out; unsigned char* ws;
};
#define WSP(T, off) ((T*)(F.ws + (off)))

DI void p0_transpose(const float* __restrict__ W, int N, const float* __restrict__ gk, bf16_t* __restrict__ WT, int ldt, int k0, int n0, int dst0, LAS float* scr, int tid) {
    const int c = tid & 63, r0 = tid >> 6;
    float v[16];
#pragma unroll
    for (int i = 0; i < 16; ++i) { const int r = r0 + 8 * i; v[i] = W[(size_t)(k0 + r) * N + n0 + c]; }
#pragma unroll
    for (int i = 0; i < 16; ++i) { const int r = r0 + 8 * i; float x = v[i]; if (gk) x *= gk[k0 + r]; scr[r * 65 + c] = x; }
    __syncthreads();
#pragma unroll
    for (int i = 0; i < 8; ++i) { const int n = r0 + 8 * i;
        *(unsigned*)(WT + (size_t)(dst0 + n) * ldt + k0 + 2 * c) = f2bf(scr[(2 * c) * 65 + n]) | (f2bf(scr[(2 * c + 1) * 65 + n]) << 16); }
    __syncthreads();
}

DI void p0_ssm_tables(const Frame& F, int task) {
    const int tid = F.tid, g = task >> 2, part = task & 3;
    LAS float* pwr = (LAS float*)F.lds; LAS float* pwi = pwr + 33 * 64; LAS float* bbr = pwi + 33 * 64; LAS float* bbi = bbr + 1024;
    const float* a_re = F.in[9] + g * 64; const float* a_im = F.in[10] + g * 64;
    const float dt = expf(F.in[11][g]);
    for (int i = tid; i < 33 * 64; i += 512) {
        const int d = i >> 6, n = i & 63; const float fd = (float)d;
        const float mag = expf(a_re[n] * dt * fd), ang = a_im[n] * dt * fd;
        pwr[i] = mag * cosf(ang); pwi[i] = mag * sinf(ang);
    }
    __syncthreads();
    for (int i = tid; i < 1024; i += 512) {
        const int n = i >> 4;
        const float are = a_re[n], aim = a_im[n], nr = pwr[64 + n] - 1.0f, ni = pwi[64 + n], den = are * are + aim * aim;
        const float cr = (nr * are + ni * aim) / den, ci = (ni * are - nr * aim) / den;
        const float br = F.in[12][(size_t)g * 1024 + i], bi = F.in[13][(size_t)g * 1024 + i];
        bbr[i] = cr * br - ci * bi; bbi[i] = cr * bi + ci * br;
    }
    __syncthreads();
    if (part == 0) {
        const int d = tid >> 4, p = tid & 15;
        float acc[16];
#pragma unroll
        for (int q = 0; q < 16; ++q) acc[q] = 0.f;
        const float* cre = F.in[14] + (size_t)(g * 16 + p) * 64; const float* cim = F.in[15] + (size_t)(g * 16 + p) * 64;
        for (int n = 0; n < 64; ++n) {
            const float cr = cre[n], ci = cim[n], pr = pwr[d * 64 + n], pi = pwi[d * 64 + n];
            const float xr = cr * pr - ci * pi, xi = cr * pi + ci * pr;
#pragma unroll
            for (int q = 0; q < 16; ++q) acc[q] += xr * bbr[n * 16 + q] - xi * bbi[n * 16 + q];
        }
        const float dv = (d == 0) ? F.in[16][g * 16 + p] : 0.f;
        u32x4 w0, w1;
#pragma unroll
        for (int q = 0; q < 16; ++q) acc[q] += (q == p) ? dv : 0.f;
        w0.x = pk2(acc[0], acc[1]); w0.y = pk2(acc[2], acc[3]); w0.z = pk2(acc[4], acc[5]); w0.w = pk2(acc[6], acc[7]);
        w1.x = pk2(acc[8], acc[9]); w1.y = pk2(acc[10], acc[11]); w1.z = pk2(acc[12], acc[13]); w1.w = pk2(acc[14], acc[15]);
        bf16_t* dst = WSP(bf16_t, WS_KT) + ((size_t)(g * 16 + (d >> 1)) * 64 + (d & 1) * 32 + p) * 8;
        *(u32x4*)dst = w0; *(u32x4*)(dst + 128) = w1;
    }
    if (part == 1 || part == 2) {
        bf16_t* wt = WSP(bf16_t, WS_WT) + (size_t)g * 65536;
        for (int idx = (part - 1) * 32768 + tid; idx < part * 32768; idx += 512) {
            const int j = idx & 7, lane = (idx >> 3) & 63, kk = (idx >> 9) & 15, nb = idx >> 13;
            const int n2 = nb * 16 + (lane & 15), n = n2 & 63, sidx = 2 * kk + (lane >> 5), pp = ((lane >> 4) & 1) * 8 + j;
            const float pr = pwr[(31 - sidx) * 64 + n], pi = pwi[(31 - sidx) * 64 + n], br = bbr[n * 16 + pp], bi = bbi[n * 16 + pp];
            wt[idx] = (bf16_t)f2bf(n2 < 64 ? pr * br - pi * bi : pr * bi + pi * br);
        }
    }
    if (part == 3) {
    for (int i = tid; i < 4096; i += 512) {
        const int e = i & 3, lane = (i >> 2) & 63, half = (i >> 8) & 1, reim = (i >> 9) & 1, nh = (i >> 10) & 1, mt = i >> 11;
        const int t = mt * 16 + (lane & 15), n = nh * 32 + (lane >> 4) * 8 + half * 4 + e;
        WSP(float, WS_PRE)[(size_t)g * 4096 + i] = reim ? pwi[(t + 1) * 64 + n] : pwr[(t + 1) * 64 + n];
    }
    if (tid < 64) { WSP(float, WS_A32)[(g * 64 + tid) * 2] = pwr[32 * 64 + tid]; WSP(float, WS_A32)[(g * 64 + tid) * 2 + 1] = pwi[32 * 64 + tid]; }
    for (int i = tid; i < 2048; i += 512) {
        const int j = i & 7, lane = (i >> 3) & 63, kk2 = i >> 9, p = lane & 15, n2 = kk2 * 32 + (lane >> 4) * 8 + j;
        const float v = n2 < 64 ? F.in[14][(size_t)(g * 16 + p) * 64 + n2] : -F.in[15][(size_t)(g * 16 + p) * 64 + n2 - 64];
        WSP(bf16_t, WS_CT)[(size_t)g * 2048 + i] = (bf16_t)f2bf(v);
    }
    }
    __syncthreads();
}

DI void p0_prologue(const Frame& F) {
    constexpr int T_SSM = 128, T_WIN = 8 * 20, T_WGLU = 64, T_WO = 128, T_WA = 8 * 44, T_WD = 22 * 16, T_XN = M / 16, T_CK = 64, T_CV = 64;
    LAS float* scr = (LAS float*)F.lds;
    const int G = F.G;
    int r = F.bid;
#define P0_LOOP(COUNT) for (int i = r; i < (COUNT); i += G)
#define P0_NEXT(COUNT) r = (r + G - (COUNT) % G) % G
    P0_LOOP(T_XN) {
        const int row = i * 16 + F.wave * 2;
        const float* xr = row < MP ? F.in[0] + (size_t)row * D : F.in[1] + (size_t)(row - MP) * D;
        f32x4 v[2][4]; float q0 = 0.f, q1 = 0.f;
#pragma unroll
        for (int k = 0; k < 4; ++k) { v[0][k] = *(const f32x4*)(xr + k * 256 + F.lane * 4); v[1][k] = *(const f32x4*)(xr + D + k * 256 + F.lane * 4); }
#pragma unroll
        for (int k = 0; k < 4; ++k) { q0 += v[0][k][0] * v[0][k][0] + v[0][k][1] * v[0][k][1] + v[0][k][2] * v[0][k][2] + v[0][k][3] * v[0][k][3];
                                      q1 += v[1][k][0] * v[1][k][0] + v[1][k][1] * v[1][k][1] + v[1][k][2] * v[1][k][2] + v[1][k][3] * v[1][k][3]; }
#pragma unroll
        for (int o = 1; o < 64; o <<= 1) { q0 += __shfl_xor(q0, o); q1 += __shfl_xor(q1, o); }
        const float rr0 = rsqrtf(q0 * (1.0f / D) + EPS), rr1 = rsqrtf(q1 * (1.0f / D) + EPS);
        bf16_t* dst = WSP(bf16_t, WS_XN) + (size_t)row * D;
#pragma unroll
        for (int k = 0; k < 4; ++k) { const f32x4 g = *(const f32x4*)(F.in[7] + k * 256 + F.lane * 4);
            u32x2 w; w.x = pk2(v[0][k][0] * rr0 * g[0], v[0][k][1] * rr0 * g[1]); w.y = pk2(v[0][k][2] * rr0 * g[2], v[0][k][3] * rr0 * g[3]); *(u32x2*)(dst + k * 256 + F.lane * 4) = w;
            w.x = pk2(v[1][k][0] * rr1 * g[0], v[1][k][1] * rr1 * g[1]); w.y = pk2(v[1][k][2] * rr1 * g[2], v[1][k][3] * rr1 * g[3]); *(u32x2*)(dst + D + k * 256 + F.lane * 4) = w; }
    }
    P0_NEXT(T_XN);
    P0_LOOP(T_WIN) p0_transpose(F.in[8], INW, nullptr, WSP(bf16_t, WS_WIN), D, (i % 8) * 128, (i / 8) * 64, (i / 8) * 64, scr, F.tid);
    P0_NEXT(T_WIN);
#undef P0_LOOP
#undef P0_NEXT
}

DI void p1_tail(const Frame& F) {
    constexpr int T_SSM = 128, T_WGLU = 64, T_CK = 64, T_CV = 64;
    const int nbusy = (M / 256) * (INW / 256) - F.G;
    if (nbusy < 0 || nbusy >= F.G || F.bid < nbusy) return;
    const int G = F.G - nbusy;
    int r = F.bid - nbusy;
#define P0_LOOP(COUNT) for (int i = r; i < (COUNT); i += G)
#define P0_NEXT(COUNT) r = (r + G - (COUNT) % G) % G
    P0_LOOP(T_SSM) p0_ssm_tables(F, i);
    P0_NEXT(T_SSM);
    P0_LOOP(T_WGLU) {
        const int ch = i * 512 + F.tid, lane = ch & 63, kk = (ch >> 6) & 15, ntg = ch >> 10;
        const float* src = F.in[17] + (size_t)(kk * 32 + (lane >> 4) * 8) * 512 + ntg * 16 + (lane & 15);
        f32x4 a, b;
#pragma unroll
        for (int j = 0; j < 4; ++j) { a[j] = src[(size_t)j * 512]; b[j] = src[(size_t)(j + 4) * 512]; }
        *(u32x4*)(WSP(bf16_t, WS_WGLU) + (size_t)ch * 8) = pack8(a, b);
    }
    P0_NEXT(T_WGLU);
    P0_LOOP(T_CK) {
        const int ch = i * 512 + F.tid, lane = ch & 63, kk = (ch >> 6) & 1, kb = (ch >> 7) & 7, kvh = (ch >> 10) & 1, sb = ch >> 11;
        const float* src = F.in[4] + (((size_t)sb * 128 + kb * 16 + (lane & 15)) * 2 + kvh) * 64 + kk * 32 + (lane >> 4) * 8;
        *(u32x4*)(WSP(bf16_t, WS_KS) + (((size_t)(sb * 2 + kvh) * 10 + kb) * 2 + kk) * 512 + lane * 8) = pack8(*(const f32x4*)src, *(const f32x4*)(src + 4));
    }
    P0_NEXT(T_CK);
    P0_LOOP(T_CV) {
        const int ch = i * 512 + F.tid, lane = ch & 63, db = (ch >> 6) & 3, kb = (ch >> 8) & 3, kvh = (ch >> 10) & 1, sb = ch >> 11;
        const float* src = F.in[5] + (((size_t)sb * 128 + kb * 32 + (lane >> 4) * 4) * 2 + kvh) * 64 + db * 16 + (lane & 15);
        f32x4 a, b;
#pragma unroll
        for (int j = 0; j < 4; ++j) { a[j] = src[(size_t)j * 128]; b[j] = src[(size_t)(16 + j) * 128]; }
        *(u32x4*)(WSP(bf16_t, WS_VTS) + (((size_t)(sb * 2 + kvh) * 5 + kb) * 4 + db) * 512 + lane * 8) = pack8(a, b);
    }
#undef P0_LOOP
#undef P0_NEXT
}

struct EpiIn {
    static constexpr bool PERM = true, AFTER_DRAIN = false;
    unsigned char* ws; float* out;
    DI void operator()(const f32x4 (&acc)[2][2][4][2], const pg8::Unit& u, int wr, int wc, int fr, int fq) const {
        bf16_t* const U = (bf16_t*)(ws + WS_U); bf16_t* const Q = (bf16_t*)(ws + WS_Q); bf16_t* const KB = (bf16_t*)(ws + WS_KB); bf16_t* const VT = (bf16_t*)(ws + WS_VT);
        bf16_t* const KS = (bf16_t*)(ws + WS_KS); bf16_t* const VTS = (bf16_t*)(ws + WS_VTS); bf16_t* const UF = (bf16_t*)(ws + WS_UF);
        const int row0 = u.pm * 256 + wr * 64 + fr;
        if (u.pn < 2) {
            const int colt = u.pn * 256 + wc * 32 + 8 * fq;
#pragma unroll
            for (int ai = 0; ai < 2; ++ai)
#pragma unroll
                for (int m = 0; m < 4; ++m) { const int row = row0 + ai * 128 + m * 16; bf16_t* rp = U + (size_t)row * 512 + colt;
                    const int tq = row < MP ? (row & 2047) : ((row - MP) & 31), sq = tq & 31, chunk = row < MP ? (tq >> 5) : ((row - MP) >> 5);
#pragma unroll
                    for (int bj = 0; bj < 2; ++bj) { const u32x4 w = pack8(acc[ai][bj][m][0], acc[ai][bj][m][1]); *(u32x4*)(rp + bj * 128) = w;
                        const int c0 = colt + bj * 128, g = c0 >> 4, lf = (((sq & 1) * 2 + ((c0 >> 3) & 1)) * 16 + (chunk & 15)) * 8;
                        bf16_t* uf = row < MP ? UF + ((((size_t)((row >> 11) * 32 + g) * 16 + (sq >> 1)) * 4 + (chunk >> 4)) * 64) * 8 + lf
                                              : UF + (size_t)MP * 512 + ((size_t)(g * 16 + (sq >> 1)) * 64) * 8 + lf;
                        *(u32x4*)uf = w; } }
        } else if (u.pn < 4) {
#pragma unroll
            for (int ai = 0; ai < 2; ++ai)
#pragma unroll
                for (int m = 0; m < 4; ++m) { const int rb = (u.pm * 256 + wr * 64 + ai * 128 + m * 16) >> 4;
#pragma unroll
                    for (int bj = 0; bj < 2; ++bj) { const int c0 = (u.pn - 2) * 256 + bj * 128 + wc * 32, h = c0 >> 6, kk = (c0 >> 5) & 1;
                        *(u32x4*)(Q + (((size_t)h * (M / 16) + rb) * 2 + kk) * 512 + (fq * 16 + fr) * 8) = pack8(acc[ai][bj][m][0] * 0.125f, acc[ai][bj][m][1] * 0.125f); } }
        } else {
            const int c = wc * 32 + 8 * fq, kvh = wc >> 1, kk = wc & 1, db = (c >> 4) & 3, fr0 = c & 15;
#pragma unroll
            for (int ai = 0; ai < 2; ++ai)
#pragma unroll
                for (int m = 0; m < 4; ++m) {
                    const int row = row0 + ai * 128 + m * 16;
                    const f32x4 k0 = acc[ai][0][m][0], k1 = acc[ai][0][m][1], v0 = acc[ai][1][m][0], v1 = acc[ai][1][m][1];
                    if (row < MP) {
                        const int b = row >> 11, t = row & 2047;
                        *(u32x4*)(KB + (((size_t)kvh * (M / 16) + (row >> 4)) * 2 + kk) * 512 + (fq * 16 + fr) * 8) = pack8(k0, k1);
                        const int w = t & 31; bf16_t* vt = VT + ((((size_t)(b * 2 + kvh) * 64 + (t >> 5)) * 4 + db) * 64 + ((w & 15) >> 2) * 16 + fr0) * 8 + (w & 3) + 4 * (w >> 4);
#pragma unroll
                        for (int j = 0; j < 4; ++j) { vt[j * 8] = (bf16_t)f2bf(v0[j]); vt[(j + 4) * 8] = (bf16_t)f2bf(v1[j]); }
                        if (t >= 1920) { float* pk = out + O_PK + ((size_t)b * 128 + (t - 1920)) * 128 + c; *(f32x4*)pk = k0; *(f32x4*)(pk + 4) = k1;
                                         float* pv = out + O_PV + ((size_t)b * 128 + (t - 1920)) * 128 + c; *(f32x4*)pv = v0; *(f32x4*)(pv + 4) = v1; }
                    } else {
                        const int sb = (row - MP) >> 5, st = (row - MP) & 31, key = 128 + st;
                        *(u32x4*)(KS + ((((size_t)(sb * 2 + kvh) * 10 + (key >> 4)) * 2 + kk) * 64 + fq * 16 + (key & 15)) * 8) = pack8(k0, k1);
                        const int w = key & 31; bf16_t* vt = VTS + ((((size_t)(sb * 2 + kvh) * 5 + (key >> 5)) * 4 + db) * 64 + ((w & 15) >> 2) * 16 + fr0) * 8 + (w & 3) + 4 * (w >> 4);
#pragma unroll
                        for (int j = 0; j < 4; ++j) { vt[j * 8] = (bf16_t)f2bf(v0[j]); vt[(j + 4) * 8] = (bf16_t)f2bf(v1[j]); }
                        float* pk = out + O_SK + ((size_t)sb * 32 + st) * 128 + c; *(f32x4*)pk = k0; *(f32x4*)(pk + 4) = k1;
                        float* pv = out + O_SV + ((size_t)sb * 32 + st) * 128 + c; *(f32x4*)pv = v0; *(f32x4*)(pv + 4) = v1;
                    }
                }
        }
    }
};

constexpr int LDO = 520;
DI void attn_task(const bf16_t* __restrict__ Qp, int nqb, const bf16_t* __restrict__ Kp, int nkb, const bf16_t* __restrict__ Vtp, int vstride,
                  float sink, const float* __restrict__ gat, bf16_t* __restrict__ outp, LAS float* ob, int h, int wave, int lane) {
    const int fr = lane & 15, fq = lane >> 4;
#pragma unroll 1
    for (int qb = 0; qb < nqb; ++qb) {
        const bf16_t* qrow = Qp + (size_t)qb * 1024 + lane * 8;
        const bf16x8 q0 = *(const bf16x8*)qrow, q1 = *(const bf16x8*)(qrow + 512);
        f32x4 s[12];
#pragma unroll
        for (int kb = 0; kb < 12; ++kb) {
            s[kb] = (f32x4){-INFINITY, -INFINITY, -INFINITY, -INFINITY};
            if (kb < nkb) {
                const bf16_t* krow = Kp + (size_t)kb * 1024 + lane * 8;
                const bf16x8 k0 = *(const bf16x8*)krow, k1 = *(const bf16x8*)(krow + 512);
                f32x4 z = (f32x4){0.f, 0.f, 0.f, 0.f};
                z = MFMA16(k0, q0, z); z = MFMA16(k1, q1, z); s[kb] = z;
            }
        }
        float m = sink;
#pragma unroll
        for (int kb = 0; kb < 12; ++kb) m = fmaxf(fmaxf(m, fmaxf(s[kb][0], s[kb][1])), fmaxf(s[kb][2], s[kb][3]));
        m = fmaxf(m, __shfl_xor(m, 16)); m = fmaxf(m, __shfl_xor(m, 32));
        float sum = 0.f;
#pragma unroll
        for (int kb = 0; kb < 12; ++kb)
#pragma unroll
            for (int e = 0; e < 4; ++e) { const float p = __expf(s[kb][e] - m); s[kb][e] = p; sum += p; }
        sum = xsum4(sum);
        const float inv = 1.0f / (sum + __expf(sink - m));
        f32x4 o[4];
#pragma unroll
        for (int db = 0; db < 4; ++db) o[db] = (f32x4){0.f, 0.f, 0.f, 0.f};
#pragma unroll
        for (int ks = 0; ks < 6; ++ks) {
            if (2 * ks < nkb) {
                const bf16x8 pb = __builtin_bit_cast(bf16x8, pack8(s[2 * ks], s[2 * ks + 1]));
#pragma unroll
                for (int db = 0; db < 4; ++db) {
                    const bf16x8 vf = *(const bf16x8*)(Vtp + (size_t)(ks * 4 + db) * 512 + lane * 8);
                    o[db] = MFMA16(vf, pb, o[db]);
                }
                if (ks & 1) __builtin_amdgcn_sched_barrier(0);
            }
        }
#pragma unroll
        for (int db = 0; db < 4; ++db) *(LAS f32x4*)(ob + (qb * 16 + fr) * LDO + h * 64 + db * 16 + fq * 4) = o[db] * inv;
    }
    __syncthreads();
    const int rpw = nqb * 2;
    const f32x4 g0 = *(const f32x4*)(gat + lane * 8), g1 = *(const f32x4*)(gat + lane * 8 + 4);
#pragma unroll 1
    for (int i = 0; i < rpw; ++i) {
        const int r = wave * rpw + i;
        f32x4 v0 = *(const LAS f32x4*)(ob + r * LDO + lane * 8), v1 = *(const LAS f32x4*)(ob + r * LDO + lane * 8 + 4);
        float q = v0[0] * v0[0] + v0[1] * v0[1] + v0[2] * v0[2] + v0[3] * v0[3] + v1[0] * v1[0] + v1[1] * v1[1] + v1[2] * v1[2] + v1[3] * v1[3];
#pragma unroll
        for (int o2 = 1; o2 < 64; o2 <<= 1) q += __shfl_xor(q, o2);
        const float rs = rsqrtf(q * (1.0f / 512.0f) + EPS);
        *(u32x4*)(outp + (size_t)r * D + lane * 8) = pack8(v0 * rs * g0, v1 * rs * g1);
    }
    __syncthreads();
}

template <int MT, bool SAMPLE>
DI void ssm_state(const Frame& F, int b, int g) {
    const int lane = F.lane, fr = lane & 15, fq = lane >> 4;
    const bf16_t* Ub = WSP(bf16_t, WS_UF) + (SAMPLE ? (size_t)MP * 512 + (size_t)g * 16 * 512 : (size_t)(b * 32 + g) * 16 * 2048) + lane * 8;
    const bf16_t* Wg = WSP(bf16_t, WS_WT) + (size_t)g * 65536 + lane * 8;
    const float* A32 = WSP(float, WS_A32) + g * 128;
    float* HIN = WSP(float, WS_HIN);
#pragma unroll 1
    for (int h2 = 0; h2 < 2; ++h2) {
        f32x4 acc[MT][4];
#pragma unroll
        for (int mt = 0; mt < MT; ++mt)
#pragma unroll
            for (int j = 0; j < 4; ++j) acc[mt][j] = (f32x4){0.f, 0.f, 0.f, 0.f};
#pragma unroll 2
        for (int kk = 0; kk < 16; ++kk) {
            bf16x8 a[MT], w[4];
#pragma unroll
            for (int mt = 0; mt < MT; ++mt) a[mt] = *(const bf16x8*)(Ub + (size_t)kk * (SAMPLE ? 512 : 2048) + mt * 512);
#pragma unroll
            for (int j = 0; j < 4; ++j) { const int nb = (j < 2) ? 2 * h2 + j : 4 + 2 * h2 + (j - 2); w[j] = *(const bf16x8*)(Wg + (size_t)(nb * 16 + kk) * 512); }
#pragma unroll
            for (int mt = 0; mt < MT; ++mt)
#pragma unroll
                for (int j = 0; j < 4; ++j) acc[mt][j] = MFMA16(a[mt], w[j], acc[mt][j]);
        }
#pragma unroll
        for (int i = 0; i < 2; ++i) {
            const int n = (2 * h2 + i) * 16 + fr;
            const float ar = A32[n * 2], ai = A32[n * 2 + 1];
            if constexpr (SAMPLE) {
#pragma unroll
                for (int e = 0; e < 4; ++e) {
                    const int sb = fq * 4 + e; const size_t idx = ((size_t)sb * 32 + g) * 64 + n;
                    const float hr = F.in[2][idx], hi = F.in[3][idx];
                    F.out[O_SRE + idx] = ar * hr - ai * hi + acc[0][i][e]; F.out[O_SIM + idx] = ar * hi + ai * hr + acc[0][2 + i][e];
                }
            } else {
            const float a2r = ar * ar - ai * ai, a2i = 2.f * ar * ai, a3r = a2r * ar - a2i * ai, a3i = a2r * ai + a2i * ar, a4r = a2r * a2r - a2i * a2i, a4i = 2.f * a2r * a2i;
            float h1r[MT], h1i[MT], h2r[MT], h2i[MT], h3r[MT], h3i[MT], er[MT], ei[MT], cr[MT], ci[MT];
#pragma unroll
            for (int mt = 0; mt < MT; ++mt) {
                const f32x4 sr = acc[mt][i], si = acc[mt][2 + i];
                h1r[mt] = sr[0]; h1i[mt] = si[0];
                h2r[mt] = ar * h1r[mt] - ai * h1i[mt] + sr[1]; h2i[mt] = ar * h1i[mt] + ai * h1r[mt] + si[1];
                h3r[mt] = ar * h2r[mt] - ai * h2i[mt] + sr[2]; h3i[mt] = ar * h2i[mt] + ai * h2r[mt] + si[2];
                er[mt] = ar * h3r[mt] - ai * h3i[mt] + sr[3]; ei[mt] = ar * h3i[mt] + ai * h3r[mt] + si[3];
                cr[mt] = 0.f; ci[mt] = 0.f;
            }
            float kr = 0.f, ki = 0.f;
#pragma unroll
            for (int gi = 0; gi < 4 * MT; ++gi) {
                const int mt = gi >> 2, src = (gi & 3) * 16 + fr;
                const float xr = __shfl(er[mt], src), xi = __shfl(ei[mt], src);
                if ((gi & 3) == fq) { cr[mt] = kr; ci[mt] = ki; }
                const float nr = a4r * kr - a4i * ki + xr, ni = a4r * ki + a4i * kr + xi; kr = nr; ki = ni;
            }
            if (fq == 0) { F.out[O_PRE + ((size_t)b * 32 + g) * 64 + n] = kr; F.out[O_PIM + ((size_t)b * 32 + g) * 64 + n] = ki; }
#pragma unroll
            for (int mt = 0; mt < MT; ++mt) {
                const int c0 = mt * 16 + fq * 4;
                float* hp = HIN + (((size_t)b * 64 + c0) * 32 + g) * 128 + n;
                const float kr0 = cr[mt], ki0 = ci[mt];
                hp[0] = kr0; hp[64] = ki0;
                hp[4096] = ar * kr0 - ai * ki0 + h1r[mt]; hp[4096 + 64] = ar * ki0 + ai * kr0 + h1i[mt];
                hp[8192] = a2r * kr0 - a2i * ki0 + h2r[mt]; hp[8192 + 64] = a2r * ki0 + a2i * kr0 + h2i[mt];
                hp[12288] = a3r * kr0 - a3i * ki0 + h3r[mt]; hp[12288 + 64] = a3r * ki0 + a3i * kr0 + h3i[mt];
            }
            }
        }
    }
}

DI void p23_phase(const Frame& F) {
    constexpr int T_SSM = 36, T_ATT = 272, T_P3 = 528;
    unsigned* hc = WSP(unsigned, WS_CTL) + 3584 + 224;
    LAS float* ob = (LAS float*)F.lds;
    for (int t = F.bid; t < T_SSM; t += F.G) {
        const int wt = t * 8 + F.wave;
        if (wt < 256) ssm_state<4, false>(F, wt >> 5, wt & 31); else ssm_state<1, true>(F, 0, wt - 256);
        asm volatile("s_waitcnt vmcnt(0)" ::: "memory");
        __syncthreads();
        if (F.tid == 0 && t < 32) {
            __builtin_amdgcn_fence(__ATOMIC_RELEASE, "agent");
            asm volatile("s_waitcnt vmcnt(0)" ::: "memory");
            (void)__hip_atomic_fetch_add((GAS unsigned*)(hc + (t >> 2)), 1u, __ATOMIC_RELAXED, __HIP_MEMORY_SCOPE_AGENT);
        }
    }
    const int t0 = (F.bid >= T_SSM % F.G) ? F.bid - T_SSM % F.G : F.bid + F.G - T_SSM % F.G;
    for (int a = t0; a < T_ATT; a += F.G) {
        const int h = F.wave, kvh = h >> 2;
        const float sink = F.in[19][h]; const float* gat = F.in[21];
        if (a < 256) {
            const int b = a >> 5, c = a & 31, c0 = c < 2 ? 0 : c - 2, row0 = b * SEQ + c * 64;
            attn_task(WSP(bf16_t, WS_Q) + ((size_t)h * (M / 16) + (row0 >> 4)) * 1024, 4, WSP(bf16_t, WS_KB) + ((size_t)kvh * (M / 16) + ((b * SEQ + c0 * 64) >> 4)) * 1024, (c - c0 + 1) * 4,
                      WSP(bf16_t, WS_VT) + ((size_t)(b * 2 + kvh) * 64 + c0 * 2) * 2048, 0, sink, gat, WSP(bf16_t, WS_MIX) + (size_t)row0 * D + 512, ob, h, F.wave, F.lane);
        } else {
            const int sb = a - 256, row0 = MP + sb * 32;
            attn_task(WSP(bf16_t, WS_Q) + ((size_t)h * (M / 16) + (row0 >> 4)) * 1024, 2, WSP(bf16_t, WS_KS) + (size_t)(sb * 2 + kvh) * 10 * 1024, 10,
                      WSP(bf16_t, WS_VTS) + (size_t)(sb * 2 + kvh) * 5 * 2048, 0, sink, gat, WSP(bf16_t, WS_MIX) + (size_t)row0 * D + 512, ob, h, F.wave, F.lane);
        }
    }
}
constexpr int P3_LDY = 520, P3_LDU = 72, P3_UST = 36864;
DI void p3_zero(const Frame& F) {
    LAS u32x4* z = (LAS u32x4*)(F.lds + P3_UST + F.wave * (64 * P3_LDU * 2));
    for (int i = F.lane; i < 32 * P3_LDU * 2 / 16; i += 64) z[i] = (u32x4){0u, 0u, 0u, 0u};
}
DI void p3_load_u(const Frame& F, int ci, u32x4 (&uv)[4]) {
    const int row0 = ci < 512 ? (ci >> 6) * SEQ + (ci & 63) * 32 : MP + (ci - 512) * 32;
    const bf16_t* up = WSP(bf16_t, WS_U) + (size_t)(row0 + (F.lane >> 3)) * 512 + F.wave * 64 + (F.lane & 7) * 8;
#pragma unroll
    for (int i = 0; i < 4; ++i) uv[i] = *(const u32x4*)(up + (size_t)i * 8 * 512);
}
DI void p3_task(const Frame& F, int ci, const u32x4 (&uv)[4]) {
    const int lane = F.lane, fr = lane & 15, fq = lane >> 4, wave = F.wave;
    const int row0 = ci < 512 ? (ci >> 6) * SEQ + (ci & 63) * 32 : MP + (ci - 512) * 32;
    constexpr int LDY = P3_LDY, LDU = P3_LDU;
    LAS bf16_t* y1 = (LAS bf16_t*)F.lds; LAS float* ssq = (LAS float*)(F.lds + 32 * LDY * 2);
    LAS bf16_t* ust = (LAS bf16_t*)(F.lds + P3_UST) + wave * (64 * LDU);
    LAS float* hst = (LAS float*)(F.lds + P3_UST + 8 * 64 * P3_LDU * 2) + wave * 512;
    f32x4 hv[2];
    {
        if (ci < 512) { const f32x4* hs = (const f32x4*)(WSP(float, WS_HIN) + ((size_t)ci * 32 + wave * 4) * 128); hv[0] = hs[lane]; hv[1] = hs[64 + lane]; }
        else {
#pragma unroll
            for (int j = 0; j < 2; ++j) { const int idx = lane + 64 * j, gg = wave * 4 + (idx >> 5), w = idx & 31;
                hv[j] = *(const f32x4*)((w < 16 ? F.in[2] : F.in[3]) + ((size_t)(ci - 512) * 32 + gg) * 64 + (w & 15) * 4); }
        }
#pragma unroll
        for (int i = 0; i < 4; ++i) *(LAS u32x4*)(ust + (32 + (lane >> 3) + 8 * i) * LDU + (lane & 7) * 8) = uv[i];
    }
#pragma unroll 2
    for (int gi = 0; gi < 4; ++gi) {
        const int g = wave * 4 + gi;
        f32x4 acc0 = (f32x4){0.f, 0.f, 0.f, 0.f}, acc1 = acc0;
        const bf16_t* Kg = WSP(bf16_t, WS_KT) + (size_t)g * 8192 + lane * 8;
        const LAS bf16_t* ub = ust + (32 + fr - (fq >> 1)) * LDU + gi * 16 + (fq & 1) * 8;
#pragma unroll
        for (int kk = 0; kk < 16; ++kk) {
            const bf16x8 kf = *(const bf16x8*)(Kg + kk * 512);
            acc1 = MFMA16(kf, *(const LAS bf16x8*)(ub + (16 - 2 * kk) * LDU), acc1);
            if (kk < 8) acc0 = MFMA16(kf, *(const LAS bf16x8*)(ub - 2 * kk * LDU), acc0);
        }
        if (gi == 0) { *(LAS f32x4*)(hst + lane * 4) = hv[0]; *(LAS f32x4*)(hst + 256 + lane * 4) = hv[1]; }
        const LAS float* hre = hst + gi * 128; const LAS float* him = hre + 64;
#pragma unroll
        for (int nh = 0; nh < 2; ++nh) {
            const int n0 = nh * 32 + fq * 8;
            const f32x4 hr0 = *(const LAS f32x4*)(hre + n0), hr1 = *(const LAS f32x4*)(hre + n0 + 4), hi0 = *(const LAS f32x4*)(him + n0), hi1 = *(const LAS f32x4*)(him + n0 + 4);
            const bf16_t* cp = WSP(bf16_t, WS_CT) + (size_t)g * 2048 + lane * 8;
            const bf16x8 cref = *(const bf16x8*)(cp + nh * 512), cimf = *(const bf16x8*)(cp + (2 + nh) * 512);
#pragma unroll
            for (int mt = 0; mt < 2; ++mt) {
                const float* pp = WSP(float, WS_PRE) + (size_t)g * 4096 + (mt * 2 + nh) * 1024 + lane * 4;
                const f32x4 pr0 = *(const f32x4*)pp, pr1 = *(const f32x4*)(pp + 256), pi0 = *(const f32x4*)(pp + 512), pi1 = *(const f32x4*)(pp + 768);
                const f32x4 gr0 = pr0 * hr0 - pi0 * hi0, gr1 = pr1 * hr1 - pi1 * hi1, gi0 = pr0 * hi0 + pi0 * hr0, gi1 = pr1 * hi1 + pi1 * hr1;
                const bf16x8 gre = __builtin_bit_cast(bf16x8, pack8(gr0, gr1)), gim = __builtin_bit_cast(bf16x8, pack8(gi0, gi1));
                if (mt == 0) { acc0 = MFMA16(cref, gre, acc0); acc0 = MFMA16(cimf, gim, acc0); }
                else         { acc1 = MFMA16(cref, gre, acc1); acc1 = MFMA16(cimf, gim, acc1); }
            }
        }
        {   u32x2 w; w.x = pk2(gelu_tanh(acc0[0]), gelu_tanh(acc0[1])); w.y = pk2(gelu_tanh(acc0[2]), gelu_tanh(acc0[3]));
            *(LAS u32x2*)(y1 + fr * LDY + g * 16 + fq * 4) = w;
            w.x = pk2(gelu_tanh(acc1[0]), gelu_tanh(acc1[1])); w.y = pk2(gelu_tanh(acc1[2]), gelu_tanh(acc1[3]));
            *(LAS u32x2*)(y1 + (16 + fr) * LDY + g * 16 + fq * 4) = w; }
    }
    __syncthreads();
    f32x4 a2[2][4];
#pragma unroll
    for (int mt = 0; mt < 2; ++mt)
#pragma unroll
        for (int nt = 0; nt < 4; ++nt) a2[mt][nt] = (f32x4){0.f, 0.f, 0.f, 0.f};
    const bf16_t* Wg = WSP(bf16_t, WS_WGLU) + (size_t)(wave * 4) * 8192 + lane * 8;
#pragma unroll 4
    for (int kk = 0; kk < 16; ++kk) {
        bf16x8 yf[2], wf[4];
#pragma unroll
        for (int mt = 0; mt < 2; ++mt) yf[mt] = *(const LAS bf16x8*)(y1 + (mt * 16 + fr) * LDY + kk * 32 + fq * 8);
#pragma unroll
        for (int nt = 0; nt < 4; ++nt) wf[nt] = *(const bf16x8*)(Wg + (size_t)nt * 8192 + kk * 512);
#pragma unroll
        for (int mt = 0; mt < 2; ++mt)
#pragma unroll
            for (int nt = 0; nt < 4; ++nt) a2[mt][nt] = MFMA16(wf[nt], yf[mt], a2[mt][nt]);
    }
    float q2[2] = {0.f, 0.f};
#pragma unroll
    for (int mt = 0; mt < 2; ++mt)
#pragma unroll
        for (int nt = 0; nt < 4; ++nt) {
            const int n = wave * 64 + nt * 16 + fq * 4;
            const f32x4 bias = *(const f32x4*)(F.in[18] + n);
            const u32x2 yw = *(const LAS u32x2*)(y1 + (mt * 16 + fr) * LDY + n);
            const float y0 = bflo(yw.x), y1v = bfhi(yw.x), y2v = bflo(yw.y), y3 = bfhi(yw.y);
            f32x4 r; r[0] = y0 * sigm(a2[mt][nt][0] + bias[0]); r[1] = y1v * sigm(a2[mt][nt][1] + bias[1]); r[2] = y2v * sigm(a2[mt][nt][2] + bias[2]); r[3] = y3 * sigm(a2[mt][nt][3] + bias[3]);
            a2[mt][nt] = r; q2[mt] += r[0] * r[0] + r[1] * r[1] + r[2] * r[2] + r[3] * r[3];
        }
    q2[0] = xsum4(q2[0]); q2[1] = xsum4(q2[1]);
    if (fq == 0) { ssq[wave * 32 + fr] = q2[0]; ssq[wave * 32 + 16 + fr] = q2[1]; }
    __syncthreads();
#pragma unroll
    for (int mt = 0; mt < 2; ++mt) {
        float tot = 0.f;
#pragma unroll
        for (int w = 0; w < 8; ++w) tot += ssq[w * 32 + mt * 16 + fr];
        const float rs = rsqrtf(tot * (1.0f / 512.0f) + EPS);
#pragma unroll
        for (int nt = 0; nt < 4; ++nt) {
            const int n = wave * 64 + nt * 16 + fq * 4;
            const f32x4 g = *(const f32x4*)(F.in[20] + n);
            u32x2 w; w.x = pk2(a2[mt][nt][0] * rs * g[0], a2[mt][nt][1] * rs * g[1]); w.y = pk2(a2[mt][nt][2] * rs * g[2], a2[mt][nt][3] * rs * g[3]);
            *(u32x2*)(WSP(bf16_t, WS_MIX) + (size_t)(row0 + mt * 16 + fr) * D + n) = w;
        }
    }
    __syncthreads();
}

DI void late_weights(const Frame& F) {
    constexpr int T_WO = 128, T_WA = 8 * 44, T_WD = 22 * 16;
    LAS float* scr = (LAS float*)F.lds;
    const int nskip = ((36 + 272 + 528) % F.G), G = F.G - nskip;
    if (F.bid < nskip || G <= 0) return;
    int r = F.bid - nskip;
#define P0_LOOP(COUNT) for (int i = r; i < (COUNT); i += G)
#define P0_NEXT(COUNT) r = (r + G - (COUNT) % G) % G
    P0_LOOP(T_WO) p0_transpose(F.in[22], D, nullptr, WSP(bf16_t, WS_WO), D, (i % 8) * 128, (i / 8) * 64, (i / 8) * 64, scr, F.tid);
    P0_NEXT(T_WO);
    P0_LOOP(T_WA) { const int n0 = (i / 8) * 64; p0_transpose(F.in[24], FF, F.in[23], WSP(bf16_t, WS_W1), D, (i % 8) * 128, n0, (n0 >> 7) * 256 + (n0 & 127), scr, F.tid); }
    P0_NEXT(T_WA);
    P0_LOOP(T_WA) { const int n0 = (i / 8) * 64; p0_transpose(F.in[25], FF, F.in[23], WSP(bf16_t, WS_W1), D, (i % 8) * 128, n0, (n0 >> 7) * 256 + 128 + (n0 & 127), scr, F.tid); }
    P0_NEXT(T_WA);
    P0_LOOP(T_WD) p0_transpose(F.in[28], D, nullptr, WSP(bf16_t, WS_W2), FF, (i % 22) * 128, (i / 22) * 64, (i / 22) * 64, scr, F.tid);
    P0_NEXT(T_WD);
#undef P0_LOOP
#undef P0_NEXT
}

DI void p3_loop(const Frame& F) {
    constexpr int T_PRE = 36 + 272, T_P3 = 528;
    unsigned* hc = WSP(unsigned, WS_CTL) + 3584 + 224;
    p3_zero(F);
    const int r0 = T_PRE % F.G, c0 = (F.bid >= r0) ? F.bid - r0 : F.bid + F.G - r0;
    u32x4 uv[4];
    if (c0 < T_P3) p3_load_u(F, c0, uv);
    for (int ci = c0; ci < T_P3; ci += F.G) {
        u32x4 un[4];
        if (ci + F.G < T_P3) p3_load_u(F, ci + F.G, un);
        if (ci < 512) {
            if (F.tid == 0) {
                while (__hip_atomic_load((GAS unsigned*)(hc + (ci >> 6)), __ATOMIC_RELAXED, __HIP_MEMORY_SCOPE_AGENT) < 4u) __builtin_amdgcn_s_sleep(1);
                __builtin_amdgcn_fence(__ATOMIC_ACQUIRE, "agent");
                asm volatile("s_waitcnt vmcnt(0)" ::: "memory");
            }
            __syncthreads();
        }
        p3_task(F, ci, uv);
#pragma unroll
        for (int i = 0; i < 4; ++i) uv[i] = un[i];
    }
}

DI void panel_rs(float* part, unsigned* cnt, LAS float* lx, int pm, int pn, float* rs_out = nullptr) {
    const int tid = threadIdx.x;
    __syncthreads();
    if (tid < 256) st_agent(part + (size_t)(pm * 4 + pn) * 256 + tid, lx[tid] + lx[256 + tid] + lx[512 + tid] + lx[768 + tid]);
    asm volatile("s_waitcnt vmcnt(0)" ::: "memory");
    __syncthreads();
    if (tid == 0) arrive_and_wait(cnt + pm, 4u);
    __syncthreads();
    if (tid < 256) { const float* pp = part + (size_t)pm * 1024 + tid; const float r = rsqrtf((ld_agent(pp) + ld_agent(pp + 256) + ld_agent(pp + 512) + ld_agent(pp + 768)) * (1.0f / D) + EPS); lx[1024 + tid] = r;
        if (rs_out && pn == 0) rs_out[pm * 256 + tid] = r; }
    __syncthreads();
}
struct EpiOut {
    static constexpr bool PERM = true, AFTER_DRAIN = false;
    const float* xp; float* RS; bf16_t* X1B; float* part; unsigned* cnt; LAS float* lx;
    DI void operator()(const f32x4 (&acc_)[2][2][4][2], const pg8::Unit& u, int wr, int wc, int fr, int fq) const {
        f32x4 (&acc)[2][2][4][2] = const_cast<f32x4 (&)[2][2][4][2]>(acc_);
        const int row0 = u.pm * 256 + wr * 64 + fr, col0 = u.pn * 256 + wc * 32 + 8 * fq;
#pragma unroll
        for (int ai = 0; ai < 2; ++ai)
#pragma unroll
            for (int m = 0; m < 4; ++m) {
                const size_t ro = (size_t)(row0 + ai * 128 + m * 16) * D + col0;
                float q = 0.f;
#pragma unroll
                for (int bj = 0; bj < 2; ++bj) {
                    const f32x4 v0 = acc[ai][bj][m][0] + *(const f32x4*)(xp + ro + bj * 128), v1 = acc[ai][bj][m][1] + *(const f32x4*)(xp + ro + bj * 128 + 4);
                    acc[ai][bj][m][0] = v0; acc[ai][bj][m][1] = v1;
                    q += v0[0] * v0[0] + v0[1] * v0[1] + v0[2] * v0[2] + v0[3] * v0[3] + v1[0] * v1[0] + v1[1] * v1[1] + v1[2] * v1[2] + v1[3] * v1[3];
                }
                q = xsum4(q);
                if (fq == 0) lx[wc * 256 + ai * 128 + wr * 64 + m * 16 + fr] = q;
            }
        panel_rs(part, cnt, lx, u.pm, u.pn, RS);
#pragma unroll
        for (int ai = 0; ai < 2; ++ai)
#pragma unroll
            for (int m = 0; m < 4; ++m) {
                const float rs = lx[1024 + ai * 128 + wr * 64 + m * 16 + fr];
                const size_t ro = (size_t)(row0 + ai * 128 + m * 16) * D + col0;
#pragma unroll
                for (int bj = 0; bj < 2; ++bj) *(u32x4*)(X1B + ro + bj * 128) = pack8(acc[ai][bj][m][0] * rs, acc[ai][bj][m][1] * rs);
            }
    }
};

struct EpiFfn {
    static constexpr bool PERM = true, AFTER_DRAIN = false;
    unsigned char* ws; const float* const* in; float* out; LAS float* bnd;
    DI void operator()(const f32x4 (&acc)[2][2][4][2], const pg8::Unit& u, int wr, int wc, int fr, int fq) const {
        const bf16_t* const X1B = (const bf16_t*)(ws + WS_X1B); const bf16_t* const W1T = (const bf16_t*)(ws + WS_W1);
        bf16_t* const H = (bf16_t*)(ws + WS_H); const float* const cstate = in[6];
        const int pm = u.pm, pn = u.pn, rowt = pm * 256, wave = wr * 4 + wc, tid = threadIdx.x;
        const bool sample = pm >= 64;
        const int cl = wc * 32 + 8 * fq, ff = pn * 128 + cl;
        LAS float* cwl = bnd + 17 * 2 * 128;
        if (tid < 128) { const float* cw = in[26] + pn * 128 + tid; cwl[tid] = cw[0]; cwl[128 + tid] = cw[FF]; cwl[256 + tid] = cw[2 * FF]; cwl[384 + tid] = in[27][pn * 128 + tid]; }
#pragma unroll
        for (int ai = 0; ai < 2; ++ai)
#pragma unroll
            for (int m = 0; m < 4; ++m) {
                const int blk = 8 * ai + 4 * wr + m;
                if (fr >= 14) {
                    const f32x4 a0 = acc[ai][0][m][0], a1 = acc[ai][0][m][1];
                    if (!sample || (blk & 1) == 0) { LAS float* bp = bnd + ((blk + 1) * 2 + (fr - 14)) * 128 + cl; *(LAS f32x4*)bp = a0; *(LAS f32x4*)(bp + 4) = a1; }
                    if (sample && (blk & 1)) { float* sp = out + O_SCONV + ((size_t)((pm - 64) * 8 + (blk >> 1)) * 2 + (fr - 14)) * FF + ff; *(f32x4*)sp = a0; *(f32x4*)(sp + 4) = a1; }
                    if (!sample && (pm & 7) == 7 && blk == 15) { float* sp = out + O_PCONV + ((size_t)(pm >> 3) * 2 + (fr - 14)) * FF + ff; *(f32x4*)sp = a0; *(f32x4*)(sp + 4) = a1; }
                    if (sample && (blk & 1) == 0) {
                        const float* sp = cstate + ((size_t)((pm - 64) * 8 + (blk >> 1)) * 2 + (fr - 14)) * FF + ff;
                        LAS float* bp = bnd + (blk * 2 + (fr - 14)) * 128 + cl; *(LAS f32x4*)bp = *(const f32x4*)sp; *(LAS f32x4*)(bp + 4) = *(const f32x4*)(sp + 4);
                    }
                    if (!sample && (pm & 7) == 0 && blk == 0) { LAS float* bp = bnd + (fr - 14) * 128 + cl; *(LAS f32x4*)bp = (f32x4){0.f, 0.f, 0.f, 0.f}; *(LAS f32x4*)(bp + 4) = (f32x4){0.f, 0.f, 0.f, 0.f}; }
                }
            }
        if (!sample && (pm & 7) != 0) {
            const int lane = fq * 16 + fr;
            const bf16_t* xp = X1B + (size_t)(rowt - 2) * D + lane * 8;
            const u32x4 xa0 = *(const u32x4*)xp, xa1 = *(const u32x4*)(xp + 512), xb0 = *(const u32x4*)(xp + D), xb1 = *(const u32x4*)(xp + D + 512);
#pragma unroll 1
            for (int ps = 0; ps < 4; ++ps) {
                float p0[4], p1[4];
                const bf16_t* wp = W1T + (size_t)(pn * 256 + wave * 16 + ps * 4) * D + lane * 8;
#pragma unroll
                for (int c = 0; c < 4; ++c) {
                    const u32x4 a = *(const u32x4*)(wp + (size_t)c * D), b = *(const u32x4*)(wp + (size_t)c * D + 512);
                    float s0 = 0.f, s1 = 0.f;
#pragma unroll
                    for (int j = 0; j < 4; ++j) {
                        s0 = dot2bf(a[j], xa0[j], s0); s0 = dot2bf(b[j], xa1[j], s0);
                        s1 = dot2bf(a[j], xb0[j], s1); s1 = dot2bf(b[j], xb1[j], s1);
                    }
                    p0[c] = s0; p1[c] = s1;
                }
#define HALO_STEP(N, BIT) _Pragma("unroll") for (int c = 0; c < N; ++c) { const bool hi_ = (lane & BIT) != 0; \
                    const float s0_ = hi_ ? p0[c] : p0[c + N], s1_ = hi_ ? p1[c] : p1[c + N]; \
                    const float r0_ = __shfl_xor(s0_, BIT), r1_ = __shfl_xor(s1_, BIT); \
                    p0[c] = (hi_ ? p0[c + N] : p0[c]) + r0_; p1[c] = (hi_ ? p1[c + N] : p1[c]) + r1_; }
                HALO_STEP(2, 32) HALO_STEP(1, 16)
#undef HALO_STEP
                float t0 = p0[0], t1 = p1[0];
                t0 += __shfl_xor(t0, 8); t1 += __shfl_xor(t1, 8); t0 += __shfl_xor(t0, 4); t1 += __shfl_xor(t1, 4); t0 += __shfl_xor(t0, 2); t1 += __shfl_xor(t1, 2); t0 += __shfl_xor(t0, 1); t1 += __shfl_xor(t1, 1);
                if ((lane & 15) == 0) { const int col = wave * 16 + ps * 4 + ((lane >> 5) & 1) * 2 + ((lane >> 4) & 1);
                    bnd[col] = t0; bnd[128 + col] = t1; }
            }
        }
        __syncthreads();
#pragma unroll
        for (int ai = 0; ai < 2; ++ai)
#pragma unroll
            for (int m = 0; m < 4; ++m) {
                const int blk = 8 * ai + 4 * wr + m, row = rowt + ai * 128 + wr * 64 + m * 16 + fr;
                f32x4 hv[2];
#pragma unroll
                for (int n = 0; n < 2; ++n) {
                    const f32x4 cur = acc[ai][0][m][n], upv = acc[ai][1][m][n];
                    f32x4 p1, p2;
#pragma unroll
                    for (int e = 0; e < 4; ++e) { p1[e] = dpp_shr<0x111>(cur[e]); p2[e] = dpp_shr<0x112>(cur[e]); }
                    const f32x4 b0 = *(const LAS f32x4*)(bnd + (blk * 2 + 0) * 128 + cl + 4 * n), b1 = *(const LAS f32x4*)(bnd + (blk * 2 + 1) * 128 + cl + 4 * n);
                    if (fr == 0) { p1 = b1; p2 = b0; } else if (fr == 1) { p2 = b1; }
                    const LAS float* wl = cwl + cl + 4 * n;
                    const f32x4 c = *(const LAS f32x4*)(wl + 384) + *(const LAS f32x4*)wl * p2 + *(const LAS f32x4*)(wl + 128) * p1 + *(const LAS f32x4*)(wl + 256) * cur;
#pragma unroll
                    for (int e = 0; e < 4; ++e) hv[n][e] = c[e] * sigm(c[e]) * upv[e];
                }
                *(u32x4*)(H + (size_t)row * FF + ff) = pack8(hv[0], hv[1]);
            }
        __syncthreads();
    }
};

struct EpiDown {
    static constexpr bool PERM = true, AFTER_DRAIN = false;
    float* out; const bf16_t* X1B; const float* RS; const float* gfin; float* part; unsigned* cnt; LAS float* lx;
    DI void operator()(const f32x4 (&acc_)[2][2][4][2], const pg8::Unit& u, int wr, int wc, int fr, int fq) const {
        f32x4 (&acc)[2][2][4][2] = const_cast<f32x4 (&)[2][2][4][2]>(acc_);
        const int row0 = u.pm * 256 + wr * 64 + fr, col0 = u.pn * 256 + wc * 32 + 8 * fq;
#pragma unroll
        for (int ai = 0; ai < 2; ++ai)
#pragma unroll
            for (int m = 0; m < 4; ++m) {
                const int row = row0 + ai * 128 + m * 16;
                const bf16_t* xrow = X1B + (size_t)row * D + col0;
                const float ir = 1.0f / RS[row];
                float q = 0.f;
#pragma unroll
                for (int bj = 0; bj < 2; ++bj) {
                    const u32x4 xw = *(const u32x4*)(xrow + bj * 128);
                    const f32x4 x0 = (f32x4){bflo(xw.x), bfhi(xw.x), bflo(xw.y), bfhi(xw.y)}, x1v = (f32x4){bflo(xw.z), bfhi(xw.z), bflo(xw.w), bfhi(xw.w)};
                    const f32x4 v0 = acc[ai][bj][m][0] + x0 * ir, v1 = acc[ai][bj][m][1] + x1v * ir;
                    acc[ai][bj][m][0] = v0; acc[ai][bj][m][1] = v1;
                    q += v0[0] * v0[0] + v0[1] * v0[1] + v0[2] * v0[2] + v0[3] * v0[3] + v1[0] * v1[0] + v1[1] * v1[1] + v1[2] * v1[2] + v1[3] * v1[3];
                }
                q = xsum4(q);
                if (fq == 0) lx[wc * 256 + ai * 128 + wr * 64 + m * 16 + fr] = q;
            }
        panel_rs(part, cnt, lx, u.pm, u.pn);
        f32x4 gv[2][2];
#pragma unroll
        for (int bj = 0; bj < 2; ++bj) { gv[bj][0] = *(const f32x4*)(gfin + col0 + bj * 128); gv[bj][1] = *(const f32x4*)(gfin + col0 + bj * 128 + 4); }
#pragma unroll
        for (int ai = 0; ai < 2; ++ai)
#pragma unroll
            for (int m = 0; m < 4; ++m) {
                float* orow = out + (size_t)(row0 + ai * 128 + m * 16) * D + col0;
                const float rs = lx[1024 + ai * 128 + wr * 64 + m * 16 + fr];
#pragma unroll
                for (int bj = 0; bj < 2; ++bj) { *(f32x4*)(orow + bj * 128) = acc[ai][bj][m][0] * rs * gv[bj][0]; *(f32x4*)(orow + bj * 128 + 4) = acc[ai][bj][m][1] * rs * gv[bj][1]; }
            }
    }
};


template <int K> DI f32x4 mini_tile_ks(const Frame& F, const bf16_t* __restrict__ A, const bf16_t* __restrict__ Bt, int row0, int col0) {
    constexpr int KC = 256, LDT = 264, NCH = K / KC, LDR = 68;
    const int tid = F.tid, lane = F.lane, fr = lane & 15, fq = lane >> 4, mt = F.wave & 1, nt = F.wave >> 1;
    LAS bf16_t* tile = (LAS bf16_t*)F.lds;
    const bf16_t* src[6]; int dst[6];
#pragma unroll
    for (int j = 0; j < 6; ++j) { const int p = tid + 512 * j, r = p >> 5, c = (p & 31) * 8;
        src[j] = (r < 32 ? A + (size_t)(row0 + r) * K : Bt + (size_t)(col0 + r - 32) * K) + c; dst[j] = r * LDT + c; }
    u32x4 pre[6];
#pragma unroll
    for (int j = 0; j < 6; ++j) pre[j] = *(const u32x4*)src[j];
    f32x4 acc = (f32x4){0.f, 0.f, 0.f, 0.f};
#pragma unroll 1
    for (int ch = 0; ch < NCH; ++ch) {
#pragma unroll
        for (int j = 0; j < 6; ++j) *(LAS u32x4*)(tile + dst[j]) = pre[j];
        __syncthreads();
        if (ch + 1 < NCH) {
#pragma unroll
            for (int j = 0; j < 6; ++j) pre[j] = *(const u32x4*)(src[j] + (size_t)(ch + 1) * KC);
        }
        const LAS bf16_t* xa = tile + (mt * 16 + fr) * LDT + fq * 8;
        const LAS bf16_t* wb = tile + (32 + nt * 16 + fr) * LDT + fq * 8;
#pragma unroll
        for (int ks = 0; ks < KC / 32; ++ks) acc = MFMA16(*(const LAS bf16x8*)(wb + ks * 32), *(const LAS bf16x8*)(xa + ks * 32), acc);
        __syncthreads();
    }
    LAS float* red = (LAS float*)F.lds;
    *(LAS f32x4*)(red + (mt * 16 + fr) * LDR + nt * 16 + fq * 4) = acc;
    __syncthreads();
    const f32x4 out = *(const LAS f32x4*)(red + (tid >> 4) * LDR + (tid & 15) * 4);
    __syncthreads();
    return out;
}
constexpr int MINI_PARK = LDS_X + 8192;
DI void p4_sample_a(const Frame& F) {
    if (F.bid >= 256) return;
    float* PS = WSP(float, WS_PARTS); unsigned* cnt = WSP(unsigned, WS_CTL) + 3584 + 192;
    const int t = F.bid, rg = t & 15, cg = t >> 4, rl = F.tid >> 4, row = MP + rg * 32 + rl, n0 = cg * 64 + (F.tid & 15) * 4;
    const f32x4 acc = mini_tile_ks<D>(F, WSP(bf16_t, WS_MIX), WSP(bf16_t, WS_WO), MP + rg * 32, cg * 64);
    const f32x4 v = acc + *(const f32x4*)(F.in[1] + (size_t)(row - MP) * D + n0);
    float q = v[0] * v[0] + v[1] * v[1] + v[2] * v[2] + v[3] * v[3];
    q += __shfl_xor(q, 1); q += __shfl_xor(q, 2); q += __shfl_xor(q, 4); q += __shfl_xor(q, 8);
    if ((F.tid & 15) == 0) st_agent(PS + (size_t)(rg * 16 + cg) * 32 + rl, q);
    *(LAS f32x4*)(F.lds + MINI_PARK + F.tid * 16) = v;
    asm volatile("s_waitcnt vmcnt(0)" ::: "memory");
    __syncthreads();
    if (F.tid == 0) (void)__hip_atomic_fetch_add((GAS unsigned*)(cnt + rg), 1u, __ATOMIC_RELAXED, __HIP_MEMORY_SCOPE_AGENT);
}
DI void p4_sample_b(const Frame& F) {
    if (F.bid >= 256) return;
    float* PS = WSP(float, WS_PARTS); unsigned* cnt = WSP(unsigned, WS_CTL) + 3584 + 192;
    const int t = F.bid, rg = t & 15, cg = t >> 4, rl = F.tid >> 4, row = MP + rg * 32 + rl, n0 = cg * 64 + (F.tid & 15) * 4;
    if (F.tid == 0) wait_ge16(cnt + rg);
    __syncthreads();
    float tot = 0.f;
#pragma unroll
    for (int c = 0; c < 16; ++c) tot += ld_agent(PS + (size_t)(rg * 16 + c) * 32 + rl);
    const float rs = rsqrtf(tot * (1.0f / D) + EPS);
    const f32x4 v = *(const LAS f32x4*)(F.lds + MINI_PARK + F.tid * 16);
    *(f32x4*)(WSP(float, WS_X1F) + (size_t)row * D + n0) = v;
    u32x2 w; w.x = pk2(v[0] * rs, v[1] * rs); w.y = pk2(v[2] * rs, v[3] * rs); *(u32x2*)(WSP(bf16_t, WS_X1B) + (size_t)row * D + n0) = w;
}
DI void p6_sample_a(const Frame& F) {
    if (F.bid >= 256) return;
    float* PS = WSP(float, WS_PARTS); unsigned* cnt = WSP(unsigned, WS_CTL) + 3584 + 208;
    const int t = F.bid, rg = t & 15, cg = t >> 4, rl = F.tid >> 4, row = MP + rg * 32 + rl, n0 = cg * 64 + (F.tid & 15) * 4;
    const f32x4 acc = mini_tile_ks<FF>(F, WSP(bf16_t, WS_H), WSP(bf16_t, WS_W2), MP + rg * 32, cg * 64);
    const f32x4 v = acc + *(const f32x4*)(WSP(float, WS_X1F) + (size_t)row * D + n0);
    float q = v[0] * v[0] + v[1] * v[1] + v[2] * v[2] + v[3] * v[3];
    q += __shfl_xor(q, 1); q += __shfl_xor(q, 2); q += __shfl_xor(q, 4); q += __shfl_xor(q, 8);
    if ((F.tid & 15) == 0) st_agent(PS + (size_t)(rg * 16 + cg) * 32 + rl, q);
    *(LAS f32x4*)(F.lds + MINI_PARK + F.tid * 16) = v;
    asm volatile("s_waitcnt vmcnt(0)" ::: "memory");
    __syncthreads();
    if (F.tid == 0) (void)__hip_atomic_fetch_add((GAS unsigned*)(cnt + rg), 1u, __ATOMIC_RELAXED, __HIP_MEMORY_SCOPE_AGENT);
}
DI void p6_sample_b(const Frame& F) {
    if (F.bid >= 256) return;
    float* PS = WSP(float, WS_PARTS); unsigned* cnt = WSP(unsigned, WS_CTL) + 3584 + 208;
    const int t = F.bid, rg = t & 15, cg = t >> 4, rl = F.tid >> 4, row = MP + rg * 32 + rl, n0 = cg * 64 + (F.tid & 15) * 4;
    if (F.tid == 0) wait_ge16(cnt + rg);
    __syncthreads();
    float tot = 0.f;
#pragma unroll
    for (int c = 0; c < 16; ++c) tot += ld_agent(PS + (size_t)(rg * 16 + c) * 32 + rl);
    const float rs = rsqrtf(tot * (1.0f / D) + EPS);
    const f32x4 v = *(const LAS f32x4*)(F.lds + MINI_PARK + F.tid * 16);
    *(f32x4*)(F.out + (size_t)row * D + n0) = v * rs * *(const f32x4*)(F.in[29] + n0);
}

#define RLX_AGENT __ATOMIC_RELAXED, __HIP_MEMORY_SCOPE_AGENT
#define XB_TMO      128
#define XB_XCNT(j)  (256  + 64 * (j))
#define XB_XSUB(j)  (1280 + 64 * (j))
#define XB_XGEN(j)  (2304 + 64 * (j))
#define XB_TOP      3328
#define XB_TOPGEN   3392
#define XCD_BAR_WORDS 3456
#define XB_SPIN_CAP (1u << 18)

__device__ __forceinline__ unsigned xb_ld(unsigned* p)              { return __hip_atomic_load(p, __ATOMIC_RELAXED, __HIP_MEMORY_SCOPE_AGENT); }
__device__ __forceinline__ unsigned xb_add(unsigned* p, unsigned v) { return __hip_atomic_fetch_add(p, v, __ATOMIC_RELAXED, __HIP_MEMORY_SCOPE_AGENT); }
__device__ __forceinline__ unsigned xb_xcc_id() { return (unsigned)__builtin_amdgcn_s_getreg((3 << 11) | 20) & 0xFu; }
#define XB_SPIN(cond, bar) do { unsigned _sp = 0; while (cond) { __builtin_amdgcn_s_sleep(1); \
    if ((++_sp & 255u) == 0u) { if (xb_ld(&(bar)[XB_TMO])) break; if (_sp > XB_SPIN_CAP) { atomicAdd(&(bar)[XB_TMO], 1u); break; } } } } while (0)

struct XcdBarrier {
    unsigned* bar; unsigned x;
    volatile LAS unsigned* st;
};

__device__ __forceinline__ XcdBarrier xcd_barrier_post(unsigned* bar, volatile LAS unsigned* st) {
    XcdBarrier b; b.bar = bar; b.x = xb_xcc_id(); b.st = st;
    if (threadIdx.x == 0) (void)xb_add(&bar[XB_XCNT(b.x)], 1u);
    return b;
}
__device__ __forceinline__ void xcd_barrier_complete(unsigned* bar, unsigned x, unsigned& nloc, unsigned& nx) {
    const unsigned G = gridDim.x * gridDim.y * gridDim.z;
    unsigned sum, cnt, mine, sp = 0u;
    for (;;) {
        sum = 0u; cnt = 0u; mine = 0u;
#pragma unroll
        for (unsigned j = 0; j < 16; ++j) { const unsigned c = xb_ld(&bar[XB_XCNT(j)]); sum += c; cnt += (c > 0u) ? 1u : 0u; mine = (j == x) ? c : mine; }
        if (sum == G) break;
        __builtin_amdgcn_s_sleep(1);
        if ((++sp & 255u) == 0u) { if (xb_ld(&bar[XB_TMO])) break; if (sp > XB_SPIN_CAP) { atomicAdd(&bar[XB_TMO], 1u); break; } }
    }
    nloc = mine > 0u ? mine : 1u; nx = cnt > 0u ? cnt : 1u;
}

__device__ __forceinline__ void xcd_barrier(const XcdBarrier& b) {
    asm volatile("s_waitcnt vmcnt(0)" ::: "memory");
    __syncthreads();
    if (threadIdx.x == 0) {
        unsigned* bar = b.bar;
        __builtin_amdgcn_s_waitcnt(0);
        unsigned nloc = b.st[0], nx = b.st[1];
        if (nloc == 0u) { xcd_barrier_complete(bar, b.x, nloc, nx); b.st[0] = nloc; b.st[1] = nx; }
        const unsigned old = xb_add(&bar[XB_XSUB(b.x)], 1u);
        const unsigned gen = old / nloc;
        if (old + 1u == (gen + 1u) * nloc) {
            __builtin_amdgcn_fence(__ATOMIC_RELEASE, "agent");
            asm volatile("s_waitcnt vmcnt(0)" ::: "memory");
            const unsigned og = xb_add(&bar[XB_TOP], 1u);
            const unsigned tg = og / nx;
            if (og + 1u == (tg + 1u) * nx) xb_add(&bar[XB_TOPGEN], 1u);
            else XB_SPIN(xb_ld(&bar[XB_TOPGEN]) == tg, bar);
            __builtin_amdgcn_fence(__ATOMIC_ACQUIRE, "agent");
            xb_add(&bar[XB_XGEN(b.x)], 1u);
            asm volatile("s_waitcnt vmcnt(0)" ::: "memory");
        } else {
            XB_SPIN(xb_ld(&bar[XB_XGEN(b.x)]) == gen, bar);
            __builtin_amdgcn_fence(__ATOMIC_ACQUIRE, "agent");
            asm volatile("s_waitcnt vmcnt(0)" ::: "memory");
        }
    }
    __syncthreads();
}

DI void grid_bar(unsigned* ctr, unsigned target) {
    asm volatile("s_waitcnt vmcnt(0)" ::: "memory");
    __syncthreads();
    if (threadIdx.x == 0) {
        __builtin_amdgcn_fence(__ATOMIC_RELEASE, "agent");
        asm volatile("s_waitcnt vmcnt(0)" ::: "memory");
        (void)__hip_atomic_fetch_add(ctr, 1u, __ATOMIC_RELAXED, __HIP_MEMORY_SCOPE_AGENT);
        while (__hip_atomic_load(ctr, __ATOMIC_RELAXED, __HIP_MEMORY_SCOPE_AGENT) < target) __builtin_amdgcn_s_sleep(1);
        __builtin_amdgcn_fence(__ATOMIC_ACQUIRE, "agent");
        asm volatile("s_waitcnt vmcnt(0)" ::: "memory");
    }
    __syncthreads();
}

#ifndef PH_MASK
#define PH_MASK 255
#endif
__global__ void __launch_bounds__(512, 2) mega_fwd(Args args) {
    extern __shared__ __attribute__((aligned(16))) unsigned char lds_raw[];
    cg::grid_group grid = cg::this_grid();
    Frame F;
    F.lds = (LAS unsigned char*)lds_raw; F.tid = threadIdx.x; F.lane = F.tid & 63; F.wave = __builtin_amdgcn_readfirstlane(F.tid >> 6);
    F.G = gridDim.x; F.bid = blockIdx.x; F.in = args.in; F.out = args.out; F.ws = args.ws;
    const int lo = args.ph_lo, hi = args.ph_hi;
#define IN(k) (((PH_MASK >> (k)) & 1) && lo <= (k) && (k) < hi)
    volatile LAS unsigned* xb_st = (volatile LAS unsigned*)(F.lds + LDS_BYTES - 64);
    if (F.tid < 2) xb_st[F.tid] = 0u;
    __syncthreads();
    XcdBarrier xbar; xbar.bar = WSP(unsigned, WS_CTL); xbar.x = 0; xbar.st = xb_st;
    if (lo + 1 < hi) xbar = xcd_barrier_post(WSP(unsigned, WS_CTL), xb_st);
    unsigned bar_n = 0;
#ifdef USE_CG_SYNC
#define SEAM(k) do { if (lo <= (k) && (k) + 1 < hi) grid.sync(); } while (0)
#else
#ifdef USE_CENTRAL_BAR
#define SEAM(k) do { if (lo <= (k) && (k) + 1 < hi) { bar_n += (unsigned)F.G; grid_bar(WSP(unsigned, WS_CTL) + 3520, bar_n); } } while (0)
#else
#define SEAM(k) do { if (lo <= (k) && (k) + 1 < hi) xcd_barrier(xbar); } while (0)
#endif
#endif
    if (hi > 8) grid.sync();
#ifndef REP_MASK
#define REP_MASK 0
#endif
#define REPS(k) for (int rep_ = 0; rep_ < 1 + ((REP_MASK >> (k)) & 1); ++rep_)
    if (IN(0)) { p0_prologue(F); } SEAM(0);
#ifdef EXTRA_SYNC
    for (int i_ = 0; i_ < EXTRA_SYNC; ++i_) SEAM(0);
#endif
#if (REP_MASK >> 0) & 1
    p0_prologue(F); grid.sync();
#endif
    if (IN(1)) {
        pg8::Gemm g{WSP(bf16_t, WS_XN), WSP(bf16_t, WS_WIN), M, INW, D}; pg8::StaticOrder S; S.init(M, INW, F.G, F.bid);
        EpiIn E{F.ws, F.out};
        pg8::gemm_phase<EpiIn, pg8::StaticOrder, true, true>(F.lds, g, S, E);
        p1_tail(F);
    } SEAM(1);
    if (IN(2)) { p23_phase(F); p3_loop(F); late_weights(F); }
#if (REP_MASK >> 2) & 1
    p2_phase(F); grid.sync();
#endif
    SEAM(2);
#if (REP_MASK >> 3) & 1
    for (int t = F.bid; t < 528; t += F.G) p3_task(F, t); grid.sync();
#endif
    if (IN(4)) {
        p4_sample_a(F);
        pg8::Gemm g{WSP(bf16_t, WS_MIX), WSP(bf16_t, WS_WO), MP, D, D}; pg8::StaticOrder S; S.init(MP, D, F.G, F.bid);
        EpiOut E{F.in[0], WSP(float, WS_SSQ), WSP(bf16_t, WS_X1B), WSP(float, WS_PART), WSP(unsigned, WS_CTL) + 3584 + 128, (LAS float*)(F.lds + LDS_X)};
        pg8::gemm_phase<EpiOut, pg8::StaticOrder, true, true>(F.lds, g, S, E);
        p4_sample_b(F);
    } SEAM(4);
    if (IN(5)) {
        pg8::Gemm g{WSP(bf16_t, WS_X1B), WSP(bf16_t, WS_W1), M, 2 * FF, D}; pg8::StaticOrder S; S.init(M, 2 * FF, F.G, F.bid);
        EpiFfn E{F.ws, F.in, F.out, (LAS float*)(F.lds + LDS_X)};
        pg8::gemm_phase<EpiFfn, pg8::StaticOrder, true, true>(F.lds, g, S, E);
    } SEAM(5);
    if (IN(6)) {
        p6_sample_a(F);
        pg8::Gemm g{WSP(bf16_t, WS_H), WSP(bf16_t, WS_W2), MP, D, FF}; pg8::StaticOrder S; S.init(MP, D, F.G, F.bid);
        EpiDown E{F.out, WSP(bf16_t, WS_X1B), WSP(float, WS_SSQ), F.in[29], WSP(float, WS_PART), WSP(unsigned, WS_CTL) + 3584 + 64, (LAS float*)(F.lds + LDS_X)};
        pg8::gemm_phase<EpiDown, pg8::StaticOrder, true, true>(F.lds, g, S, E);
        p6_sample_b(F);
    }
#undef IN
#undef SEAM
}

extern "C" void kernel_launch(void* const* d_in, const int* in_sizes, int n_in, void* d_out, int out_size, void* d_ws, size_t ws_size, hipStream_t stream) {
    static int grid = 0;
    if (grid == 0) {
        if (n_in != 30 || ws_size < WS_END) { fprintf(stderr, "kernel_launch: unexpected n_in %d / ws_size %zu (need %zu)\n", n_in, ws_size, (size_t)WS_END); grid = -1; return; }
        int dev = 0, cus = 0, per_cu = 0;
        (void)hipGetDevice(&dev); (void)hipDeviceGetAttribute(&cus, hipDeviceAttributeMultiprocessorCount, dev);
        if (hipFuncSetAttribute((const void*)mega_fwd, hipFuncAttributeMaxDynamicSharedMemorySize, LDS_BYTES) != hipSuccess) { fprintf(stderr, "hipFuncSetAttribute failed\n"); grid = -1; return; }
        if (hipOccupancyMaxActiveBlocksPerMultiprocessor(&per_cu, (const void*)mega_fwd, 512, LDS_BYTES) != hipSuccess || per_cu < 1) { fprintf(stderr, "occupancy query: %d\n", per_cu); per_cu = 1; }
        (void)hipGetLastError();
        grid = cus * (per_cu > 1 ? 1 : per_cu);
        if (grid <= 0) grid = 256;
    }
    if (grid < 0) return;
    Args a{};
    for (int i = 0; i < 30; ++i) a.in[i] = (const float*)d_in[i];
    a.out = (float*)d_out; a.ws = (unsigned char*)d_ws;
    (void)hipMemsetAsync((unsigned char*)d_ws + WS_CTL, 0, 16384, stream);
#if N_LAUNCHES == 1
    a.ph_lo = 0; a.ph_hi = 8;
    void* kargs[] = {&a};
    hipError_t e = hipLaunchCooperativeKernel((const void*)mega_fwd, dim3(grid), dim3(512), kargs, LDS_BYTES, stream);
    if (e != hipSuccess) fprintf(stderr, "cooperative launch failed: %s (grid %d)\n", hipGetErrorString(e), grid);
#else
    for (int p = 0; p < 8; ++p) { a.ph_lo = p; a.ph_hi = p + 1; for (int r = 0; r < 1 + ((HOST_REP >> p) & 1); ++r) hipLaunchKernelGGL(mega_fwd, dim3(grid), dim3(512), LDS_BYTES, stream, a); }
#endif
}
```
